# Optimizing an MI355X kernel written in HIP

```python
import jax, jax.numpy as jnp
from jax import lax
import numpy as np

D_MODEL = 1024
BATCH = 4
SEQ = 4096
DEPTH = 1

CHUNK = 64
Q_BLOCK = 128
GLA_HEADS = 4
GLA_DK = 128
GLA_DV = 256
GLA_RANK = 16
GLA_TAU = 16.0
GLA_QK = GLA_HEADS * GLA_DK
GLA_V = GLA_HEADS * GLA_DV
FOX_HEADS = 8
FOX_HD = 128
FOX_W = FOX_HEADS * FOX_HD
N_EXPERTS = 32
TOP_K = 4
D_FF = 1024
SWIGLU_LIMIT = 7.0
SWIGLU_ALPHA = 1.702
MOE_BLOCK = 128
LN_EPS = 1e-5
DEEPNORM_ALPHA = (2 * DEPTH) ** 0.25
DEEPNORM_BETA = (8 * DEPTH) ** -0.25
IN_SPLITS = (GLA_QK, GLA_QK, GLA_V, GLA_RANK, GLA_V, FOX_W, FOX_W, FOX_W, FOX_HEADS, D_MODEL, D_MODEL)
IN_COLS = sum(IN_SPLITS)

kernel_name = "gla_fox_gated_hybrid_moe_deepnorm"


def split_cols(t, sizes):
    idx, acc = [], 0
    for s in sizes[:-1]:
        acc += s
        idx.append(acc)
    return jnp.split(t, idx, axis=-1)


def layer_norm(x, g, b):
    xf = x.astype(jnp.float32)
    mu = jnp.mean(xf, axis=-1, keepdims=True)
    var = jnp.mean(jnp.square(xf - mu), axis=-1, keepdims=True)
    y = (xf - mu) * lax.rsqrt(var + LN_EPS) * g.astype(jnp.float32) + b.astype(jnp.float32)
    return y.astype(x.dtype)


def gla_branch(q, k, v, gate_low, r, w_gate_up, b_gate, g_norm):
    B, S, _ = q.shape
    n = S // CHUNK
    f32 = jnp.float32
    log_a = jax.nn.log_sigmoid((gate_low @ w_gate_up + b_gate).astype(f32)) / GLA_TAU
    qh = q.astype(f32).reshape(B, n, CHUNK, GLA_HEADS, GLA_DK) * (GLA_DK ** -0.5)
    kh = k.astype(f32).reshape(B, n, CHUNK, GLA_HEADS, GLA_DK)
    vh = v.astype(f32).reshape(B, n, CHUNK, GLA_HEADS, GLA_DV)
    la = log_a.reshape(B, n, CHUNK, GLA_HEADS, GLA_DK)
    cum = jnp.cumsum(la, axis=2)
    total = cum[:, :, -1]
    k_dec = kh * jnp.exp(total[:, :, None] - cum)
    d_state = jnp.einsum('bnchk,bnchv->bnhkv', k_dec, vh)

    def step(state, inp):
        dec, ds = inp
        new = jnp.exp(dec)[..., None] * state + ds
        return new, new

    s0 = jnp.zeros((B, GLA_HEADS, GLA_DK, GLA_DV), f32)
    _, states = lax.scan(step, s0, (jnp.moveaxis(total, 1, 0), jnp.moveaxis(d_state, 1, 0)))
    states = jnp.moveaxis(states, 0, 1)
    o = jnp.einsum('bnchk,bnhkv->bnchv', qh, states)
    o = o * lax.rsqrt(jnp.mean(jnp.square(o), axis=-1, keepdims=True) + LN_EPS) * g_norm.astype(f32)
    o = o.reshape(B, S, GLA_V) * jax.nn.silu(r.astype(f32))
    return o.astype(q.dtype)


def fox_branch(q, k, v, f_logit):
    B, S, _ = q.shape
    f32 = jnp.float32
    qh = q.reshape(B, S, FOX_HEADS, FOX_HD).transpose(0, 2, 1, 3)
    kh = k.reshape(B, S, FOX_HEADS, FOX_HD).transpose(0, 2, 1, 3)
    vh = v.reshape(B, S, FOX_HEADS, FOX_HD).transpose(0, 2, 1, 3)
    cum_f = jnp.cumsum(jax.nn.log_sigmoid(f_logit.astype(f32)), axis=1).transpose(0, 2, 1)
    scale = FOX_HD ** -0.5
    outs = []
    for i in range(S // Q_BLOCK):
        lo, hi = i * Q_BLOCK, (i + 1) * Q_BLOCK
        s = jnp.einsum('bhqd,bhkd->bhqk', qh[:, :, lo:hi], kh[:, :, :hi]).astype(f32) * scale
        s = s + cum_f[:, :, lo:hi, None] - cum_f[:, :, None, :hi]
        causal = (lo + jnp.arange(Q_BLOCK))[:, None] >= jnp.arange(hi)[None, :]
        p = jax.nn.softmax(jnp.where(causal, s, -jnp.inf), axis=-1)
        outs.append(jnp.einsum('bhqk,bhkd->bhqd', p.astype(vh.dtype), vh[:, :, :hi]))
    o = jnp.concatenate(outs, axis=2)
    return o.transpose(0, 2, 1, 3).reshape(B, S, FOX_W)


def moe_ffn(h, w_router, b_router, w_gate_up, b_gate_up, w_down, b_down):
    B, S, D = h.shape
    T = B * S
    xt = h.reshape(T, D)
    logits = (xt @ w_router + b_router).astype(jnp.float32)
    top_val, top_idx = lax.top_k(logits, TOP_K)
    gates = jax.nn.softmax(top_val, axis=-1)
    A = T * TOP_K
    flat_e = top_idx.reshape(A)
    flat_tok = jnp.repeat(jnp.arange(T, dtype=jnp.int32), TOP_K)
    flat_g = gates.reshape(A)
    order = jnp.argsort(flat_e)
    se = flat_e[order]
    counts = jnp.bincount(flat_e, length=N_EXPERTS)
    starts = jnp.cumsum(counts) - counts
    padded = (counts + MOE_BLOCK - 1) // MOE_BLOCK * MOE_BLOCK
    pad_ends = jnp.cumsum(padded)
    pad_starts = pad_ends - padded
    dest = pad_starts[se] + jnp.arange(A, dtype=jnp.int32) - starts[se]
    n_blocks = (A + N_EXPERTS * (MOE_BLOCK - 1) + MOE_BLOCK - 1) // MOE_BLOCK
    P = n_blocks * MOE_BLOCK
    slot_tok = jnp.zeros((P,), jnp.int32).at[dest].set(flat_tok[order])
    slot_g = jnp.zeros((P,), jnp.float32).at[dest].set(flat_g[order])
    blk_start = jnp.arange(n_blocks, dtype=jnp.int32) * MOE_BLOCK
    blk_e = jnp.minimum(jnp.sum(blk_start[:, None] >= pad_ends[None, :], axis=1), N_EXPERTS - 1)
    xs = xt[slot_tok].reshape(n_blocks, MOE_BLOCK, D)

    def expert_block(args):
        xb, e = args
        gu = xb @ w_gate_up[e] + b_gate_up[e]
        gate = jnp.minimum(gu[:, :D_FF], SWIGLU_LIMIT)
        up = jnp.clip(gu[:, D_FF:], -SWIGLU_LIMIT, SWIGLU_LIMIT)
        glu = gate * jax.nn.sigmoid(SWIGLU_ALPHA * gate)
        return ((up + 1.0) * glu) @ w_down[e] + b_down[e]

    ys = lax.map(expert_block, (xs, blk_e)).reshape(P, D)
    ys = ys * slot_g[:, None].astype(ys.dtype)
    out = jax.ops.segment_sum(ys, slot_tok, num_segments=T)
    return out.reshape(B, S, D)


def setup_inputs(seed: int = 0) -> dict:
    key = jax.random.key(seed)
    ks = jax.random.split(key, 24)
    L, D, E = DEPTH, D_MODEL, N_EXPERTS
    nrm = lambda k, shape: jax.random.normal(k, shape, jnp.float32)
    col_scale = np.ones((IN_COLS,), np.float32)
    off = 2 * GLA_QK
    col_scale[off:off + GLA_V] = DEEPNORM_BETA
    off = 2 * GLA_QK + GLA_V + GLA_RANK + GLA_V + 2 * FOX_W
    col_scale[off:off + FOX_W] = DEEPNORM_BETA
    w_in = nrm(ks[1], (L, D, IN_COLS)) * (D ** -0.5) * jnp.asarray(col_scale)
    return {
        "x": nrm(ks[0], (BATCH, SEQ, D)),
        "ln_in_g": 1.0 + 0.02 * nrm(ks[2], (D,)),
        "ln_in_b": 0.02 * nrm(ks[3], (D,)),
        "w_in": w_in,
        "w_gla_gate_up": nrm(ks[4], (L, GLA_RANK, GLA_QK)) * (GLA_RANK ** -0.5),
        "b_gla_gate": 1.0 + 0.5 * nrm(ks[5], (L, GLA_QK)),
        "g_gla_norm": 1.0 + 0.02 * nrm(ks[6], (L, GLA_DV)),
        "b_forget": 4.0 + 0.5 * nrm(ks[7], (L, FOX_HEADS)),
        "w_gla_proj": nrm(ks[8], (L, GLA_V, D)) * (GLA_V ** -0.5) * DEEPNORM_BETA,
        "w_fox_proj": nrm(ks[9], (L, FOX_W, D)) * (FOX_W ** -0.5) * DEEPNORM_BETA,
        "w_out": nrm(ks[10], (L, D, D)) * (D ** -0.5) * DEEPNORM_BETA,
        "ln_mix_g": 1.0 + 0.02 * nrm(ks[11], (L, D)),
        "ln_mix_b": 0.02 * nrm(ks[12], (L, D)),
        "w_router": nrm(ks[13], (L, D, E)) * (D ** -0.5),
        "b_router": 0.01 * nrm(ks[14], (L, E)),
        "w_gate_up": nrm(ks[15], (L, E, D, 2 * D_FF)) * (D ** -0.5) * DEEPNORM_BETA,
        "b_gate_up": 0.02 * nrm(ks[16], (L, E, 2 * D_FF)),
        "w_down": nrm(ks[17], (L, E, D_FF, D)) * (D_FF ** -0.5) * DEEPNORM_BETA,
        "b_down": 0.02 * nrm(ks[18], (L, E, D)),
        "ln_ffn_g": 1.0 + 0.02 * nrm(ks[19], (L, D)),
        "ln_ffn_b": 0.02 * nrm(ks[20], (L, D)),
    }


def reference(x, ln_in_g, ln_in_b, w_in, w_gla_gate_up, b_gla_gate, g_gla_norm, b_forget,
              w_gla_proj, w_fox_proj, w_out, ln_mix_g, ln_mix_b, w_router, b_router,
              w_gate_up, b_gate_up, w_down, b_down, ln_ffn_g, ln_ffn_b):
    h = layer_norm(x, ln_in_g, ln_in_b)
    for l in range(DEPTH):
        proj = h @ w_in[l]
        (gq, gk, gv, g_low, g_r, fq, fk, fv, f_f, z_gla, z_fox) = split_cols(proj, IN_SPLITS)
        y_gla = gla_branch(gq, gk, gv, g_low, g_r, w_gla_gate_up[l], b_gla_gate[l], g_gla_norm[l]) @ w_gla_proj[l]
        y_fox = fox_branch(fq, fk, fv, f_f + b_forget[l]) @ w_fox_proj[l]
        mixed = jax.nn.sigmoid(z_gla) * y_gla + jax.nn.sigmoid(z_fox) * y_fox
        h = layer_norm(DEEPNORM_ALPHA * h + mixed @ w_out[l], ln_mix_g[l], ln_mix_b[l])
        ffn = moe_ffn(h, w_router[l], b_router[l], w_gate_up[l], b_gate_up[l], w_down[l], b_down[l])
        h = layer_norm(DEEPNORM_ALPHA * h + ffn, ln_ffn_g[l], ln_ffn_b[l])
    return h
```

```cpp
#include <hip/hip_runtime.h>
#include <hip/hip_bf16.h>
#include <cstdio>
#include <cstdint>
#include <cmath>
namespace pg8 {
#define PG8_LAS __attribute__((address_space(3)))
typedef unsigned short bf16_t;
typedef short bf16x8 __attribute__((ext_vector_type(8)));
typedef float f32x4 __attribute__((ext_vector_type(4)));
typedef unsigned u32x4 __attribute__((ext_vector_type(4)));
constexpr int BM = 256, BK = 64, HALF = 128, HTB = HALF * BK * 2  , STAGE_BYTES = 8 * HTB, NXCD = 8, WGM = 8;

__host__ __device__ __forceinline__ int lds_byte(int r, int c) { const int st = (r >> 4) * 2 + (c >> 5), rr = r & 15, cc = c & 31, ob = rr * 64 + cc * 2; return st * 1024 + (ob ^ (((ob >> 9) & 1) << 5)); }
__host__ __device__ __forceinline__ void stage_rc(int b, int& R, int& C) { const int st = b / 1024, sb = b % 1024, swz = sb ^ (((sb >> 9) & 1) << 5); R = (st >> 1) * 16 + swz / 64; C = (st & 1) * 32 + (swz % 64) / 2; }
__host__ __device__ __forceinline__ int perm32(int rho) { const int n = rho >> 4, i = rho & 15; return 8 * (i >> 2) + 4 * n + (i & 3); }

struct Unit { int pm, pn, ab, bb, aux; };
struct Gemm { const bf16_t* A; const bf16_t* Bt; int M, N, K; };

struct StaticOrder {
    int nM, nN, nwg, G, c;
    __host__ __device__ void init(int M, int N, int G_, int c_) { nM = M / BM; nN = N / BM; nwg = nM * nN; G = G_; c = c_; }
    __host__ __device__ bool next(int i, Unit& u) const {
        const long L = (long)i * G + c; if (L >= nwg) return false;
        int wgid = (int)L; { const int q = nwg / NXCD, r = nwg % NXCD, xcd = wgid % NXCD, off = wgid / NXCD; wgid = (xcd < r ? xcd * (q + 1) : r * (q + 1) + (xcd - r) * q) + off; }
        const int nig = WGM * nN, gid = wgid / nig, fm = gid * WGM, gsz = (nM - fm) < WGM ? (nM - fm) : WGM;
        u.pm = fm + ((wgid % nig) % gsz); u.pn = (wgid % nig) / gsz; u.ab = u.pm; u.bb = u.pn; u.aux = 0; return true;
    }
    __device__ __forceinline__ void a_ready(const Unit&) const {}
    __device__ __forceinline__ void done(const Unit&) const {}
    __device__ __forceinline__ const PG8_LAS int* rowidx(int) const { return nullptr; }
};

__device__ __forceinline__ unsigned cvt_pk_bf16(float lo, float hi) { unsigned r; asm volatile("v_cvt_pk_bf16_f32 %0, %1, %2" : "=v"(r) : "v"(lo), "v"(hi)); return r; }
typedef float f32x2 __attribute__((ext_vector_type(2)));
__device__ __forceinline__ f32x2 gelu_pk(f32x2 v) {
    const f32x2 av = __builtin_elementwise_abs(v), d = av * 0.2316418882f + 1.0f;
    f32x2 t; t.x = __builtin_amdgcn_rcpf(d.x); t.y = __builtin_amdgcn_rcpf(d.y);
    f32x2 q = t * 0.5307027145f + (-0.7265760135f); q = q * t + 0.7107068705f; q = q * t + (-0.142248368f); q = q * t + 0.127414796f; q = q * t;
    const f32x2 s = (v * v) * (-0.72134752044f);
    f32x2 e; e.x = __builtin_amdgcn_exp2f(s.x); e.y = __builtin_amdgcn_exp2f(s.y);
    const f32x2 m = v * (q * e), r = v - m;
    f32x2 o; o.x = v.x < 0.f ? m.x : r.x; o.y = v.y < 0.f ? m.y : r.y; return o;
}

template <int ACT  > struct EpiBf16 {
    static constexpr bool PERM = true, AFTER_DRAIN = false; static_assert(ACT == 0 || ACT == 1, "EpiBf16: ACT is 0 (none) or 1 (gelu_pk)");
    bf16_t* O; int ldc; const float* bias; int split_cols; size_t split_stride; float scale0;
    __device__ __forceinline__ void operator()(const f32x4 (&acc)[2][2][4][2], const Unit& u, int wr, int wc, int fr, int fq) const {
        const int row0 = u.pm * BM + wr * 64 + fr; int colt = u.pn * BM; bf16_t* base = O;
        float sc = 1.f; if (split_cols) { const int t = colt / split_cols; base += (size_t)t * split_stride; colt -= t * split_cols; if (t == 0) sc = scale0; }
        const int col0 = colt + wc * 32 + 8 * fq, bcol0 = u.pn * BM + wc * 32 + 8 * fq;
        f32x4 bv[2][2];
#pragma unroll
        for (int bj = 0; bj < 2; ++bj)
#pragma unroll
            for (int n = 0; n < 2; ++n) bv[bj][n] = bias ? *(const f32x4*)(bias + bcol0 + bj * HALF + 4 * n) : (f32x4){0.f, 0.f, 0.f, 0.f};
#pragma unroll
        for (int ai = 0; ai < 2; ++ai)
#pragma unroll
            for (int m = 0; m < 4; ++m) { bf16_t* rowp = base + (size_t)(row0 + ai * HALF + m * 16) * ldc + col0;
#pragma unroll
                for (int bj = 0; bj < 2; ++bj) { f32x4 v0 = acc[ai][bj][m][0] + bv[bj][0], v1 = acc[ai][bj][m][1] + bv[bj][1];
                    if (ACT == 1) { f32x2 a = gelu_pk((f32x2){v0[0], v0[1]}), b = gelu_pk((f32x2){v0[2], v0[3]}), c = gelu_pk((f32x2){v1[0], v1[1]}), d = gelu_pk((f32x2){v1[2], v1[3]});
                        v0 = (f32x4){a.x, a.y, b.x, b.y}; v1 = (f32x4){c.x, c.y, d.x, d.y}; }
                    v0 = v0 * sc; v1 = v1 * sc; u32x4 w; w.x = cvt_pk_bf16(v0[0], v0[1]); w.y = cvt_pk_bf16(v0[2], v0[3]); w.z = cvt_pk_bf16(v1[0], v1[1]); w.w = cvt_pk_bf16(v1[2], v1[3]);
                    *(u32x4*)(rowp + bj * HALF) = w; } }
    }
};

struct PanelStats {
    unsigned* xbuf;
    unsigned* cnt;
    unsigned* tmo;
    int ntn; float eps;
    unsigned code;
    __device__ __forceinline__ bool run(const f32x4 (&v)[2][2][4][2], const Unit& u, int wr, int wc, int fr, int fq, PG8_LAS unsigned char* lds, int wid, int lane) const {
        typedef float f32x2v __attribute__((ext_vector_type(2)));
        PG8_LAS f32x2v* P = (PG8_LAS f32x2v*)lds;
        PG8_LAS f32x2v* S = (PG8_LAS f32x2v*)(lds + 8192);
        PG8_LAS unsigned* flag = (PG8_LAS unsigned*)(lds + 8192 + 2048);
#pragma unroll
        for (int ai = 0; ai < 2; ++ai)
#pragma unroll
            for (int m = 0; m < 4; ++m) {
                float s = 0.f;
#pragma unroll
                for (int bj = 0; bj < 2; ++bj)
#pragma unroll
                    for (int n = 0; n < 2; ++n) { const f32x4 x = v[ai][bj][m][n]; s += (x[0] + x[1]) + (x[2] + x[3]); }
                s += __shfl_xor(s, 16); s += __shfl_xor(s, 32);
                const float mw = s * (1.0f / 64.0f); float q = 0.f;
#pragma unroll
                for (int bj = 0; bj < 2; ++bj)
#pragma unroll
                    for (int n = 0; n < 2; ++n) { const f32x4 d = v[ai][bj][m][n] - mw; q += (d[0] * d[0] + d[1] * d[1]) + (d[2] * d[2] + d[3] * d[3]); }
                q += __shfl_xor(q, 16); q += __shfl_xor(q, 32);
                if (fq == 0) P[(ai * HALF + wr * 64 + m * 16 + fr) * 4 + wc] = (f32x2v){mw, q};
            }
        asm volatile("s_waitcnt lgkmcnt(0)" ::: "memory"); __builtin_amdgcn_s_barrier(); asm volatile("" ::: "memory");
#if defined(BROKEN_EXCHANGE_NO_WAIT)
#warning BROKEN CONTROL BUILD: the row-statistics exchange does not wait; results are wrong by design
        if (blockIdx.x >= 64) { const long long t0_ = clock64(); while (clock64() - t0_ < 60000) __builtin_amdgcn_s_sleep(8); }
#endif
        const int row = wid * 32 + (lane & 31);
        if (lane < 32) {
            const f32x2v a = P[row * 4 + 0], b = P[row * 4 + 1], c = P[row * 4 + 2], d = P[row * 4 + 3];
            const float mt = (a.x + b.x + c.x + d.x) * 0.25f;
            const float da = a.x - mt, db = b.x - mt, dc = c.x - mt, dd = d.x - mt;
            const float m2 = (a.y + b.y) + (c.y + d.y) + 64.0f * ((da * da + db * db) + (dc * dc + dd * dd));
            unsigned long long* slot = (unsigned long long*)xbuf + ((size_t)(u.pm * BM + row) * 4 + u.pn);
            __hip_atomic_store(slot, ((unsigned long long)__float_as_uint(m2) << 32) | __float_as_uint(mt), __ATOMIC_RELAXED, __HIP_MEMORY_SCOPE_AGENT);
        }
        asm volatile("s_waitcnt vmcnt(0)" ::: "memory");
        if (lane == 0) __hip_atomic_fetch_add(cnt + 64 * u.pm, 1u, __ATOMIC_RELAXED, __HIP_MEMORY_SCOPE_AGENT);
        if (wid == 0) {
            bool dead = false; const unsigned long long t0 = __builtin_amdgcn_s_memrealtime(); const unsigned want = 8u * (unsigned)ntn;
            for (;;) {
#if defined(BROKEN_EXCHANGE_NO_WAIT)
                break;
#endif
                if ((unsigned)__builtin_amdgcn_readfirstlane(__hip_atomic_load(cnt + 64 * u.pm, __ATOMIC_RELAXED, __HIP_MEMORY_SCOPE_AGENT)) >= want) break;
                if (__builtin_amdgcn_s_memrealtime() - t0 > 2000000ull) {
                    if (lane == 0) { unsigned expect = 0u; __hip_atomic_compare_exchange_strong(tmo + 1, &expect, code | (unsigned)(u.pm & 0xff), __ATOMIC_RELAXED, __ATOMIC_RELAXED, __HIP_MEMORY_SCOPE_AGENT);
                                     __hip_atomic_store(tmo, 1u, __ATOMIC_RELAXED, __HIP_MEMORY_SCOPE_AGENT); }
                    dead = true; break; }
                __builtin_amdgcn_s_sleep(2);
            }
            __builtin_amdgcn_fence(__ATOMIC_ACQUIRE, "agent");
            if (lane == 0) flag[0] = dead ? 1u : 0u;
        }
        asm volatile("s_waitcnt vmcnt(0) lgkmcnt(0)" ::: "memory"); __builtin_amdgcn_s_barrier(); asm volatile("" ::: "memory");
        const bool bad = flag[0] != 0u;
        if (lane < 32) {
            const unsigned long long* slot = (const unsigned long long*)xbuf + (size_t)(u.pm * BM + row) * 4; float mt[4], m2[4]; float ms = 0.f;
#pragma unroll
            for (int t = 0; t < 4; ++t) { if (t < ntn) { const unsigned long long w = __hip_atomic_load(slot + t, __ATOMIC_RELAXED, __HIP_MEMORY_SCOPE_AGENT); mt[t] = __uint_as_float((unsigned)w); m2[t] = __uint_as_float((unsigned)(w >> 32)); } else { mt[t] = 0.f; m2[t] = 0.f; } ms += mt[t]; }
            const float mean = ms / (float)ntn; float q = 0.f;
#pragma unroll
            for (int t = 0; t < 4; ++t) if (t < ntn) { const float dm = mt[t] - mean; q += m2[t] + 256.0f * dm * dm; }
            S[row] = (f32x2v){mean, 1.0f / sqrtf(q / (256.0f * (float)ntn) + eps)};
        }
        asm volatile("s_waitcnt lgkmcnt(0)" ::: "memory"); __builtin_amdgcn_s_barrier(); asm volatile("" ::: "memory");
        return bad;
    }
};
struct EpiLnRes {
    static constexpr bool PERM = false, AFTER_DRAIN = true;
    const float* base; float* out; int ldc; const float* bias; PanelStats st; unsigned poison;
    __device__ __forceinline__ void fused(f32x4 (&acc)[2][2][4][2], const Unit& u, int wr, int wc, int fr, int fq, PG8_LAS unsigned char* lds, int wid, int lane) const {
        typedef float f32x2v __attribute__((ext_vector_type(2)));
        const PG8_LAS f32x2v* S = (const PG8_LAS f32x2v*)(lds + 8192);
        const int col0 = u.pn * BM + wc * 32 + 4 * fq;
#pragma unroll
        for (int bj = 0; bj < 2; ++bj)
#pragma unroll
            for (int n = 0; n < 2; ++n) { const f32x4 bv = bias ? *(const f32x4*)(bias + col0 + bj * HALF + n * 16) : (f32x4){0.f, 0.f, 0.f, 0.f};
#pragma unroll
                for (int ai = 0; ai < 2; ++ai)
#pragma unroll
                    for (int m = 0; m < 4; ++m) acc[ai][bj][m][n] += bv; }
        f32x4 pre[4][2][2];
#pragma unroll
        for (int m = 0; m < 4; ++m) { const size_t off = (size_t)(u.pm * BM + wr * 64 + m * 16 + fr) * ldc + col0;
#pragma unroll
            for (int bj = 0; bj < 2; ++bj)
#pragma unroll
                for (int n = 0; n < 2; ++n) pre[m][bj][n] = *(const f32x4*)(base + off + bj * HALF + n * 16); }
        const bool bad = st.run(acc, u, wr, wc, fr, fq, lds, wid, lane) || poison != 0u;
        const float qnan = __builtin_nanf("");
#pragma unroll
        for (int ai = 0; ai < 2; ++ai)
#pragma unroll
            for (int m = 0; m < 4; ++m) { const int r = ai * HALF + wr * 64 + m * 16 + fr; const f32x2v sr = S[r]; const size_t off = (size_t)(u.pm * BM + r) * ldc + col0;
#pragma unroll
                for (int bj = 0; bj < 2; ++bj)
#pragma unroll
                    for (int n = 0; n < 2; ++n) { const f32x4 bs = ai == 0 ? pre[m][bj][n] : *(const f32x4*)(base + off + bj * HALF + n * 16); f32x4 o = bs + (acc[ai][bj][m][n] - sr.x) * sr.y;
                        if (bad) o = (f32x4){qnan, qnan, qnan, qnan}; *(f32x4*)(out + off + bj * HALF + n * 16) = o; }
                if (m & 1) asm volatile("" ::: "memory"); }
    }
};
struct EpiLnResLn {
    static constexpr bool PERM = false, AFTER_DRAIN = true;
    const float* base; float* out; bf16_t* xn; int ldc; const float* bias; PanelStats st1, st2; unsigned poison;
    __device__ __forceinline__ void fused(f32x4 (&acc)[2][2][4][2], const Unit& u, int wr, int wc, int fr, int fq, PG8_LAS unsigned char* lds, int wid, int lane) const {
        typedef float f32x2v __attribute__((ext_vector_type(2))); typedef unsigned u32x2v __attribute__((ext_vector_type(2)));
        const PG8_LAS f32x2v* S = (const PG8_LAS f32x2v*)(lds + 8192);
        const int col0 = u.pn * BM + wc * 32 + 4 * fq;
#pragma unroll
        for (int bj = 0; bj < 2; ++bj)
#pragma unroll
            for (int n = 0; n < 2; ++n) { const f32x4 bv = bias ? *(const f32x4*)(bias + col0 + bj * HALF + n * 16) : (f32x4){0.f, 0.f, 0.f, 0.f};
#pragma unroll
                for (int ai = 0; ai < 2; ++ai)
#pragma unroll
                    for (int m = 0; m < 4; ++m) acc[ai][bj][m][n] += bv; }
        bool bad = st1.run(acc, u, wr, wc, fr, fq, lds, wid, lane) || poison != 0u;
        const float qnan = __builtin_nanf("");
#pragma unroll
        for (int ai = 0; ai < 2; ++ai)
#pragma unroll
            for (int m = 0; m < 4; ++m) { const int r = ai * HALF + wr * 64 + m * 16 + fr; const f32x2v sr = S[r]; const size_t off = (size_t)(u.pm * BM + r) * ldc + col0;
#pragma unroll
                for (int bj = 0; bj < 2; ++bj)
#pragma unroll
                    for (int n = 0; n < 2; ++n) { const f32x4 bs = *(const f32x4*)(base + off + bj * HALF + n * 16); acc[ai][bj][m][n] = bs + (acc[ai][bj][m][n] - sr.x) * sr.y; }
                asm volatile("" : "+v"(acc[ai][0][m][0]), "+v"(acc[ai][0][m][1]), "+v"(acc[ai][1][m][0]), "+v"(acc[ai][1][m][1]));
                if (m & 1) asm volatile("" ::: "memory"); }
        const bool bad1 = bad;
        bad = st2.run(acc, u, wr, wc, fr, fq, lds, wid, lane) || bad;
#pragma unroll
        for (int ai = 0; ai < 2; ++ai)
#pragma unroll
            for (int m = 0; m < 4; ++m) { const int r = ai * HALF + wr * 64 + m * 16 + fr; const f32x2v sr = S[r]; const size_t off = (size_t)(u.pm * BM + r) * ldc + col0;
#pragma unroll
                for (int bj = 0; bj < 2; ++bj)
#pragma unroll
                    for (int n = 0; n < 2; ++n) { const f32x4 x1 = acc[ai][bj][m][n]; *(f32x4*)(out + off + bj * HALF + n * 16) = bad1 ? (f32x4){qnan, qnan, qnan, qnan} : x1;
                        const f32x4 o = (x1 - sr.x) * sr.y; u32x2v w; w.x = cvt_pk_bf16(o[0], o[1]); w.y = cvt_pk_bf16(o[2], o[3]);
                        if (bad) { w.x = 0x7fc07fc0u; w.y = 0x7fc07fc0u; } *(u32x2v*)(xn + off + bj * HALF + n * 16) = w; }
                asm volatile("" ::: "memory"); }
    }
};

template <class Epi, class Sched, bool ALIGN_EPI = false, bool SP2 = false, bool GATHER = false>
__device__ __forceinline__ void gemm_phase(PG8_LAS unsigned char* lds, const Gemm g, const Sched& S, const Epi& E) {
    const int tid = threadIdx.x, wid = __builtin_amdgcn_readfirstlane(tid >> 6), lane = tid & 63, wr = wid >> 2, wc = wid & 3, fr = lane & 15, fq = lane >> 4;
    const int K = g.K, nt = K / BK;
    unsigned voffA[2], voffB[2]; int gR[2], gC[2];
#pragma unroll
    for (int i = 0; i < 2; ++i) { int R, C; stage_rc(tid * 16 + i * 8192, R, C); const int Rb = Epi::PERM ? ((R & ~31) + perm32(R & 31)) : R;
        voffA[i] = (unsigned)(R * K + C) * 2u; voffB[i] = (unsigned)(Rb * K + C) * 2u; gR[i] = R; gC[i] = C; }
    const size_t kstep = (size_t)(BK * 2);
    const size_t hstep = (size_t)HALF * K * 2;
    const size_t tstep = 2 * hstep;
    const unsigned ldsw = (unsigned)wid * 1024u;
    const int aoff = lds_byte(wr * 64 + fr, fq * 8), boff = lds_byte(wc * 32 + fr, fq * 8);
#define PG8_SA(b, h) (((b) * 2 + (h)) * HTB)
#define PG8_SB(b, h) ((4 + (b) * 2 + (h)) * HTB)
#define PG8_STAGE(bufoff, gbase, voff) do { _Pragma("unroll") for (int _i = 0; _i < 2; ++_i) \
        __builtin_amdgcn_global_load_lds((const unsigned*)((const char*)(gbase) + (voff)[_i]), (PG8_LAS unsigned*)(lds + (bufoff) + ldsw + _i * 8192), 16, 0, 0); } while (0)
#define PG8_STAGE_A(bufoff, gbase, h, nx) do { const unsigned _v0 = GATHER ? ((nx) ? vaN[h][0] : vaC[h][0]) : voffA[0], _v1 = GATHER ? ((nx) ? vaN[h][1] : vaC[h][1]) : voffA[1]; \
        const char* _gb = (const char*)(gbase) + (GATHER ? (size_t)0 : (size_t)(h) * hstep); \
        __builtin_amdgcn_global_load_lds((const unsigned*)(_gb + _v0), (PG8_LAS unsigned*)(lds + (bufoff) + ldsw), 16, 0, 0); \
        __builtin_amdgcn_global_load_lds((const unsigned*)(_gb + _v1), (PG8_LAS unsigned*)(lds + (bufoff) + ldsw + 8192), 16, 0, 0); } while (0)
#define PG8_LOADVA(va, uix) do { const PG8_LAS int* _ip = S.rowidx(uix); _Pragma("unroll") for (int _h = 0; _h < 2; ++_h) _Pragma("unroll") for (int _i = 0; _i < 2; ++_i) \
        va[_h][_i] = ((unsigned)_ip[_h * HALF + gR[_i]] * (unsigned)K + (unsigned)gC[_i]) * 2u; } while (0)
#define PG8_LDA(dst, b, h) do { _Pragma("unroll") for (int m = 0; m < 4; ++m) _Pragma("unroll") for (int k = 0; k < 2; ++k) dst[m][k] = *(const PG8_LAS bf16x8*)(lds + PG8_SA(b, h) + aoff + m * 2048 + k * 1024); } while (0)
#define PG8_LDB(dst, b, h) do { _Pragma("unroll") for (int n = 0; n < 2; ++n) _Pragma("unroll") for (int k = 0; k < 2; ++k) dst[n][k] = *(const PG8_LAS bf16x8*)(lds + PG8_SB(b, h) + boff + n * 2048 + k * 1024); } while (0)
#define PG8_MMA(ai, bj, At, Bt) do { __builtin_amdgcn_s_setprio(1); _Pragma("unroll") for (int m = 0; m < 4; ++m) _Pragma("unroll") for (int n = 0; n < 2; ++n) _Pragma("unroll") for (int k = 0; k < 2; ++k) \
        acc[ai][bj][m][n] = __builtin_amdgcn_mfma_f32_16x16x32_bf16(Bt[n][k], At[m][k], acc[ai][bj][m][n], 0, 0, 0); __builtin_amdgcn_s_setprio(0); } while (0)
#define PG8_WAIT_V(n) asm volatile("s_waitcnt vmcnt(" #n ")" ::: "memory")
#define PG8_WAIT_L(n) asm volatile("s_waitcnt lgkmcnt(" #n ")" ::: "memory")
#define PG8_BAR __builtin_amdgcn_s_barrier()
#define PG8_SCHED __builtin_amdgcn_sched_barrier(0)
    Unit cur, nxt; int ui = 0;
    static_assert(SP2, "only the SP2 loop is kept in this file");
    if (!S.next(0, cur)) return;
    f32x4 acc[2][2][4][2];
#pragma unroll
    for (int a = 0; a < 2; ++a)
#pragma unroll
        for (int b = 0; b < 2; ++b)
#pragma unroll
            for (int m = 0; m < 4; ++m)
#pragma unroll
                for (int n = 0; n < 2; ++n) acc[a][b][m][n] = (f32x4){0.f, 0.f, 0.f, 0.f};
    bf16x8 At[4][2], B0[2][2], B1[2][2];
    const char* cA = (const char*)g.A + (GATHER ? (size_t)0 : (size_t)cur.ab * tstep); const char* cB = (const char*)g.Bt + (size_t)cur.bb * tstep;
    unsigned vaC[2][2] = {{0u, 0u}, {0u, 0u}}, vaN[2][2] = {{0u, 0u}, {0u, 0u}};
    if constexpr (GATHER) { PG8_LOADVA(vaC, 0); }
    S.a_ready(cur);
    if constexpr (SP2) {
        PG8_STAGE(PG8_SB(0, 0), cB, voffB); PG8_STAGE(PG8_SB(0, 1), cB + hstep, voffB); PG8_STAGE_A(PG8_SA(0, 0), cA, 0, false); PG8_STAGE_A(PG8_SA(0, 1), cA, 1, false);
        if (wr == 1) PG8_BAR;
        PG8_WAIT_V(2); PG8_BAR;
        PG8_STAGE(PG8_SB(1, 0), cB + kstep, voffB); PG8_STAGE_A(PG8_SA(1, 0), cA + kstep, 0, false); PG8_STAGE(PG8_SB(1, 1), cB + hstep + kstep, voffB);
        PG8_WAIT_V(6); PG8_BAR;
    }
    for (;;) {
        const bool has_next = S.next(ui + 1, nxt);
        const char* nA = (has_next && !GATHER) ? (const char*)g.A + (size_t)nxt.ab * tstep : cA; const char* nB = has_next ? (const char*)g.Bt + (size_t)nxt.bb * tstep : cB;
        if constexpr (GATHER) { if (has_next) { PG8_LOADVA(vaN, ui + 1); } else { vaN[0][0] = vaC[0][0]; vaN[0][1] = vaC[0][1]; vaN[1][0] = vaC[1][0]; vaN[1][1] = vaC[1][1]; } }
        for (int t = 0; t < nt; t += 2) {
            const bool last = (t == nt - 2);
            const char* a1 = cA + (size_t)(t + 1) * kstep;
            const char* a2 = last ? nA : cA + (size_t)(t + 2) * kstep; const char* b2 = last ? nB : cB + (size_t)(t + 2) * kstep;
            const char* a3 = a2 + kstep; const char* b3 = b2 + kstep;
            if (last && has_next) S.a_ready(nxt);
            if constexpr (SP2) {
            PG8_LDB(B0, 0, 0); PG8_LDB(B1, 0, 1); PG8_SCHED; PG8_LDA(At, 0, 0); PG8_STAGE_A(PG8_SA(1, 1), a1, 1, false);
            PG8_WAIT_V(8); PG8_WAIT_L(0); PG8_BAR; PG8_MMA(0, 0, At, B0); PG8_MMA(0, 1, At, B1); PG8_BAR; PG8_SCHED;
            PG8_LDA(At, 0, 1); PG8_STAGE(PG8_SB(0, 0), b2, voffB); PG8_STAGE(PG8_SB(0, 1), b2 + hstep, voffB); PG8_STAGE_A(PG8_SA(0, 0), a2, 0, last);
            PG8_WAIT_V(8); PG8_WAIT_L(0); PG8_BAR; PG8_MMA(1, 0, At, B0); PG8_MMA(1, 1, At, B1); PG8_BAR; PG8_SCHED;
            PG8_LDB(B0, 1, 0); PG8_LDB(B1, 1, 1); PG8_SCHED; PG8_LDA(At, 1, 0); PG8_STAGE_A(PG8_SA(0, 1), a2, 1, last);
            PG8_WAIT_V(8); PG8_WAIT_L(0); PG8_BAR; PG8_MMA(0, 0, At, B0); PG8_MMA(0, 1, At, B1); PG8_BAR; PG8_SCHED;
            PG8_LDA(At, 1, 1); PG8_STAGE(PG8_SB(1, 0), b3, voffB); PG8_STAGE(PG8_SB(1, 1), b3 + hstep, voffB); PG8_STAGE_A(PG8_SA(1, 0), a3, 0, last);
            PG8_WAIT_V(8); PG8_WAIT_L(0); PG8_BAR; PG8_MMA(1, 0, At, B0); PG8_MMA(1, 1, At, B1); PG8_BAR; PG8_SCHED;
            }
        }
        if constexpr (ALIGN_EPI) { if (wr == 0) PG8_BAR; }
        if constexpr (!Epi::AFTER_DRAIN) { E(acc, cur, wr, wc, fr, fq); S.done(cur); }
        if (!has_next) break;
#pragma unroll
        for (int a = 0; a < 2; ++a)
#pragma unroll
            for (int b = 0; b < 2; ++b)
#pragma unroll
                for (int m = 0; m < 4; ++m)
#pragma unroll
                    for (int n = 0; n < 2; ++n) acc[a][b][m][n] = (f32x4){0.f, 0.f, 0.f, 0.f};
        cur = nxt; cA = nA; cB = nB; ++ui;
        if constexpr (GATHER) { vaC[0][0] = vaN[0][0]; vaC[0][1] = vaN[0][1]; vaC[1][0] = vaN[1][0]; vaC[1][1] = vaN[1][1]; }
        if constexpr (ALIGN_EPI) { if (wr == 1) PG8_BAR; }
    }
    PG8_WAIT_V(0);
    if constexpr (!ALIGN_EPI) { if (wr == 0) PG8_BAR; }
    PG8_BAR;
    if constexpr (Epi::AFTER_DRAIN) { E.fused(acc, cur, wr, wc, fr, fq, lds, wid, lane); S.done(cur); }
#undef PG8_SA
#undef PG8_SB
#undef PG8_STAGE
#undef PG8_STAGE_A
#undef PG8_LOADVA
#undef PG8_LDA
#undef PG8_LDB
#undef PG8_MMA
#undef PG8_WAIT_V
#undef PG8_WAIT_L
#undef PG8_BAR
#undef PG8_SCHED
}
}
namespace pg8 {
__device__ __forceinline__ float bf_lo(unsigned w) { return __uint_as_float(w << 16); }
__device__ __forceinline__ float bf_hi(unsigned w) { return __uint_as_float(w & 0xffff0000u); }
__device__ __forceinline__ float sigm(float x) { return 1.0f / (1.0f + __expf(-x)); }

struct EpiF32 {
    static constexpr bool PERM = false, AFTER_DRAIN = false;
    float* C; int ldc;
    __device__ __forceinline__ void operator()(const f32x4 (&acc)[2][2][4][2], const Unit& u, int wr, int wc, int fr, int fq) const {
        const int row0 = u.pm * BM + wr * 64 + fr, col0 = u.pn * BM + wc * 32 + 4 * fq;
#pragma unroll
        for (int ai = 0; ai < 2; ++ai)
#pragma unroll
            for (int m = 0; m < 4; ++m) { float* rowp = C + (size_t)(row0 + ai * HALF + m * 16) * ldc + col0;
#pragma unroll
                for (int bj = 0; bj < 2; ++bj)
#pragma unroll
                    for (int n = 0; n < 2; ++n) *(f32x4*)(rowp + bj * HALF + n * 16) = acc[ai][bj][m][n]; }
    }
};

struct EpiProj {
    static constexpr bool PERM = true, AFTER_DRAIN = false;
    bf16_t* O; float* SMp;
    __device__ __forceinline__ void operator()(const f32x4 (&acc)[2][2][4][2], const Unit& u, int wr, int wc, int fr, int fq) const {
        const int row0 = u.pm * BM + wr * 64 + fr;
        if (u.pn < 32) {
            const int col0 = u.pn * BM + wc * 32 + 8 * fq;
#pragma unroll
            for (int ai = 0; ai < 2; ++ai)
#pragma unroll
                for (int m = 0; m < 4; ++m) { bf16_t* rowp = O + (size_t)(row0 + ai * HALF + m * 16) * 8192 + col0;
#pragma unroll
                    for (int bj = 0; bj < 2; ++bj) { const f32x4 v0 = acc[ai][bj][m][0], v1 = acc[ai][bj][m][1];
                        u32x4 w; w.x = cvt_pk_bf16(v0[0], v0[1]); w.y = cvt_pk_bf16(v0[2], v0[3]); w.z = cvt_pk_bf16(v1[0], v1[1]); w.w = cvt_pk_bf16(v1[2], v1[3]);
                        *(u32x4*)(rowp + bj * HALF) = w; } }
        } else if (wc == 0) {
#pragma unroll
            for (int ai = 0; ai < 2; ++ai)
#pragma unroll
                for (int m = 0; m < 4; ++m) { float* rp = SMp + (size_t)(row0 + ai * HALF + m * 16) * 32 + 8 * fq;
                    *(f32x4*)rp = acc[ai][0][m][0]; *(f32x4*)(rp + 4) = acc[ai][0][m][1]; }
        }
    }
};

struct EpiMix {
    static constexpr bool PERM = true, AFTER_DRAIN = false;
    const bf16_t* P; bf16_t* MIX; int zg_off, zf_off;
    __device__ __forceinline__ void operator()(const f32x4 (&acc)[2][2][4][2], const Unit& u, int wr, int wc, int fr, int fq) const {
        const int row0 = u.pm * BM + wr * 64 + fr, col0 = u.pn * BM + wc * 32 + 8 * fq; const int kind = u.aux; const int zoff = kind ? zf_off : zg_off;
#pragma unroll
        for (int ai = 0; ai < 2; ++ai)
#pragma unroll
            for (int m = 0; m < 4; ++m) { const int row = row0 + ai * HALF + m * 16;
#pragma unroll
                for (int bj = 0; bj < 2; ++bj) { const int col = col0 + bj * HALF;
                    const u32x4 z = *(const u32x4*)(P + (size_t)row * 8192 + zoff + col);
                    const f32x4 v0 = acc[ai][bj][m][0], v1 = acc[ai][bj][m][1];
                    float o0 = v0[0] * sigm(bf_lo(z.x)), o1 = v0[1] * sigm(bf_hi(z.x)), o2 = v0[2] * sigm(bf_lo(z.y)), o3 = v0[3] * sigm(bf_hi(z.y));
                    float o4 = v1[0] * sigm(bf_lo(z.z)), o5 = v1[1] * sigm(bf_hi(z.z)), o6 = v1[2] * sigm(bf_lo(z.w)), o7 = v1[3] * sigm(bf_hi(z.w));
                    bf16_t* mp = MIX + (size_t)row * 1024 + col;
                    if (kind) { const u32x4 p = *(const u32x4*)mp; o0 += bf_lo(p.x); o1 += bf_hi(p.x); o2 += bf_lo(p.y); o3 += bf_hi(p.y); o4 += bf_lo(p.z); o5 += bf_hi(p.z); o6 += bf_lo(p.w); o7 += bf_hi(p.w); }
                    u32x4 w; w.x = cvt_pk_bf16(o0, o1); w.y = cvt_pk_bf16(o2, o3); w.z = cvt_pk_bf16(o4, o5); w.w = cvt_pk_bf16(o6, o7);
                    *(u32x4*)mp = w; } }
    }
};

struct EpiAct {
    static constexpr bool PERM = true, AFTER_DRAIN = false;
    bf16_t* ACT; const float* bgu;
    __device__ __forceinline__ void operator()(const f32x4 (&acc)[2][2][4][2], const Unit& u, int wr, int wc, int fr, int fq) const {
        const int e = u.aux, c0 = wc * 32 + 8 * fq; const float* bg = bgu + (size_t)e * 2048 + u.pn * 128 + c0; const float* bu = bg + 1024;
        const f32x4 bg0 = *(const f32x4*)bg, bg1 = *(const f32x4*)(bg + 4), bu0 = *(const f32x4*)bu, bu1 = *(const f32x4*)(bu + 4);
#pragma unroll
        for (int ai = 0; ai < 2; ++ai)
#pragma unroll
            for (int m = 0; m < 4; ++m) { const size_t row = (size_t)u.ab * BM + ai * HALF + m * 16 + wr * 64 + fr;
                const f32x4 g0 = acc[ai][0][m][0] + bg0, g1 = acc[ai][0][m][1] + bg1, p0 = acc[ai][1][m][0] + bu0, p1 = acc[ai][1][m][1] + bu1;
                float o[8];
#pragma unroll
                for (int j = 0; j < 8; ++j) { const float gv = j < 4 ? g0[j & 3] : g1[j & 3], uv = j < 4 ? p0[j & 3] : p1[j & 3];
                    const float gate = fminf(gv, 7.0f), up = fminf(fmaxf(uv, -7.0f), 7.0f); o[j] = (up + 1.0f) * (gate * sigm(1.702f * gate)); }
                u32x4 w; w.x = cvt_pk_bf16(o[0], o[1]); w.y = cvt_pk_bf16(o[2], o[3]); w.z = cvt_pk_bf16(o[4], o[5]); w.w = cvt_pk_bf16(o[6], o[7]);
                *(u32x4*)(ACT + row * 1024 + u.pn * 128 + c0) = w; }
    }
};

struct EpiDown {
    static constexpr bool PERM = true, AFTER_DRAIN = false;
    bf16_t* YS; const float* bd;
    __device__ __forceinline__ void operator()(const f32x4 (&acc)[2][2][4][2], const Unit& u, int wr, int wc, int fr, int fq) const {
        const int e = u.aux, col0 = u.pn * BM + wc * 32 + 8 * fq;
        f32x4 bv[2][2];
#pragma unroll
        for (int bj = 0; bj < 2; ++bj)
#pragma unroll
            for (int n = 0; n < 2; ++n) bv[bj][n] = *(const f32x4*)(bd + (size_t)e * 1024 + col0 + bj * HALF + 4 * n);
#pragma unroll
        for (int ai = 0; ai < 2; ++ai)
#pragma unroll
            for (int m = 0; m < 4; ++m) { bf16_t* rowp = YS + ((size_t)u.ab * BM + ai * HALF + m * 16 + wr * 64 + fr) * 1024 + col0;
#pragma unroll
                for (int bj = 0; bj < 2; ++bj) { const f32x4 v0 = acc[ai][bj][m][0] + bv[bj][0], v1 = acc[ai][bj][m][1] + bv[bj][1];
                    u32x4 w; w.x = cvt_pk_bf16(v0[0], v0[1]); w.y = cvt_pk_bf16(v0[2], v0[3]); w.z = cvt_pk_bf16(v1[0], v1[1]); w.w = cvt_pk_bf16(v1[2], v1[3]);
                    *(u32x4*)(rowp + bj * HALF) = w; } }
    }
};

struct MixOrder {
    StaticOrder so;
    __device__ void init(int M, int N, int G_, int c_) { so.init(M, N, G_, c_); }
    __device__ __forceinline__ bool next(int i, Unit& u) const { if (!so.next(i >> 1, u)) return false; const int kind = i & 1; u.aux = kind; u.ab = kind * (so.nM) + u.pm; u.bb = kind * (so.nN) + u.pn; return true; }
    __device__ __forceinline__ void a_ready(const Unit&) const {}
    __device__ __forceinline__ void done(const Unit&) const {}
    __device__ __forceinline__ const PG8_LAS int* rowidx(int) const { return nullptr; }
};
constexpr int MAXU = 12;
struct GroupedOrder {
    const PG8_LAS int* desc; const PG8_LAS int* idx;
    __device__ __forceinline__ bool next(int i, Unit& u) const {
        if (i >= MAXU) return false; const PG8_LAS int* d = desc + i * 8;
        if (__builtin_amdgcn_readfirstlane(d[0]) == 0) return false;
        u.ab = __builtin_amdgcn_readfirstlane(d[1]); u.bb = __builtin_amdgcn_readfirstlane(d[2]); u.pn = __builtin_amdgcn_readfirstlane(d[3]); u.aux = __builtin_amdgcn_readfirstlane(d[4]); u.pm = u.ab; return true; }
    __device__ __forceinline__ void a_ready(const Unit&) const {}
    __device__ __forceinline__ void done(const Unit&) const {}
    __device__ __forceinline__ const PG8_LAS int* rowidx(int i) const { return idx + i * 256; }
};
}
namespace fox {
constexpr int D = 128, PKV = 8192  , PO = 1024  ;
constexpr float THR = 8.f; constexpr bool WSKIP = false;
constexpr float SCALE = 0.08838834764831845f;
constexpr int NW = 8, QBLK = 32, KVBLK = 64, QB = NW * QBLK;
constexpr int SHM_V = KVBLK * D * 2, SHM_K = KVBLK * D * 2;
constexpr int LDS_BIAS = 2 * SHM_V + 2 * SHM_K + NW * 64 * 4;
constexpr int LDS_BYTES = LDS_BIAS + 4096 * 4;

using bf16 = __hip_bfloat16;
typedef short bf16x8 __attribute__((ext_vector_type(8)));
typedef short s16x4 __attribute__((ext_vector_type(4)));
typedef float f32x16 __attribute__((ext_vector_type(16)));
typedef float f32x4 __attribute__((ext_vector_type(4)));
typedef unsigned u32x4 __attribute__((ext_vector_type(4)));
template <class A, class Bt> struct same_t { static constexpr bool v = false; };
template <class A> struct same_t<A, A> { static constexpr bool v = true; };

#define KSWZ(row, colB) ((row) * 256 + ((colB) ^ (((row) & 7) << 4)))
#define SBAR() __builtin_amdgcn_sched_barrier(0)
__device__ __forceinline__ int v_st(int k, int c) { const int kk = (k & ~0xC) | ((k & 4) << 1) | ((k & 8) >> 1); return ((kk >> 3) * 4 + (c >> 5)) * 512 + ((kk & 7) * 32 + (c & 31)) * 2; }
__device__ __forceinline__ int v_rd_base(int lane) { return ((lane & 3) << 3) | (((lane >> 2) & 3) << 6) | (((lane >> 4) & 1) << 5) | (((lane >> 5) & 1) << 8); }
constexpr int v_rd_off(int d0, int ks, int half) { return d0 * 512 + ks * 4096 + half * 2048; }
__device__ __forceinline__ int crow(int r, int hi) { return (r & 3) + 8 * (r >> 2) + 4 * hi; }
__device__ __forceinline__ unsigned cvtpk(float lo, float hi) {
    unsigned r; asm volatile("v_cvt_pk_bf16_f32 %0, %1, %2" : "=v"(r) : "v"(lo), "v"(hi)); return r;
}
__device__ __forceinline__ bf16x8 pack8(f32x4 a, f32x4 b) {
    u32x4 w = {cvtpk(a[0], a[1]), cvtpk(a[2], a[3]), cvtpk(b[0], b[1]), cvtpk(b[2], b[3])};
    return *reinterpret_cast<bf16x8*>(&w);
}
template <class T> __device__ __forceinline__ bf16x8 load8(const T* p) {
    if constexpr (same_t<T, float>::v) { return pack8(*(const f32x4*)p, *(const f32x4*)(p + 4)); }
    else { return *reinterpret_cast<const bf16x8*>(p); }
}
__device__ __forceinline__ void mask_tile(f32x16& p0, f32x16& p1, int dq, unsigned W) {
    const float NEG = -__builtin_inff();
#pragma unroll
    for (int r = 0; r < 16; ++r) {
        const int c = (r & 3) + 8 * (r >> 2);
        if ((unsigned)(dq - c) >= W) p0[r] = NEG;
        if ((unsigned)(dq - c - 32) >= W) p1[r] = NEG;
    }
}
__device__ __forceinline__ void partialSM(f32x16& p0, f32x16& p1, float& m_reg, float& mn, float& alpha) {
    float pmax = p0[0]; for (int r = 1; r < 16; ++r) pmax = fmaxf(pmax, p0[r]); for (int r = 0; r < 16; ++r) pmax = fmaxf(pmax, p1[r]);
    { auto rr = __builtin_amdgcn_permlane32_swap(__float_as_uint(pmax), __float_as_uint(pmax), false, false);
      pmax = fmaxf(__uint_as_float(rr[0]), __uint_as_float(rr[1])); }
    constexpr float C2 = 1.4426950408889634f * SCALE;
    if (__builtin_expect(__all((pmax - m_reg) * SCALE <= THR), 1)) { mn = m_reg; alpha = 1.f; }
    else { mn = fmaxf(m_reg, pmax); alpha = __builtin_amdgcn_exp2f((m_reg - mn) * C2); m_reg = mn; }
    const float mnL = -mn * C2;
    for (int r = 0; r < 16; ++r) p0[r] = fmaf(p0[r], C2, mnL); for (int r = 0; r < 16; ++r) p1[r] = fmaf(p1[r], C2, mnL);
    for (int r = 0; r < 16; ++r) p0[r] = __builtin_amdgcn_exp2f(p0[r]);
}
__device__ __forceinline__ void finishSM(f32x16& p0, f32x16& p1, float alpha, float& l_reg, bf16x8& pa0, bf16x8& pa1, bf16x8& pa2, bf16x8& pa3) {
    for (int r = 0; r < 16; ++r) p1[r] = __builtin_amdgcn_exp2f(p1[r]);
    float ps = 0; for (int r = 0; r < 16; ++r) ps += p0[r]; for (int r = 0; r < 16; ++r) ps += p1[r];
    { auto rr = __builtin_amdgcn_permlane32_swap(__float_as_uint(ps), __float_as_uint(ps), false, false);
      ps = __uint_as_float(rr[0]) + __uint_as_float(rr[1]); }
    l_reg = l_reg * alpha + ps;
#define PK4(P, B_, OUT) do { unsigned a0 = cvtpk(P[B_+0], P[B_+1]), a1 = cvtpk(P[B_+2], P[B_+3]);                          \
        unsigned b0 = cvtpk(P[B_+4], P[B_+5]), b1 = cvtpk(P[B_+6], P[B_+7]);                                             \
        auto r0 = __builtin_amdgcn_permlane32_swap(a0, b0, false, false); auto r1 = __builtin_amdgcn_permlane32_swap(a1, b1, false, false); \
        u32x4 w = {r0[0], r1[0], r0[1], r1[1]}; OUT = *reinterpret_cast<bf16x8*>(&w); } while (0)
    PK4(p0, 0, pa0); PK4(p0, 8, pa1); PK4(p1, 0, pa2); PK4(p1, 8, pa3);
#undef PK4
}
template <int KB, bool SK>
__device__ __forceinline__ void qkt(f32x16& p0, f32x16& p1, const char* K_lds, int r32, int hi, const bf16x8* qr, bool act, const float* bias_t  ) {
    if (SK && !act) { const float NEG = -__builtin_inff();
#pragma unroll
        for (int r = 0; r < 16; ++r) { p0[r] = NEG; p1[r] = NEG; } return; }
#pragma unroll
    for (int g4 = 0; g4 < 4; ++g4) { const f32x4 b0 = *(const f32x4*)(bias_t + 8 * g4), b1 = *(const f32x4*)(bias_t + 32 + 8 * g4);
#pragma unroll
        for (int j = 0; j < 4; ++j) { p0[4 * g4 + j] = b0[j]; p1[4 * g4 + j] = b1[j]; } }
    const char* kb[4];
#pragma unroll
    for (int dd = 0; dd < 4; ++dd) kb[dd] = K_lds + KB * SHM_K + KSWZ(r32, (dd * 16 + hi * 8) * 2);
#pragma unroll
    for (int d0 = 0; d0 < 8; ++d0) { const char* a = kb[d0 & 3] + (d0 >> 2) * 128;
        bf16x8 b0 = *reinterpret_cast<const bf16x8*>(a);
        bf16x8 b1 = *reinterpret_cast<const bf16x8*>(a + 32 * 256);
        p0 = __builtin_amdgcn_mfma_f32_32x32x16_bf16(b0, qr[d0], p0, 0, 0, 0);
        p1 = __builtin_amdgcn_mfma_f32_32x32x16_bf16(b1, qr[d0], p1, 0, 0, 0); }
}
template <int VB, bool SK>
__device__ __forceinline__ void pv_tile(f32x16* o, int vb0, bf16x8 pa0, bf16x8 pa1, bf16x8 pa2, bf16x8 pa3, bool act) {
    if (SK && !act) return;
#define TRRD(dst, off) asm volatile("ds_read_b64_tr_b16 %0, %1 offset:%2" : "=&v"(dst) : "v"(vb0), "i"(off) : "memory")
#define PV_D0(d0) do { s16x4 l0, l1, l2, l3, h0, h1, h2, h3; constexpr int b_ = VB * SHM_V + v_rd_off(d0, 0, 0);     \
        TRRD(l0, b_); TRRD(h0, b_ + 2048); TRRD(l1, b_ + 4096); TRRD(h1, b_ + 6144); TRRD(l2, b_ + 8192); TRRD(h2, b_ + 10240); TRRD(l3, b_ + 12288); TRRD(h3, b_ + 14336); \
        asm volatile("s_waitcnt lgkmcnt(0)" ::: "memory"); SBAR();                 \
        o[d0] = __builtin_amdgcn_mfma_f32_32x32x16_bf16(pa0, (bf16x8){l0[0], l0[1], l0[2], l0[3], h0[0], h0[1], h0[2], h0[3]}, o[d0], 0, 0, 0);   \
        o[d0] = __builtin_amdgcn_mfma_f32_32x32x16_bf16(pa1, (bf16x8){l1[0], l1[1], l1[2], l1[3], h1[0], h1[1], h1[2], h1[3]}, o[d0], 0, 0, 0);   \
        o[d0] = __builtin_amdgcn_mfma_f32_32x32x16_bf16(pa2, (bf16x8){l2[0], l2[1], l2[2], l2[3], h2[0], h2[1], h2[2], h2[3]}, o[d0], 0, 0, 0);   \
        o[d0] = __builtin_amdgcn_mfma_f32_32x32x16_bf16(pa3, (bf16x8){l3[0], l3[1], l3[2], l3[3], h3[0], h3[1], h3[2], h3[3]}, o[d0], 0, 0, 0); } while (0)
    PV_D0(0); PV_D0(1); PV_D0(2); PV_D0(3);
#undef PV_D0
#undef TRRD
}

template <class TIn, class TOut> struct BlockRef { const TIn* Q; const TIn* K; const TIn* V; TOut* O; int P0; };
template <class TIn> struct Seam {
    bf16x8 qr[8];
    bf16x8 st_v0, st_v1, st_k0, st_k1; f32x4 sf0, sf1, sf2, sf3;
    f32x4 tq[16];
};
__device__ __forceinline__ int swa_jlo(int P0, int W) { const int lowk = P0 - W + 1; return lowk > 0 ? lowk / KVBLK : 0; }
#define ROW(p, k0, rr) ((p) + (size_t)((k0) + (rr)) * PKV + sc)
#define VMW() asm volatile("s_waitcnt vmcnt(0)" ::: "memory")
#define VMWN(n) asm volatile("s_waitcnt vmcnt(%0)" :: "i"(n) : "memory")
#define SLOAD_H(Kp, Vp, k0) do { S.st_v0 = load8<TIn>(ROW(Vp, k0, sr)); S.st_v1 = load8<TIn>(ROW(Vp, k0, 32 + sr));              \
                         S.st_k0 = load8<TIn>(ROW(Kp, k0, sr)); S.st_k1 = load8<TIn>(ROW(Kp, k0, 32 + sr)); } while (0)
#define SWRITE_HK(bf) do { *(bf16x8*)(K_lds + (bf) * SHM_K + kws) = S.st_k0; *(bf16x8*)(K_lds + (bf) * SHM_K + kws + 32 * 256) = S.st_k1; } while (0)
#define SWRITE_HV(bf) do { *(bf16x8*)(V_lds + (bf) * SHM_V + vst0) = S.st_v0; *(bf16x8*)(V_lds + (bf) * SHM_V + vst1) = S.st_v1; } while (0)
#define SWRITE_H(bf) do { SWRITE_HV(bf); SWRITE_HK(bf); } while (0)
#define SLOAD_F(p, k0) do { S.sf0 = *(const f32x4*)ROW(p, k0, sr); S.sf1 = *(const f32x4*)(ROW(p, k0, sr) + 4);                \
                            S.sf2 = *(const f32x4*)ROW(p, k0, 32 + sr); S.sf3 = *(const f32x4*)(ROW(p, k0, 32 + sr) + 4); } while (0)
#define SWRITE_KF(bf) do { *(bf16x8*)(K_lds + (bf) * SHM_K + kws) = pack8(S.sf0, S.sf1); *(bf16x8*)(K_lds + (bf) * SHM_K + kws + 32 * 256) = pack8(S.sf2, S.sf3); } while (0)
#define SWRITE_VF(bf) do { *(bf16x8*)(V_lds + (bf) * SHM_V + vst0) = pack8(S.sf0, S.sf1); *(bf16x8*)(V_lds + (bf) * SHM_V + vst1) = pack8(S.sf2, S.sf3); } while (0)
template <class TIn, class TOut>
__device__ __forceinline__ void causal_swa_prime(const BlockRef<TIn, TOut>& cur, int W, char* lds, Seam<TIn>& S) {
    constexpr bool F32 = same_t<TIn, float>::v;
    const int tid = threadIdx.x, wid = __builtin_amdgcn_readfirstlane(tid >> 6), lane = tid & 63, r32 = lane & 31, hi = lane >> 5;
    const int sr = tid >> 4, sc = (tid & 15) * 8, kws = KSWZ(sr, sc * 2); char* K_lds = lds + 2 * SHM_V;
    const int kb0 = swa_jlo(cur.P0, W) * KVBLK;
    for (int d0 = 0; d0 < 8; ++d0) S.qr[d0] = load8<TIn>(cur.Q + (size_t)(wid * QBLK + r32) * PKV + d0 * 16 + hi * 8);
    if constexpr (F32) { SLOAD_F((const float*)cur.K, kb0); VMW(); SWRITE_KF(0); SBAR(); SLOAD_F((const float*)cur.V, kb0); }
    else { SLOAD_H(cur.K, cur.V, kb0); VMW(); SWRITE_HK(0); }
    __syncthreads();
}
template <class TIn, class TOut>
__device__ __forceinline__ void causal_swa_block(const BlockRef<TIn, TOut>& cur, const BlockRef<TIn, TOut>& nxt, int skv, int W, char* lds, Seam<TIn>& S) {
    constexpr bool F32 = same_t<TIn, float>::v;
    const int tid = threadIdx.x, wid = __builtin_amdgcn_readfirstlane(tid >> 6), lane = tid & 63, r32 = lane & 31, hi = lane >> 5;
    const int j_lo = swa_jlo(cur.P0, W);
    int j_hi = (cur.P0 + QB - 1) / KVBLK + 1; if (j_hi > skv / KVBLK) j_hi = skv / KVBLK;
    const int NT = j_hi - j_lo;
    const int kbn = swa_jlo(nxt.P0, W) * KVBLK;
    const int qlo = cur.P0 + wid * QBLK, qm = qlo + r32 - 4 * hi;
    char* V_lds = lds; char* K_lds = lds + 2 * SHM_V;
    float* ws = (float*)(lds + 2 * SHM_V + 2 * SHM_K) + wid * 64; float* li_l = ws, * al_l = ws + 32;
    const float* bias_l = (const float*)(lds + LDS_BIAS) + 4 * hi;
    float m_reg = -1e30f, l_reg = 0; f32x16 o[4] = {};
    const int sr = tid >> 4, sc = (tid & 15) * 8, vst0 = v_st(sr, sc), vst1 = v_st(32 + sr, sc), kws = KSWZ(sr, sc * 2);
    const int vb0 = (int)(uintptr_t)V_lds + v_rd_base(lane);
    const TIn* Kh = cur.K; const TIn* Vh = cur.V;
#define RESC(a) do { if (__any((a) < 1.f)) { if (hi == 0) al_l[r32] = (a); asm volatile("s_waitcnt lgkmcnt(0)" ::: "memory");              \
                     for (int d_ = 0; d_ < 4; ++d_) for (int r = 0; r < 16; ++r) o[d_][r] *= al_l[crow(r, hi)]; } } while (0)
#define KBASE(t) ((j_lo + (t)) * KVBLK)
#define BIAS_T(t) (bias_l + KBASE(t))
#define ACT(t) (KBASE(t) <= qlo + QBLK - 1 && KBASE(t) + KVBLK - 1 >= qlo - W + 1)
#define MASKT(P0_, P1_, t) do { const int kb_ = KBASE(t); if ((!SK || ACT(t)) && (kb_ + KVBLK - 1 > qlo || kb_ <= qlo + QBLK - 1 - W)) mask_tile(P0_, P1_, qm - kb_, (unsigned)W); } while (0)
    constexpr int NQL = F32 ? 16 : 8;
    constexpr bool SK = WSKIP && !F32;
#define SEAM_K0() do { VMWN(NQL); if constexpr (F32) { SWRITE_KF(0); SBAR(); SLOAD_F((const float*)nxt.V, kbn); } else { SWRITE_HK(0); } SBAR(); } while (0)
    f32x16 pA0, pA1, pB0, pB1; float mnA, mnB, alA, alB; bf16x8 pa0, pa1, pa2, pa3;
    if constexpr (F32) { VMW(); SWRITE_VF(0); SBAR(); } else { SWRITE_HV(0); SBAR(); }
    if (NT > 1) { if constexpr (F32) SLOAD_F((const float*)Kh, KBASE(1)); else SLOAD_H(Kh, Vh, KBASE(1)); }
    SBAR(); qkt<0, SK>(pA0, pA1, K_lds, r32, hi, S.qr, ACT(0), BIAS_T(0));
    if constexpr (F32) { if (NT > 1) { VMW(); SWRITE_KF(1); SBAR(); SLOAD_F((const float*)Vh, KBASE(1)); } }
    MASKT(pA0, pA1, 0); partialSM(pA0, pA1, m_reg, mnA, alA);
    if (NT > 1) { VMW(); if constexpr (F32) { SWRITE_VF(1); SBAR(); if (NT > 2) SLOAD_F((const float*)Kh, KBASE(2)); } else SWRITE_H(1); }
    __syncthreads();
#define HALF_STEP(PX0, PX1, mnX, alX, PY0, PY1, alY, t, KB, VB, SB) do {                                                      \
        SBAR(); qkt<KB, SK>(PX0, PX1, K_lds, r32, hi, S.qr, ACT(t), BIAS_T(t));                                             \
        finishSM(PY0, PY1, alY, l_reg, pa0, pa1, pa2, pa3); SBAR();                                                           \
        if ((t) + 1 < NT) { if constexpr (F32) { VMW(); SWRITE_KF(SB); SBAR(); SLOAD_F((const float*)Vh, KBASE((t) + 1)); }  \
                            else { SLOAD_H(Kh, Vh, KBASE((t) + 1)); } SBAR(); }                                               \
        pv_tile<VB, SK>(o, vb0, pa0, pa1, pa2, pa3, ACT((t) - 1)); MASKT(PX0, PX1, (t)); partialSM(PX0, PX1, m_reg, mnX, alX);                                        \
        __syncthreads();                                                                                                      \
        if ((t) + 1 < NT) { VMW(); if constexpr (F32) { SWRITE_VF(SB); SBAR(); if ((t) + 2 < NT) SLOAD_F((const float*)Kh, KBASE((t) + 2)); } \
                            else { SWRITE_H(SB); } }                                                                          \
        RESC(alX); __syncthreads(); } while (0)
    for (int t = 1; t + 1 < NT; t += 2) {
        HALF_STEP(pB0, pB1, mnB, alB, pA0, pA1, alA, t, 1, 0, 0);
        HALF_STEP(pA0, pA1, mnA, alA, pB0, pB1, alB, t + 1, 0, 1, 1);
    }
    const bool even = (NT & 1) == 0;
    if (even) { SBAR(); qkt<1, SK>(pB0, pB1, K_lds, r32, hi, S.qr, ACT(NT - 1), BIAS_T(NT - 1)); SBAR(); }
#define QROW(e) (nxt.Q + (size_t)(wid * QBLK + r32) * PKV + ((e) >> 1) * 16 + hi * 8 + ((e) & 1) * 4)
    if constexpr (F32) { SLOAD_F((const float*)nxt.K, kbn); SBAR();
#pragma unroll
        for (int e = 0; e < 8; ++e) S.tq[e] = *(const f32x4*)QROW(e); }
    else { SLOAD_H(nxt.K, nxt.V, kbn); SBAR();
#pragma unroll
        for (int d0 = 0; d0 < 8; ++d0) S.qr[d0] = load8<TIn>(nxt.Q + (size_t)(wid * QBLK + r32) * PKV + d0 * 16 + hi * 8); }
    SBAR();
    finishSM(pA0, pA1, alA, l_reg, pa0, pa1, pa2, pa3); SBAR();
    if constexpr (F32) {
#pragma unroll
        for (int e = 8; e < 16; ++e) S.tq[e] = *(const f32x4*)QROW(e); SBAR(); }
#undef QROW
    pv_tile<0, SK>(o, vb0, pa0, pa1, pa2, pa3, ACT(even ? NT - 2 : NT - 1));
    if (even) { MASKT(pB0, pB1, NT - 1); partialSM(pB0, pB1, m_reg, mnB, alB); __syncthreads(); RESC(alB);
        finishSM(pB0, pB1, alB, l_reg, pa0, pa1, pa2, pa3); SBAR(); pv_tile<1, SK>(o, vb0, pa0, pa1, pa2, pa3, ACT(NT - 1)); }
    SBAR(); SEAM_K0();
    if (hi == 0) li_l[r32] = l_reg; asm volatile("s_waitcnt lgkmcnt(0)" ::: "memory");
    float rli[16];
#pragma unroll
    for (int r = 0; r < 16; ++r) rli[r] = __builtin_amdgcn_rcpf(li_l[crow(r, hi)]);
    TOut* Ow = cur.O + (size_t)(wid * QBLK) * PO;
#pragma unroll
    for (int r = 0; r < 16; ++r) { const int orow = crow(r, hi);
#pragma unroll
        for (int d0 = 0; d0 < 4; ++d0) { const float v = o[d0][r] * rli[r];
            if constexpr (same_t<TOut, float>::v) { Ow[(size_t)orow * PO + d0 * 32 + r32] = v; }
            else { const float vn = __shfl_xor(v, 1);
                   if ((r32 & 1) == 0) *(unsigned*)(Ow + (size_t)orow * PO + d0 * 32 + r32) = cvtpk(v, vn); } } }
    if constexpr (F32) {
#pragma unroll
        for (int d0 = 0; d0 < 8; ++d0) S.qr[d0] = pack8(S.tq[2 * d0], S.tq[2 * d0 + 1]); }
    __syncthreads();
#undef RESC
#undef KBASE
#undef BIAS_T
#undef ACT
#undef MASKT
#undef SEAM_K0
#undef HALF_STEP
}
#undef ROW
#undef VMW
#undef VMWN
#undef SLOAD_H
#undef SWRITE_HK
#undef SWRITE_HV
#undef SWRITE_H
#undef SLOAD_F
#undef SWRITE_KF
#undef SWRITE_VF

}
#define GAS __attribute__((address_space(1)))
#define LAS __attribute__((address_space(3)))
typedef unsigned short bf16;
typedef unsigned v4u __attribute__((ext_vector_type(4)));
typedef float f32x4 __attribute__((ext_vector_type(4)));
typedef short bf16x8 __attribute__((ext_vector_type(8)));
typedef GAS unsigned gu32;
typedef GAS unsigned long long gu64;
#define RLX_AGENT __ATOMIC_RELAXED, __HIP_MEMORY_SCOPE_AGENT
#define LDS_WAIT() asm volatile("s_waitcnt lgkmcnt(0)" ::: "memory")
#define VM_WAIT() asm volatile("s_waitcnt vmcnt(0)" ::: "memory")
__device__ __forceinline__ unsigned long long rt() { return __builtin_amdgcn_s_memrealtime(); }
__device__ __forceinline__ unsigned f2bf(float f) { unsigned u = __builtin_bit_cast(unsigned, f); return (u + 0x7fffu + ((u >> 16) & 1u)) >> 16; }
__device__ __forceinline__ unsigned pk2(float lo, float hi) { return f2bf(lo) | (f2bf(hi) << 16); }

#define XB_TMO      128
#define XB_XCNT(j)  (256  + 64 * (j))
#define XB_XSUB(j)  (1280 + 64 * (j))
#define XB_XGEN(j)  (2304 + 64 * (j))
#define XB_TOP      3328
#define XB_TOPGEN   3392
#define XCD_BAR_WORDS 3456
#define XB_SPIN_CAP (1u << 18)

__device__ __forceinline__ unsigned xb_ld(unsigned* p)              { return __hip_atomic_load(p, __ATOMIC_RELAXED, __HIP_MEMORY_SCOPE_AGENT); }
__device__ __forceinline__ unsigned xb_add(unsigned* p, unsigned v) { return __hip_atomic_fetch_add(p, v, __ATOMIC_RELAXED, __HIP_MEMORY_SCOPE_AGENT); }
__device__ __forceinline__ unsigned xb_xcc_id() { return (unsigned)__builtin_amdgcn_s_getreg((3 << 11) | 20) & 0xFu; }
#define XB_SPIN(cond, bar) do { unsigned _sp = 0; while (cond) { __builtin_amdgcn_s_sleep(1); \
    if ((++_sp & 255u) == 0u) { if (xb_ld(&(bar)[XB_TMO])) break; if (_sp > XB_SPIN_CAP) { atomicAdd(&(bar)[XB_TMO], 1u); break; } } } } while (0)

struct XcdBarrier {
    unsigned* bar; unsigned x;
    volatile LAS unsigned* st;
};

__device__ __forceinline__ XcdBarrier xcd_barrier_post(unsigned* bar, volatile LAS unsigned* st) {
    XcdBarrier b; b.bar = bar; b.x = xb_xcc_id(); b.st = st;
    if (threadIdx.x == 0) (void)xb_add(&bar[XB_XCNT(b.x)], 1u);
    return b;
}
__device__ __forceinline__ void xcd_barrier_complete(unsigned* bar, unsigned x, unsigned& nloc, unsigned& nx) {
    const unsigned G = gridDim.x * gridDim.y * gridDim.z;
    unsigned sum, cnt, mine, sp = 0u;
    for (;;) {
        sum = 0u; cnt = 0u; mine = 0u;
#pragma unroll
        for (unsigned j = 0; j < 16; ++j) { const unsigned c = xb_ld(&bar[XB_XCNT(j)]); sum += c; cnt += (c > 0u) ? 1u : 0u; mine = (j == x) ? c : mine; }
        if (sum == G) break;
        __builtin_amdgcn_s_sleep(1);
        if ((++sp & 255u) == 0u) { if (xb_ld(&bar[XB_TMO])) break; if (sp > XB_SPIN_CAP) { atomicAdd(&bar[XB_TMO], 1u); break; } }
    }
    nloc = mine > 0u ? mine : 1u; nx = cnt > 0u ? cnt : 1u;
}

__device__ __forceinline__ void xcd_barrier(const XcdBarrier& b) {
    asm volatile("s_waitcnt vmcnt(0)" ::: "memory");
    __syncthreads();
    if (threadIdx.x == 0) {
        unsigned* bar = b.bar;
        __builtin_amdgcn_s_waitcnt(0);
        unsigned nloc = b.st[0], nx = b.st[1];
        if (nloc == 0u) { xcd_barrier_complete(bar, b.x, nloc, nx); b.st[0] = nloc; b.st[1] = nx; }
        const unsigned old = xb_add(&bar[XB_XSUB(b.x)], 1u);
        const unsigned gen = old / nloc;
        if (old + 1u == (gen + 1u) * nloc) {
            __builtin_amdgcn_fence(__ATOMIC_RELEASE, "agent");
            asm volatile("s_waitcnt vmcnt(0)" ::: "memory");
            const unsigned og = xb_add(&bar[XB_TOP], 1u);
            const unsigned tg = og / nx;
            if (og + 1u == (tg + 1u) * nx) xb_add(&bar[XB_TOPGEN], 1u);
            else XB_SPIN(xb_ld(&bar[XB_TOPGEN]) == tg, bar);
            __builtin_amdgcn_fence(__ATOMIC_ACQUIRE, "agent");
            xb_add(&bar[XB_XGEN(b.x)], 1u);
            asm volatile("s_waitcnt vmcnt(0)" ::: "memory");
        } else {
            XB_SPIN(xb_ld(&bar[XB_XGEN(b.x)]) == gen, bar);
            __builtin_amdgcn_fence(__ATOMIC_ACQUIRE, "agent");
            asm volatile("s_waitcnt vmcnt(0)" ::: "memory");
        }
    }
    __syncthreads();
}
constexpr int NWAVES = 8, NTHR = NWAVES * 64;
constexpr int T_TOK = 16384, SEQ = 4096, NBATCH = 4, DM = 1024;
constexpr int IN_COLS = 8216, NPROJ = 8192, NPROJ_PAD = 8448;
constexpr int C_GQ = 0, C_GK = 512, C_GV = 1024, C_GR = 2048, C_FQ = 3072, C_FK = 4096, C_FV = 5120, C_ZG = 6144, C_ZF = 7168;
constexpr int NE = 32, DFF = 1024, NCHUNK = 64;
constexpr float LN_EPS = 1e-5f;
constexpr float DN_ALPHA = 1.189207115002721f;
constexpr float FOX_INV_SCALE = 11.313708498984761f;
constexpr float GLA_QSCALE = 0.08838834764831845f;
constexpr int SLOT_ROWS = 73728;

constexpr size_t MiB = 1u << 20;
constexpr size_t WS_CTL = 0, CTL_ZERO_BYTES = 1 * MiB;
constexpr size_t WS_WIN = 2 * MiB;
constexpr size_t WS_WPROJ = 19 * MiB;
constexpr size_t WS_WOUT = 23 * MiB;
constexpr size_t WS_WGU = 25 * MiB;
constexpr size_t WS_WDN = 153 * MiB;
constexpr size_t WS_H0B = 217 * MiB;
constexpr size_t WS_SM = 249 * MiB;
constexpr size_t WS_FB = 251 * MiB;
constexpr size_t WS_DECAY = 252 * MiB;
constexpr size_t WS_KDEC = 253 * MiB;
constexpr size_t WS_AO = 269 * MiB;
constexpr size_t WS_MIXED = 333 * MiB;
constexpr size_t WS_H1F = 365 * MiB;
constexpr size_t WS_H1B = 429 * MiB;
constexpr size_t WS_TOKOF = 461 * MiB;
constexpr size_t WS_PAIR = 463 * MiB;
constexpr size_t WS_PROJ = 464 * MiB;
constexpr size_t WS_ACT = WS_PROJ;
constexpr size_t WS_YS = 720 * MiB;
constexpr size_t WS_END = 864 * MiB;
static_assert(WS_WIN + (size_t)NPROJ_PAD * 1024 * 2 <= WS_WPROJ && WS_WGU + (size_t)32 * 2048 * 1024 * 2 <= WS_WDN && WS_WDN + (size_t)32 * 1024 * 1024 * 2 <= WS_H0B, "ws map");
static_assert(WS_PROJ + (size_t)T_TOK * 8192 * 2 <= WS_YS && WS_ACT + (size_t)SLOT_ROWS * 1024 * 2 <= WS_YS && WS_YS + (size_t)SLOT_ROWS * 1024 * 2 <= WS_END, "ws map");
constexpr int CW_TMO = 0, CW_CODE = 1;
constexpr int CW_BAR = 4096;
constexpr int CW_CNT = 8192;

constexpr int RING_OFF = 0, RING_BYTES = 131072;
constexpr int LDSCTL_OFF = RING_BYTES, MISC_OFF = LDSCTL_OFF + 320;
constexpr int TBL_OFF = RING_BYTES + 512;
constexpr int TBL_CUM = TBL_OFF, TBL_CNT = TBL_OFF + 256, TBL_DESC = TBL_OFF + 384, TBL_IDX = TBL_OFF + 768;
constexpr int LDS_BYTES = 147456;
static_assert(TBL_IDX + pg8::MAXU * 256 * 4 <= LDS_BYTES && fox::LDS_BYTES <= RING_BYTES, "LDS map");

__device__ __forceinline__ float bfu(unsigned short h) { return __uint_as_float((unsigned)h << 16); }
__device__ __forceinline__ float logsig(float x) { return fminf(x, 0.f) - log1pf(expf(-fabsf(x))); }
__device__ __forceinline__ float wave_sum(float v) {
#pragma unroll
    for (int o = 1; o < 64; o <<= 1) v += __shfl_xor(v, o);
    return v;
}

__device__ __forceinline__ void p0_transpose_item(const float* W, int npitch, int srccol, bf16* WT, int dstrow, LAS float* scr, int kb, int lane) {
    const int k0 = 64 * kb;
#pragma unroll 8
    for (int i = 0; i < 32; ++i) { const int kk = 2 * i + (lane >> 5); scr[kk * 33 + (lane & 31)] = W[(size_t)(k0 + kk) * npitch + srccol + (lane & 31)]; }
    LDS_WAIT(); asm volatile("" ::: "memory");
    const int c = lane & 7;
#pragma unroll
    for (int j = 0; j < 4; ++j) { const int n = (lane >> 3) + 8 * j; const LAS float* s = scr + (8 * c) * 33 + n;
        v4u o; o.x = pk2(s[0 * 33], s[1 * 33]); o.y = pk2(s[2 * 33], s[3 * 33]); o.z = pk2(s[4 * 33], s[5 * 33]); o.w = pk2(s[6 * 33], s[7 * 33]);
        *(GAS v4u*)(WT + (size_t)(dstrow + n) * 1024 + k0 + 8 * c) = o; }
    LDS_WAIT(); asm volatile("" ::: "memory");
}
__device__ __forceinline__ void ln_row(const f32x4 (&xin)[4], f32x4 (&y)[4], const float* g, const float* b, int lane) {
    float s = 0.f;
#pragma unroll
    for (int j = 0; j < 4; ++j) s += (xin[j].x + xin[j].y) + (xin[j].z + xin[j].w);
    const float mean = wave_sum(s) * (1.f / DM); float s2 = 0.f;
#pragma unroll
    for (int j = 0; j < 4; ++j) { y[j] = xin[j] - mean; s2 += (y[j].x * y[j].x + y[j].y * y[j].y) + (y[j].z * y[j].z + y[j].w * y[j].w); }
    const float rstd = 1.f / sqrtf(wave_sum(s2) * (1.f / DM) + LN_EPS);
#pragma unroll
    for (int j = 0; j < 4; ++j) { const f32x4 gv = *(const f32x4*)(g + 4 * lane + 256 * j), bv = *(const f32x4*)(b + 4 * lane + 256 * j); y[j] = y[j] * rstd * gv + bv; }
}
__device__ __forceinline__ void store_row_bf16(bf16* orow, const f32x4 (&y)[4], int lane) {
    GAS unsigned long long* o8 = (GAS unsigned long long*)orow + lane;
#pragma unroll
    for (int j = 0; j < 4; ++j) o8[64 * j] = (unsigned long long)pk2(y[j].x, y[j].y) | ((unsigned long long)pk2(y[j].z, y[j].w) << 32);
}

struct Args { const float* in[21]; float* out; unsigned char* ws; int ph_lo, ph_hi, li, pad; };
constexpr int NPH = 11;

__global__ void __launch_bounds__(NTHR, 2) mega_fwd(Args args) {
    extern __shared__ __attribute__((aligned(16))) unsigned char lds[];
    LAS unsigned char* const ldsl = (LAS unsigned char*)lds;
    volatile LAS unsigned* const MISC = (volatile LAS unsigned*)(ldsl + MISC_OFF);
    const int tid = threadIdx.x, lane = tid & 63, wave = __builtin_amdgcn_readfirstlane(tid >> 6);
    const int G = gridDim.x; const int bx = blockIdx.x; const int vcu = (G % 8 == 0) ? (bx % 8) * (G / 8) + bx / 8 : bx;
    unsigned char* const ws = args.ws;
    gu32* const ctl = (gu32*)(ws + WS_CTL);
    const float* x = args.in[0]; const float* ln_in_g = args.in[1]; const float* ln_in_b = args.in[2]; const float* w_in = args.in[3];
    const float* w_gup = args.in[4]; const float* b_gla_gate = args.in[5]; const float* g_gla_norm = args.in[6]; const float* b_forget = args.in[7];
    const float* w_gla_proj = args.in[8]; const float* w_fox_proj = args.in[9]; const float* w_out = args.in[10];
    const float* ln_mix_g = args.in[11]; const float* ln_mix_b = args.in[12]; const float* w_router = args.in[13]; const float* b_router = args.in[14];
    const float* w_gate_up = args.in[15]; const float* b_gate_up = args.in[16]; const float* w_down = args.in[17]; const float* b_down = args.in[18];
    const float* ln_ffn_g = args.in[19]; const float* ln_ffn_b = args.in[20];
    float* const out = args.out;
    bf16* const WIN_T = (bf16*)(ws + WS_WIN); bf16* const WPROJ_T = (bf16*)(ws + WS_WPROJ); bf16* const WOUT_T = (bf16*)(ws + WS_WOUT);
    bf16* const WGU_T = (bf16*)(ws + WS_WGU); bf16* const WDN_T = (bf16*)(ws + WS_WDN);
    bf16* const H0B = (bf16*)(ws + WS_H0B); float* const SM = (float*)(ws + WS_SM); float* const FB = (float*)(ws + WS_FB); float* const DECAY = (float*)(ws + WS_DECAY);
    bf16* const KDEC = (bf16*)(ws + WS_KDEC); bf16* const AO = (bf16*)(ws + WS_AO); bf16* const MIXED = (bf16*)(ws + WS_MIXED);
    float* const H1F = (float*)(ws + WS_H1F); bf16* const H1B = (bf16*)(ws + WS_H1B);
    int* const TOKOF = (int*)(ws + WS_TOKOF); int* const PAIR_E = (int*)(ws + WS_PAIR); int* const PAIR_POS = PAIR_E + T_TOK * 4; float* const PAIR_G = (float*)(PAIR_POS + T_TOK * 4);
    bf16* const PROJ = (bf16*)(ws + WS_PROJ); bf16* const ACT = (bf16*)(ws + WS_ACT); bf16* const YS = (bf16*)(ws + WS_YS);

    for (int u = tid; u < (LDS_BYTES - LDSCTL_OFF) / 4; u += NTHR) ((LAS unsigned*)(ldsl + LDSCTL_OFF))[u] = 0u;
    __syncthreads();
    const int lo = args.ph_lo, hi = args.ph_hi;
    const bool use_bar = (hi - lo) > 1;
    XcdBarrier bar; bar.bar = (unsigned*)(ctl + CW_BAR); bar.x = 0; bar.st = nullptr;
    if (use_bar) bar = xcd_barrier_post((unsigned*)(ctl + CW_BAR), MISC + 8);
#ifndef PH_MASK
#define PH_MASK 0x7FF
#endif
#define IN(k) ((((PH_MASK) >> (k)) & 1) && lo <= (k) && (k) < hi)
#define SEAM(k) do { if (IN(k) && IN((k) + 1)) xcd_barrier(bar); } while (0)

    if (IN(0)) {
        LAS float* scr = (LAS float*)(ldsl + RING_OFF + wave * 16384);
        const int gw = vcu * NWAVES + wave, NGW = G * NWAVES;
        constexpr int I_IN = 256 * 16, I_PRJ = 3 * 512, I_GU = 32 * 1024, I_DN = 32 * 512, NITEMS = I_IN + I_PRJ + I_GU + I_DN;
        for (int it0 = gw; it0 < NITEMS; it0 += NGW) {
            int it = it0;
            if (it < I_IN) { const int db = it >> 4, kb = it & 15, dst = 32 * db, src = dst + (dst < 2048 ? 0 : (dst < 6144 ? 16 : 24));
                p0_transpose_item(w_in, IN_COLS, src, WIN_T, dst, scr, kb, lane); continue; }
            it -= I_IN;
            if (it < I_PRJ) { const int m = it >> 9, r = it & 511, db = r >> 4, kb = r & 15;
                const float* W = m == 0 ? w_gla_proj : (m == 1 ? w_fox_proj : w_out); bf16* WT = m < 2 ? WPROJ_T + (size_t)m * 1024 * 1024 : WOUT_T;
                p0_transpose_item(W, 1024, 32 * db, WT, 32 * db, scr, kb, lane); continue; }
            it -= I_PRJ;
            if (it < I_GU) { const int e = it >> 10, r = it & 1023, db = r >> 4, kb = r & 15, pn = db >> 3, jb = db & 7;
                const int src = jb < 4 ? 128 * pn + 32 * jb : 1024 + 128 * pn + 32 * (jb - 4);
                p0_transpose_item(w_gate_up + (size_t)e * 1024 * 2048, 2048, src, WGU_T + (size_t)e * 2048 * 1024, 32 * db, scr, kb, lane); continue; }
            it -= I_GU;
            { const int e = it >> 9, r = it & 511, db = r >> 4, kb = r & 15;
                p0_transpose_item(w_down + (size_t)e * 1024 * 1024, 1024, 32 * db, WDN_T + (size_t)e * 1024 * 1024, 32 * db, scr, kb, lane); }
        }
        for (int i = vcu * NTHR + tid; i < 256 * 1024; i += G * NTHR) { const int r = i >> 10, k = i & 1023;
            float v = 0.f; if (r < 16) v = w_in[(size_t)k * IN_COLS + 2048 + r]; else if (r < 24) v = w_in[(size_t)k * IN_COLS + 6160 + (r - 16)];
            WIN_T[(size_t)(NPROJ + r) * 1024 + k] = (bf16)f2bf(v); }
        for (int m = gw; m < T_TOK; m += NGW) { const GAS f32x4* xr = (const GAS f32x4*)(x + (size_t)m * DM) + lane; f32x4 v[4], y[4];
#pragma unroll
            for (int j = 0; j < 4; ++j) v[j] = xr[64 * j];
            ln_row(v, y, ln_in_g, ln_in_b, lane); store_row_bf16(H0B + (size_t)m * DM, y, lane); }
    }
    SEAM(0);

    if (IN(1)) {
        pg8::Gemm g{H0B, WIN_T, T_TOK, NPROJ_PAD, DM}; pg8::StaticOrder S; S.init(T_TOK, NPROJ_PAD, G, bx);
        pg8::EpiProj E{PROJ, SM};
        pg8::gemm_phase<pg8::EpiProj, pg8::StaticOrder, true, true, false>(ldsl + RING_OFF, g, S, E);
    }
    SEAM(1);

    if (IN(2)) {
        LAS float* sc = (LAS float*)(ldsl + RING_OFF);
        for (int bh = vcu; bh < 32; bh += G) {
            const int b = bh >> 3, h = bh & 7; const float bf_ = b_forget[h];
            float v[8]; float run = 0.f;
#pragma unroll
            for (int j = 0; j < 8; ++j) { const int s = tid * 8 + j; run += logsig(SM[(size_t)(b * SEQ + s) * 32 + 16 + h] + bf_); v[j] = run; }
            float incl = run;
#pragma unroll
            for (int o = 1; o < 64; o <<= 1) { const float t = __shfl_up(incl, o); if (lane >= o) incl += t; }
            if (lane == 63) sc[wave] = incl;
            __syncthreads();
            float woff = 0.f;
            for (int w = 0; w < wave; ++w) woff += sc[w];
            const float off = woff + (incl - run);
#pragma unroll
            for (int j = 0; j < 8; ++j) FB[(size_t)bh * SEQ + tid * 8 + j] = -(off + v[j]) * FOX_INV_SCALE;
            __syncthreads();
        }
        for (int it = vcu; it < NBATCH * NCHUNK * 4; it += G) {
            const int h = it & 3, n = (it >> 2) & 63, b = it >> 8; const int j = tid & 127, cq = tid >> 7; const int col = h * 128 + j;
            const size_t tok0 = (size_t)b * SEQ + n * 64;
            float wu[16];
#pragma unroll
            for (int r = 0; r < 16; ++r) wu[r] = w_gup[r * 512 + col];
            const float bg = b_gla_gate[col];
            float cum[16]; float run = 0.f;
#pragma unroll
            for (int c = 0; c < 16; ++c) { const float* gl = SM + (tok0 + cq * 16 + c) * 32; float z = bg;
#pragma unroll
                for (int r = 0; r < 16; ++r) z += gl[r] * wu[r];
                run += logsig(z) * (1.0f / 16.0f); cum[c] = run; }
            sc[cq * 128 + j] = run;
            __syncthreads();
            float off = 0.f, total = 0.f;
#pragma unroll
            for (int q = 0; q < 4; ++q) { const float t = sc[q * 128 + j]; total += t; if (q < cq) off += t; }
#pragma unroll
            for (int c = 0; c < 16; ++c) { const size_t tok = tok0 + cq * 16 + c; const float kv = bfu(PROJ[tok * 8192 + C_GK + col]);
                KDEC[tok * 512 + col] = (bf16)f2bf(kv * expf(total - (off + cum[c]))); }
            if (cq == 0) DECAY[(size_t)(b * NCHUNK + n) * 512 + col] = expf(total);
            __syncthreads();
        }
    }
    SEAM(2);

    if (IN(3)) {
#ifndef NO_GLA
        if (vcu < 16) {
            const int it = vcu; const int b = it >> 2, h = it & 3; const int dv = tid & 255, half = tid >> 8;
            LAS unsigned short* QQ = (LAS unsigned short*)(ldsl + RING_OFF);
            LAS unsigned short* KD = (LAS unsigned short*)(ldsl + RING_OFF + 16384);
            LAS unsigned short* VV = (LAS unsigned short*)(ldsl + RING_OFF + 32768);
            LAS float* RED = (LAS float*)(ldsl + RING_OFF + 65536);
            LAS float* DEC = (LAS float*)(ldsl + TBL_IDX);
            LAS float* RSTD = DEC + 128;
            float S[64];
#pragma unroll
            for (int i = 0; i < 64; ++i) S[i] = 0.f;
            const float gn = g_gla_norm[dv];
            for (int n = 0; n < NCHUNK; ++n) {
                const size_t tok0 = (size_t)b * SEQ + n * 64;
                for (int i = tid; i < 1024; i += NTHR) { const int c = i >> 4, ch = i & 15;
                    *(LAS v4u*)(QQ + c * 128 + ch * 8) = *(const GAS v4u*)(PROJ + (tok0 + c) * 8192 + C_GQ + h * 128 + ch * 8);
                    *(LAS v4u*)(KD + c * 128 + ch * 8) = *(const GAS v4u*)(KDEC + (tok0 + c) * 512 + h * 128 + ch * 8); }
                for (int i = tid; i < 2048; i += NTHR) { const int c = i >> 5, ch = i & 31;
                    *(LAS v4u*)(VV + c * 256 + ch * 8) = *(const GAS v4u*)(PROJ + (tok0 + c) * 8192 + C_GV + h * 256 + ch * 8); }
                if (tid < 128) DEC[tid] = DECAY[(size_t)(b * NCHUNK + n) * 512 + h * 128 + tid];
                __syncthreads();
#pragma unroll
                for (int i = 0; i < 64; ++i) S[i] *= DEC[64 * half + i];
                for (int c = 0; c < 64; ++c) { const float vv = bfu(VV[c * 256 + dv]);
#pragma unroll
                    for (int g8 = 0; g8 < 8; ++g8) { const v4u kk = *(const LAS v4u*)(KD + c * 128 + 64 * half + 8 * g8);
                        S[8 * g8 + 0] += pg8::bf_lo(kk.x) * vv; S[8 * g8 + 1] += pg8::bf_hi(kk.x) * vv; S[8 * g8 + 2] += pg8::bf_lo(kk.y) * vv; S[8 * g8 + 3] += pg8::bf_hi(kk.y) * vv;
                        S[8 * g8 + 4] += pg8::bf_lo(kk.z) * vv; S[8 * g8 + 5] += pg8::bf_hi(kk.z) * vv; S[8 * g8 + 6] += pg8::bf_lo(kk.w) * vv; S[8 * g8 + 7] += pg8::bf_hi(kk.w) * vv; } }
                for (int ph = 0; ph < 2; ++ph) {
                    if (half == ph) {
                        for (int c = 0; c < 64; ++c) { float po = 0.f;
#pragma unroll
                            for (int g8 = 0; g8 < 8; ++g8) { const v4u qq = *(const LAS v4u*)(QQ + c * 128 + 64 * half + 8 * g8);
                                po += pg8::bf_lo(qq.x) * S[8 * g8 + 0]; po += pg8::bf_hi(qq.x) * S[8 * g8 + 1]; po += pg8::bf_lo(qq.y) * S[8 * g8 + 2]; po += pg8::bf_hi(qq.y) * S[8 * g8 + 3];
                                po += pg8::bf_lo(qq.z) * S[8 * g8 + 4]; po += pg8::bf_hi(qq.z) * S[8 * g8 + 5]; po += pg8::bf_lo(qq.w) * S[8 * g8 + 6]; po += pg8::bf_hi(qq.w) * S[8 * g8 + 7]; }
                            if (ph == 0) RED[c * 256 + dv] = po; else RED[c * 256 + dv] += po; }
                    }
                    __syncthreads();
                }
                { const int c = tid >> 3, part = tid & 7; float s = 0.f;
                    for (int i = 0; i < 32; ++i) { const float o = RED[c * 256 + part * 32 + i] * GLA_QSCALE; s += o * o; }
                    s += __shfl_xor(s, 1); s += __shfl_xor(s, 2); s += __shfl_xor(s, 4);
                    if (part == 0) RSTD[c] = 1.0f / sqrtf(s * (1.0f / 256.0f) + LN_EPS); }
                __syncthreads();
                for (int i = tid; i < 64 * 256; i += NTHR) { const int c = i >> 8, d = i & 255;
                    const float r = bfu(PROJ[(tok0 + c) * 8192 + C_GR + h * 256 + d]);
                    const float o = RED[c * 256 + d] * GLA_QSCALE * RSTD[c] * g_gla_norm[d] * (r * pg8::sigm(r));
                    AO[(tok0 + c) * 1024 + h * 256 + d] = (bf16)f2bf(o); }
                __syncthreads();
            }
            (void)gn;
        }
#endif
#ifndef NO_ATT
        {
            char* const lg = (char*)lds;
            if (vcu < 256) {
                const int it = vcu; const int bh = it >> 3, s = it & 7, b = bh >> 3, h = bh & 7;
                float* bl = (float*)(lg + fox::LDS_BIAS);
                for (int i = tid; i < SEQ; i += NTHR) bl[i] = FB[(size_t)bh * SEQ + i];
                const fox::bf16* Pq = (const fox::bf16*)PROJ; fox::bf16* Oo = (fox::bf16*)(AO + (size_t)T_TOK * 1024);
                fox::BlockRef<fox::bf16, fox::bf16> r0, r1;
                r0.K = r1.K = Pq + (size_t)(b * SEQ) * 8192 + C_FK + h * 128; r0.V = r1.V = Pq + (size_t)(b * SEQ) * 8192 + C_FV + h * 128;
                r0.Q = Pq + (size_t)(b * SEQ + s * 256) * 8192 + C_FQ + h * 128; r1.Q = Pq + (size_t)(b * SEQ + (15 - s) * 256) * 8192 + C_FQ + h * 128;
                r0.O = Oo + (size_t)(b * SEQ + s * 256) * 1024 + h * 128; r1.O = Oo + (size_t)(b * SEQ + (15 - s) * 256) * 1024 + h * 128;
                r0.P0 = s * 256; r1.P0 = (15 - s) * 256;
                fox::Seam<fox::bf16> Sm;
                fox::causal_swa_prime<fox::bf16, fox::bf16>(r0, SEQ, lg, Sm);
                fox::BlockRef<fox::bf16, fox::bf16> cur = r0;
                for (int pass = 0; pass < 2; ++pass) { fox::BlockRef<fox::bf16, fox::bf16> nx = r1;
                    asm volatile("" : "+s"(nx.K), "+s"(nx.V), "+s"(nx.Q));
                    fox::causal_swa_block<fox::bf16, fox::bf16>(cur, nx, SEQ, SEQ, lg, Sm); cur = nx; }
            }
        }
#endif
    }
    SEAM(3);

    if (IN(4)) {
        pg8::Gemm g{AO, WPROJ_T, 2 * T_TOK, 2048, DM}; pg8::MixOrder S; S.init(T_TOK, DM, G, bx);
        pg8::EpiMix E{PROJ, MIXED, C_ZG, C_ZF};
        pg8::gemm_phase<pg8::EpiMix, pg8::MixOrder, false, true, false>(ldsl + RING_OFF, g, S, E);
    }
    SEAM(4);

    if (IN(5)) {
        pg8::Gemm g{MIXED, WOUT_T, T_TOK, DM, DM}; pg8::StaticOrder S; S.init(T_TOK, DM, G, bx);
        pg8::EpiF32 E{H1F, DM};
        pg8::gemm_phase<pg8::EpiF32, pg8::StaticOrder, false, true, false>(ldsl + RING_OFF, g, S, E);
    }
    SEAM(5);

    if (IN(6)) {
        const int gw = vcu * NWAVES + wave, NGW = G * NWAVES;
        for (int m = gw; m < T_TOK; m += NGW) { const GAS f32x4* xr = (const GAS f32x4*)(x + (size_t)m * DM) + lane; GAS f32x4* hr = (GAS f32x4*)(H1F + (size_t)m * DM) + lane; f32x4 v[4], y[4], z[4];
#pragma unroll
            for (int j = 0; j < 4; ++j) v[j] = xr[64 * j];
            ln_row(v, y, ln_in_g, ln_in_b, lane);
#pragma unroll
            for (int j = 0; j < 4; ++j) y[j] = y[j] * DN_ALPHA + hr[64 * j];
            ln_row(y, z, ln_mix_g, ln_mix_b, lane);
#pragma unroll
            for (int j = 0; j < 4; ++j) hr[64 * j] = z[j];
            store_row_bf16(H1B + (size_t)m * DM, z, lane); }
    }
    SEAM(6);

    if (IN(7)) {
        LAS float* WR = (LAS float*)(ldsl + RING_OFF);
        LAS float* LOG = (LAS float*)(ldsl + TBL_IDX);
        LAS int* HIST = (LAS int*)(ldsl + TBL_CNT); LAS int* BASE = (LAS int*)(ldsl + TBL_CUM);
        for (int i = tid; i < 1024 * 32 / 4; i += NTHR) *(LAS f32x4*)(WR + 4 * i) = *(const GAS f32x4*)(w_router + 4 * i);
        if (tid < 32) HIST[tid] = 0;
        __syncthreads();
        for (int tg = vcu; tg < T_TOK / 64; tg += G) {
            const int tl = tid >> 3, eg = tid & 7; const int tok = tg * 64 + tl;
            f32x4 a = {0.f, 0.f, 0.f, 0.f}; const GAS f32x4* hr = (const GAS f32x4*)(H1F + (size_t)tok * DM);
            for (int k4 = 0; k4 < 256; ++k4) { const f32x4 hv = hr[k4];
                a += hv.x * *(const LAS f32x4*)(WR + (4 * k4 + 0) * 32 + 4 * eg); a += hv.y * *(const LAS f32x4*)(WR + (4 * k4 + 1) * 32 + 4 * eg);
                a += hv.z * *(const LAS f32x4*)(WR + (4 * k4 + 2) * 32 + 4 * eg); a += hv.w * *(const LAS f32x4*)(WR + (4 * k4 + 3) * 32 + 4 * eg); }
            const f32x4 br = *(const f32x4*)(b_router + 4 * eg);
            *(LAS f32x4*)(LOG + tl * 32 + 4 * eg) = a + br;
            __syncthreads();
            int te[4] = {0, 0, 0, 0}, tr[4] = {0, 0, 0, 0}; float tg_[4] = {0.f, 0.f, 0.f, 0.f};
            if (tid < 64) { const int t2 = tg * 64 + tid; float lv[32];
#pragma unroll
                for (int e = 0; e < 32; ++e) lv[e] = LOG[tid * 32 + e];
                float tv[4];
#pragma unroll
                for (int k = 0; k < 4; ++k) { float best = -3.0e38f; int bi = 0;
#pragma unroll
                    for (int e = 0; e < 32; ++e) { if (lv[e] > best) { best = lv[e]; bi = e; } }
                    tv[k] = best; te[k] = bi;
#pragma unroll
                    for (int e = 0; e < 32; ++e) if (e == bi) lv[e] = -3.0e38f; }
                float ssum = 0.f;
#pragma unroll
                for (int k = 0; k < 4; ++k) { tg_[k] = expf(tv[k] - tv[0]); ssum += tg_[k]; }
#pragma unroll
                for (int k = 0; k < 4; ++k) { tg_[k] /= ssum; tr[k] = atomicAdd((int*)(HIST + te[k]), 1); }
                (void)t2; }
            __syncthreads();
            if (tid < 32) BASE[tid] = (int)__hip_atomic_fetch_add(ctl + CW_CNT + tid, (unsigned)HIST[tid], __ATOMIC_RELAXED, __HIP_MEMORY_SCOPE_AGENT);
            __syncthreads();
            if (tid < 64) { const int t2 = tg * 64 + tid;
#pragma unroll
                for (int k = 0; k < 4; ++k) { const int e = te[k], pos = BASE[e] + tr[k];
                    TOKOF[(size_t)e * T_TOK + pos] = t2; PAIR_E[t2 * 4 + k] = e; PAIR_POS[t2 * 4 + k] = pos; PAIR_G[t2 * 4 + k] = tg_[k]; } }
            __syncthreads();
            if (tid < 32) HIST[tid] = 0;
            __syncthreads();
        }
    }
    SEAM(7);

#define GROUPED_PREP(NT_, GATHER_) do { \
        LAS int* CUM = (LAS int*)(ldsl + TBL_CUM); LAS int* CNT = (LAS int*)(ldsl + TBL_CNT); LAS int* DESC = (LAS int*)(ldsl + TBL_DESC); LAS int* IDX = (LAS int*)(ldsl + TBL_IDX); \
        if (tid == 0) { int c = 0; for (int e = 0; e < NE; ++e) { const int n = (int)__hip_atomic_load(ctl + CW_CNT + e, __ATOMIC_RELAXED, __HIP_MEMORY_SCOPE_AGENT); CNT[e] = n; CUM[e] = c; c += (n + 255) >> 8; } CUM[NE] = c; } \
        __syncthreads(); \
        if (tid < pg8::MAXU) { const int nwg = (NT_) * CUM[NE]; const long L = (long)tid * G + bx; int valid = 0, ab = 0, bb = 0, pn = 0, e = 0, pm = 0; \
            if (L < nwg) { int wgid = (int)L; { const int q = nwg / 8, r = nwg % 8, xcd = wgid % 8, off = wgid / 8; wgid = (xcd < r ? xcd * (q + 1) : r * (q + 1) + (xcd - r) * q) + off; } \
                while (e < NE - 1 && wgid >= (NT_) * CUM[e + 1]) ++e; \
                const int r2 = wgid - (NT_) * CUM[e], te_ = CUM[e + 1] - CUM[e]; pn = r2 / te_; pm = r2 % te_; ab = CUM[e] + pm; bb = e * (NT_) + pn; valid = 1; } \
            DESC[tid * 8 + 0] = valid; DESC[tid * 8 + 1] = ab; DESC[tid * 8 + 2] = bb; DESC[tid * 8 + 3] = pn; DESC[tid * 8 + 4] = e; DESC[tid * 8 + 5] = pm; } \
        __syncthreads(); \
        if (GATHER_) { for (int i = 0; i < pg8::MAXU; ++i) { if (DESC[i * 8] == 0) break; const int e = DESC[i * 8 + 4], pm = DESC[i * 8 + 5]; \
            if (tid < 256) { const int slot = pm * 256 + tid; IDX[i * 256 + tid] = slot < CNT[e] ? TOKOF[(size_t)e * T_TOK + slot] : 0; } } \
            __syncthreads(); } } while (0)
    if (IN(8)) {
        GROUPED_PREP(8, true);
        pg8::Gemm g{H1B, WGU_T, T_TOK, 2048, DM}; pg8::GroupedOrder S{(const LAS int*)(ldsl + TBL_DESC), (const LAS int*)(ldsl + TBL_IDX)};
        pg8::EpiAct E{ACT, b_gate_up};
        pg8::gemm_phase<pg8::EpiAct, pg8::GroupedOrder, true, true, true>(ldsl + RING_OFF, g, S, E);
    }
    SEAM(8);
    if (IN(9)) {
        GROUPED_PREP(4, false);
        pg8::Gemm g{ACT, WDN_T, SLOT_ROWS, 1024, DFF}; pg8::GroupedOrder S{(const LAS int*)(ldsl + TBL_DESC), (const LAS int*)(ldsl + TBL_IDX)};
        pg8::EpiDown E{YS, b_down};
        pg8::gemm_phase<pg8::EpiDown, pg8::GroupedOrder, true, true, false>(ldsl + RING_OFF, g, S, E);
    }
    SEAM(9);

    if (IN(10)) {
        LAS int* CUM = (LAS int*)(ldsl + TBL_CUM);
        if (tid == 0) { int c = 0; for (int e = 0; e < NE; ++e) { const int n = (int)__hip_atomic_load(ctl + CW_CNT + e, __ATOMIC_RELAXED, __HIP_MEMORY_SCOPE_AGENT); CUM[e] = c; c += (n + 255) >> 8; } CUM[NE] = c; }
        __syncthreads();
        const int gw = vcu * NWAVES + wave, NGW = G * NWAVES;
        for (int m = gw; m < T_TOK; m += NGW) { const GAS f32x4* hr = (const GAS f32x4*)(H1F + (size_t)m * DM) + lane; f32x4 v[4], y[4];
#pragma unroll
            for (int j = 0; j < 4; ++j) v[j] = hr[64 * j] * DN_ALPHA;
#pragma unroll
            for (int k = 0; k < 4; ++k) { const int e = PAIR_E[m * 4 + k], pos = PAIR_POS[m * 4 + k]; const float gk = PAIR_G[m * 4 + k];
                const GAS unsigned long long* yr = (const GAS unsigned long long*)(YS + ((size_t)CUM[e] * 256 + pos) * 1024) + lane;
#pragma unroll
                for (int j = 0; j < 4; ++j) { const unsigned long long w = yr[64 * j]; const unsigned wl = (unsigned)w, wh = (unsigned)(w >> 32);
                    v[j].x += gk * pg8::bf_lo(wl); v[j].y += gk * pg8::bf_hi(wl); v[j].z += gk * pg8::bf_lo(wh); v[j].w += gk * pg8::bf_hi(wh); } }
            ln_row(v, y, ln_ffn_g, ln_ffn_b, lane);
            GAS f32x4* orow = (GAS f32x4*)(out + (size_t)m * DM) + lane;
#pragma unroll
            for (int j = 0; j < 4; ++j) orow[64 * j] = y[j]; }
    }
#undef IN
#undef SEAM
#undef GROUPED_PREP
}

#ifndef MK_SPLIT
#define MK_SPLIT 1
#endif
extern "C" void kernel_launch(void* const* d_in, const int* in_sizes, int n_in, void* d_out, int out_size, void* d_ws, size_t ws_size, hipStream_t stream) {
    static int grid = 0;
    if (grid == 0) {
        if (n_in != 21 || in_sizes[0] != T_TOK * DM || out_size != T_TOK * DM || ws_size < WS_END) {
            fprintf(stderr, "kernel_launch: built for 21 inputs, x/out of %d floats, >= %zu bytes of workspace; got n_in %d, in0 %d, out %d, ws %zu; nothing launched\n", T_TOK * DM, (size_t)WS_END, n_in, n_in > 0 ? in_sizes[0] : -1, out_size, ws_size); grid = -1; return; }
        int dev = 0, cus = 0, per_cu = 0;
        if (hipGetDevice(&dev) != hipSuccess || hipDeviceGetAttribute(&cus, hipDeviceAttributeMultiprocessorCount, dev) != hipSuccess) { fprintf(stderr, "kernel_launch: device query failed\n"); grid = -1; return; }
        if (hipFuncSetAttribute((const void*)mega_fwd, hipFuncAttributeMaxDynamicSharedMemorySize, LDS_BYTES) != hipSuccess) { fprintf(stderr, "kernel_launch: hipFuncSetAttribute failed\n"); grid = -1; return; }
        if (hipOccupancyMaxActiveBlocksPerMultiprocessor(&per_cu, (const void*)mega_fwd, NTHR, LDS_BYTES) != hipSuccess || per_cu < 1) fprintf(stderr, "kernel_launch: occupancy query reports %d blocks per CU\n", per_cu);
        (void)hipGetLastError();
        grid = cus;
        if (grid != 256) { fprintf(stderr, "kernel_launch: this kernel's work split needs exactly 256 CUs, device has %d; nothing launched\n", grid); grid = -1; return; }
    }
    if (grid < 0) return;
    if (hipMemsetAsync((char*)d_ws + WS_CTL, 0, CTL_ZERO_BYTES, stream) != hipSuccess) { fprintf(stderr, "kernel_launch: hipMemsetAsync failed\n"); return; }
    Args a{};
    for (int i = 0; i < 21; ++i) a.in[i] = (const float*)d_in[i];
    a.out = (float*)d_out; a.ws = (unsigned char*)d_ws;
#if MK_SPLIT
    for (int p = 0; p < NPH; ++p) { a.ph_lo = p; a.ph_hi = p + 1; a.li = p; hipLaunchKernelGGL(mega_fwd, dim3(grid), dim3(NTHR), LDS_BYTES, stream, a); }
#else
    a.ph_lo = 0; a.ph_hi = NPH; a.li = 0;
    hipLaunchKernelGGL(mega_fwd, dim3(grid), dim3(NTHR), LDS_BYTES, stream, a);
#endif
    const hipError_t le = hipPeekAtLastError();
    if (le != hipSuccess) fprintf(stderr, "kernel_launch: launch failed: %s\n", hipGetErrorName(le));
}
```

```cpp
#define DUP_MASK 0
#include <hip/hip_runtime.h>
#include <hip/hip_bf16.h>
#include <cstdio>
#include <cstdint>
#include <cmath>
namespace pg8 {
#define PG8_LAS __attribute__((address_space(3)))
typedef unsigned short bf16_t;
typedef short bf16x8 __attribute__((ext_vector_type(8)));
typedef float f32x4 __attribute__((ext_vector_type(4)));
typedef unsigned u32x4 __attribute__((ext_vector_type(4)));
constexpr int BM = 256, BK = 64, HALF = 128, HTB = HALF * BK * 2  , STAGE_BYTES = 8 * HTB, NXCD = 8, WGM = 8;

__host__ __device__ __forceinline__ int lds_byte(int r, int c) { const int st = (r >> 4) * 2 + (c >> 5), rr = r & 15, cc = c & 31, ob = rr * 64 + cc * 2; return st * 1024 + (ob ^ (((ob >> 9) & 1) << 5)); }
__host__ __device__ __forceinline__ void stage_rc(int b, int& R, int& C) { const int st = b / 1024, sb = b % 1024, swz = sb ^ (((sb >> 9) & 1) << 5); R = (st >> 1) * 16 + swz / 64; C = (st & 1) * 32 + (swz % 64) / 2; }
__host__ __device__ __forceinline__ int perm32(int rho) { const int n = rho >> 4, i = rho & 15; return 8 * (i >> 2) + 4 * n + (i & 3); }

struct Unit { int pm, pn, ab, bb, aux; };
struct Gemm { const bf16_t* A; const bf16_t* Bt; int M, N, K; };

struct StaticOrder {
    int nM, nN, nwg, G, c;
    __host__ __device__ void init(int M, int N, int G_, int c_) { nM = M / BM; nN = N / BM; nwg = nM * nN; G = G_; c = c_; }
    __host__ __device__ bool next(int i, Unit& u) const {
        const long L = (long)i * G + c; if (L >= nwg) return false;
        int wgid = (int)L; { const int q = nwg / NXCD, r = nwg % NXCD, xcd = wgid % NXCD, off = wgid / NXCD; wgid = (xcd < r ? xcd * (q + 1) : r * (q + 1) + (xcd - r) * q) + off; }
        const int nig = WGM * nN, gid = wgid / nig, fm = gid * WGM, gsz = (nM - fm) < WGM ? (nM - fm) : WGM;
        u.pm = fm + ((wgid % nig) % gsz); u.pn = (wgid % nig) / gsz; u.ab = u.pm; u.bb = u.pn; u.aux = 0; return true;
    }
    __device__ __forceinline__ void a_ready(const Unit&) const {}
    __device__ __forceinline__ void done(const Unit&) const {}
    __device__ __forceinline__ const PG8_LAS int* rowidx(int) const { return nullptr; }
};

__device__ __forceinline__ unsigned cvt_pk_bf16(float lo, float hi) { unsigned r; asm volatile("v_cvt_pk_bf16_f32 %0, %1, %2" : "=v"(r) : "v"(lo), "v"(hi)); return r; }
typedef float f32x2 __attribute__((ext_vector_type(2)));
__device__ __forceinline__ f32x2 gelu_pk(f32x2 v) {
    const f32x2 av = __builtin_elementwise_abs(v), d = av * 0.2316418882f + 1.0f;
    f32x2 t; t.x = __builtin_amdgcn_rcpf(d.x); t.y = __builtin_amdgcn_rcpf(d.y);
    f32x2 q = t * 0.5307027145f + (-0.7265760135f); q = q * t + 0.7107068705f; q = q * t + (-0.142248368f); q = q * t + 0.127414796f; q = q * t;
    const f32x2 s = (v * v) * (-0.72134752044f);
    f32x2 e; e.x = __builtin_amdgcn_exp2f(s.x); e.y = __builtin_amdgcn_exp2f(s.y);
    const f32x2 m = v * (q * e), r = v - m;
    f32x2 o; o.x = v.x < 0.f ? m.x : r.x; o.y = v.y < 0.f ? m.y : r.y; return o;
}

template <int ACT  > struct EpiBf16 {
    static constexpr bool PERM = true, AFTER_DRAIN = false; static_assert(ACT == 0 || ACT == 1, "EpiBf16: ACT is 0 (none) or 1 (gelu_pk)");
    bf16_t* O; int ldc; const float* bias; int split_cols; size_t split_stride; float scale0;
    __device__ __forceinline__ void operator()(const f32x4 (&acc)[2][2][4][2], const Unit& u, int wr, int wc, int fr, int fq) const {
        const int row0 = u.pm * BM + wr * 64 + fr; int colt = u.pn * BM; bf16_t* base = O;
        float sc = 1.f; if (split_cols) { const int t = colt / split_cols; base += (size_t)t * split_stride; colt -= t * split_cols; if (t == 0) sc = scale0; }
        const int col0 = colt + wc * 32 + 8 * fq, bcol0 = u.pn * BM + wc * 32 + 8 * fq;
        f32x4 bv[2][2];
#pragma unroll
        for (int bj = 0; bj < 2; ++bj)
#pragma unroll
            for (int n = 0; n < 2; ++n) bv[bj][n] = bias ? *(const f32x4*)(bias + bcol0 + bj * HALF + 4 * n) : (f32x4){0.f, 0.f, 0.f, 0.f};
#pragma unroll
        for (int ai = 0; ai < 2; ++ai)
#pragma unroll
            for (int m = 0; m < 4; ++m) { bf16_t* rowp = base + (size_t)(row0 + ai * HALF + m * 16) * ldc + col0;
#pragma unroll
                for (int bj = 0; bj < 2; ++bj) { f32x4 v0 = acc[ai][bj][m][0] + bv[bj][0], v1 = acc[ai][bj][m][1] + bv[bj][1];
                    if (ACT == 1) { f32x2 a = gelu_pk((f32x2){v0[0], v0[1]}), b = gelu_pk((f32x2){v0[2], v0[3]}), c = gelu_pk((f32x2){v1[0], v1[1]}), d = gelu_pk((f32x2){v1[2], v1[3]});
                        v0 = (f32x4){a.x, a.y, b.x, b.y}; v1 = (f32x4){c.x, c.y, d.x, d.y}; }
                    v0 = v0 * sc; v1 = v1 * sc; u32x4 w; w.x = cvt_pk_bf16(v0[0], v0[1]); w.y = cvt_pk_bf16(v0[2], v0[3]); w.z = cvt_pk_bf16(v1[0], v1[1]); w.w = cvt_pk_bf16(v1[2], v1[3]);
                    *(u32x4*)(rowp + bj * HALF) = w; } }
    }
};

struct PanelStats {
    unsigned* xbuf;
    unsigned* cnt;
    unsigned* tmo;
    int ntn; float eps;
    unsigned code;
    __device__ __forceinline__ bool run(const f32x4 (&v)[2][2][4][2], const Unit& u, int wr, int wc, int fr, int fq, PG8_LAS unsigned char* lds, int wid, int lane) const {
        typedef float f32x2v __attribute__((ext_vector_type(2)));
        PG8_LAS f32x2v* P = (PG8_LAS f32x2v*)lds;
        PG8_LAS f32x2v* S = (PG8_LAS f32x2v*)(lds + 8192);
        PG8_LAS unsigned* flag = (PG8_LAS unsigned*)(lds + 8192 + 2048);
#pragma unroll
        for (int ai = 0; ai < 2; ++ai)
#pragma unroll
            for (int m = 0; m < 4; ++m) {
                float s = 0.f;
#pragma unroll
                for (int bj = 0; bj < 2; ++bj)
#pragma unroll
                    for (int n = 0; n < 2; ++n) { const f32x4 x = v[ai][bj][m][n]; s += (x[0] + x[1]) + (x[2] + x[3]); }
                s += __shfl_xor(s, 16); s += __shfl_xor(s, 32);
                const float mw = s * (1.0f / 64.0f); float q = 0.f;
#pragma unroll
                for (int bj = 0; bj < 2; ++bj)
#pragma unroll
                    for (int n = 0; n < 2; ++n) { const f32x4 d = v[ai][bj][m][n] - mw; q += (d[0] * d[0] + d[1] * d[1]) + (d[2] * d[2] + d[3] * d[3]); }
                q += __shfl_xor(q, 16); q += __shfl_xor(q, 32);
                if (fq == 0) P[(ai * HALF + wr * 64 + m * 16 + fr) * 4 + wc] = (f32x2v){mw, q};
            }
        asm volatile("s_waitcnt lgkmcnt(0)" ::: "memory"); __builtin_amdgcn_s_barrier(); asm volatile("" ::: "memory");
#if defined(BROKEN_EXCHANGE_NO_WAIT)
#warning BROKEN CONTROL BUILD: the row-statistics exchange does not wait; results are wrong by design
        if (blockIdx.x >= 64) { const long long t0_ = clock64(); while (clock64() - t0_ < 60000) __builtin_amdgcn_s_sleep(8); }
#endif
        const int row = wid * 32 + (lane & 31);
        if (lane < 32) {
            const f32x2v a = P[row * 4 + 0], b = P[row * 4 + 1], c = P[row * 4 + 2], d = P[row * 4 + 3];
            const float mt = (a.x + b.x + c.x + d.x) * 0.25f;
            const float da = a.x - mt, db = b.x - mt, dc = c.x - mt, dd = d.x - mt;
            const float m2 = (a.y + b.y) + (c.y + d.y) + 64.0f * ((da * da + db * db) + (dc * dc + dd * dd));
            unsigned long long* slot = (unsigned long long*)xbuf + ((size_t)(u.pm * BM + row) * 4 + u.pn);
            __hip_atomic_store(slot, ((unsigned long long)__float_as_uint(m2) << 32) | __float_as_uint(mt), __ATOMIC_RELAXED, __HIP_MEMORY_SCOPE_AGENT);
        }
        asm volatile("s_waitcnt vmcnt(0)" ::: "memory");
        if (lane == 0) __hip_atomic_fetch_add(cnt + 64 * u.pm, 1u, __ATOMIC_RELAXED, __HIP_MEMORY_SCOPE_AGENT);
        if (wid == 0) {
            bool dead = false; const unsigned long long t0 = __builtin_amdgcn_s_memrealtime(); const unsigned want = 8u * (unsigned)ntn;
            for (;;) {
#if defined(BROKEN_EXCHANGE_NO_WAIT)
                break;
#endif
                if ((unsigned)__builtin_amdgcn_readfirstlane(__hip_atomic_load(cnt + 64 * u.pm, __ATOMIC_RELAXED, __HIP_MEMORY_SCOPE_AGENT)) >= want) break;
                if (__builtin_amdgcn_s_memrealtime() - t0 > 2000000ull) {
                    if (lane == 0) { unsigned expect = 0u; __hip_atomic_compare_exchange_strong(tmo + 1, &expect, code | (unsigned)(u.pm & 0xff), __ATOMIC_RELAXED, __ATOMIC_RELAXED, __HIP_MEMORY_SCOPE_AGENT);
                                     __hip_atomic_store(tmo, 1u, __ATOMIC_RELAXED, __HIP_MEMORY_SCOPE_AGENT); }
                    dead = true; break; }
                __builtin_amdgcn_s_sleep(2);
            }
            __builtin_amdgcn_fence(__ATOMIC_ACQUIRE, "agent");
            if (lane == 0) flag[0] = dead ? 1u : 0u;
        }
        asm volatile("s_waitcnt vmcnt(0) lgkmcnt(0)" ::: "memory"); __builtin_amdgcn_s_barrier(); asm volatile("" ::: "memory");
        const bool bad = flag[0] != 0u;
        if (lane < 32) {
            const unsigned long long* slot = (const unsigned long long*)xbuf + (size_t)(u.pm * BM + row) * 4; float mt[4], m2[4]; float ms = 0.f;
#pragma unroll
            for (int t = 0; t < 4; ++t) { if (t < ntn) { const unsigned long long w = __hip_atomic_load(slot + t, __ATOMIC_RELAXED, __HIP_MEMORY_SCOPE_AGENT); mt[t] = __uint_as_float((unsigned)w); m2[t] = __uint_as_float((unsigned)(w >> 32)); } else { mt[t] = 0.f; m2[t] = 0.f; } ms += mt[t]; }
            const float mean = ms / (float)ntn; float q = 0.f;
#pragma unroll
            for (int t = 0; t < 4; ++t) if (t < ntn) { const float dm = mt[t] - mean; q += m2[t] + 256.0f * dm * dm; }
            S[row] = (f32x2v){mean, 1.0f / sqrtf(q / (256.0f * (float)ntn) + eps)};
        }
        asm volatile("s_waitcnt lgkmcnt(0)" ::: "memory"); __builtin_amdgcn_s_barrier(); asm volatile("" ::: "memory");
        return bad;
    }
};
struct EpiLnRes {
    static constexpr bool PERM = false, AFTER_DRAIN = true;
    const float* base; float* out; int ldc; const float* bias; PanelStats st; unsigned poison;
    __device__ __forceinline__ void fused(f32x4 (&acc)[2][2][4][2], const Unit& u, int wr, int wc, int fr, int fq, PG8_LAS unsigned char* lds, int wid, int lane) const {
        typedef float f32x2v __attribute__((ext_vector_type(2)));
        const PG8_LAS f32x2v* S = (const PG8_LAS f32x2v*)(lds + 8192);
        const int col0 = u.pn * BM + wc * 32 + 4 * fq;
#pragma unroll
        for (int bj = 0; bj < 2; ++bj)
#pragma unroll
            for (int n = 0; n < 2; ++n) { const f32x4 bv = bias ? *(const f32x4*)(bias + col0 + bj * HALF + n * 16) : (f32x4){0.f, 0.f, 0.f, 0.f};
#pragma unroll
                for (int ai = 0; ai < 2; ++ai)
#pragma unroll
                    for (int m = 0; m < 4; ++m) acc[ai][bj][m][n] += bv; }
        f32x4 pre[4][2][2];
#pragma unroll
        for (int m = 0; m < 4; ++m) { const size_t off = (size_t)(u.pm * BM + wr * 64 + m * 16 + fr) * ldc + col0;
#pragma unroll
            for (int bj = 0; bj < 2; ++bj)
#pragma unroll
                for (int n = 0; n < 2; ++n) pre[m][bj][n] = *(const f32x4*)(base + off + bj * HALF + n * 16); }
        const bool bad = st.run(acc, u, wr, wc, fr, fq, lds, wid, lane) || poison != 0u;
        const float qnan = __builtin_nanf("");
#pragma unroll
        for (int ai = 0; ai < 2; ++ai)
#pragma unroll
            for (int m = 0; m < 4; ++m) { const int r = ai * HALF + wr * 64 + m * 16 + fr; const f32x2v sr = S[r]; const size_t off = (size_t)(u.pm * BM + r) * ldc + col0;
#pragma unroll
                for (int bj = 0; bj < 2; ++bj)
#pragma unroll
                    for (int n = 0; n < 2; ++n) { const f32x4 bs = ai == 0 ? pre[m][bj][n] : *(const f32x4*)(base + off + bj * HALF + n * 16); f32x4 o = bs + (acc[ai][bj][m][n] - sr.x) * sr.y;
                        if (bad) o = (f32x4){qnan, qnan, qnan, qnan}; *(f32x4*)(out + off + bj * HALF + n * 16) = o; }
                if (m & 1) asm volatile("" ::: "memory"); }
    }
};
struct EpiLnResLn {
    static constexpr bool PERM = false, AFTER_DRAIN = true;
    const float* base; float* out; bf16_t* xn; int ldc; const float* bias; PanelStats st1, st2; unsigned poison;
    __device__ __forceinline__ void fused(f32x4 (&acc)[2][2][4][2], const Unit& u, int wr, int wc, int fr, int fq, PG8_LAS unsigned char* lds, int wid, int lane) const {
        typedef float f32x2v __attribute__((ext_vector_type(2))); typedef unsigned u32x2v __attribute__((ext_vector_type(2)));
        const PG8_LAS f32x2v* S = (const PG8_LAS f32x2v*)(lds + 8192);
        const int col0 = u.pn * BM + wc * 32 + 4 * fq;
#pragma unroll
        for (int bj = 0; bj < 2; ++bj)
#pragma unroll
            for (int n = 0; n < 2; ++n) { const f32x4 bv = bias ? *(const f32x4*)(bias + col0 + bj * HALF + n * 16) : (f32x4){0.f, 0.f, 0.f, 0.f};
#pragma unroll
                for (int ai = 0; ai < 2; ++ai)
#pragma unroll
                    for (int m = 0; m < 4; ++m) acc[ai][bj][m][n] += bv; }
        bool bad = st1.run(acc, u, wr, wc, fr, fq, lds, wid, lane) || poison != 0u;
        const float qnan = __builtin_nanf("");
#pragma unroll
        for (int ai = 0; ai < 2; ++ai)
#pragma unroll
            for (int m = 0; m < 4; ++m) { const int r = ai * HALF + wr * 64 + m * 16 + fr; const f32x2v sr = S[r]; const size_t off = (size_t)(u.pm * BM + r) * ldc + col0;
#pragma unroll
                for (int bj = 0; bj < 2; ++bj)
#pragma unroll
                    for (int n = 0; n < 2; ++n) { const f32x4 bs = *(const f32x4*)(base + off + bj * HALF + n * 16); acc[ai][bj][m][n] = bs + (acc[ai][bj][m][n] - sr.x) * sr.y; }
                asm volatile("" : "+v"(acc[ai][0][m][0]), "+v"(acc[ai][0][m][1]), "+v"(acc[ai][1][m][0]), "+v"(acc[ai][1][m][1]));
                if (m & 1) asm volatile("" ::: "memory"); }
        const bool bad1 = bad;
        bad = st2.run(acc, u, wr, wc, fr, fq, lds, wid, lane) || bad;
#pragma unroll
        for (int ai = 0; ai < 2; ++ai)
#pragma unroll
            for (int m = 0; m < 4; ++m) { const int r = ai * HALF + wr * 64 + m * 16 + fr; const f32x2v sr = S[r]; const size_t off = (size_t)(u.pm * BM + r) * ldc + col0;
#pragma unroll
                for (int bj = 0; bj < 2; ++bj)
#pragma unroll
                    for (int n = 0; n < 2; ++n) { const f32x4 x1 = acc[ai][bj][m][n]; *(f32x4*)(out + off + bj * HALF + n * 16) = bad1 ? (f32x4){qnan, qnan, qnan, qnan} : x1;
                        const f32x4 o = (x1 - sr.x) * sr.y; u32x2v w; w.x = cvt_pk_bf16(o[0], o[1]); w.y = cvt_pk_bf16(o[2], o[3]);
                        if (bad) { w.x = 0x7fc07fc0u; w.y = 0x7fc07fc0u; } *(u32x2v*)(xn + off + bj * HALF + n * 16) = w; }
                asm volatile("" ::: "memory"); }
    }
};

template <class E, class = void> struct epi_chains { static constexpr bool value = false; };
template <class E> struct epi_chains<E, decltype((void)E::CHAIN)> { static constexpr bool value = E::CHAIN; };
template <class Epi, class Sched, bool ALIGN_EPI = false, bool SP2 = false, bool GATHER = false>
__device__ __forceinline__ void gemm_phase(PG8_LAS unsigned char* lds, const Gemm g, const Sched& S, const Epi& E) {
    const int tid = threadIdx.x, wid = __builtin_amdgcn_readfirstlane(tid >> 6), lane = tid & 63, wr = wid >> 2, wc = wid & 3, fr = lane & 15, fq = lane >> 4;
    const int K = g.K, nt = K / BK;
    unsigned voffA[2], voffB[2]; int gR[2], gC[2];
#pragma unroll
    for (int i = 0; i < 2; ++i) { int R, C; stage_rc(tid * 16 + i * 8192, R, C); const int Rb = Epi::PERM ? ((R & ~31) + perm32(R & 31)) : R;
        voffA[i] = (unsigned)(R * K + C) * 2u; voffB[i] = (unsigned)(Rb * K + C) * 2u; gR[i] = R; gC[i] = C; }
    const size_t kstep = (size_t)(BK * 2);
    const size_t hstep = (size_t)HALF * K * 2;
    const size_t tstep = 2 * hstep;
    const unsigned ldsw = (unsigned)wid * 1024u;
    const int aoff = lds_byte(wr * 64 + fr, fq * 8), boff = lds_byte(wc * 32 + fr, fq * 8);
#define PG8_SA(b, h) (((b) * 2 + (h)) * HTB)
#define PG8_SB(b, h) ((4 + (b) * 2 + (h)) * HTB)
#define PG8_STAGE(bufoff, gbase, voff) do { _Pragma("unroll") for (int _i = 0; _i < 2; ++_i) \
        __builtin_amdgcn_global_load_lds((const unsigned*)((const char*)(gbase) + (voff)[_i]), (PG8_LAS unsigned*)(lds + (bufoff) + ldsw + _i * 8192), 16, 0, 0); } while (0)
#define PG8_STAGE_A(bufoff, gbase, h, nx) do { const unsigned _v0 = GATHER ? ((nx) ? vaN[h][0] : vaC[h][0]) : voffA[0], _v1 = GATHER ? ((nx) ? vaN[h][1] : vaC[h][1]) : voffA[1]; \
        const char* _gb = (const char*)(gbase) + (GATHER ? (size_t)0 : (size_t)(h) * hstep); \
        __builtin_amdgcn_global_load_lds((const unsigned*)(_gb + _v0), (PG8_LAS unsigned*)(lds + (bufoff) + ldsw), 16, 0, 0); \
        __builtin_amdgcn_global_load_lds((const unsigned*)(_gb + _v1), (PG8_LAS unsigned*)(lds + (bufoff) + ldsw + 8192), 16, 0, 0); } while (0)
#define PG8_LOADVA(va, uix) do { const PG8_LAS int* _ip = S.rowidx(uix); _Pragma("unroll") for (int _h = 0; _h < 2; ++_h) _Pragma("unroll") for (int _i = 0; _i < 2; ++_i) \
        va[_h][_i] = ((unsigned)_ip[_h * HALF + gR[_i]] * (unsigned)K + (unsigned)gC[_i]) * 2u; } while (0)
#define PG8_LDA(dst, b, h) do { _Pragma("unroll") for (int m = 0; m < 4; ++m) _Pragma("unroll") for (int k = 0; k < 2; ++k) dst[m][k] = *(const PG8_LAS bf16x8*)(lds + PG8_SA(b, h) + aoff + m * 2048 + k * 1024); } while (0)
#define PG8_LDB(dst, b, h) do { _Pragma("unroll") for (int n = 0; n < 2; ++n) _Pragma("unroll") for (int k = 0; k < 2; ++k) dst[n][k] = *(const PG8_LAS bf16x8*)(lds + PG8_SB(b, h) + boff + n * 2048 + k * 1024); } while (0)
#define PG8_MMA(ai, bj, At, Bt) do { __builtin_amdgcn_s_setprio(1); _Pragma("unroll") for (int m = 0; m < 4; ++m) _Pragma("unroll") for (int n = 0; n < 2; ++n) _Pragma("unroll") for (int k = 0; k < 2; ++k) \
        acc[ai][bj][m][n] = __builtin_amdgcn_mfma_f32_16x16x32_bf16(Bt[n][k], At[m][k], acc[ai][bj][m][n], 0, 0, 0); __builtin_amdgcn_s_setprio(0); } while (0)
#define PG8_WAIT_V(n) asm volatile("s_waitcnt vmcnt(" #n ")" ::: "memory")
#define PG8_WAIT_L(n) asm volatile("s_waitcnt lgkmcnt(" #n ")" ::: "memory")
#define PG8_BAR __builtin_amdgcn_s_barrier()
#define PG8_SCHED __builtin_amdgcn_sched_barrier(0)
    Unit cur, nxt; int ui = 0;
    static_assert(SP2, "only the SP2 loop is kept in this file");
    if (!S.next(0, cur)) return;
    f32x4 acc[2][2][4][2];
#pragma unroll
    for (int a = 0; a < 2; ++a)
#pragma unroll
        for (int b = 0; b < 2; ++b)
#pragma unroll
            for (int m = 0; m < 4; ++m)
#pragma unroll
                for (int n = 0; n < 2; ++n) acc[a][b][m][n] = (f32x4){0.f, 0.f, 0.f, 0.f};
    bf16x8 At[4][2], B0[2][2], B1[2][2];
    const char* cA = (const char*)g.A + (GATHER ? (size_t)0 : (size_t)cur.ab * tstep); const char* cB = (const char*)g.Bt + (size_t)cur.bb * tstep;
    unsigned vaC[2][2] = {{0u, 0u}, {0u, 0u}}, vaN[2][2] = {{0u, 0u}, {0u, 0u}};
    if constexpr (GATHER) { PG8_LOADVA(vaC, 0); }
    S.a_ready(cur);
    if constexpr (SP2) {
        PG8_STAGE(PG8_SB(0, 0), cB, voffB); PG8_STAGE(PG8_SB(0, 1), cB + hstep, voffB); PG8_STAGE_A(PG8_SA(0, 0), cA, 0, false); PG8_STAGE_A(PG8_SA(0, 1), cA, 1, false);
        if (wr == 1) PG8_BAR;
        PG8_WAIT_V(2); PG8_BAR;
        PG8_STAGE(PG8_SB(1, 0), cB + kstep, voffB); PG8_STAGE_A(PG8_SA(1, 0), cA + kstep, 0, false); PG8_STAGE(PG8_SB(1, 1), cB + hstep + kstep, voffB);
        PG8_WAIT_V(6); PG8_BAR;
    }
    for (;;) {
        const bool has_next = S.next(ui + 1, nxt);
        const char* nA = (has_next && !GATHER) ? (const char*)g.A + (size_t)nxt.ab * tstep : cA; const char* nB = has_next ? (const char*)g.Bt + (size_t)nxt.bb * tstep : cB;
        if constexpr (GATHER) { if (has_next) { PG8_LOADVA(vaN, ui + 1); } else { vaN[0][0] = vaC[0][0]; vaN[0][1] = vaC[0][1]; vaN[1][0] = vaC[1][0]; vaN[1][1] = vaC[1][1]; } }
        for (int t = 0; t < nt; t += 2) {
            const bool last = (t == nt - 2);
            const char* a1 = cA + (size_t)(t + 1) * kstep;
            const char* a2 = last ? nA : cA + (size_t)(t + 2) * kstep; const char* b2 = last ? nB : cB + (size_t)(t + 2) * kstep;
            const char* a3 = a2 + kstep; const char* b3 = b2 + kstep;
            if (last && has_next) S.a_ready(nxt);
            if constexpr (SP2) {
            PG8_LDB(B0, 0, 0); PG8_LDB(B1, 0, 1); PG8_SCHED; PG8_LDA(At, 0, 0); PG8_STAGE_A(PG8_SA(1, 1), a1, 1, false);
            PG8_WAIT_V(8); PG8_WAIT_L(0); PG8_BAR; PG8_MMA(0, 0, At, B0); PG8_MMA(0, 1, At, B1); PG8_BAR; PG8_SCHED;
            PG8_LDA(At, 0, 1); PG8_STAGE(PG8_SB(0, 0), b2, voffB); PG8_STAGE(PG8_SB(0, 1), b2 + hstep, voffB); PG8_STAGE_A(PG8_SA(0, 0), a2, 0, last);
            PG8_WAIT_V(8); PG8_WAIT_L(0); PG8_BAR; PG8_MMA(1, 0, At, B0); PG8_MMA(1, 1, At, B1); PG8_BAR; PG8_SCHED;
            PG8_LDB(B0, 1, 0); PG8_LDB(B1, 1, 1); PG8_SCHED; PG8_LDA(At, 1, 0); PG8_STAGE_A(PG8_SA(0, 1), a2, 1, last);
            PG8_WAIT_V(8); PG8_WAIT_L(0); PG8_BAR; PG8_MMA(0, 0, At, B0); PG8_MMA(0, 1, At, B1); PG8_BAR; PG8_SCHED;
            PG8_LDA(At, 1, 1); PG8_STAGE(PG8_SB(1, 0), b3, voffB); PG8_STAGE(PG8_SB(1, 1), b3 + hstep, voffB); PG8_STAGE_A(PG8_SA(1, 0), a3, 0, last);
            PG8_WAIT_V(8); PG8_WAIT_L(0); PG8_BAR; PG8_MMA(1, 0, At, B0); PG8_MMA(1, 1, At, B1); PG8_BAR; PG8_SCHED;
            }
        }
        if constexpr (ALIGN_EPI) { if (wr == 0) PG8_BAR; }
        if constexpr (!Epi::AFTER_DRAIN) { E(acc, cur, wr, wc, fr, fq); S.done(cur); }
        if (!has_next) break;
        if (!epi_chains<Epi>::value || cur.aux != 0) {
#pragma unroll
        for (int a = 0; a < 2; ++a)
#pragma unroll
            for (int b = 0; b < 2; ++b)
#pragma unroll
                for (int m = 0; m < 4; ++m)
#pragma unroll
                    for (int n = 0; n < 2; ++n) acc[a][b][m][n] = (f32x4){0.f, 0.f, 0.f, 0.f};
        }
        cur = nxt; cA = nA; cB = nB; ++ui;
        if constexpr (GATHER) { vaC[0][0] = vaN[0][0]; vaC[0][1] = vaN[0][1]; vaC[1][0] = vaN[1][0]; vaC[1][1] = vaN[1][1]; }
        if constexpr (ALIGN_EPI) { if (wr == 1) PG8_BAR; }
    }
    PG8_WAIT_V(0);
    if constexpr (!ALIGN_EPI) { if (wr == 0) PG8_BAR; }
    PG8_BAR;
    if constexpr (Epi::AFTER_DRAIN) { E.fused(acc, cur, wr, wc, fr, fq, lds, wid, lane); S.done(cur); }
#undef PG8_SA
#undef PG8_SB
#undef PG8_STAGE
#undef PG8_STAGE_A
#undef PG8_LOADVA
#undef PG8_LDA
#undef PG8_LDB
#undef PG8_MMA
#undef PG8_WAIT_V
#undef PG8_WAIT_L
#undef PG8_BAR
#undef PG8_SCHED
}
}
namespace pg8 {
__device__ __forceinline__ float bf_lo(unsigned w) { return __uint_as_float(w << 16); }
__device__ __forceinline__ float bf_hi(unsigned w) { return __uint_as_float(w & 0xffff0000u); }
__device__ __forceinline__ float sigm(float x) { return __builtin_amdgcn_rcpf(1.0f + __expf(-x)); }

struct EpiF32 {
    static constexpr bool PERM = false, AFTER_DRAIN = false;
    float* C; int ldc;
    __device__ __forceinline__ void operator()(const f32x4 (&acc)[2][2][4][2], const Unit& u, int wr, int wc, int fr, int fq) const {
        const int row0 = u.pm * BM + wr * 64 + fr, col0 = u.pn * BM + wc * 32 + 4 * fq;
#pragma unroll
        for (int ai = 0; ai < 2; ++ai)
#pragma unroll
            for (int m = 0; m < 4; ++m) { float* rowp = C + (size_t)(row0 + ai * HALF + m * 16) * ldc + col0;
#pragma unroll
                for (int bj = 0; bj < 2; ++bj)
#pragma unroll
                    for (int n = 0; n < 2; ++n) *(f32x4*)(rowp + bj * HALF + n * 16) = acc[ai][bj][m][n]; }
    }
};

struct EpiProj {
    static constexpr bool PERM = true, AFTER_DRAIN = false;
    bf16_t* O; float* SMp; bf16_t* QKV;
    __device__ __forceinline__ void operator()(const f32x4 (&acc)[2][2][4][2], const Unit& u, int wr, int wc, int fr, int fq) const {
        const int row0 = u.pm * BM + wr * 64 + fr;
        if (u.pn >= 12 && u.pn < 24) {
            const int which = (u.pn - 12) >> 2, hp = (u.pn - 12) & 3; bf16_t* base = QKV + (size_t)which * (32u * 4096u * 128u) + wc * 32 + 8 * fq;
#pragma unroll
            for (int ai = 0; ai < 2; ++ai)
#pragma unroll
                for (int m = 0; m < 4; ++m) { const int row = row0 + ai * HALF + m * 16; const int b = row >> 12, s = row & 4095;
#pragma unroll
                    for (int bj = 0; bj < 2; ++bj) { const f32x4 v0 = acc[ai][bj][m][0], v1 = acc[ai][bj][m][1];
                        u32x4 w; w.x = cvt_pk_bf16(v0[0], v0[1]); w.y = cvt_pk_bf16(v0[2], v0[3]); w.z = cvt_pk_bf16(v1[0], v1[1]); w.w = cvt_pk_bf16(v1[2], v1[3]);
                        *(u32x4*)(base + ((size_t)(b * 8 + 2 * hp + bj) * 4096 + s) * 128) = w; } }
        } else if (u.pn < 32) {
            const int col0 = u.pn * BM + wc * 32 + 8 * fq;
#pragma unroll
            for (int ai = 0; ai < 2; ++ai)
#pragma unroll
                for (int m = 0; m < 4; ++m) { bf16_t* rowp = O + (size_t)(row0 + ai * HALF + m * 16) * 8192 + col0;
#pragma unroll
                    for (int bj = 0; bj < 2; ++bj) { const f32x4 v0 = acc[ai][bj][m][0], v1 = acc[ai][bj][m][1];
                        u32x4 w; w.x = cvt_pk_bf16(v0[0], v0[1]); w.y = cvt_pk_bf16(v0[2], v0[3]); w.z = cvt_pk_bf16(v1[0], v1[1]); w.w = cvt_pk_bf16(v1[2], v1[3]);
                        *(u32x4*)(rowp + bj * HALF) = w; } }
        } else if (wc == 0) {
#pragma unroll
            for (int ai = 0; ai < 2; ++ai)
#pragma unroll
                for (int m = 0; m < 4; ++m) { float* rp = SMp + (size_t)(row0 + ai * HALF + m * 16) * 32 + 8 * fq;
                    *(f32x4*)rp = acc[ai][0][m][0]; *(f32x4*)(rp + 4) = acc[ai][0][m][1]; }
        }
    }
};

struct EpiMix {
    static constexpr bool PERM = true, AFTER_DRAIN = false, CHAIN = true;
    const bf16_t* P; bf16_t* MIX; int zg_off, zf_off;
    __device__ __forceinline__ void operator()(f32x4 (&acc)[2][2][4][2], const Unit& u, int wr, int wc, int fr, int fq) const {
        const int row0 = u.pm * BM + wr * 64 + fr, col0 = u.pn * BM + wc * 32 + 8 * fq; const int kind = u.aux;
#pragma unroll
        for (int ai = 0; ai < 2; ++ai) {
            u32x4 zf[4][2], zg[4][2];
#pragma unroll
            for (int m = 0; m < 4; ++m)
#pragma unroll
                for (int bj = 0; bj < 2; ++bj) { const bf16_t* zp = P + (size_t)(row0 + ai * HALF + m * 16) * 8192 + col0 + bj * HALF;
                    zf[m][bj] = *(const u32x4*)(zp + zf_off); if (kind == 0) zg[m][bj] = *(const u32x4*)(zp + zg_off); }
#pragma unroll
            for (int m = 0; m < 4; ++m)
#pragma unroll
                for (int bj = 0; bj < 2; ++bj) {
                    const u32x4 a = zf[m][bj]; float ef[8] = {bf_lo(a.x), bf_hi(a.x), bf_lo(a.y), bf_hi(a.y), bf_lo(a.z), bf_hi(a.z), bf_lo(a.w), bf_hi(a.w)};
#pragma unroll
                    for (int j = 0; j < 8; ++j) ef[j] = 1.0f + __expf(-ef[j]);
                    if (kind == 0) {
                        const u32x4 g = zg[m][bj]; float eg[8] = {bf_lo(g.x), bf_hi(g.x), bf_lo(g.y), bf_hi(g.y), bf_lo(g.z), bf_hi(g.z), bf_lo(g.w), bf_hi(g.w)};
#pragma unroll
                        for (int j = 0; j < 8; ++j) { const float r = ef[j] * __builtin_amdgcn_rcpf(1.0f + __expf(-eg[j])); if (j < 4) acc[ai][bj][m][0][j] *= r; else acc[ai][bj][m][1][j - 4] *= r; }
                    } else {
                        float o[8];
#pragma unroll
                        for (int j = 0; j < 8; ++j) o[j] = (j < 4 ? acc[ai][bj][m][0][j] : acc[ai][bj][m][1][j - 4]) * __builtin_amdgcn_rcpf(ef[j]);
                        u32x4 w; w.x = cvt_pk_bf16(o[0], o[1]); w.y = cvt_pk_bf16(o[2], o[3]); w.z = cvt_pk_bf16(o[4], o[5]); w.w = cvt_pk_bf16(o[6], o[7]);
                        *(u32x4*)(MIX + (size_t)(row0 + ai * HALF + m * 16) * 1024 + col0 + bj * HALF) = w; } }
        }
    }
};

struct EpiAct {
    static constexpr bool PERM = true, AFTER_DRAIN = false;
    bf16_t* ACT; const float* bgu;
    __device__ __forceinline__ void operator()(const f32x4 (&acc)[2][2][4][2], const Unit& u, int wr, int wc, int fr, int fq) const {
        const int e = u.aux, c0 = wc * 32 + 8 * fq; const float* bg = bgu + (size_t)e * 2048 + u.pn * 128 + c0; const float* bu = bg + 1024;
        const f32x4 bg0 = *(const f32x4*)bg, bg1 = *(const f32x4*)(bg + 4), bu0 = *(const f32x4*)bu, bu1 = *(const f32x4*)(bu + 4);
#pragma unroll
        for (int ai = 0; ai < 2; ++ai)
#pragma unroll
            for (int m = 0; m < 4; ++m) { const size_t row = (size_t)u.ab * BM + ai * HALF + m * 16 + wr * 64 + fr;
                const f32x4 g0 = acc[ai][0][m][0] + bg0, g1 = acc[ai][0][m][1] + bg1, p0 = acc[ai][1][m][0] + bu0, p1 = acc[ai][1][m][1] + bu1;
                float o[8];
#pragma unroll
                for (int j = 0; j < 8; ++j) { const float gv = j < 4 ? g0[j & 3] : g1[j & 3], uv = j < 4 ? p0[j & 3] : p1[j & 3];
                    const float gate = fminf(gv, 7.0f), up = fminf(fmaxf(uv, -7.0f), 7.0f); o[j] = (up + 1.0f) * (gate * sigm(1.702f * gate)); }
                u32x4 w; w.x = cvt_pk_bf16(o[0], o[1]); w.y = cvt_pk_bf16(o[2], o[3]); w.z = cvt_pk_bf16(o[4], o[5]); w.w = cvt_pk_bf16(o[6], o[7]);
                *(u32x4*)(ACT + row * 1024 + u.pn * 128 + c0) = w; }
    }
};

struct EpiDown {
    static constexpr bool PERM = true, AFTER_DRAIN = false;
    bf16_t* YS; const float* bd;
    __device__ __forceinline__ void operator()(const f32x4 (&acc)[2][2][4][2], const Unit& u, int wr, int wc, int fr, int fq) const {
        const int e = u.aux, col0 = u.pn * BM + wc * 32 + 8 * fq;
        f32x4 bv[2][2];
#pragma unroll
        for (int bj = 0; bj < 2; ++bj)
#pragma unroll
            for (int n = 0; n < 2; ++n) bv[bj][n] = *(const f32x4*)(bd + (size_t)e * 1024 + col0 + bj * HALF + 4 * n);
#pragma unroll
        for (int ai = 0; ai < 2; ++ai)
#pragma unroll
            for (int m = 0; m < 4; ++m) { bf16_t* rowp = YS + ((size_t)u.ab * BM + ai * HALF + m * 16 + wr * 64 + fr) * 1024 + col0;
#pragma unroll
                for (int bj = 0; bj < 2; ++bj) { const f32x4 v0 = acc[ai][bj][m][0] + bv[bj][0], v1 = acc[ai][bj][m][1] + bv[bj][1];
                    u32x4 w; w.x = cvt_pk_bf16(v0[0], v0[1]); w.y = cvt_pk_bf16(v0[2], v0[3]); w.z = cvt_pk_bf16(v1[0], v1[1]); w.w = cvt_pk_bf16(v1[2], v1[3]);
                    *(u32x4*)(rowp + bj * HALF) = w; } }
    }
};

struct MixOrder {
    StaticOrder so;
    __device__ void init(int M, int N, int G_, int c_) { so.init(M, N, G_, c_); }
    __device__ __forceinline__ bool next(int i, Unit& u) const { if (!so.next(i >> 1, u)) return false; const int kind = i & 1; u.aux = kind; u.ab = kind * (so.nM) + u.pm; u.bb = kind * (so.nN) + u.pn; return true; }
    __device__ __forceinline__ void a_ready(const Unit&) const {}
    __device__ __forceinline__ void done(const Unit&) const {}
    __device__ __forceinline__ const PG8_LAS int* rowidx(int) const { return nullptr; }
};
constexpr int MAXU = 12;
struct GroupedOrder {
    const PG8_LAS int* desc; const PG8_LAS int* idx;
    __device__ __forceinline__ bool next(int i, Unit& u) const {
        if (i >= MAXU) return false; const PG8_LAS int* d = desc + i * 8;
        if (__builtin_amdgcn_readfirstlane(d[0]) == 0) return false;
        u.ab = __builtin_amdgcn_readfirstlane(d[1]); u.bb = __builtin_amdgcn_readfirstlane(d[2]); u.pn = __builtin_amdgcn_readfirstlane(d[3]); u.aux = __builtin_amdgcn_readfirstlane(d[4]); u.pm = u.ab; return true; }
    __device__ __forceinline__ void a_ready(const Unit&) const {}
    __device__ __forceinline__ void done(const Unit&) const {}
    __device__ __forceinline__ const PG8_LAS int* rowidx(int i) const { return idx + i * 256; }
};
}
namespace fox {
constexpr int D = 128, PKV = 128  , PO = 1024  ;
constexpr float THR = 8.f; constexpr bool WSKIP = false;
constexpr float SCALE = 0.08838834764831845f;
constexpr int NW = 8, QBLK = 32, KVBLK = 64, QB = NW * QBLK;
constexpr int SHM_V = KVBLK * D * 2, SHM_K = KVBLK * D * 2;
constexpr int LDS_BIAS = 2 * SHM_V + 2 * SHM_K + NW * 64 * 4;
constexpr int LDS_JUNK = LDS_BIAS + 2 * 4096 * 4;
constexpr int LDS_BYTES = LDS_JUNK + 256;

using bf16 = __hip_bfloat16;
typedef short bf16x8 __attribute__((ext_vector_type(8)));
typedef short s16x4 __attribute__((ext_vector_type(4)));
typedef float f32x16 __attribute__((ext_vector_type(16)));
typedef float f32x4 __attribute__((ext_vector_type(4)));
typedef unsigned u32x4 __attribute__((ext_vector_type(4)));
template <class A, class Bt> struct same_t { static constexpr bool v = false; };
template <class A> struct same_t<A, A> { static constexpr bool v = true; };

#define KSWZ(row, colB) ((row) * 256 + ((colB) ^ (((row) & 7) << 4)))
#define SBAR() __builtin_amdgcn_sched_barrier(0)
__device__ __forceinline__ int v_st(int k, int c) { const int kk = (k & ~0xC) | ((k & 4) << 1) | ((k & 8) >> 1); return ((kk >> 3) * 4 + (c >> 5)) * 512 + ((kk & 7) * 32 + (c & 31)) * 2; }
__device__ __forceinline__ int v_rd_base(int lane) { return ((lane & 3) << 3) | (((lane >> 2) & 3) << 6) | (((lane >> 4) & 1) << 5) | (((lane >> 5) & 1) << 8); }
constexpr int v_rd_off(int d0, int ks, int half) { return d0 * 512 + ks * 4096 + half * 2048; }
__device__ __forceinline__ int crow(int r, int hi) { return (r & 3) + 8 * (r >> 2) + 4 * hi; }
__device__ __forceinline__ unsigned cvtpk(float lo, float hi) {
    unsigned r; asm volatile("v_cvt_pk_bf16_f32 %0, %1, %2" : "=v"(r) : "v"(lo), "v"(hi)); return r;
}
__device__ __forceinline__ bf16x8 pack8(f32x4 a, f32x4 b) {
    u32x4 w = {cvtpk(a[0], a[1]), cvtpk(a[2], a[3]), cvtpk(b[0], b[1]), cvtpk(b[2], b[3])};
    return *reinterpret_cast<bf16x8*>(&w);
}
template <class T> __device__ __forceinline__ bf16x8 load8(const T* p) {
    if constexpr (same_t<T, float>::v) { return pack8(*(const f32x4*)p, *(const f32x4*)(p + 4)); }
    else { return *reinterpret_cast<const bf16x8*>(p); }
}
__device__ __forceinline__ void mask_tile(f32x16& p0, f32x16& p1, int dq, unsigned W) {
    const float NEG = -__builtin_inff();
#pragma unroll
    for (int r = 0; r < 16; ++r) {
        const int c = (r & 3) + 8 * (r >> 2);
        if ((unsigned)(dq - c) >= W) p0[r] = NEG;
        if ((unsigned)(dq - c - 32) >= W) p1[r] = NEG;
    }
}
__device__ __forceinline__ void partialSM(f32x16& p0, f32x16& p1, float& m_reg, float& mn, float& alpha) {
    float pmax = p0[0]; for (int r = 1; r < 16; ++r) pmax = fmaxf(pmax, p0[r]); for (int r = 0; r < 16; ++r) pmax = fmaxf(pmax, p1[r]);
    { auto rr = __builtin_amdgcn_permlane32_swap(__float_as_uint(pmax), __float_as_uint(pmax), false, false);
      pmax = fmaxf(__uint_as_float(rr[0]), __uint_as_float(rr[1])); }
    constexpr float C2 = 1.4426950408889634f * SCALE;
    if (__builtin_expect(__all((pmax - m_reg) * SCALE <= THR), 1)) { mn = m_reg; alpha = 1.f; }
    else { mn = fmaxf(m_reg, pmax); alpha = __builtin_amdgcn_exp2f((m_reg - mn) * C2); m_reg = mn; }
    const float mnL = -mn * C2;
    for (int r = 0; r < 16; ++r) p0[r] = fmaf(p0[r], C2, mnL); for (int r = 0; r < 16; ++r) p1[r] = fmaf(p1[r], C2, mnL);
    for (int r = 0; r < 16; ++r) p0[r] = __builtin_amdgcn_exp2f(p0[r]);
}
__device__ __forceinline__ void finishSM(f32x16& p0, f32x16& p1, float alpha, float& l_reg, bf16x8& pa0, bf16x8& pa1, bf16x8& pa2, bf16x8& pa3) {
    for (int r = 0; r < 16; ++r) p1[r] = __builtin_amdgcn_exp2f(p1[r]);
    float ps = 0; for (int r = 0; r < 16; ++r) ps += p0[r]; for (int r = 0; r < 16; ++r) ps += p1[r];
    { auto rr = __builtin_amdgcn_permlane32_swap(__float_as_uint(ps), __float_as_uint(ps), false, false);
      ps = __uint_as_float(rr[0]) + __uint_as_float(rr[1]); }
    l_reg = l_reg * alpha + ps;
#define PK4(P, B_, OUT) do { unsigned a0 = cvtpk(P[B_+0], P[B_+1]), a1 = cvtpk(P[B_+2], P[B_+3]);                          \
        unsigned b0 = cvtpk(P[B_+4], P[B_+5]), b1 = cvtpk(P[B_+6], P[B_+7]);                                             \
        auto r0 = __builtin_amdgcn_permlane32_swap(a0, b0, false, false); auto r1 = __builtin_amdgcn_permlane32_swap(a1, b1, false, false); \
        u32x4 w = {r0[0], r1[0], r0[1], r1[1]}; OUT = *reinterpret_cast<bf16x8*>(&w); } while (0)
    PK4(p0, 0, pa0); PK4(p0, 8, pa1); PK4(p1, 0, pa2); PK4(p1, 8, pa3);
#undef PK4
}
template <int KB, bool SK>
__device__ __forceinline__ void qkt(f32x16& p0, f32x16& p1, const char* K_lds, int r32, int hi, const bf16x8* qr, bool act, const float* bias_t  ) {
    if (SK && !act) { const float NEG = -__builtin_inff();
#pragma unroll
        for (int r = 0; r < 16; ++r) { p0[r] = NEG; p1[r] = NEG; } return; }
#pragma unroll
    for (int g4 = 0; g4 < 4; ++g4) { const f32x4 b0 = *(const f32x4*)(bias_t + 8 * g4), b1 = *(const f32x4*)(bias_t + 32 + 8 * g4);
#pragma unroll
        for (int j = 0; j < 4; ++j) { p0[4 * g4 + j] = b0[j]; p1[4 * g4 + j] = b1[j]; } }
    const char* kb[4];
#pragma unroll
    for (int dd = 0; dd < 4; ++dd) kb[dd] = K_lds + KB * SHM_K + KSWZ(r32, (dd * 16 + hi * 8) * 2);
#pragma unroll
    for (int d0 = 0; d0 < 8; ++d0) { const char* a = kb[d0 & 3] + (d0 >> 2) * 128;
        bf16x8 b0 = *reinterpret_cast<const bf16x8*>(a);
        bf16x8 b1 = *reinterpret_cast<const bf16x8*>(a + 32 * 256);
        p0 = __builtin_amdgcn_mfma_f32_32x32x16_bf16(b0, qr[d0], p0, 0, 0, 0);
        p1 = __builtin_amdgcn_mfma_f32_32x32x16_bf16(b1, qr[d0], p1, 0, 0, 0); }
}
template <int VB, bool SK>
__device__ __forceinline__ void pv_tile(f32x16* o, int vb0, bf16x8 pa0, bf16x8 pa1, bf16x8 pa2, bf16x8 pa3, bool act) {
    if (SK && !act) return;
#define TRRD(dst, off) asm volatile("ds_read_b64_tr_b16 %0, %1 offset:%2" : "=&v"(dst) : "v"(vb0), "i"(off) : "memory")
#define PV_D0(d0) do { s16x4 l0, l1, l2, l3, h0, h1, h2, h3; constexpr int b_ = VB * SHM_V + v_rd_off(d0, 0, 0);     \
        TRRD(l0, b_); TRRD(h0, b_ + 2048); TRRD(l1, b_ + 4096); TRRD(h1, b_ + 6144); TRRD(l2, b_ + 8192); TRRD(h2, b_ + 10240); TRRD(l3, b_ + 12288); TRRD(h3, b_ + 14336); \
        asm volatile("s_waitcnt lgkmcnt(0)" ::: "memory"); SBAR();                 \
        o[d0] = __builtin_amdgcn_mfma_f32_32x32x16_bf16(pa0, (bf16x8){l0[0], l0[1], l0[2], l0[3], h0[0], h0[1], h0[2], h0[3]}, o[d0], 0, 0, 0);   \
        o[d0] = __builtin_amdgcn_mfma_f32_32x32x16_bf16(pa1, (bf16x8){l1[0], l1[1], l1[2], l1[3], h1[0], h1[1], h1[2], h1[3]}, o[d0], 0, 0, 0);   \
        o[d0] = __builtin_amdgcn_mfma_f32_32x32x16_bf16(pa2, (bf16x8){l2[0], l2[1], l2[2], l2[3], h2[0], h2[1], h2[2], h2[3]}, o[d0], 0, 0, 0);   \
        o[d0] = __builtin_amdgcn_mfma_f32_32x32x16_bf16(pa3, (bf16x8){l3[0], l3[1], l3[2], l3[3], h3[0], h3[1], h3[2], h3[3]}, o[d0], 0, 0, 0); } while (0)
    PV_D0(0); PV_D0(1); PV_D0(2); PV_D0(3);
#undef PV_D0
#undef TRRD
}

template <class TIn, class TOut> struct BlockRef { const TIn* Q; const TIn* K; const TIn* V; TOut* O; int P0; };
template <class TIn> struct Seam {
    bf16x8 qr[8];
    bf16x8 st_v0, st_v1, st_k0, st_k1; f32x4 sf0, sf1, sf2, sf3;
    f32x4 tq[16];
};
__device__ __forceinline__ int swa_jlo(int P0, int W) { const int lowk = P0 - W + 1; return lowk > 0 ? lowk / KVBLK : 0; }
#define ROW(p, k0, rr) ((p) + (size_t)((k0) + (rr)) * PKV + sc)
#define VMW() asm volatile("s_waitcnt vmcnt(0)" ::: "memory")
#define VMWN(n) asm volatile("s_waitcnt vmcnt(%0)" :: "i"(n) : "memory")
#define SLOAD_H(Kp, Vp, k0) do { S.st_v0 = load8<TIn>(ROW(Vp, k0, sr)); S.st_v1 = load8<TIn>(ROW(Vp, k0, 32 + sr));              \
                         S.st_k0 = load8<TIn>(ROW(Kp, k0, sr)); S.st_k1 = load8<TIn>(ROW(Kp, k0, 32 + sr)); } while (0)
#define SWRITE_HK(bf) do { *(bf16x8*)(K_lds + (bf) * SHM_K + kws) = S.st_k0; *(bf16x8*)(K_lds + (bf) * SHM_K + kws + 32 * 256) = S.st_k1; } while (0)
#define SWRITE_HV(bf) do { *(bf16x8*)(V_lds + (bf) * SHM_V + vst0) = S.st_v0; *(bf16x8*)(V_lds + (bf) * SHM_V + vst1) = S.st_v1; } while (0)
#define SWRITE_H(bf) do { SWRITE_HV(bf); SWRITE_HK(bf); } while (0)
#define SLOAD_F(p, k0) do { S.sf0 = *(const f32x4*)ROW(p, k0, sr); S.sf1 = *(const f32x4*)(ROW(p, k0, sr) + 4);                \
                            S.sf2 = *(const f32x4*)ROW(p, k0, 32 + sr); S.sf3 = *(const f32x4*)(ROW(p, k0, 32 + sr) + 4); } while (0)
#define SWRITE_KF(bf) do { *(bf16x8*)(K_lds + (bf) * SHM_K + kws) = pack8(S.sf0, S.sf1); *(bf16x8*)(K_lds + (bf) * SHM_K + kws + 32 * 256) = pack8(S.sf2, S.sf3); } while (0)
#define SWRITE_VF(bf) do { *(bf16x8*)(V_lds + (bf) * SHM_V + vst0) = pack8(S.sf0, S.sf1); *(bf16x8*)(V_lds + (bf) * SHM_V + vst1) = pack8(S.sf2, S.sf3); } while (0)
template <class TIn, class TOut>
__device__ __forceinline__ void causal_swa_prime(const BlockRef<TIn, TOut>& cur, int W, char* lds, Seam<TIn>& S, int tid_in) {
    constexpr bool F32 = same_t<TIn, float>::v;
    const int tid = tid_in, wid = __builtin_amdgcn_readfirstlane(tid >> 6), lane = tid & 63, r32 = lane & 31, hi = lane >> 5;
    const int sr = tid >> 4, sc = (tid & 15) * 8, kws = KSWZ(sr, sc * 2); char* K_lds = lds + 2 * SHM_V;
    const int kb0 = swa_jlo(cur.P0, W) * KVBLK;
    for (int d0 = 0; d0 < 8; ++d0) S.qr[d0] = load8<TIn>(cur.Q + (size_t)(wid * QBLK + r32) * PKV + d0 * 16 + hi * 8);
    if constexpr (F32) { SLOAD_F((const float*)cur.K, kb0); VMW(); SWRITE_KF(0); SBAR(); SLOAD_F((const float*)cur.V, kb0); }
    else { SLOAD_H(cur.K, cur.V, kb0); VMW(); SWRITE_HK(0); }
    __syncthreads();
}
template <class TIn, class TOut>
__device__ __forceinline__ void causal_swa_block(const BlockRef<TIn, TOut>& cur, const BlockRef<TIn, TOut>& nxt, int skv, int W, char* lds, Seam<TIn>& S, int bias_buf, int tid_in) {
    constexpr bool F32 = same_t<TIn, float>::v;
    const int tid = tid_in, wid = __builtin_amdgcn_readfirstlane(tid >> 6), lane = tid & 63, r32 = lane & 31, hi = lane >> 5;
    const int j_lo = swa_jlo(cur.P0, W);
    int j_hi = (cur.P0 + QB - 1) / KVBLK + 1; if (j_hi > skv / KVBLK) j_hi = skv / KVBLK;
    const int NT = j_hi - j_lo;
    const int kbn = swa_jlo(nxt.P0, W) * KVBLK;
    const int qlo = cur.P0 + wid * QBLK, qm = qlo + r32 - 4 * hi;
    char* V_lds = lds; char* K_lds = lds + 2 * SHM_V;
    float* ws = (float*)(lds + 2 * SHM_V + 2 * SHM_K) + wid * 64; float* li_l = ws, * al_l = ws + 32;
    const float* bias_l = (const float*)(lds + LDS_BIAS + bias_buf * 16384) + 4 * hi;
    float m_reg = -1e30f, l_reg = 0; f32x16 o[4] = {};
    const int sr = tid >> 4, sc = (tid & 15) * 8, vst0 = v_st(sr, sc), vst1 = v_st(32 + sr, sc), kws = KSWZ(sr, sc * 2);
    const int vb0 = (int)(uintptr_t)V_lds + v_rd_base(lane);
    const TIn* Kh = cur.K; const TIn* Vh = cur.V;
#define RESC(a) do { if (__any((a) < 1.f)) { if (hi == 0) al_l[r32] = (a); asm volatile("s_waitcnt lgkmcnt(0)" ::: "memory");              \
                     for (int d_ = 0; d_ < 4; ++d_) for (int r = 0; r < 16; ++r) o[d_][r] *= al_l[crow(r, hi)]; } } while (0)
#define KBASE(t) ((j_lo + (t)) * KVBLK)
#define BIAS_T(t) (bias_l + KBASE(t))
    const TIn* pf_src = (((tid >> 7) & 1) ? Vh : Kh) + (size_t)((tid & 127) >> 1) * PKV + (tid & 1) * 64;
#define L2_PREFETCH(kb_) do { if (tid < 256) __builtin_amdgcn_global_load_lds((const unsigned*)(pf_src + (size_t)(kb_) * PKV), (__attribute__((address_space(3))) unsigned*)(uintptr_t)__builtin_amdgcn_readfirstlane((unsigned)(uintptr_t)(lds + LDS_JUNK)), 4, 0, 0); } while (0)
#define ACT(t) (KBASE(t) <= qlo + QBLK - 1 && KBASE(t) + KVBLK - 1 >= qlo - W + 1)
#define MASKT(P0_, P1_, t) do { const int kb_ = KBASE(t); if ((!SK || ACT(t)) && (kb_ + KVBLK - 1 > qlo || kb_ <= qlo + QBLK - 1 - W)) mask_tile(P0_, P1_, qm - kb_, (unsigned)W); } while (0)
    constexpr int NQL = F32 ? 16 : 8;
    constexpr bool SK = WSKIP && !F32;
#define SEAM_K0() do { VMWN(NQL); if constexpr (F32) { SWRITE_KF(0); SBAR(); SLOAD_F((const float*)nxt.V, kbn); } else { SWRITE_HK(0); } SBAR(); } while (0)
    f32x16 pA0, pA1, pB0, pB1; float mnA, mnB, alA, alB; bf16x8 pa0, pa1, pa2, pa3;
    if constexpr (F32) { VMW(); SWRITE_VF(0); SBAR(); } else { SWRITE_HV(0); SBAR(); }
    if (NT > 1) { if constexpr (F32) SLOAD_F((const float*)Kh, KBASE(1)); else SLOAD_H(Kh, Vh, KBASE(1)); }
    SBAR(); qkt<0, SK>(pA0, pA1, K_lds, r32, hi, S.qr, ACT(0), BIAS_T(0));
    if constexpr (F32) { if (NT > 1) { VMW(); SWRITE_KF(1); SBAR(); SLOAD_F((const float*)Vh, KBASE(1)); } }
    MASKT(pA0, pA1, 0); partialSM(pA0, pA1, m_reg, mnA, alA);
    if (NT > 1) { VMW(); if constexpr (F32) { SWRITE_VF(1); SBAR(); if (NT > 2) SLOAD_F((const float*)Kh, KBASE(2)); } else SWRITE_H(1); }
    __syncthreads();
#define HALF_STEP(PX0, PX1, mnX, alX, PY0, PY1, alY, t, KB, VB, SB) do {                                                      \
        SBAR(); qkt<KB, SK>(PX0, PX1, K_lds, r32, hi, S.qr, ACT(t), BIAS_T(t));                                             \
        finishSM(PY0, PY1, alY, l_reg, pa0, pa1, pa2, pa3); SBAR();                                                           \
        if ((t) + 1 < NT) { if constexpr (F32) { VMW(); SWRITE_KF(SB); SBAR(); SLOAD_F((const float*)Vh, KBASE((t) + 1)); }  \
                            else { SLOAD_H(Kh, Vh, KBASE((t) + 1)); } SBAR(); }                                               \
        pv_tile<VB, SK>(o, vb0, pa0, pa1, pa2, pa3, ACT((t) - 1)); MASKT(PX0, PX1, (t)); partialSM(PX0, PX1, m_reg, mnX, alX);                                        \
        __syncthreads();                                                                                                      \
        if ((t) + 1 < NT) { VMW(); if constexpr (F32) { SWRITE_VF(SB); SBAR(); if ((t) + 2 < NT) SLOAD_F((const float*)Kh, KBASE((t) + 2)); } \
                            else { SWRITE_H(SB); } }                                                                          \
        RESC(alX); __syncthreads(); } while (0)
    for (int t = 1; t + 1 < NT; t += 2) {
        HALF_STEP(pB0, pB1, mnB, alB, pA0, pA1, alA, t, 1, 0, 0);
        HALF_STEP(pA0, pA1, mnA, alA, pB0, pB1, alB, t + 1, 0, 1, 1);
    }
    const bool even = (NT & 1) == 0;
    if (even) { SBAR(); qkt<1, SK>(pB0, pB1, K_lds, r32, hi, S.qr, ACT(NT - 1), BIAS_T(NT - 1)); SBAR(); }
#define QROW(e) (nxt.Q + (size_t)(wid * QBLK + r32) * PKV + ((e) >> 1) * 16 + hi * 8 + ((e) & 1) * 4)
    if constexpr (F32) { SLOAD_F((const float*)nxt.K, kbn); SBAR();
#pragma unroll
        for (int e = 0; e < 8; ++e) S.tq[e] = *(const f32x4*)QROW(e); }
    else { SLOAD_H(nxt.K, nxt.V, kbn); SBAR();
#pragma unroll
        for (int d0 = 0; d0 < 8; ++d0) S.qr[d0] = load8<TIn>(nxt.Q + (size_t)(wid * QBLK + r32) * PKV + d0 * 16 + hi * 8); }
    SBAR();
    finishSM(pA0, pA1, alA, l_reg, pa0, pa1, pa2, pa3); SBAR();
    if constexpr (F32) {
#pragma unroll
        for (int e = 8; e < 16; ++e) S.tq[e] = *(const f32x4*)QROW(e); SBAR(); }
#undef QROW
    pv_tile<0, SK>(o, vb0, pa0, pa1, pa2, pa3, ACT(even ? NT - 2 : NT - 1));
    if (even) { MASKT(pB0, pB1, NT - 1); partialSM(pB0, pB1, m_reg, mnB, alB); __syncthreads(); RESC(alB);
        finishSM(pB0, pB1, alB, l_reg, pa0, pa1, pa2, pa3); SBAR(); pv_tile<1, SK>(o, vb0, pa0, pa1, pa2, pa3, ACT(NT - 1)); }
    SBAR(); SEAM_K0();
    if (hi == 0) li_l[r32] = l_reg; asm volatile("s_waitcnt lgkmcnt(0)" ::: "memory");
    float rli[16];
#pragma unroll
    for (int r = 0; r < 16; ++r) rli[r] = __builtin_amdgcn_rcpf(li_l[crow(r, hi)]);
    TOut* Ow = cur.O + (size_t)(wid * QBLK) * PO;
#pragma unroll
    for (int r = 0; r < 16; ++r) { const int orow = crow(r, hi);
#pragma unroll
        for (int d0 = 0; d0 < 4; ++d0) { const float v = o[d0][r] * rli[r];
            if constexpr (same_t<TOut, float>::v) { Ow[(size_t)orow * PO + d0 * 32 + r32] = v; }
            else { const float vn = __shfl_xor(v, 1);
                   if ((r32 & 1) == 0) *(unsigned*)(Ow + (size_t)orow * PO + d0 * 32 + r32) = cvtpk(v, vn); } } }
    if constexpr (F32) {
#pragma unroll
        for (int d0 = 0; d0 < 8; ++d0) S.qr[d0] = pack8(S.tq[2 * d0], S.tq[2 * d0 + 1]); }
    __syncthreads();
#undef RESC
#undef KBASE
#undef BIAS_T
#undef L2_PREFETCH
#undef ACT
#undef MASKT
#undef SEAM_K0
#undef HALF_STEP
}
#undef ROW
#undef VMW
#undef VMWN
#undef SLOAD_H
#undef SWRITE_HK
#undef SWRITE_HV
#undef SWRITE_H
#undef SLOAD_F
#undef SWRITE_KF
#undef SWRITE_VF

}
#define GAS __attribute__((address_space(1)))
#define LAS __attribute__((address_space(3)))
typedef unsigned short bf16;
typedef unsigned v4u __attribute__((ext_vector_type(4)));
typedef float f32x4 __attribute__((ext_vector_type(4)));
typedef short bf16x8 __attribute__((ext_vector_type(8)));
typedef GAS unsigned gu32;
typedef GAS unsigned long long gu64;
#define RLX_AGENT __ATOMIC_RELAXED, __HIP_MEMORY_SCOPE_AGENT
#define LDS_WAIT() asm volatile("s_waitcnt lgkmcnt(0)" ::: "memory")
#define VM_WAIT() asm volatile("s_waitcnt vmcnt(0)" ::: "memory")
__device__ __forceinline__ unsigned long long rt() { return __builtin_amdgcn_s_memrealtime(); }
__device__ __forceinline__ unsigned f2bf(float f) { unsigned u = __builtin_bit_cast(unsigned, f); return (u + 0x7fffu + ((u >> 16) & 1u)) >> 16; }
__device__ __forceinline__ unsigned pk2(float lo, float hi) { return f2bf(lo) | (f2bf(hi) << 16); }

#define XB_TMO      128
#define XB_XCNT(j)  (256  + 64 * (j))
#define XB_XSUB(j)  (1280 + 64 * (j))
#define XB_XGEN(j)  (2304 + 64 * (j))
#define XB_TOP      3328
#define XB_TOPGEN   3392
#define XCD_BAR_WORDS 3456
#define XB_SPIN_CAP (1u << 18)

__device__ __forceinline__ unsigned xb_ld(unsigned* p)              { return __hip_atomic_load(p, __ATOMIC_RELAXED, __HIP_MEMORY_SCOPE_AGENT); }
__device__ __forceinline__ unsigned xb_add(unsigned* p, unsigned v) { return __hip_atomic_fetch_add(p, v, __ATOMIC_RELAXED, __HIP_MEMORY_SCOPE_AGENT); }
__device__ __forceinline__ unsigned xb_xcc_id() { return (unsigned)__builtin_amdgcn_s_getreg((3 << 11) | 20) & 0xFu; }
#define XB_SPIN(cond, bar) do { unsigned _sp = 0; while (cond) { __builtin_amdgcn_s_sleep(1); \
    if ((++_sp & 255u) == 0u) { if (xb_ld(&(bar)[XB_TMO])) break; if (_sp > XB_SPIN_CAP) { atomicAdd(&(bar)[XB_TMO], 1u); break; } } } } while (0)

struct XcdBarrier {
    unsigned* bar; unsigned x;
    volatile LAS unsigned* st;
};

__device__ __forceinline__ XcdBarrier xcd_barrier_post(unsigned* bar, volatile LAS unsigned* st) {
    XcdBarrier b; b.bar = bar; b.x = xb_xcc_id(); b.st = st;
    if (threadIdx.x == 0) (void)xb_add(&bar[XB_XCNT(b.x)], 1u);
    return b;
}
__device__ __forceinline__ void xcd_barrier_complete(unsigned* bar, unsigned x, unsigned& nloc, unsigned& nx) {
    const unsigned G = gridDim.x * gridDim.y * gridDim.z;
    unsigned sum, cnt, mine, sp = 0u;
    for (;;) {
        sum = 0u; cnt = 0u; mine = 0u;
#pragma unroll
        for (unsigned j = 0; j < 16; ++j) { const unsigned c = xb_ld(&bar[XB_XCNT(j)]); sum += c; cnt += (c > 0u) ? 1u : 0u; mine = (j == x) ? c : mine; }
        if (sum == G) break;
        __builtin_amdgcn_s_sleep(1);
        if ((++sp & 255u) == 0u) { if (xb_ld(&bar[XB_TMO])) break; if (sp > XB_SPIN_CAP) { atomicAdd(&bar[XB_TMO], 1u); break; } }
    }
    nloc = mine > 0u ? mine : 1u; nx = cnt > 0u ? cnt : 1u;
}

__device__ __forceinline__ void xcd_barrier(const XcdBarrier& b) {
    asm volatile("s_waitcnt vmcnt(0)" ::: "memory");
    __syncthreads();
    if (threadIdx.x == 0) {
        unsigned* bar = b.bar;
        __builtin_amdgcn_s_waitcnt(0);
        unsigned nloc = b.st[0], nx = b.st[1];
        if (nloc == 0u) { xcd_barrier_complete(bar, b.x, nloc, nx); b.st[0] = nloc; b.st[1] = nx; }
        const unsigned old = xb_add(&bar[XB_XSUB(b.x)], 1u);
        const unsigned gen = old / nloc;
        if (old + 1u == (gen + 1u) * nloc) {
            __builtin_amdgcn_fence(__ATOMIC_RELEASE, "agent");
            asm volatile("s_waitcnt vmcnt(0)" ::: "memory");
            const unsigned og = xb_add(&bar[XB_TOP], 1u);
            const unsigned tg = og / nx;
            if (og + 1u == (tg + 1u) * nx) xb_add(&bar[XB_TOPGEN], 1u);
            else XB_SPIN(xb_ld(&bar[XB_TOPGEN]) == tg, bar);
            __builtin_amdgcn_fence(__ATOMIC_ACQUIRE, "agent");
            xb_add(&bar[XB_XGEN(b.x)], 1u);
            asm volatile("s_waitcnt vmcnt(0)" ::: "memory");
        } else {
            XB_SPIN(xb_ld(&bar[XB_XGEN(b.x)]) == gen, bar);
            __builtin_amdgcn_fence(__ATOMIC_ACQUIRE, "agent");
            asm volatile("s_waitcnt vmcnt(0)" ::: "memory");
        }
    }
    __syncthreads();
}
#ifndef STAMP_K
#define STAMP_K -1
#endif
#ifndef DUP_MASK
#define DUP_MASK 0
#endif
constexpr int NWAVES = 8, NTHR = NWAVES * 64;
constexpr int T_TOK = 16384, SEQ = 4096, NBATCH = 4, DM = 1024;
constexpr int IN_COLS = 8216, NPROJ = 8192, NPROJ_PAD = 8448;
constexpr int C_GQ = 0, C_GK = 512, C_GV = 1024, C_GR = 2048, C_FQ = 3072, C_FK = 4096, C_FV = 5120, C_ZG = 6144, C_ZF = 7168;
constexpr int NE = 32, DFF = 1024, NCHUNK = 64;
constexpr float LN_EPS = 1e-5f;
constexpr float DN_ALPHA = 1.189207115002721f;
constexpr float FOX_INV_SCALE = 11.313708498984761f;
constexpr float GLA_QSCALE = 0.08838834764831845f;
constexpr int SLOT_ROWS = 73728;

constexpr size_t MiB = 1u << 20;
constexpr size_t WS_CTL = 0, CTL_ZERO_BYTES = 1 * MiB;
constexpr size_t WS_WIN = 2 * MiB;
constexpr size_t WS_WPROJ = 19 * MiB;
constexpr size_t WS_WOUT = 23 * MiB;
constexpr size_t WS_WGU = 25 * MiB;
constexpr size_t WS_WDN = 153 * MiB;
constexpr size_t WS_H0B = 217 * MiB;
constexpr size_t WS_SM = 249 * MiB;
constexpr size_t WS_FB = 251 * MiB;
constexpr size_t WS_DECAY = 252 * MiB;
constexpr size_t WS_KDEC = 253 * MiB;
constexpr size_t WS_AO = 269 * MiB;
constexpr size_t WS_MIXED = 333 * MiB;
constexpr size_t WS_H1F = 365 * MiB;
constexpr size_t WS_H1B = 429 * MiB;
constexpr size_t WS_TOKOF = 461 * MiB;
constexpr size_t WS_PAIR = 463 * MiB;
constexpr size_t WS_PROJ = 464 * MiB;
constexpr size_t WS_ACT = WS_PROJ;
constexpr size_t WS_YS = 720 * MiB;
constexpr size_t WS_FQKV = 864 * MiB;
constexpr size_t WS_END = 960 * MiB;
static_assert(WS_WIN + (size_t)NPROJ_PAD * 1024 * 2 <= WS_WPROJ && WS_WGU + (size_t)32 * 2048 * 1024 * 2 <= WS_WDN && WS_WDN + (size_t)32 * 1024 * 1024 * 2 <= WS_H0B, "ws map");
static_assert(WS_PROJ + (size_t)T_TOK * 8192 * 2 <= WS_YS && WS_ACT + (size_t)SLOT_ROWS * 1024 * 2 <= WS_YS && WS_YS + (size_t)SLOT_ROWS * 1024 * 2 <= WS_END, "ws map");
constexpr int CW_TMO = 0, CW_CODE = 1;
constexpr int CW_BAR = 4096;
constexpr int CW_CNT = 8192;
constexpr int CW_Q = 12288;

constexpr int RING_OFF = 0, RING_BYTES = 131072;
constexpr int LDSCTL_OFF = RING_BYTES, MISC_OFF = LDSCTL_OFF + 320;
constexpr int TBL_OFF = RING_BYTES + 512;
constexpr int TBL_CUM = TBL_OFF, TBL_CNT = TBL_OFF + 256, TBL_DESC = TBL_OFF + 384, TBL_IDX = TBL_OFF + 768;
constexpr int LDS_BYTES = 147456;
static_assert(TBL_IDX + pg8::MAXU * 256 * 4 <= LDS_BYTES && fox::LDS_BYTES <= RING_BYTES, "LDS map");

__device__ __forceinline__ float bfu(unsigned short h) { return __uint_as_float((unsigned)h << 16); }
__device__ __forceinline__ float logsig(float x) { return fminf(x, 0.f) - __logf(1.0f + __expf(-fabsf(x))); }
__device__ __forceinline__ float wave_sum(float v) {
#pragma unroll
    for (int o = 1; o < 64; o <<= 1) v += __shfl_xor(v, o);
    return v;
}

__device__ __forceinline__ void p0_tile_load(f32x4 (&v)[16], const float* W, int npitch, int srccol, int kb, int lane) {
    const int q = lane & 15, rg = lane >> 4, k0 = 64 * kb + 16 * rg;
    const GAS f32x4* src = (const GAS f32x4*)(W + (size_t)k0 * npitch + srccol + 4 * q);
#pragma unroll
    for (int i = 0; i < 16; ++i) v[i] = src[(size_t)i * (npitch / 4)];
}
__device__ __forceinline__ void p0_tile_store(const f32x4 (&v)[16], bf16* WT, int dstrow, int kb, int lane) {
    const int q = lane & 15, rg = lane >> 4, k0 = 64 * kb + 16 * rg;
#pragma unroll
    for (int j = 0; j < 4; ++j) { GAS v4u* dst = (GAS v4u*)(WT + (size_t)(dstrow + 4 * q + j) * 1024 + k0);
        v4u a, b;
        a.x = pk2(v[0][j], v[1][j]); a.y = pk2(v[2][j], v[3][j]); a.z = pk2(v[4][j], v[5][j]); a.w = pk2(v[6][j], v[7][j]);
        b.x = pk2(v[8][j], v[9][j]); b.y = pk2(v[10][j], v[11][j]); b.z = pk2(v[12][j], v[13][j]); b.w = pk2(v[14][j], v[15][j]);
        dst[0] = a; dst[1] = b; }
}
__device__ __forceinline__ void p0_transpose_tile(const float* W, int npitch, int srccol, bf16* WT, int dstrow, int kb, int lane) {
    const int q = lane & 15, rg = lane >> 4, k0 = 64 * kb + 16 * rg;
    const GAS f32x4* src = (const GAS f32x4*)(W + (size_t)k0 * npitch + srccol + 4 * q);
    f32x4 v[16];
#pragma unroll
    for (int i = 0; i < 16; ++i) v[i] = __builtin_nontemporal_load(src + (size_t)i * (npitch / 4));
#pragma unroll
    for (int j = 0; j < 4; ++j) { GAS v4u* dst = (GAS v4u*)(WT + (size_t)(dstrow + 4 * q + j) * 1024 + k0);
        v4u a, b;
        a.x = pk2(v[0][j], v[1][j]); a.y = pk2(v[2][j], v[3][j]); a.z = pk2(v[4][j], v[5][j]); a.w = pk2(v[6][j], v[7][j]);
        b.x = pk2(v[8][j], v[9][j]); b.y = pk2(v[10][j], v[11][j]); b.z = pk2(v[12][j], v[13][j]); b.w = pk2(v[14][j], v[15][j]);
        __builtin_nontemporal_store(a, dst); __builtin_nontemporal_store(b, dst + 1); }
}
__device__ __forceinline__ void* ldptr(const LAS unsigned long long* PT, int i) { const unsigned long long v = PT[i];
    const unsigned lo = __builtin_amdgcn_readfirstlane((unsigned)v), hi = __builtin_amdgcn_readfirstlane((unsigned)(v >> 32)); return (void*)(GAS unsigned char*)(uintptr_t)(((unsigned long long)hi << 32) | lo); }
constexpr int CV_PRJ = 3 * 256, CV_GU = 32 * 512, CV_DN = 32 * 256, CV_ITEMS = CV_PRJ + CV_GU + CV_DN;
constexpr int CV_P1 = 192 * 8 * 3;
__device__ __forceinline__ void conv_tile(int it, const LAS unsigned long long* PT, int ln) {
    unsigned char* const wsb = (unsigned char*)ldptr(PT, 22);
    if (it < CV_PRJ) { const int mm = it >> 8, r = it & 255, db = r >> 4, kb = r & 15;
        const float* W = (const float*)ldptr(PT, 8 + mm); bf16* WT = mm < 2 ? (bf16*)(wsb + WS_WPROJ) + (size_t)mm * 1024 * 1024 : (bf16*)(wsb + WS_WOUT);
        p0_transpose_tile(W, 1024, 64 * db, WT, 64 * db, kb, ln); return; }
    it -= CV_PRJ;
    if (it < CV_GU) { const int e = it >> 9, r = it & 511, db = r >> 4, kb = r & 15, pn = db >> 2, jb = db & 3;
        const int src = jb < 2 ? 128 * pn + 64 * jb : 1024 + 128 * pn + 64 * (jb - 2);
        p0_transpose_tile((const float*)ldptr(PT, 15) + (size_t)e * 1024 * 2048, 2048, src, (bf16*)(wsb + WS_WGU) + (size_t)e * 2048 * 1024, 64 * db, kb, ln); return; }
    it -= CV_GU;
    { const int e = it >> 8, r = it & 255, db = r >> 4, kb = r & 15;
        p0_transpose_tile((const float*)ldptr(PT, 17) + (size_t)e * 1024 * 1024, 1024, 64 * db, (bf16*)(wsb + WS_WDN) + (size_t)e * 1024 * 1024, 64 * db, kb, ln); }
}
__device__ __forceinline__ void ln_row(const f32x4 (&xin)[4], f32x4 (&y)[4], const float* g, const float* b, int lane) {
    float s = 0.f;
#pragma unroll
    for (int j = 0; j < 4; ++j) s += (xin[j].x + xin[j].y) + (xin[j].z + xin[j].w);
    const float mean = wave_sum(s) * (1.f / DM); float s2 = 0.f;
#pragma unroll
    for (int j = 0; j < 4; ++j) { y[j] = xin[j] - mean; s2 += (y[j].x * y[j].x + y[j].y * y[j].y) + (y[j].z * y[j].z + y[j].w * y[j].w); }
    const float rstd = 1.f / sqrtf(wave_sum(s2) * (1.f / DM) + LN_EPS);
#pragma unroll
    for (int j = 0; j < 4; ++j) { const f32x4 gv = *(const f32x4*)(g + 4 * lane + 256 * j), bv = *(const f32x4*)(b + 4 * lane + 256 * j); y[j] = y[j] * rstd * gv + bv; }
}
__device__ __forceinline__ void store_row_bf16(bf16* orow, const f32x4 (&y)[4], int lane) {
    GAS unsigned long long* o8 = (GAS unsigned long long*)orow + lane;
#pragma unroll
    for (int j = 0; j < 4; ++j) o8[64 * j] = (unsigned long long)pk2(y[j].x, y[j].y) | ((unsigned long long)pk2(y[j].z, y[j].w) << 32);
}

struct Args { const float* in[21]; float* out; unsigned char* ws; int ph_lo, ph_hi, li, pad; };
constexpr int NPH = 11;

__global__ void __launch_bounds__(NTHR, 2) mega_fwd(Args args) {
    extern __shared__ __attribute__((aligned(16))) unsigned char lds[];
    LAS unsigned char* const ldsl = (LAS unsigned char*)lds;
    volatile LAS unsigned* const MISC = (volatile LAS unsigned*)(ldsl + MISC_OFF);
    const int tid = threadIdx.x, lane = tid & 63, wave = __builtin_amdgcn_readfirstlane(tid >> 6);
    const int G = gridDim.x; const int bx = blockIdx.x; const int vcu = (G % 8 == 0) ? (bx % 8) * (G / 8) + bx / 8 : bx;
    for (int u = tid; u < (LDS_BYTES - LDSCTL_OFF) / 4; u += NTHR) ((LAS unsigned*)(ldsl + LDSCTL_OFF))[u] = 0u;
    __syncthreads();
    LAS unsigned long long* const PT = (LAS unsigned long long*)(ldsl + LDSCTL_OFF);
    if (tid == 0) {
#pragma unroll
        for (int i = 0; i < 21; ++i) PT[i] = (unsigned long long)(uintptr_t)args.in[i];
        PT[21] = (unsigned long long)(uintptr_t)args.out; PT[22] = (unsigned long long)(uintptr_t)args.ws; }
    __syncthreads();
#define INP(i) ((const float*)ldptr(PT, (i)))
#define WSB ((unsigned char*)ldptr(PT, 22))
    const int lo = args.ph_lo, hi = args.ph_hi;
    unsigned long long t_stamp_a = 0ull; const unsigned long long t_stamp_0 = (STAMP_K >= 0) ? __builtin_amdgcn_s_memrealtime() : 0ull;
    const bool use_bar = (hi - lo) > 1;
    if (use_bar) (void)xcd_barrier_post((unsigned*)(WSB + WS_CTL) + CW_BAR, MISC + 8);
#ifndef PH_MASK
#define PH_MASK 0x7FF
#endif
#define IN(k) ((((PH_MASK) >> (k)) & 1) && lo <= (k) && (k) < hi)
#ifndef DUP_MASK
#define DUP_MASK 0
#endif
#define DUP(k) for (int rep_ = 0; rep_ < 1 + (((DUP_MASK) >> (k)) & 1); ++rep_)
#define SEAM(k) do { if (STAMP_K == (k) && bx == 0 && tid == 0) { t_stamp_a = __builtin_amdgcn_s_memrealtime(); } if (IN(k) && IN((k) + 1)) { XcdBarrier b_; b_.bar = (unsigned*)(WSB + WS_CTL) + CW_BAR; b_.x = xb_xcc_id(); b_.st = MISC + 8; xcd_barrier(b_); if ((DUP_MASK >> 16) & 1) { xcd_barrier(b_); xcd_barrier(b_); } } if (STAMP_K == (k) + 100 && bx == 0 && tid == 0) { t_stamp_a = __builtin_amdgcn_s_memrealtime(); } } while (0)

    if (IN(0)) DUP(0) {
        bf16* const WIN_T = (bf16*)(WSB + WS_WIN); bf16* const WPROJ_T = (bf16*)(WSB + WS_WPROJ); bf16* const WOUT_T = (bf16*)(WSB + WS_WOUT); bf16* const WGU_T = (bf16*)(WSB + WS_WGU); bf16* const WDN_T = (bf16*)(WSB + WS_WDN); bf16* const H0B = (bf16*)(WSB + WS_H0B);
        const float* const x = INP(0); const float* const ln_in_g = INP(1); const float* const ln_in_b = INP(2); const float* const w_in = INP(3); const float* const w_gla_proj = INP(8); const float* const w_fox_proj = INP(9); const float* const w_out = INP(10); const float* const w_gate_up = INP(15); const float* const w_down = INP(17);
        const int gw = vcu * NWAVES + wave, NGW = G * NWAVES;
        constexpr int I_IN = 128 * 16;
        for (int it = gw; it < I_IN; it += NGW) { const int db = it >> 4, kb = it & 15, dst = 64 * db, src = dst + (dst < 2048 ? 0 : (dst < 6144 ? 16 : 24));
            p0_transpose_tile(w_in, IN_COLS, src, WIN_T, dst, kb, lane); }
        for (int i = vcu * NTHR + tid; i < 256 * 1024; i += G * NTHR) { const int r = i >> 10, k = i & 1023;
            float v = 0.f; if (r < 16) v = w_in[(size_t)k * IN_COLS + 2048 + r]; else if (r < 24) v = w_in[(size_t)k * IN_COLS + 6160 + (r - 16)];
            WIN_T[(size_t)(NPROJ + r) * 1024 + k] = (bf16)f2bf(v); }
        for (int m0 = gw; m0 < T_TOK; m0 += 4 * NGW) {
            f32x4 v[4][4], y[4];
#pragma unroll
            for (int r = 0; r < 4; ++r) { const GAS f32x4* xr = (const GAS f32x4*)(x + (size_t)(m0 + r * NGW) * DM) + lane;
#pragma unroll
                for (int j = 0; j < 4; ++j) v[r][j] = xr[64 * j]; }
#pragma unroll
            for (int r = 0; r < 4; ++r) { ln_row(v[r], y, ln_in_g, ln_in_b, lane); store_row_bf16(H0B + (size_t)(m0 + r * NGW) * DM, y, lane); } }
    }
    SEAM(0);

    if (IN(1)) DUP(1) {
        bf16* const H0B = (bf16*)(WSB + WS_H0B); bf16* const WIN_T = (bf16*)(WSB + WS_WIN); bf16* const PROJ = (bf16*)(WSB + WS_PROJ); float* const SM = (float*)(WSB + WS_SM);
        pg8::Gemm g{H0B, WIN_T, T_TOK, NPROJ_PAD, DM}; pg8::StaticOrder S; S.init(T_TOK, NPROJ_PAD, G, bx);
        pg8::EpiProj E{PROJ, SM, (bf16*)(WSB + WS_FQKV)};
        pg8::gemm_phase<pg8::EpiProj, pg8::StaticOrder, true, true, false>(ldsl + RING_OFF, g, S, E);
        if (bx >= 64 && rep_ == 0) {
            const int cw = ((bx - 64) * NWAVES + wave) * 3;
#pragma unroll 1
            for (int t = 0; t < 3; ++t) conv_tile(cw + t, PT, lane);
        }
    }
    SEAM(1);

    if (IN(2)) DUP(2) {
        float* const SM = (float*)(WSB + WS_SM); float* const FB = (float*)(WSB + WS_FB); float* const DECAY = (float*)(WSB + WS_DECAY); bf16* const KDEC = (bf16*)(WSB + WS_KDEC); bf16* const VT = (bf16*)(WSB + WS_MIXED); bf16* const PROJ = (bf16*)(WSB + WS_PROJ);
        const float* const w_gup = INP(4); const float* const b_gla_gate = INP(5); const float* const b_forget = INP(7);
        LAS float* sc = (LAS float*)(ldsl + RING_OFF);
        for (int bh = vcu; bh < 32; bh += G) {
            const int b = bh >> 3, h = bh & 7; const float bf_ = b_forget[h];
            float v[8]; float run = 0.f;
#pragma unroll
            for (int j = 0; j < 8; ++j) { const int s = tid * 8 + j; run += logsig(SM[(size_t)(b * SEQ + s) * 32 + 16 + h] + bf_); v[j] = run; }
            float incl = run;
#pragma unroll
            for (int o = 1; o < 64; o <<= 1) { const float t = __shfl_up(incl, o); if (lane >= o) incl += t; }
            if (lane == 63) sc[wave] = incl;
            __syncthreads();
            float woff = 0.f;
            for (int w = 0; w < wave; ++w) woff += sc[w];
            const float off = woff + (incl - run);
#pragma unroll
            for (int j = 0; j < 8; ++j) FB[(size_t)bh * SEQ + tid * 8 + j] = -(off + v[j]) * FOX_INV_SCALE;
            __syncthreads();
        }
        {
            LAS float* const GL = (LAS float*)(ldsl + RING_OFF + 4096);
            LAS unsigned short* const KL = (LAS unsigned short*)(ldsl + RING_OFF + 8192);
            LAS unsigned short* const VL = (LAS unsigned short*)(ldsl + RING_OFF + 8192 + 16384);
            const int j = tid & 127, cq = tid >> 7; const int h = vcu & 3; const int col = h * 128 + j;
            float wu[16];
#pragma unroll
            for (int r = 0; r < 16; ++r) wu[r] = w_gup[r * 512 + col];
            const float bg = b_gla_gate[col];
            v4u kq[2], vq[4]; f32x4 gq = {0.f, 0.f, 0.f, 0.f};
#define PREP_LOAD(it_) do { const int n_ = ((it_) >> 2) & 63, b_ = (it_) >> 8; const size_t t0_ = (size_t)b_ * SEQ + n_ * 64; \
                _Pragma("unroll") for (int i = 0; i < 2; ++i) { const int p = tid + NTHR * i; kq[i] = *(const GAS v4u*)(PROJ + (t0_ + (p >> 4)) * 8192 + C_GK + h * 128 + (p & 15) * 8); } \
                _Pragma("unroll") for (int i = 0; i < 4; ++i) { const int p = tid + NTHR * i; vq[i] = *(const GAS v4u*)(PROJ + (t0_ + (p >> 5)) * 8192 + C_GV + h * 256 + (p & 31) * 8); } \
                if (tid < 256) gq = *(const GAS f32x4*)(SM + (t0_ + (tid >> 2)) * 32 + 4 * (tid & 3)); } while (0)
            PREP_LOAD(vcu);
            for (int it = vcu; it < NBATCH * NCHUNK * 4; it += G) {
                const int n = (it >> 2) & 63, b = it >> 8;
#pragma unroll
                for (int i = 0; i < 2; ++i) { const int p = tid + NTHR * i; *(LAS v4u*)(KL + (p >> 4) * 128 + (p & 15) * 8) = kq[i]; }
#pragma unroll
                for (int i = 0; i < 4; ++i) { const int p = tid + NTHR * i; *(LAS v4u*)(VL + (p >> 5) * 256 + (p & 31) * 8) = vq[i]; }
                if (tid < 256) *(LAS f32x4*)(GL + (tid >> 2) * 16 + 4 * (tid & 3)) = gq;
                __syncthreads();
                if (it + G < NBATCH * NCHUNK * 4) PREP_LOAD(it + G);
                float cum[16]; float run = 0.f;
#pragma unroll
                for (int c = 0; c < 16; ++c) { const LAS float* gl = GL + (cq * 16 + c) * 16; float z = bg;
#pragma unroll
                    for (int r4 = 0; r4 < 4; ++r4) { const f32x4 g4 = *(const LAS f32x4*)(gl + 4 * r4); z += g4.x * wu[4 * r4] + g4.y * wu[4 * r4 + 1] + g4.z * wu[4 * r4 + 2] + g4.w * wu[4 * r4 + 3]; }
                    run += logsig(z) * (1.0f / 16.0f); cum[c] = run; }
                sc[cq * 128 + j] = run;
                __syncthreads();
                float off = 0.f, total = 0.f;
#pragma unroll
                for (int q = 0; q < 4; ++q) { const float t = sc[q * 128 + j]; total += t; if (q < cq) off += t; }
                {   unsigned pk[8];
#pragma unroll
                    for (int c = 0; c < 16; c += 2) { const int cc = cq * 16 + c;
                        pk[c >> 1] = pk2(bfu(KL[cc * 128 + j]) * __expf(total - (off + cum[c])), bfu(KL[(cc + 1) * 128 + j]) * __expf(total - (off + cum[c + 1]))); }
                    GAS v4u* dst = (GAS v4u*)(KDEC + (size_t)it * 8192 + j * 64 + cq * 16);
                    v4u w0, w1; w0.x = pk[0]; w0.y = pk[1]; w0.z = pk[2]; w0.w = pk[3]; w1.x = pk[4]; w1.y = pk[5]; w1.z = pk[6]; w1.w = pk[7]; dst[0] = w0; dst[1] = w1; }
                if (cq == 0) DECAY[(size_t)(b * NCHUNK + n) * 512 + col] = expf(total);
                {   const int dv = tid & 255, ch = tid >> 8; unsigned pk[16];
#pragma unroll
                    for (int c = 0; c < 32; c += 2) pk[c >> 1] = (unsigned)VL[(ch * 32 + c) * 256 + dv] | ((unsigned)VL[(ch * 32 + c + 1) * 256 + dv] << 16);
                    GAS v4u* dst = (GAS v4u*)(VT + (size_t)it * 16384 + dv * 64 + ch * 32);
#pragma unroll
                    for (int q = 0; q < 4; ++q) { v4u w; w.x = pk[4 * q]; w.y = pk[4 * q + 1]; w.z = pk[4 * q + 2]; w.w = pk[4 * q + 3]; dst[q] = w; } }
                __syncthreads();
            }
#undef PREP_LOAD
        }
    }
    SEAM(2);

    if (IN(3)) {
        float* const FB = (float*)(WSB + WS_FB); float* const DECAY = (float*)(WSB + WS_DECAY); bf16* const KDEC = (bf16*)(WSB + WS_KDEC); bf16* const VT = (bf16*)(WSB + WS_MIXED); bf16* const PROJ = (bf16*)(WSB + WS_PROJ); bf16* const AO = (bf16*)(WSB + WS_AO);
        const float* const g_gla_norm = INP(6);
        LAS int* const QW = (LAS int*)(ldsl + TBL_CUM);
        DUP(13) {
        gu32* const ctlq = (gu32*)(WSB + WS_CTL) + CW_Q + rep_ * 1024;
        int qoff = 0;
#define P2_FETCH(dst) do { if (tid == 0) { int code_ = -1, t_ = qoff; for (; t_ < 8; ++t_) { const int k_ = (bx + t_) & 7; const unsigned i_ = __hip_atomic_fetch_add(ctlq + 64 * k_, 1u, __ATOMIC_RELAXED, __HIP_MEMORY_SCOPE_AGENT); \
                if (i_ < 66u) { code_ = k_ * 66 + (int)i_; break; } } QW[0] = code_; QW[1] = t_; } \
            __syncthreads(); dst = __builtin_amdgcn_readfirstlane(QW[0]); qoff = __builtin_amdgcn_readfirstlane(QW[1]); __syncthreads(); } while (0)
        int code; P2_FETCH(code);
        bool primed = false; int bbuf = 0;
        fox::Seam<fox::bf16> Sm;
        char* const lg = (char*)lds;
        const fox::bf16* const Pq = (const fox::bf16*)(WSB + WS_FQKV); fox::bf16* const Oo = (fox::bf16*)(AO + (size_t)T_TOK * 1024);
#define P2_REF(r_, code_) do { const int k_ = (code_) / 66, a_ = (code_) % 66 - 2; const int qb_ = 15 - (a_ >> 2), bh_ = 4 * k_ + (a_ & 3), b_ = bh_ >> 3, h_ = bh_ & 7; \
            r_.K = Pq + ((size_t)32 + bh_) * (SEQ * 128); r_.V = Pq + ((size_t)64 + bh_) * (SEQ * 128); r_.Q = Pq + ((size_t)bh_ * SEQ + qb_ * 256) * 128; \
            r_.O = Oo + (size_t)(b_ * SEQ + qb_ * 256) * 1024 + h_ * 128; r_.P0 = qb_ * 256; } while (0)
#define P2_BIAS(code_, buf_) do { const int k_ = (code_) / 66, a_ = (code_) % 66 - 2; const int bh_ = 4 * k_ + (a_ & 3); LAS f32x4* bl_ = (LAS f32x4*)(ldsl + fox::LDS_BIAS + (buf_) * 16384); \
            const GAS f32x4* src_ = (const GAS f32x4*)(FB + (size_t)bh_ * SEQ); bl_[tidl] = src_[tidl]; bl_[tidl + NTHR] = src_[tidl + NTHR]; } while (0)
        while (code >= 0) {
          int tidl = tid; asm volatile("" : "+v"(tidl));
          if (code % 66 < 2) {
            primed = false;
            typedef float f32x16 __attribute__((ext_vector_type(16)));
            const int gitem = 2 * (code / 66) + code % 66;
            const int tid = tidl, lane = tid & 63, wave = __builtin_amdgcn_readfirstlane(tid >> 6);
            const int b = gitem >> 2, h = gitem & 3; const int r32 = lane & 31, hi = lane >> 5;
#define GLA_KT(bf_) (ldsl + RING_OFF + (bf_) * 18432)
#define GLA_QT(bf_) (ldsl + RING_OFF + 36864 + (bf_) * 16896)
#define GLA_DC(bf_) ((LAS float*)(ldsl + RING_OFF + 70656 + (bf_) * 512))
#define GLA_OS (ldsl + RING_OFF + 71680)
#define GLA_SS ((LAS float*)(ldsl + RING_OFF + 71680 + 33792))
            bf16* const ORAW = (bf16*)(WSB + WS_H1B); float* const SSQ = (float*)(WSB + WS_TOKOF);
            f32x16 Sacc[4];
#pragma unroll
            for (int m = 0; m < 4; ++m)
#pragma unroll
                for (int r = 0; r < 16; ++r) Sacc[m][r] = 0.f;
            const int p0 = tid, p1 = tid + 512;
            const unsigned kdst0 = (p0 >> 3) * 144 + (p0 & 7) * 16, kdst1 = (p1 >> 3) * 144 + (p1 & 7) * 16, qdst0 = (p0 >> 4) * 264 + (p0 & 15) * 16, qdst1 = (p1 >> 4) * 264 + (p1 & 15) * 16;
            v4u kst0, kst1, qst0, qst1; float dcs = 0.f; bf16x8 vf[4];
#define GLA_LOAD_STAGE(n_) do { const size_t item_ = (size_t)((b * NCHUNK + (n_)) * 4 + h); const size_t tok0_ = (size_t)b * SEQ + (size_t)(n_) * 64; \
                kst0 = *(const GAS v4u*)(KDEC + item_ * 8192 + (p0 >> 3) * 64 + (p0 & 7) * 8); kst1 = *(const GAS v4u*)(KDEC + item_ * 8192 + (p1 >> 3) * 64 + (p1 & 7) * 8); \
                qst0 = *(const GAS v4u*)(PROJ + (tok0_ + (p0 >> 4)) * 8192 + C_GQ + h * 128 + (p0 & 15) * 8); qst1 = *(const GAS v4u*)(PROJ + (tok0_ + (p1 >> 4)) * 8192 + C_GQ + h * 128 + (p1 & 15) * 8); \
                if (tid < 128) dcs = DECAY[(size_t)(b * NCHUNK + (n_)) * 512 + h * 128 + tid]; } while (0)
#define GLA_LOAD_V(n_) do { const bf16* vb_ = VT + (size_t)((b * NCHUNK + (n_)) * 4 + h) * 16384 + (size_t)(32 * wave + r32) * 64 + 8 * hi; \
                _Pragma("unroll") for (int ks = 0; ks < 4; ++ks) vf[ks] = *(const GAS bf16x8*)(vb_ + 16 * ks); } while (0)
            GLA_LOAD_STAGE(0); GLA_LOAD_V(0);
            for (int n = 0; n < NCHUNK; ++n) {
                const size_t tok0 = (size_t)b * SEQ + (size_t)n * 64; const int bf = n & 1;
                LAS unsigned char* const KT = GLA_KT(bf); LAS unsigned char* const QT = GLA_QT(bf); LAS float* const DC = GLA_DC(bf);
                *(LAS v4u*)(KT + kdst0) = kst0; *(LAS v4u*)(KT + kdst1) = kst1; *(LAS v4u*)(QT + qdst0) = qst0; *(LAS v4u*)(QT + qdst1) = qst1;
                if (tid < 128) DC[tid] = dcs;
                __syncthreads();
                if (n + 1 < NCHUNK) GLA_LOAD_STAGE(n + 1);
#pragma unroll
                for (int m = 0; m < 4; ++m)
#pragma unroll
                    for (int g4 = 0; g4 < 4; ++g4) { const f32x4 d4 = *(const LAS f32x4*)(DC + 32 * m + 8 * g4 + 4 * hi);
                        Sacc[m][4 * g4 + 0] *= d4.x; Sacc[m][4 * g4 + 1] *= d4.y; Sacc[m][4 * g4 + 2] *= d4.z; Sacc[m][4 * g4 + 3] *= d4.w; }
#pragma unroll
                for (int m = 0; m < 4; ++m)
#pragma unroll
                    for (int ks = 0; ks < 4; ++ks) { const bf16x8 kf = *(const LAS bf16x8*)(KT + (32 * m + r32) * 144 + (16 * ks + 8 * hi) * 2);
                        Sacc[m] = __builtin_amdgcn_mfma_f32_32x32x16_bf16(kf, vf[ks], Sacc[m], 0, 0, 0); }
                if (n + 1 < NCHUNK) GLA_LOAD_V(n + 1);
                f32x16 ot[2];
#pragma unroll
                for (int nt = 0; nt < 2; ++nt)
#pragma unroll
                    for (int r = 0; r < 16; ++r) ot[nt][r] = 0.f;
#pragma unroll
                for (int m = 0; m < 4; ++m)
#pragma unroll
                    for (int sx = 0; sx < 2; ++sx) {
                        v4u ap; ap.x = pg8::cvt_pk_bf16(Sacc[m][8 * sx + 0], Sacc[m][8 * sx + 1]); ap.y = pg8::cvt_pk_bf16(Sacc[m][8 * sx + 2], Sacc[m][8 * sx + 3]);
                        ap.z = pg8::cvt_pk_bf16(Sacc[m][8 * sx + 4], Sacc[m][8 * sx + 5]); ap.w = pg8::cvt_pk_bf16(Sacc[m][8 * sx + 6], Sacc[m][8 * sx + 7]);
                        const bf16x8 af = __builtin_bit_cast(bf16x8, ap);
#pragma unroll
                        for (int nt = 0; nt < 2; ++nt) { const LAS unsigned char* qp = QT + (32 * nt + r32) * 264 + (32 * m + 16 * sx + 4 * hi) * 2;
                            const unsigned long long qlo = *(const LAS unsigned long long*)qp, qhi = *(const LAS unsigned long long*)(qp + 16);
                            v4u bp; bp.x = (unsigned)qlo; bp.y = (unsigned)(qlo >> 32); bp.z = (unsigned)qhi; bp.w = (unsigned)(qhi >> 32);
                            ot[nt] = __builtin_amdgcn_mfma_f32_32x32x16_bf16(af, __builtin_bit_cast(bf16x8, bp), ot[nt], 0, 0, 0); } }
#pragma unroll
                for (int nt = 0; nt < 2; ++nt) { float a = 0.f; const int c = 32 * nt + r32;
#pragma unroll
                    for (int r = 0; r < 16; ++r) a += ot[nt][r] * ot[nt][r];
                    a += __shfl_xor(a, 32);
                    if (hi == 0) GLA_SS[c * 8 + wave] = a;
#pragma unroll
                    for (int g4 = 0; g4 < 4; ++g4)
                        *(LAS unsigned long long*)(GLA_OS + c * 528 + (32 * wave + 8 * g4 + 4 * hi) * 2) = (unsigned long long)pg8::cvt_pk_bf16(ot[nt][4 * g4 + 0], ot[nt][4 * g4 + 1]) | ((unsigned long long)pg8::cvt_pk_bf16(ot[nt][4 * g4 + 2], ot[nt][4 * g4 + 3]) << 32); }
                __syncthreads();
#pragma unroll
                for (int i = 0; i < 4; ++i) { const int c = (tid >> 5) + 16 * i, ch = tid & 31;
                    *(GAS v4u*)(ORAW + (tok0 + c) * 1024 + h * 256 + ch * 8) = *(const LAS v4u*)(GLA_OS + c * 528 + ch * 16); }
                if (tid < 64) { float t = 0.f;
#pragma unroll
                    for (int w = 0; w < 8; ++w) t += GLA_SS[tid * 8 + w];
                    SSQ[(tok0 + tid) * 4 + h] = t; }
            }
#undef GLA_KT
#undef GLA_QT
#undef GLA_DC
#undef GLA_OS
#undef GLA_SS
#undef GLA_LOAD_STAGE
#undef GLA_LOAD_V
            __syncthreads();
            P2_FETCH(code);
            asm volatile("" : "=v"(Sm.qr[0]), "=v"(Sm.qr[1]), "=v"(Sm.qr[2]), "=v"(Sm.qr[3]), "=v"(Sm.qr[4]), "=v"(Sm.qr[5]), "=v"(Sm.qr[6]), "=v"(Sm.qr[7]), "=v"(Sm.st_v0), "=v"(Sm.st_v1), "=v"(Sm.st_k0), "=v"(Sm.st_k1));
          } else {
            fox::BlockRef<fox::bf16, fox::bf16> cur; P2_REF(cur, code);
            if (!primed) { P2_BIAS(code, bbuf); fox::causal_swa_prime<fox::bf16, fox::bf16>(cur, SEQ, lg, Sm, tidl); }
            int ncode; P2_FETCH(ncode);
            const bool nx_att = ncode >= 0 && (ncode % 66) >= 2;
            fox::BlockRef<fox::bf16, fox::bf16> nx = cur; if (nx_att) { P2_REF(nx, ncode); P2_BIAS(ncode, bbuf ^ 1); }
            asm volatile("" : "+s"(nx.K), "+s"(nx.V), "+s"(nx.Q));
            fox::causal_swa_block<fox::bf16, fox::bf16>(cur, nx, SEQ, SEQ, lg, Sm, bbuf, tidl);
            if (rep_ == 0) {
                const int ntc = 4 * (16 - ((code % 66 - 2) >> 2)); const int ncv = (ntc * (CV_ITEMS - CV_P1) + 17407) / 17408;
                if (tid == 0) QW[2] = (int)__hip_atomic_fetch_add(ctlq + 64 * 8, (unsigned)ncv, __ATOMIC_RELAXED, __HIP_MEMORY_SCOPE_AGENT);
                __syncthreads();
                const int cv0 = __builtin_amdgcn_readfirstlane(QW[2]); int cv1 = cv0 + ncv; if (cv1 > CV_ITEMS - CV_P1) cv1 = CV_ITEMS - CV_P1;
                const int wv = __builtin_amdgcn_readfirstlane(tidl >> 6), ln = tidl & 63;
                for (int it0 = cv0 + wv; it0 < cv1; it0 += NWAVES) conv_tile(CV_P1 + it0, PT, ln);
            }
            primed = nx_att; bbuf ^= 1; code = ncode;
          }
        }
#undef P2_FETCH
#undef P2_REF
#undef P2_BIAS
        }
    }
    SEAM(3);

    if (IN(4)) DUP(4) {
        bf16* const AO = (bf16*)(WSB + WS_AO); bf16* const PROJ = (bf16*)(WSB + WS_PROJ); const bf16* const ORAW = (const bf16*)(WSB + WS_H1B); const float* const SSQ = (const float*)(WSB + WS_TOKOF);
        const float* const g_gla_norm = INP(6);
        const int gw = vcu * NWAVES + wave, NGW = G * NWAVES;
        const f32x4 gn = *(const f32x4*)(g_gla_norm + 4 * lane);
        for (int m0 = gw; m0 < T_TOK; m0 += 4 * NGW) {
            f32x4 hs4[4]; unsigned long long ow[4][4], rw[4][4];
#pragma unroll
            for (int r = 0; r < 4; ++r) { const size_t mm = (size_t)(m0 + r * NGW); hs4[r] = *(const f32x4*)(SSQ + mm * 4);
                const GAS unsigned long long* orow = (const GAS unsigned long long*)(ORAW + mm * 1024) + lane; const GAS unsigned long long* rrow = (const GAS unsigned long long*)(PROJ + mm * 8192 + C_GR) + lane;
#pragma unroll
                for (int j = 0; j < 4; ++j) { ow[r][j] = orow[64 * j]; rw[r][j] = rrow[64 * j]; } }
#pragma unroll
            for (int r = 0; r < 4; ++r) { GAS unsigned long long* drow = (GAS unsigned long long*)(AO + (size_t)(m0 + r * NGW) * 1024) + lane;
#pragma unroll
                for (int j = 0; j < 4; ++j) { const float tot = hs4[r][j] * (GLA_QSCALE * GLA_QSCALE); const float rs = GLA_QSCALE / sqrtf(tot * (1.0f / 256.0f) + LN_EPS);
                    const unsigned ol = (unsigned)ow[r][j], oh = (unsigned)(ow[r][j] >> 32), rl = (unsigned)rw[r][j], rh = (unsigned)(rw[r][j] >> 32);
                    const float r0 = pg8::bf_lo(rl), r1 = pg8::bf_hi(rl), r2 = pg8::bf_lo(rh), r3 = pg8::bf_hi(rh);
                    const float o0 = pg8::bf_lo(ol) * rs * gn.x * (r0 * pg8::sigm(r0)), o1 = pg8::bf_hi(ol) * rs * gn.y * (r1 * pg8::sigm(r1)), o2 = pg8::bf_lo(oh) * rs * gn.z * (r2 * pg8::sigm(r2)), o3 = pg8::bf_hi(oh) * rs * gn.w * (r3 * pg8::sigm(r3));
                    drow[64 * j] = (unsigned long long)pg8::cvt_pk_bf16(o0, o1) | ((unsigned long long)pg8::cvt_pk_bf16(o2, o3) << 32); } } }
    }
    SEAM(4);

    if (IN(5)) DUP(5) {
        bf16* const AO = (bf16*)(WSB + WS_AO); bf16* const WPROJ_T = (bf16*)(WSB + WS_WPROJ); bf16* const PROJ = (bf16*)(WSB + WS_PROJ); bf16* const MIXED = (bf16*)(WSB + WS_MIXED);
        pg8::Gemm g{AO, WPROJ_T, 2 * T_TOK, 2048, DM}; pg8::MixOrder S; S.init(T_TOK, DM, G, bx);
        pg8::EpiMix E{PROJ, MIXED, C_ZG, C_ZF};
        pg8::gemm_phase<pg8::EpiMix, pg8::MixOrder, true, true, false>(ldsl + RING_OFF, g, S, E);
    }
    SEAM(5);

    if (IN(6)) DUP(6) {
        bf16* const MIXED = (bf16*)(WSB + WS_MIXED); bf16* const WOUT_T = (bf16*)(WSB + WS_WOUT); float* const H1F = (float*)(WSB + WS_H1F);
        pg8::Gemm g{MIXED, WOUT_T, T_TOK, DM, DM}; pg8::StaticOrder S; S.init(T_TOK, DM, G, bx);
        pg8::EpiBf16<0> E{(bf16*)(WSB + WS_YS), DM, nullptr, 0, 0, 1.f};
        pg8::gemm_phase<pg8::EpiBf16<0>, pg8::StaticOrder, true, true, false>(ldsl + RING_OFF, g, S, E);
    }
    SEAM(6);

    if (IN(7)) {
        gu32* const ctl = (gu32*)(WSB + WS_CTL);
        bf16* const H1B = (bf16*)(WSB + WS_H1B); int* const TOKOF = (int*)(WSB + WS_TOKOF); int* const PAIR_E = (int*)(WSB + WS_PAIR); int* const PAIR_POS = PAIR_E + T_TOK * 4; float* const PAIR_G = (float*)(PAIR_POS + T_TOK * 4);
        const float* const x = INP(0); const float* const ln_in_g = INP(1); const float* const ln_in_b = INP(2); const float* const ln_mix_g = INP(11); const float* const ln_mix_b = INP(12);
        const float* const w_router = INP(13); const float* const b_router = INP(14); const bf16* const PRE = (const bf16*)(WSB + WS_YS);
        LAS float* const WRT = (LAS float*)(ldsl + RING_OFF);
        LAS float* const LOGT = (LAS float*)(ldsl + TBL_IDX) + wave * 64;
        LAS int* const HIST = (LAS int*)(ldsl + TBL_CNT); LAS int* const BASE = (LAS int*)(ldsl + TBL_CUM);
#pragma unroll 4
        for (int i = 0; i < 16; ++i) { const int p = tid + NTHR * i, e4 = p & 7, k = p >> 3; const f32x4 w = *(const GAS f32x4*)(w_router + 4 * p);
            WRT[(4 * e4 + 0) * 1024 + k] = w.x; WRT[(4 * e4 + 1) * 1024 + k] = w.y; WRT[(4 * e4 + 2) * 1024 + k] = w.z; WRT[(4 * e4 + 3) * 1024 + k] = w.w; }
        if (tid < 32) HIST[tid] = 0;
        __syncthreads();
        const int gw = vcu * NWAVES + wave, NGW = G * NWAVES;
        int te[4][4], tr[4][4]; float tgt[4][4];
        f32x4 vx[2][4]; unsigned long long vp[2][4];
#define ROW_LOAD(g_) do { _Pragma("unroll") for (int r = 0; r < 2; ++r) { const size_t mm = (size_t)(gw + (2 * (g_) + r) * NGW); const GAS f32x4* xr = (const GAS f32x4*)(x + mm * DM) + lane; const GAS unsigned long long* pr = (const GAS unsigned long long*)(PRE + mm * DM) + lane; \
            _Pragma("unroll") for (int j = 0; j < 4; ++j) { vx[r][j] = xr[64 * j]; vp[r][j] = pr[64 * j]; } } } while (0)
        ROW_LOAD(0);
#pragma unroll 1
        for (int g = 0; g < 4; ++g) {
            f32x4 z[2][4];
            {   f32x4 y[4];
#pragma unroll
                for (int r = 0; r < 2; ++r) { const size_t mm = (size_t)(gw + (2 * g + r) * NGW);
                    ln_row(vx[r], y, ln_in_g, ln_in_b, lane);
#pragma unroll
                    for (int j = 0; j < 4; ++j) { const unsigned wl = (unsigned)vp[r][j], wh = (unsigned)(vp[r][j] >> 32); y[j] = y[j] * DN_ALPHA + (f32x4){pg8::bf_lo(wl), pg8::bf_hi(wl), pg8::bf_lo(wh), pg8::bf_hi(wh)}; }
                    ln_row(y, z[r], ln_mix_g, ln_mix_b, lane);
                    store_row_bf16(H1B + mm * DM, z[r], lane); } }
            if (g < 3) ROW_LOAD(g + 1);
            float vals[64];
            typedef float f32x2r __attribute__((ext_vector_type(2)));
            f32x2r zz[4][4];
#pragma unroll
            for (int j = 0; j < 4; ++j) { zz[j][0] = (f32x2r){z[0][j].x, z[1][j].x}; zz[j][1] = (f32x2r){z[0][j].y, z[1][j].y}; zz[j][2] = (f32x2r){z[0][j].z, z[1][j].z}; zz[j][3] = (f32x2r){z[0][j].w, z[1][j].w}; }
#pragma unroll
            for (int e = 0; e < 32; ++e) { f32x2r a = {0.f, 0.f};
#pragma unroll
                for (int j = 0; j < 4; ++j) { const f32x4 w = *(const LAS f32x4*)(WRT + e * 1024 + 4 * lane + 256 * j);
                    a = __builtin_elementwise_fma(zz[j][0], (f32x2r){w.x, w.x}, a); a = __builtin_elementwise_fma(zz[j][1], (f32x2r){w.y, w.y}, a);
                    a = __builtin_elementwise_fma(zz[j][2], (f32x2r){w.z, w.z}, a); a = __builtin_elementwise_fma(zz[j][3], (f32x2r){w.w, w.w}, a); }
                vals[e] = a.x; vals[32 + e] = a.y; }
#define ROW_RED(S_, H_) _Pragma("unroll") for (int i = 0; i < (H_); ++i) { const bool up = (lane & (S_)) != 0; const float snd = up ? vals[i] : vals[i + (H_)], kp = up ? vals[i + (H_)] : vals[i]; vals[i] = kp + __shfl_xor(snd, (S_)); }
            ROW_RED(32, 32) ROW_RED(16, 16) ROW_RED(8, 8) ROW_RED(4, 4) ROW_RED(2, 2) ROW_RED(1, 1)
#undef ROW_RED
            float lv = vals[0] + b_router[lane & 31];
            int te_[4] = {0, 0, 0, 0}, tr_[4] = {0, 0, 0, 0}; float tg_[4] = {0.f, 0.f, 0.f, 0.f}, tv[4];
#pragma unroll
            for (int k = 0; k < 4; ++k) { float bv = lv; int bi = lane & 31;
#pragma unroll
                for (int s = 1; s < 32; s <<= 1) { const float ov = __shfl_xor(bv, s); const int oi = __shfl_xor(bi, s); const bool tk = (ov > bv) || (ov == bv && oi < bi); bv = tk ? ov : bv; bi = tk ? oi : bi; }
                tv[k] = bv; te_[k] = bi; if ((lane & 31) == bi) lv = -3.0e38f; }
            { float ssum = 0.f;
#pragma unroll
                for (int k = 0; k < 4; ++k) { tg_[k] = __expf(tv[k] - tv[0]); ssum += tg_[k]; }
                const float rs = 1.0f / ssum;
#pragma unroll
                for (int k = 0; k < 4; ++k) tg_[k] *= rs; }
            if ((lane & 31) == 0) {
#pragma unroll
                for (int k = 0; k < 4; ++k) tr_[k] = atomicAdd((int*)(HIST + te_[k]), 1); }
#pragma unroll
            for (int gg = 0; gg < 4; ++gg) if (gg == g) {
#pragma unroll
                for (int k = 0; k < 4; ++k) { te[gg][k] = te_[k]; tr[gg][k] = tr_[k]; tgt[gg][k] = tg_[k]; } }
        }
#undef ROW_LOAD
        __syncthreads();
        if (tid < 32) BASE[tid] = (int)__hip_atomic_fetch_add(ctl + CW_CNT + 64 * tid, (unsigned)HIST[tid], __ATOMIC_RELAXED, __HIP_MEMORY_SCOPE_AGENT);
        __syncthreads();
        if ((lane & 31) == 0) {
#pragma unroll
            for (int g = 0; g < 4; ++g) { const int t2 = gw + (2 * g + (lane >> 5)) * NGW;
#pragma unroll
                for (int k = 0; k < 4; ++k) { const int e = te[g][k], pos = BASE[e] + tr[g][k];
                    TOKOF[(size_t)e * T_TOK + pos] = t2; PAIR_E[t2 * 4 + k] = e; PAIR_POS[t2 * 4 + k] = pos; PAIR_G[t2 * 4 + k] = tgt[g][k]; } } }
    }
    SEAM(7);

#define GROUPED_PREP(NT_, GATHER_) do { \
        LAS int* CUM = (LAS int*)(ldsl + TBL_CUM); LAS int* CNT = (LAS int*)(ldsl + TBL_CNT); LAS int* DESC = (LAS int*)(ldsl + TBL_DESC); LAS int* IDX = (LAS int*)(ldsl + TBL_IDX); \
        if (tid == 0) { int c = 0; for (int e = 0; e < NE; ++e) { const int n = (int)__hip_atomic_load(ctl + CW_CNT + 64 * e, __ATOMIC_RELAXED, __HIP_MEMORY_SCOPE_AGENT); CNT[e] = n; CUM[e] = c; c += (n + 255) >> 8; } CUM[NE] = c; } \
        __syncthreads(); \
        if (tid < pg8::MAXU) { const int nwg = (NT_) * CUM[NE]; const long L = (long)tid * G + bx; int valid = 0, ab = 0, bb = 0, pn = 0, e = 0, pm = 0; \
            if (L < nwg) { int wgid = (int)L; { const int q = nwg / 8, r = nwg % 8, xcd = wgid % 8, off = wgid / 8; wgid = (xcd < r ? xcd * (q + 1) : r * (q + 1) + (xcd - r) * q) + off; } \
                while (e < NE - 1 && wgid >= (NT_) * CUM[e + 1]) ++e; \
                const int r2 = wgid - (NT_) * CUM[e], te_ = CUM[e + 1] - CUM[e]; pn = r2 / te_; pm = r2 % te_; ab = CUM[e] + pm; bb = e * (NT_) + pn; valid = 1; } \
            DESC[tid * 8 + 0] = valid; DESC[tid * 8 + 1] = ab; DESC[tid * 8 + 2] = bb; DESC[tid * 8 + 3] = pn; DESC[tid * 8 + 4] = e; DESC[tid * 8 + 5] = pm; } \
        __syncthreads(); \
        if (GATHER_) { for (int i = 0; i < pg8::MAXU; ++i) { if (DESC[i * 8] == 0) break; const int e = DESC[i * 8 + 4], pm = DESC[i * 8 + 5]; \
            if (tid < 256) { const int slot = pm * 256 + tid; IDX[i * 256 + tid] = slot < CNT[e] ? TOKOF[(size_t)e * T_TOK + slot] : 0; } } \
            __syncthreads(); } } while (0)
    if (IN(8)) DUP(8) {
        gu32* const ctl = (gu32*)(WSB + WS_CTL);
        int* const TOKOF = (int*)(WSB + WS_TOKOF); bf16* const H1B = (bf16*)(WSB + WS_H1B); bf16* const WGU_T = (bf16*)(WSB + WS_WGU); bf16* const ACT = (bf16*)(WSB + WS_ACT);
        const float* const b_gate_up = INP(16);
        GROUPED_PREP(8, true);
        pg8::Gemm g{H1B, WGU_T, T_TOK, 2048, DM}; pg8::GroupedOrder S{(const LAS int*)(ldsl + TBL_DESC), (const LAS int*)(ldsl + TBL_IDX)};
        pg8::EpiAct E{ACT, b_gate_up};
        pg8::gemm_phase<pg8::EpiAct, pg8::GroupedOrder, true, true, true>(ldsl + RING_OFF, g, S, E);
    }
#if (DUP_MASK >> 12) & 1
    if (IN(8)) {
        gu32* const ctl = (gu32*)(WSB + WS_CTL);
        int* const TOKOF = (int*)(WSB + WS_TOKOF); bf16* const H1B = (bf16*)(WSB + WS_H1B); bf16* const WGU_T = (bf16*)(WSB + WS_WGU); bf16* const ACT = (bf16*)(WSB + WS_ACT);
        const float* const b_gate_up = INP(16);
        GROUPED_PREP(8, true);
        pg8::Gemm g{H1B, WGU_T, T_TOK, 2048, DM}; pg8::GroupedOrder S{(const LAS int*)(ldsl + TBL_DESC), (const LAS int*)(ldsl + TBL_IDX)};
        pg8::EpiAct E{ACT, b_gate_up};
        pg8::gemm_phase<pg8::EpiAct, pg8::GroupedOrder, true, true, true>(ldsl + RING_OFF, g, S, E);
    }
#endif
    SEAM(8);
    if (IN(9)) DUP(9) {
        gu32* const ctl = (gu32*)(WSB + WS_CTL);
        bf16* const ACT = (bf16*)(WSB + WS_ACT); bf16* const WDN_T = (bf16*)(WSB + WS_WDN); bf16* const YS = (bf16*)(WSB + WS_YS);
        int* const TOKOF = nullptr;
        const float* const b_down = INP(18);
        GROUPED_PREP(4, false);
        pg8::Gemm g{ACT, WDN_T, SLOT_ROWS, 1024, DFF}; pg8::GroupedOrder S{(const LAS int*)(ldsl + TBL_DESC), (const LAS int*)(ldsl + TBL_IDX)};
        pg8::EpiDown E{YS, b_down};
        pg8::gemm_phase<pg8::EpiDown, pg8::GroupedOrder, true, true, false>(ldsl + RING_OFF, g, S, E);
    }
    SEAM(9);

    if (IN(10)) DUP(10) {
        gu32* const ctl = (gu32*)(WSB + WS_CTL);
        const bf16* const H1B = (const bf16*)(WSB + WS_H1B); int* const PAIR_E = (int*)(WSB + WS_PAIR); int* const PAIR_POS = PAIR_E + T_TOK * 4; float* const PAIR_G = (float*)(PAIR_POS + T_TOK * 4); bf16* const YS = (bf16*)(WSB + WS_YS);
        const float* const ln_ffn_g = INP(19); const float* const ln_ffn_b = INP(20);
        float* const out = (float*)ldptr(PT, 21);
        LAS int* CUM = (LAS int*)(ldsl + TBL_CUM);
        if (tid == 0) { int c = 0; for (int e = 0; e < NE; ++e) { const int n = (int)__hip_atomic_load(ctl + CW_CNT + 64 * e, __ATOMIC_RELAXED, __HIP_MEMORY_SCOPE_AGENT); CUM[e] = c; c += (n + 255) >> 8; } CUM[NE] = c; }
        __syncthreads();
        const int gw = vcu * NWAVES + wave, NGW = G * NWAVES;
        int pslot = 0; float pgate = 0.f;
        if (lane < 32) { const int q = (gw + (lane >> 2) * NGW) * 4 + (lane & 3); pslot = CUM[PAIR_E[q]] * 256 + PAIR_POS[q]; pgate = PAIR_G[q]; }
        for (int it = 0; it < 4; ++it) {
            f32x4 v[2][4], y[4]; unsigned long long yv[2][4][4]; float gk[2][4];
#pragma unroll
            for (int r = 0; r < 2; ++r) { const size_t mm = (size_t)(gw + (2 * it + r) * NGW); const GAS unsigned long long* hr = (const GAS unsigned long long*)(H1B + mm * DM) + lane;
#pragma unroll
                for (int j = 0; j < 4; ++j) { const unsigned long long w = hr[64 * j]; const unsigned wl = (unsigned)w, wh = (unsigned)(w >> 32); v[r][j] = (f32x4){pg8::bf_lo(wl), pg8::bf_hi(wl), pg8::bf_lo(wh), pg8::bf_hi(wh)}; }
#pragma unroll
                for (int k = 0; k < 4; ++k) { const int slot = __builtin_amdgcn_readfirstlane(__shfl(pslot, (2 * it + r) * 4 + k)); gk[r][k] = __shfl(pgate, (2 * it + r) * 4 + k);
                    const GAS unsigned long long* yr = (const GAS unsigned long long*)(YS + (size_t)slot * 1024) + lane;
#pragma unroll
                    for (int j = 0; j < 4; ++j) yv[r][k][j] = yr[64 * j]; } }
#pragma unroll
            for (int r = 0; r < 2; ++r) { const size_t mm = (size_t)(gw + (2 * it + r) * NGW);
#pragma unroll
                for (int j = 0; j < 4; ++j) v[r][j] = v[r][j] * DN_ALPHA;
#pragma unroll
                for (int k = 0; k < 4; ++k)
#pragma unroll
                    for (int j = 0; j < 4; ++j) { const unsigned long long w = yv[r][k][j]; const unsigned wl = (unsigned)w, wh = (unsigned)(w >> 32); const float g = gk[r][k];
                        v[r][j].x += g * pg8::bf_lo(wl); v[r][j].y += g * pg8::bf_hi(wl); v[r][j].z += g * pg8::bf_lo(wh); v[r][j].w += g * pg8::bf_hi(wh); }
                ln_row(v[r], y, ln_ffn_g, ln_ffn_b, lane);
                GAS f32x4* orow = (GAS f32x4*)(out + mm * DM) + lane;
#pragma unroll
                for (int j = 0; j < 4; ++j) orow[64 * j] = y[j]; } }
    }
    if (STAMP_K >= 0 && bx == 0 && tid == 0) { const unsigned long long t_end = __builtin_amdgcn_s_memrealtime(), dt = t_stamp_a - t_stamp_0; while (__builtin_amdgcn_s_memrealtime() - t_end < dt) __builtin_amdgcn_s_sleep(8); }
#undef IN
#undef INP
#undef WSB
#undef SEAM
#undef GROUPED_PREP
}

#ifndef MK_SPLIT
#define MK_SPLIT 0
#endif
extern "C" void kernel_launch(void* const* d_in, const int* in_sizes, int n_in, void* d_out, int out_size, void* d_ws, size_t ws_size, hipStream_t stream) {
    static int grid = 0;
    if (grid == 0) {
        if (n_in != 21 || in_sizes[0] != T_TOK * DM || out_size != T_TOK * DM || ws_size < WS_END) {
            fprintf(stderr, "kernel_launch: built for 21 inputs, x/out of %d floats, >= %zu bytes of workspace; got n_in %d, in0 %d, out %d, ws %zu; nothing launched\n", T_TOK * DM, (size_t)WS_END, n_in, n_in > 0 ? in_sizes[0] : -1, out_size, ws_size); grid = -1; return; }
        int dev = 0, cus = 0, per_cu = 0;
        if (hipGetDevice(&dev) != hipSuccess || hipDeviceGetAttribute(&cus, hipDeviceAttributeMultiprocessorCount, dev) != hipSuccess) { fprintf(stderr, "kernel_launch: device query failed\n"); grid = -1; return; }
        if (hipFuncSetAttribute((const void*)mega_fwd, hipFuncAttributeMaxDynamicSharedMemorySize, LDS_BYTES) != hipSuccess) { fprintf(stderr, "kernel_launch: hipFuncSetAttribute failed\n"); grid = -1; return; }
        if (hipOccupancyMaxActiveBlocksPerMultiprocessor(&per_cu, (const void*)mega_fwd, NTHR, LDS_BYTES) != hipSuccess || per_cu < 1) fprintf(stderr, "kernel_launch: occupancy query reports %d blocks per CU\n", per_cu);
        (void)hipGetLastError();
        grid = cus;
        if (grid != 256) { fprintf(stderr, "kernel_launch: this kernel's work split needs exactly 256 CUs, device has %d; nothing launched\n", grid); grid = -1; return; }
    }
    if (grid < 0) return;
    if (hipMemsetAsync((char*)d_ws + WS_CTL, 0, CTL_ZERO_BYTES, stream) != hipSuccess) { fprintf(stderr, "kernel_launch: hipMemsetAsync failed\n"); return; }
    Args a{};
    for (int i = 0; i < 21; ++i) a.in[i] = (const float*)d_in[i];
    a.out = (float*)d_out; a.ws = (unsigned char*)d_ws;
#if MK_SPLIT
    for (int p = 0; p < NPH; ++p) { a.ph_lo = p; a.ph_hi = p + 1; a.li = p; hipLaunchKernelGGL(mega_fwd, dim3(grid), dim3(NTHR), LDS_BYTES, stream, a); }
#else
    a.ph_lo = 0; a.ph_hi = NPH; a.li = 0;
    hipLaunchKernelGGL(mega_fwd, dim3(grid), dim3(NTHR), LDS_BYTES, stream, a);
#endif
    const hipError_t le = hipPeekAtLastError();
    if (le != hipSuccess) fprintf(stderr, "kernel_launch: launch failed: %s\n", hipGetErrorName(le));
}
```

```cpp
#define DUP_MASK 0
#include <hip/hip_runtime.h>
#include <hip/hip_bf16.h>
#include <cstdio>
#include <cstdint>
#include <cmath>
namespace pg8 {
#define PG8_LAS __attribute__((address_space(3)))
typedef unsigned short bf16_t;
typedef short bf16x8 __attribute__((ext_vector_type(8)));
typedef float f32x4 __attribute__((ext_vector_type(4)));
typedef unsigned u32x4 __attribute__((ext_vector_type(4)));
constexpr int BM = 256, BK = 64, HALF = 128, HTB = HALF * BK * 2  , STAGE_BYTES = 8 * HTB, NXCD = 8, WGM = 8;

__host__ __device__ __forceinline__ int lds_byte(int r, int c) { const int st = (r >> 4) * 2 + (c >> 5), rr = r & 15, cc = c & 31, ob = rr * 64 + cc * 2; return st * 1024 + (ob ^ (((ob >> 9) & 1) << 5)); }
__host__ __device__ __forceinline__ void stage_rc(int b, int& R, int& C) { const int st = b / 1024, sb = b % 1024, swz = sb ^ (((sb >> 9) & 1) << 5); R = (st >> 1) * 16 + swz / 64; C = (st & 1) * 32 + (swz % 64) / 2; }
__host__ __device__ __forceinline__ int perm32(int rho) { const int n = rho >> 4, i = rho & 15; return 8 * (i >> 2) + 4 * n + (i & 3); }

struct Unit { int pm, pn, ab, bb, aux; };
struct Gemm { const bf16_t* A; const bf16_t* Bt; int M, N, K; };

struct StaticOrder {
    int nM, nN, nwg, G, c;
    __host__ __device__ void init(int M, int N, int G_, int c_) { nM = M / BM; nN = N / BM; nwg = nM * nN; G = G_; c = c_; }
    __host__ __device__ bool next(int i, Unit& u) const {
        const long L = (long)i * G + c; if (L >= nwg) return false;
        int wgid = (int)L; { const int q = nwg / NXCD, r = nwg % NXCD, xcd = wgid % NXCD, off = wgid / NXCD; wgid = (xcd < r ? xcd * (q + 1) : r * (q + 1) + (xcd - r) * q) + off; }
        const int nig = WGM * nN, gid = wgid / nig, fm = gid * WGM, gsz = (nM - fm) < WGM ? (nM - fm) : WGM;
        u.pm = fm + ((wgid % nig) % gsz); u.pn = (wgid % nig) / gsz; u.ab = u.pm; u.bb = u.pn; u.aux = 0; return true;
    }
    __device__ __forceinline__ void a_ready(const Unit&) const {}
    __device__ __forceinline__ void done(const Unit&) const {}
    __device__ __forceinline__ const PG8_LAS int* rowidx(int) const { return nullptr; }
};

__device__ __forceinline__ unsigned cvt_pk_bf16(float lo, float hi) { unsigned r; asm volatile("v_cvt_pk_bf16_f32 %0, %1, %2" : "=v"(r) : "v"(lo), "v"(hi)); return r; }
typedef float f32x2 __attribute__((ext_vector_type(2)));
__device__ __forceinline__ f32x2 gelu_pk(f32x2 v) {
    const f32x2 av = __builtin_elementwise_abs(v), d = av * 0.2316418882f + 1.0f;
    f32x2 t; t.x = __builtin_amdgcn_rcpf(d.x); t.y = __builtin_amdgcn_rcpf(d.y);
    f32x2 q = t * 0.5307027145f + (-0.7265760135f); q = q * t + 0.7107068705f; q = q * t + (-0.142248368f); q = q * t + 0.127414796f; q = q * t;
    const f32x2 s = (v * v) * (-0.72134752044f);
    f32x2 e; e.x = __builtin_amdgcn_exp2f(s.x); e.y = __builtin_amdgcn_exp2f(s.y);
    const f32x2 m = v * (q * e), r = v - m;
    f32x2 o; o.x = v.x < 0.f ? m.x : r.x; o.y = v.y < 0.f ? m.y : r.y; return o;
}

template <int ACT  > struct EpiBf16 {
    static constexpr bool PERM = true, AFTER_DRAIN = false; static_assert(ACT == 0 || ACT == 1, "EpiBf16: ACT is 0 (none) or 1 (gelu_pk)");
    bf16_t* O; int ldc; const float* bias; int split_cols; size_t split_stride; float scale0;
    __device__ __forceinline__ void operator()(const f32x4 (&acc)[2][2][4][2], const Unit& u, int wr, int wc, int fr, int fq) const {
        const int row0 = u.pm * BM + wr * 64 + fr; int colt = u.pn * BM; bf16_t* base = O;
        float sc = 1.f; if (split_cols) { const int t = colt / split_cols; base += (size_t)t * split_stride; colt -= t * split_cols; if (t == 0) sc = scale0; }
        const int col0 = colt + wc * 32 + 8 * fq, bcol0 = u.pn * BM + wc * 32 + 8 * fq;
        f32x4 bv[2][2];
#pragma unroll
        for (int bj = 0; bj < 2; ++bj)
#pragma unroll
            for (int n = 0; n < 2; ++n) bv[bj][n] = bias ? *(const f32x4*)(bias + bcol0 + bj * HALF + 4 * n) : (f32x4){0.f, 0.f, 0.f, 0.f};
#pragma unroll
        for (int ai = 0; ai < 2; ++ai)
#pragma unroll
            for (int m = 0; m < 4; ++m) { bf16_t* rowp = base + (size_t)(row0 + ai * HALF + m * 16) * ldc + col0;
#pragma unroll
                for (int bj = 0; bj < 2; ++bj) { f32x4 v0 = acc[ai][bj][m][0] + bv[bj][0], v1 = acc[ai][bj][m][1] + bv[bj][1];
                    if (ACT == 1) { f32x2 a = gelu_pk((f32x2){v0[0], v0[1]}), b = gelu_pk((f32x2){v0[2], v0[3]}), c = gelu_pk((f32x2){v1[0], v1[1]}), d = gelu_pk((f32x2){v1[2], v1[3]});
                        v0 = (f32x4){a.x, a.y, b.x, b.y}; v1 = (f32x4){c.x, c.y, d.x, d.y}; }
                    v0 = v0 * sc; v1 = v1 * sc; u32x4 w; w.x = cvt_pk_bf16(v0[0], v0[1]); w.y = cvt_pk_bf16(v0[2], v0[3]); w.z = cvt_pk_bf16(v1[0], v1[1]); w.w = cvt_pk_bf16(v1[2], v1[3]);
                    *(u32x4*)(rowp + bj * HALF) = w; } }
    }
};

struct PanelStats {
    unsigned* xbuf;
    unsigned* cnt;
    unsigned* tmo;
    int ntn; float eps;
    unsigned code;
    __device__ __forceinline__ bool run(const f32x4 (&v)[2][2][4][2], const Unit& u, int wr, int wc, int fr, int fq, PG8_LAS unsigned char* lds, int wid, int lane) const {
        typedef float f32x2v __attribute__((ext_vector_type(2)));
        PG8_LAS f32x2v* P = (PG8_LAS f32x2v*)lds;
        PG8_LAS f32x2v* S = (PG8_LAS f32x2v*)(lds + 8192);
        PG8_LAS unsigned* flag = (PG8_LAS unsigned*)(lds + 8192 + 2048);
#pragma unroll
        for (int ai = 0; ai < 2; ++ai)
#pragma unroll
            for (int m = 0; m < 4; ++m) {
                float s = 0.f;
#pragma unroll
                for (int bj = 0; bj < 2; ++bj)
#pragma unroll
                    for (int n = 0; n < 2; ++n) { const f32x4 x = v[ai][bj][m][n]; s += (x[0] + x[1]) + (x[2] + x[3]); }
                s += __shfl_xor(s, 16); s += __shfl_xor(s, 32);
                const float mw = s * (1.0f / 64.0f); float q = 0.f;
#pragma unroll
                for (int bj = 0; bj < 2; ++bj)
#pragma unroll
                    for (int n = 0; n < 2; ++n) { const f32x4 d = v[ai][bj][m][n] - mw; q += (d[0] * d[0] + d[1] * d[1]) + (d[2] * d[2] + d[3] * d[3]); }
                q += __shfl_xor(q, 16); q += __shfl_xor(q, 32);
                if (fq == 0) P[(ai * HALF + wr * 64 + m * 16 + fr) * 4 + wc] = (f32x2v){mw, q};
            }
        asm volatile("s_waitcnt lgkmcnt(0)" ::: "memory"); __builtin_amdgcn_s_barrier(); asm volatile("" ::: "memory");
#if defined(BROKEN_EXCHANGE_NO_WAIT)
#warning BROKEN CONTROL BUILD: the row-statistics exchange does not wait; results are wrong by design
        if (blockIdx.x >= 64) { const long long t0_ = clock64(); while (clock64() - t0_ < 60000) __builtin_amdgcn_s_sleep(8); }
#endif
        const int row = wid * 32 + (lane & 31);
        if (lane < 32) {
            const f32x2v a = P[row * 4 + 0], b = P[row * 4 + 1], c = P[row * 4 + 2], d = P[row * 4 + 3];
            const float mt = (a.x + b.x + c.x + d.x) * 0.25f;
            const float da = a.x - mt, db = b.x - mt, dc = c.x - mt, dd = d.x - mt;
            const float m2 = (a.y + b.y) + (c.y + d.y) + 64.0f * ((da * da + db * db) + (dc * dc + dd * dd));
            unsigned long long* slot = (unsigned long long*)xbuf + ((size_t)(u.pm * BM + row) * 4 + u.pn);
            __hip_atomic_store(slot, ((unsigned long long)__float_as_uint(m2) << 32) | __float_as_uint(mt), __ATOMIC_RELAXED, __HIP_MEMORY_SCOPE_AGENT);
        }
        asm volatile("s_waitcnt vmcnt(0)" ::: "memory");
        if (lane == 0) __hip_atomic_fetch_add(cnt + 64 * u.pm, 1u, __ATOMIC_RELAXED, __HIP_MEMORY_SCOPE_AGENT);
        if (wid == 0) {
            bool dead = false; const unsigned long long t0 = __builtin_amdgcn_s_memrealtime(); const unsigned want = 8u * (unsigned)ntn;
            for (;;) {
#if defined(BROKEN_EXCHANGE_NO_WAIT)
                break;
#endif
                if ((unsigned)__builtin_amdgcn_readfirstlane(__hip_atomic_load(cnt + 64 * u.pm, __ATOMIC_RELAXED, __HIP_MEMORY_SCOPE_AGENT)) >= want) break;
                if (__builtin_amdgcn_s_memrealtime() - t0 > 2000000ull) {
                    if (lane == 0) { unsigned expect = 0u; __hip_atomic_compare_exchange_strong(tmo + 1, &expect, code | (unsigned)(u.pm & 0xff), __ATOMIC_RELAXED, __ATOMIC_RELAXED, __HIP_MEMORY_SCOPE_AGENT);
                                     __hip_atomic_store(tmo, 1u, __ATOMIC_RELAXED, __HIP_MEMORY_SCOPE_AGENT); }
                    dead = true; break; }
                __builtin_amdgcn_s_sleep(2);
            }
            __builtin_amdgcn_fence(__ATOMIC_ACQUIRE, "agent");
            if (lane == 0) flag[0] = dead ? 1u : 0u;
        }
        asm volatile("s_waitcnt vmcnt(0) lgkmcnt(0)" ::: "memory"); __builtin_amdgcn_s_barrier(); asm volatile("" ::: "memory");
        const bool bad = flag[0] != 0u;
        if (lane < 32) {
            const unsigned long long* slot = (const unsigned long long*)xbuf + (size_t)(u.pm * BM + row) * 4; float mt[4], m2[4]; float ms = 0.f;
#pragma unroll
            for (int t = 0; t < 4; ++t) { if (t < ntn) { const unsigned long long w = __hip_atomic_load(slot + t, __ATOMIC_RELAXED, __HIP_MEMORY_SCOPE_AGENT); mt[t] = __uint_as_float((unsigned)w); m2[t] = __uint_as_float((unsigned)(w >> 32)); } else { mt[t] = 0.f; m2[t] = 0.f; } ms += mt[t]; }
            const float mean = ms / (float)ntn; float q = 0.f;
#pragma unroll
            for (int t = 0; t < 4; ++t) if (t < ntn) { const float dm = mt[t] - mean; q += m2[t] + 256.0f * dm * dm; }
            S[row] = (f32x2v){mean, 1.0f / sqrtf(q / (256.0f * (float)ntn) + eps)};
        }
        asm volatile("s_waitcnt lgkmcnt(0)" ::: "memory"); __builtin_amdgcn_s_barrier(); asm volatile("" ::: "memory");
        return bad;
    }
};
struct EpiLnRes {
    static constexpr bool PERM = false, AFTER_DRAIN = true;
    const float* base; float* out; int ldc; const float* bias; PanelStats st; unsigned poison;
    __device__ __forceinline__ void fused(f32x4 (&acc)[2][2][4][2], const Unit& u, int wr, int wc, int fr, int fq, PG8_LAS unsigned char* lds, int wid, int lane) const {
        typedef float f32x2v __attribute__((ext_vector_type(2)));
        const PG8_LAS f32x2v* S = (const PG8_LAS f32x2v*)(lds + 8192);
        const int col0 = u.pn * BM + wc * 32 + 4 * fq;
#pragma unroll
        for (int bj = 0; bj < 2; ++bj)
#pragma unroll
            for (int n = 0; n < 2; ++n) { const f32x4 bv = bias ? *(const f32x4*)(bias + col0 + bj * HALF + n * 16) : (f32x4){0.f, 0.f, 0.f, 0.f};
#pragma unroll
                for (int ai = 0; ai < 2; ++ai)
#pragma unroll
                    for (int m = 0; m < 4; ++m) acc[ai][bj][m][n] += bv; }
        f32x4 pre[4][2][2];
#pragma unroll
        for (int m = 0; m < 4; ++m) { const size_t off = (size_t)(u.pm * BM + wr * 64 + m * 16 + fr) * ldc + col0;
#pragma unroll
            for (int bj = 0; bj < 2; ++bj)
#pragma unroll
                for (int n = 0; n < 2; ++n) pre[m][bj][n] = *(const f32x4*)(base + off + bj * HALF + n * 16); }
        const bool bad = st.run(acc, u, wr, wc, fr, fq, lds, wid, lane) || poison != 0u;
        const float qnan = __builtin_nanf("");
#pragma unroll
        for (int ai = 0; ai < 2; ++ai)
#pragma unroll
            for (int m = 0; m < 4; ++m) { const int r = ai * HALF + wr * 64 + m * 16 + fr; const f32x2v sr = S[r]; const size_t off = (size_t)(u.pm * BM + r) * ldc + col0;
#pragma unroll
                for (int bj = 0; bj < 2; ++bj)
#pragma unroll
                    for (int n = 0; n < 2; ++n) { const f32x4 bs = ai == 0 ? pre[m][bj][n] : *(const f32x4*)(base + off + bj * HALF + n * 16); f32x4 o = bs + (acc[ai][bj][m][n] - sr.x) * sr.y;
                        if (bad) o = (f32x4){qnan, qnan, qnan, qnan}; *(f32x4*)(out + off + bj * HALF + n * 16) = o; }
                if (m & 1) asm volatile("" ::: "memory"); }
    }
};
struct EpiLnResLn {
    static constexpr bool PERM = false, AFTER_DRAIN = true;
    const float* base; float* out; bf16_t* xn; int ldc; const float* bias; PanelStats st1, st2; unsigned poison;
    __device__ __forceinline__ void fused(f32x4 (&acc)[2][2][4][2], const Unit& u, int wr, int wc, int fr, int fq, PG8_LAS unsigned char* lds, int wid, int lane) const {
        typedef float f32x2v __attribute__((ext_vector_type(2))); typedef unsigned u32x2v __attribute__((ext_vector_type(2)));
        const PG8_LAS f32x2v* S = (const PG8_LAS f32x2v*)(lds + 8192);
        const int col0 = u.pn * BM + wc * 32 + 4 * fq;
#pragma unroll
        for (int bj = 0; bj < 2; ++bj)
#pragma unroll
            for (int n = 0; n < 2; ++n) { const f32x4 bv = bias ? *(const f32x4*)(bias + col0 + bj * HALF + n * 16) : (f32x4){0.f, 0.f, 0.f, 0.f};
#pragma unroll
                for (int ai = 0; ai < 2; ++ai)
#pragma unroll
                    for (int m = 0; m < 4; ++m) acc[ai][bj][m][n] += bv; }
        bool bad = st1.run(acc, u, wr, wc, fr, fq, lds, wid, lane) || poison != 0u;
        const float qnan = __builtin_nanf("");
#pragma unroll
        for (int ai = 0; ai < 2; ++ai)
#pragma unroll
            for (int m = 0; m < 4; ++m) { const int r = ai * HALF + wr * 64 + m * 16 + fr; const f32x2v sr = S[r]; const size_t off = (size_t)(u.pm * BM + r) * ldc + col0;
#pragma unroll
                for (int bj = 0; bj < 2; ++bj)
#pragma unroll
                    for (int n = 0; n < 2; ++n) { const f32x4 bs = *(const f32x4*)(base + off + bj * HALF + n * 16); acc[ai][bj][m][n] = bs + (acc[ai][bj][m][n] - sr.x) * sr.y; }
                asm volatile("" : "+v"(acc[ai][0][m][0]), "+v"(acc[ai][0][m][1]), "+v"(acc[ai][1][m][0]), "+v"(acc[ai][1][m][1]));
                if (m & 1) asm volatile("" ::: "memory"); }
        const bool bad1 = bad;
        bad = st2.run(acc, u, wr, wc, fr, fq, lds, wid, lane) || bad;
#pragma unroll
        for (int ai = 0; ai < 2; ++ai)
#pragma unroll
            for (int m = 0; m < 4; ++m) { const int r = ai * HALF + wr * 64 + m * 16 + fr; const f32x2v sr = S[r]; const size_t off = (size_t)(u.pm * BM + r) * ldc + col0;
#pragma unroll
                for (int bj = 0; bj < 2; ++bj)
#pragma unroll
                    for (int n = 0; n < 2; ++n) { const f32x4 x1 = acc[ai][bj][m][n]; *(f32x4*)(out + off + bj * HALF + n * 16) = bad1 ? (f32x4){qnan, qnan, qnan, qnan} : x1;
                        const f32x4 o = (x1 - sr.x) * sr.y; u32x2v w; w.x = cvt_pk_bf16(o[0], o[1]); w.y = cvt_pk_bf16(o[2], o[3]);
                        if (bad) { w.x = 0x7fc07fc0u; w.y = 0x7fc07fc0u; } *(u32x2v*)(xn + off + bj * HALF + n * 16) = w; }
                asm volatile("" ::: "memory"); }
    }
};

template <class E, class = void> struct epi_chains { static constexpr bool value = false; };
template <class E> struct epi_chains<E, decltype((void)E::CHAIN)> { static constexpr bool value = E::CHAIN; };
template <class Epi, class Sched, bool ALIGN_EPI = false, bool SP2 = false, bool GATHER = false>
__device__ __forceinline__ void gemm_phase(PG8_LAS unsigned char* lds, const Gemm g, const Sched& S, const Epi& E) {
    const int tid = threadIdx.x, wid = __builtin_amdgcn_readfirstlane(tid >> 6), lane = tid & 63, wr = wid >> 2, wc = wid & 3, fr = lane & 15, fq = lane >> 4;
    const int K = g.K, nt = K / BK;
    unsigned voffA[2], voffB[2]; int gR[2], gC[2];
#pragma unroll
    for (int i = 0; i < 2; ++i) { int R, C; stage_rc(tid * 16 + i * 8192, R, C); const int Rb = Epi::PERM ? ((R & ~31) + perm32(R & 31)) : R;
        voffA[i] = (unsigned)(R * K + C) * 2u; voffB[i] = (unsigned)(Rb * K + C) * 2u; gR[i] = R; gC[i] = C; }
    const size_t kstep = (size_t)(BK * 2);
    const size_t hstep = (size_t)HALF * K * 2;
    const size_t tstep = 2 * hstep;
    const unsigned ldsw = (unsigned)wid * 1024u;
    const int aoff = lds_byte(wr * 64 + fr, fq * 8), boff = lds_byte(wc * 32 + fr, fq * 8);
#define PG8_SA(b, h) (((b) * 2 + (h)) * HTB)
#define PG8_SB(b, h) ((4 + (b) * 2 + (h)) * HTB)
#define PG8_STAGE(bufoff, gbase, voff) do { _Pragma("unroll") for (int _i = 0; _i < 2; ++_i) \
        __builtin_amdgcn_global_load_lds((const unsigned*)((const char*)(gbase) + (voff)[_i]), (PG8_LAS unsigned*)(lds + (bufoff) + ldsw + _i * 8192), 16, 0, 0); } while (0)
#define PG8_STAGE_A(bufoff, gbase, h, nx) do { const unsigned _v0 = GATHER ? ((nx) ? vaN[h][0] : vaC[h][0]) : voffA[0], _v1 = GATHER ? ((nx) ? vaN[h][1] : vaC[h][1]) : voffA[1]; \
        const char* _gb = (const char*)(gbase) + (GATHER ? (size_t)0 : (size_t)(h) * hstep); \
        __builtin_amdgcn_global_load_lds((const unsigned*)(_gb + _v0), (PG8_LAS unsigned*)(lds + (bufoff) + ldsw), 16, 0, 0); \
        __builtin_amdgcn_global_load_lds((const unsigned*)(_gb + _v1), (PG8_LAS unsigned*)(lds + (bufoff) + ldsw + 8192), 16, 0, 0); } while (0)
#define PG8_LOADVA(va, uix) do { const PG8_LAS int* _ip = S.rowidx(uix); _Pragma("unroll") for (int _h = 0; _h < 2; ++_h) _Pragma("unroll") for (int _i = 0; _i < 2; ++_i) \
        va[_h][_i] = ((unsigned)_ip[_h * HALF + gR[_i]] * (unsigned)K + (unsigned)gC[_i]) * 2u; } while (0)
#define PG8_LDA(dst, b, h) do { _Pragma("unroll") for (int m = 0; m < 4; ++m) _Pragma("unroll") for (int k = 0; k < 2; ++k) dst[m][k] = *(const PG8_LAS bf16x8*)(lds + PG8_SA(b, h) + aoff + m * 2048 + k * 1024); } while (0)
#define PG8_LDB(dst, b, h) do { _Pragma("unroll") for (int n = 0; n < 2; ++n) _Pragma("unroll") for (int k = 0; k < 2; ++k) dst[n][k] = *(const PG8_LAS bf16x8*)(lds + PG8_SB(b, h) + boff + n * 2048 + k * 1024); } while (0)
#define PG8_MMA(ai, bj, At, Bt) do { __builtin_amdgcn_s_setprio(1); _Pragma("unroll") for (int m = 0; m < 4; ++m) _Pragma("unroll") for (int n = 0; n < 2; ++n) _Pragma("unroll") for (int k = 0; k < 2; ++k) \
        acc[ai][bj][m][n] = __builtin_amdgcn_mfma_f32_16x16x32_bf16(Bt[n][k], At[m][k], acc[ai][bj][m][n], 0, 0, 0); __builtin_amdgcn_s_setprio(0); } while (0)
#define PG8_WAIT_V(n) asm volatile("s_waitcnt vmcnt(" #n ")" ::: "memory")
#define PG8_WAIT_L(n) asm volatile("s_waitcnt lgkmcnt(" #n ")" ::: "memory")
#define PG8_BAR __builtin_amdgcn_s_barrier()
#define PG8_SCHED __builtin_amdgcn_sched_barrier(0)
    Unit cur, nxt; int ui = 0;
    static_assert(SP2, "only the SP2 loop is kept in this file");
    if (!S.next(0, cur)) return;
    f32x4 acc[2][2][4][2];
#pragma unroll
    for (int a = 0; a < 2; ++a)
#pragma unroll
        for (int b = 0; b < 2; ++b)
#pragma unroll
            for (int m = 0; m < 4; ++m)
#pragma unroll
                for (int n = 0; n < 2; ++n) acc[a][b][m][n] = (f32x4){0.f, 0.f, 0.f, 0.f};
    bf16x8 At[4][2], B0[2][2], B1[2][2];
    const char* cA = (const char*)g.A + (GATHER ? (size_t)0 : (size_t)cur.ab * tstep); const char* cB = (const char*)g.Bt + (size_t)cur.bb * tstep;
    unsigned vaC[2][2] = {{0u, 0u}, {0u, 0u}}, vaN[2][2] = {{0u, 0u}, {0u, 0u}};
    if constexpr (GATHER) { PG8_LOADVA(vaC, 0); }
    S.a_ready(cur);
    if constexpr (SP2) {
        PG8_STAGE(PG8_SB(0, 0), cB, voffB); PG8_STAGE(PG8_SB(0, 1), cB + hstep, voffB); PG8_STAGE_A(PG8_SA(0, 0), cA, 0, false); PG8_STAGE_A(PG8_SA(0, 1), cA, 1, false);
        if (wr == 1) PG8_BAR;
        PG8_WAIT_V(2); PG8_BAR;
        PG8_STAGE(PG8_SB(1, 0), cB + kstep, voffB); PG8_STAGE_A(PG8_SA(1, 0), cA + kstep, 0, false); PG8_STAGE(PG8_SB(1, 1), cB + hstep + kstep, voffB);
        PG8_WAIT_V(6); PG8_BAR;
    }
    for (;;) {
        const bool has_next = S.next(ui + 1, nxt);
        const char* nA = (has_next && !GATHER) ? (const char*)g.A + (size_t)nxt.ab * tstep : cA; const char* nB = has_next ? (const char*)g.Bt + (size_t)nxt.bb * tstep : cB;
        if constexpr (GATHER) { if (has_next) { PG8_LOADVA(vaN, ui + 1); } else { vaN[0][0] = vaC[0][0]; vaN[0][1] = vaC[0][1]; vaN[1][0] = vaC[1][0]; vaN[1][1] = vaC[1][1]; } }
        for (int t = 0; t < nt; t += 2) {
            const bool last = (t == nt - 2);
            const char* a1 = cA + (size_t)(t + 1) * kstep;
            const char* a2 = last ? nA : cA + (size_t)(t + 2) * kstep; const char* b2 = last ? nB : cB + (size_t)(t + 2) * kstep;
            const char* a3 = a2 + kstep; const char* b3 = b2 + kstep;
            if (last && has_next) S.a_ready(nxt);
            if constexpr (SP2) {
            PG8_LDB(B0, 0, 0); PG8_LDB(B1, 0, 1); PG8_SCHED; PG8_LDA(At, 0, 0); PG8_STAGE_A(PG8_SA(1, 1), a1, 1, false);
            PG8_WAIT_V(8); PG8_WAIT_L(0); PG8_BAR; PG8_MMA(0, 0, At, B0); PG8_MMA(0, 1, At, B1); PG8_BAR; PG8_SCHED;
            PG8_LDA(At, 0, 1); PG8_STAGE(PG8_SB(0, 0), b2, voffB); PG8_STAGE(PG8_SB(0, 1), b2 + hstep, voffB); PG8_STAGE_A(PG8_SA(0, 0), a2, 0, last);
            PG8_WAIT_V(8); PG8_WAIT_L(0); PG8_BAR; PG8_MMA(1, 0, At, B0); PG8_MMA(1, 1, At, B1); PG8_BAR; PG8_SCHED;
            PG8_LDB(B0, 1, 0); PG8_LDB(B1, 1, 1); PG8_SCHED; PG8_LDA(At, 1, 0); PG8_STAGE_A(PG8_SA(0, 1), a2, 1, last);
            PG8_WAIT_V(8); PG8_WAIT_L(0); PG8_BAR; PG8_MMA(0, 0, At, B0); PG8_MMA(0, 1, At, B1); PG8_BAR; PG8_SCHED;
            PG8_LDA(At, 1, 1); PG8_STAGE(PG8_SB(1, 0), b3, voffB); PG8_STAGE(PG8_SB(1, 1), b3 + hstep, voffB); PG8_STAGE_A(PG8_SA(1, 0), a3, 0, last);
            PG8_WAIT_V(8); PG8_WAIT_L(0); PG8_BAR; PG8_MMA(1, 0, At, B0); PG8_MMA(1, 1, At, B1); PG8_BAR; PG8_SCHED;
            }
        }
        if constexpr (ALIGN_EPI) { if (wr == 0) PG8_BAR; }
        if constexpr (!Epi::AFTER_DRAIN) { E(acc, cur, wr, wc, fr, fq); S.done(cur); }
        if (!has_next) break;
        if (!epi_chains<Epi>::value || cur.aux != 0) {
#pragma unroll
        for (int a = 0; a < 2; ++a)
#pragma unroll
            for (int b = 0; b < 2; ++b)
#pragma unroll
                for (int m = 0; m < 4; ++m)
#pragma unroll
                    for (int n = 0; n < 2; ++n) acc[a][b][m][n] = (f32x4){0.f, 0.f, 0.f, 0.f};
        }
        cur = nxt; cA = nA; cB = nB; ++ui;
        if constexpr (GATHER) { vaC[0][0] = vaN[0][0]; vaC[0][1] = vaN[0][1]; vaC[1][0] = vaN[1][0]; vaC[1][1] = vaN[1][1]; }
        if constexpr (ALIGN_EPI) { if (wr == 1) PG8_BAR; }
    }
    PG8_WAIT_V(0);
    if constexpr (!ALIGN_EPI) { if (wr == 0) PG8_BAR; }
    PG8_BAR;
    if constexpr (Epi::AFTER_DRAIN) { E.fused(acc, cur, wr, wc, fr, fq, lds, wid, lane); S.done(cur); }
#undef PG8_SA
#undef PG8_SB
#undef PG8_STAGE
#undef PG8_STAGE_A
#undef PG8_LOADVA
#undef PG8_LDA
#undef PG8_LDB
#undef PG8_MMA
#undef PG8_WAIT_V
#undef PG8_WAIT_L
#undef PG8_BAR
#undef PG8_SCHED
}
}
namespace pg8 {
__device__ __forceinline__ float bf_lo(unsigned w) { return __uint_as_float(w << 16); }
__device__ __forceinline__ float bf_hi(unsigned w) { return __uint_as_float(w & 0xffff0000u); }
__device__ __forceinline__ float sigm(float x) { return __builtin_amdgcn_rcpf(1.0f + __expf(-x)); }

struct EpiF32 {
    static constexpr bool PERM = false, AFTER_DRAIN = false;
    float* C; int ldc;
    __device__ __forceinline__ void operator()(const f32x4 (&acc)[2][2][4][2], const Unit& u, int wr, int wc, int fr, int fq) const {
        const int row0 = u.pm * BM + wr * 64 + fr, col0 = u.pn * BM + wc * 32 + 4 * fq;
#pragma unroll
        for (int ai = 0; ai < 2; ++ai)
#pragma unroll
            for (int m = 0; m < 4; ++m) { float* rowp = C + (size_t)(row0 + ai * HALF + m * 16) * ldc + col0;
#pragma unroll
                for (int bj = 0; bj < 2; ++bj)
#pragma unroll
                    for (int n = 0; n < 2; ++n) *(f32x4*)(rowp + bj * HALF + n * 16) = acc[ai][bj][m][n]; }
    }
};

struct EpiProj {
    static constexpr bool PERM = true, AFTER_DRAIN = false;
    bf16_t* O; float* SMp; bf16_t* QKV; bf16_t* ZIMG;
    __device__ __forceinline__ void operator()(const f32x4 (&acc)[2][2][4][2], const Unit& u, int wr, int wc, int fr, int fq) const {
        const int row0 = u.pm * BM + wr * 64 + fr;
        if (u.pn >= 12 && u.pn < 24) {
            const int which = (u.pn - 12) >> 2, hp = (u.pn - 12) & 3; bf16_t* base = QKV + (size_t)which * (32u * 4096u * 128u) + wc * 32 + 8 * fq;
#pragma unroll
            for (int ai = 0; ai < 2; ++ai)
#pragma unroll
                for (int m = 0; m < 4; ++m) { const int row = row0 + ai * HALF + m * 16; const int b = row >> 12, s = row & 4095;
#pragma unroll
                    for (int bj = 0; bj < 2; ++bj) { const f32x4 v0 = acc[ai][bj][m][0], v1 = acc[ai][bj][m][1];
                        u32x4 w; w.x = cvt_pk_bf16(v0[0], v0[1]); w.y = cvt_pk_bf16(v0[2], v0[3]); w.z = cvt_pk_bf16(v1[0], v1[1]); w.w = cvt_pk_bf16(v1[2], v1[3]);
                        *(u32x4*)(base + ((size_t)(b * 8 + 2 * hp + bj) * 4096 + s) * 128) = w; } }
        } else if (u.pn >= 24 && u.pn < 32) {
            bf16_t* zb = ZIMG + ((size_t)((u.pm * 4 + (u.pn & 3)) * 2 + ((u.pn - 24) >> 2)) * 16 * 512 + (wr * 4 + wc) * 64 + (fq * 16 + fr)) * 8;
#pragma unroll
            for (int ai = 0; ai < 2; ++ai)
#pragma unroll
                for (int m = 0; m < 4; ++m)
#pragma unroll
                    for (int bj = 0; bj < 2; ++bj) { const f32x4 v0 = acc[ai][bj][m][0], v1 = acc[ai][bj][m][1];
                        u32x4 w; w.x = cvt_pk_bf16(v0[0], v0[1]); w.y = cvt_pk_bf16(v0[2], v0[3]); w.z = cvt_pk_bf16(v1[0], v1[1]); w.w = cvt_pk_bf16(v1[2], v1[3]);
                        *(u32x4*)(zb + (size_t)((ai * 4 + m) * 2 + bj) * 512 * 8) = w; }
        } else if (u.pn < 32) {
            const int col0 = u.pn * BM + wc * 32 + 8 * fq;
#pragma unroll
            for (int ai = 0; ai < 2; ++ai)
#pragma unroll
                for (int m = 0; m < 4; ++m) { bf16_t* rowp = O + (size_t)(row0 + ai * HALF + m * 16) * 8192 + col0;
#pragma unroll
                    for (int bj = 0; bj < 2; ++bj) { const f32x4 v0 = acc[ai][bj][m][0], v1 = acc[ai][bj][m][1];
                        u32x4 w; w.x = cvt_pk_bf16(v0[0], v0[1]); w.y = cvt_pk_bf16(v0[2], v0[3]); w.z = cvt_pk_bf16(v1[0], v1[1]); w.w = cvt_pk_bf16(v1[2], v1[3]);
                        *(u32x4*)(rowp + bj * HALF) = w; } }
        } else if (wc == 0) {
#pragma unroll
            for (int ai = 0; ai < 2; ++ai)
#pragma unroll
                for (int m = 0; m < 4; ++m) { float* rp = SMp + (size_t)(row0 + ai * HALF + m * 16) * 32 + 8 * fq;
                    *(f32x4*)rp = acc[ai][0][m][0]; *(f32x4*)(rp + 4) = acc[ai][0][m][1]; }
        }
    }
};

struct EpiMix {
    static constexpr bool PERM = true, AFTER_DRAIN = false, CHAIN = true;
    const bf16_t* ZIMG; bf16_t* MIX;
    __device__ __forceinline__ void operator()(f32x4 (&acc)[2][2][4][2], const Unit& u, int wr, int wc, int fr, int fq) const {
        const int row0 = u.pm * BM + wr * 64 + fr, col0 = u.pn * BM + wc * 32 + 8 * fq; const int kind = u.aux;
        const bf16_t* zimg = ZIMG + ((size_t)((u.pm * 4 + u.pn) * 2) * 16 * 512 + (wr * 4 + wc) * 64 + (fq * 16 + fr)) * 8;
#pragma unroll
        for (int ai = 0; ai < 2; ++ai) {
            u32x4 zf[4][2], zg[4][2];
#pragma unroll
            for (int m = 0; m < 4; ++m)
#pragma unroll
                for (int bj = 0; bj < 2; ++bj) { const bf16_t* zp = zimg + (size_t)((ai * 4 + m) * 2 + bj) * 512 * 8;
                    zf[m][bj] = *(const u32x4*)(zp + 16 * 512 * 8); if (kind == 0) zg[m][bj] = *(const u32x4*)zp; }
#pragma unroll
            for (int m = 0; m < 4; ++m)
#pragma unroll
                for (int bj = 0; bj < 2; ++bj) {
                    const u32x4 a = zf[m][bj]; float ef[8] = {bf_lo(a.x), bf_hi(a.x), bf_lo(a.y), bf_hi(a.y), bf_lo(a.z), bf_hi(a.z), bf_lo(a.w), bf_hi(a.w)};
#pragma unroll
                    for (int j = 0; j < 8; ++j) ef[j] = 1.0f + __expf(-ef[j]);
                    if (kind == 0) {
                        const u32x4 g = zg[m][bj]; float eg[8] = {bf_lo(g.x), bf_hi(g.x), bf_lo(g.y), bf_hi(g.y), bf_lo(g.z), bf_hi(g.z), bf_lo(g.w), bf_hi(g.w)};
#pragma unroll
                        for (int j = 0; j < 8; ++j) { const float r = ef[j] * __builtin_amdgcn_rcpf(1.0f + __expf(-eg[j])); if (j < 4) acc[ai][bj][m][0][j] *= r; else acc[ai][bj][m][1][j - 4] *= r; }
                    } else {
                        float o[8];
#pragma unroll
                        for (int j = 0; j < 8; ++j) o[j] = (j < 4 ? acc[ai][bj][m][0][j] : acc[ai][bj][m][1][j - 4]) * __builtin_amdgcn_rcpf(ef[j]);
                        u32x4 w; w.x = cvt_pk_bf16(o[0], o[1]); w.y = cvt_pk_bf16(o[2], o[3]); w.z = cvt_pk_bf16(o[4], o[5]); w.w = cvt_pk_bf16(o[6], o[7]);
                        *(u32x4*)(MIX + (size_t)(row0 + ai * HALF + m * 16) * 1024 + col0 + bj * HALF) = w; } }
        }
    }
};

struct EpiAct {
    static constexpr bool PERM = true, AFTER_DRAIN = false;
    bf16_t* ACT; const float* bgu;
    __device__ __forceinline__ void operator()(const f32x4 (&acc)[2][2][4][2], const Unit& u, int wr, int wc, int fr, int fq) const {
        const int e = u.aux, c0 = wc * 32 + 8 * fq; const float* bg = bgu + (size_t)e * 2048 + u.pn * 128 + c0; const float* bu = bg + 1024;
        const f32x4 bg0 = *(const f32x4*)bg, bg1 = *(const f32x4*)(bg + 4), bu0 = *(const f32x4*)bu, bu1 = *(const f32x4*)(bu + 4);
#pragma unroll
        for (int ai = 0; ai < 2; ++ai)
#pragma unroll
            for (int m = 0; m < 4; ++m) { const size_t row = (size_t)u.ab * BM + ai * HALF + m * 16 + wr * 64 + fr;
                const f32x4 g0 = acc[ai][0][m][0] + bg0, g1 = acc[ai][0][m][1] + bg1, p0 = acc[ai][1][m][0] + bu0, p1 = acc[ai][1][m][1] + bu1;
                float o[8];
#pragma unroll
                for (int j = 0; j < 8; ++j) { const float gv = j < 4 ? g0[j & 3] : g1[j & 3], uv = j < 4 ? p0[j & 3] : p1[j & 3];
                    const float gate = fminf(gv, 7.0f), up = fminf(fmaxf(uv, -7.0f), 7.0f); o[j] = (up + 1.0f) * (gate * sigm(1.702f * gate)); }
                u32x4 w; w.x = cvt_pk_bf16(o[0], o[1]); w.y = cvt_pk_bf16(o[2], o[3]); w.z = cvt_pk_bf16(o[4], o[5]); w.w = cvt_pk_bf16(o[6], o[7]);
                *(u32x4*)(ACT + row * 1024 + u.pn * 128 + c0) = w; }
    }
};

struct EpiDown {
    static constexpr bool PERM = true, AFTER_DRAIN = false;
    bf16_t* YS; const float* bd;
    __device__ __forceinline__ void operator()(const f32x4 (&acc)[2][2][4][2], const Unit& u, int wr, int wc, int fr, int fq) const {
        const int e = u.aux, col0 = u.pn * BM + wc * 32 + 8 * fq;
        f32x4 bv[2][2];
#pragma unroll
        for (int bj = 0; bj < 2; ++bj)
#pragma unroll
            for (int n = 0; n < 2; ++n) bv[bj][n] = *(const f32x4*)(bd + (size_t)e * 1024 + col0 + bj * HALF + 4 * n);
#pragma unroll
        for (int ai = 0; ai < 2; ++ai)
#pragma unroll
            for (int m = 0; m < 4; ++m) { bf16_t* rowp = YS + ((size_t)u.ab * BM + ai * HALF + m * 16 + wr * 64 + fr) * 1024 + col0;
#pragma unroll
                for (int bj = 0; bj < 2; ++bj) { const f32x4 v0 = acc[ai][bj][m][0] + bv[bj][0], v1 = acc[ai][bj][m][1] + bv[bj][1];
                    u32x4 w; w.x = cvt_pk_bf16(v0[0], v0[1]); w.y = cvt_pk_bf16(v0[2], v0[3]); w.z = cvt_pk_bf16(v1[0], v1[1]); w.w = cvt_pk_bf16(v1[2], v1[3]);
                    *(u32x4*)(rowp + bj * HALF) = w; } }
    }
};

struct MixOrder {
    StaticOrder so;
    __device__ void init(int M, int N, int G_, int c_) { so.init(M, N, G_, c_); }
    __device__ __forceinline__ bool next(int i, Unit& u) const { if (!so.next(i >> 1, u)) return false; const int kind = i & 1; u.aux = kind; u.ab = kind * (so.nM) + u.pm; u.bb = kind * (so.nN) + u.pn; return true; }
    __device__ __forceinline__ void a_ready(const Unit&) const {}
    __device__ __forceinline__ void done(const Unit&) const {}
    __device__ __forceinline__ const PG8_LAS int* rowidx(int) const { return nullptr; }
};
constexpr int MAXU = 12;
struct GroupedOrder {
    const PG8_LAS int* desc; const PG8_LAS int* idx;
    __device__ __forceinline__ bool next(int i, Unit& u) const {
        if (i >= MAXU) return false; const PG8_LAS int* d = desc + i * 8;
        if (__builtin_amdgcn_readfirstlane(d[0]) == 0) return false;
        u.ab = __builtin_amdgcn_readfirstlane(d[1]); u.bb = __builtin_amdgcn_readfirstlane(d[2]); u.pn = __builtin_amdgcn_readfirstlane(d[3]); u.aux = __builtin_amdgcn_readfirstlane(d[4]); u.pm = u.ab; return true; }
    __device__ __forceinline__ void a_ready(const Unit&) const {}
    __device__ __forceinline__ void done(const Unit&) const {}
    __device__ __forceinline__ const PG8_LAS int* rowidx(int i) const { return idx + i * 256; }
};
}
namespace fox {
constexpr int D = 128, PKV = 128  , PO = 1024  ;
constexpr float THR = 8.f; constexpr bool WSKIP = false;
constexpr float SCALE = 0.08838834764831845f;
constexpr int NW = 8, QBLK = 32, KVBLK = 64, QB = NW * QBLK;
constexpr int SHM_V = KVBLK * D * 2, SHM_K = KVBLK * D * 2;
constexpr int LDS_BIAS = 2 * SHM_V + 2 * SHM_K + NW * 64 * 4;
constexpr int LDS_JUNK = LDS_BIAS + 2 * 4096 * 4;
constexpr int LDS_BYTES = LDS_JUNK + 256;

using bf16 = __hip_bfloat16;
typedef short bf16x8 __attribute__((ext_vector_type(8)));
typedef short s16x4 __attribute__((ext_vector_type(4)));
typedef float f32x16 __attribute__((ext_vector_type(16)));
typedef float f32x4 __attribute__((ext_vector_type(4)));
typedef unsigned u32x4 __attribute__((ext_vector_type(4)));
template <class A, class Bt> struct same_t { static constexpr bool v = false; };
template <class A> struct same_t<A, A> { static constexpr bool v = true; };

#define KSWZ(row, colB) ((row) * 256 + ((colB) ^ (((row) & 7) << 4)))
#define SBAR() __builtin_amdgcn_sched_barrier(0)
__device__ __forceinline__ int v_st(int k, int c) { const int kk = (k & ~0xC) | ((k & 4) << 1) | ((k & 8) >> 1); return ((kk >> 3) * 4 + (c >> 5)) * 512 + ((kk & 7) * 32 + (c & 31)) * 2; }
__device__ __forceinline__ int v_rd_base(int lane) { return ((lane & 3) << 3) | (((lane >> 2) & 3) << 6) | (((lane >> 4) & 1) << 5) | (((lane >> 5) & 1) << 8); }
constexpr int v_rd_off(int d0, int ks, int half) { return d0 * 512 + ks * 4096 + half * 2048; }
__device__ __forceinline__ int crow(int r, int hi) { return (r & 3) + 8 * (r >> 2) + 4 * hi; }
__device__ __forceinline__ unsigned cvtpk(float lo, float hi) {
    unsigned r; asm volatile("v_cvt_pk_bf16_f32 %0, %1, %2" : "=v"(r) : "v"(lo), "v"(hi)); return r;
}
__device__ __forceinline__ bf16x8 pack8(f32x4 a, f32x4 b) {
    u32x4 w = {cvtpk(a[0], a[1]), cvtpk(a[2], a[3]), cvtpk(b[0], b[1]), cvtpk(b[2], b[3])};
    return *reinterpret_cast<bf16x8*>(&w);
}
template <class T> __device__ __forceinline__ bf16x8 load8(const T* p) {
    if constexpr (same_t<T, float>::v) { return pack8(*(const f32x4*)p, *(const f32x4*)(p + 4)); }
    else { return *reinterpret_cast<const bf16x8*>(p); }
}
__device__ __forceinline__ void mask_tile(f32x16& p0, f32x16& p1, int dq, unsigned W) {
    const float NEG = -__builtin_inff();
#pragma unroll
    for (int r = 0; r < 16; ++r) {
        const int c = (r & 3) + 8 * (r >> 2);
        if ((unsigned)(dq - c) >= W) p0[r] = NEG;
        if ((unsigned)(dq - c - 32) >= W) p1[r] = NEG;
    }
}
__device__ __forceinline__ void partialSM(f32x16& p0, f32x16& p1, float& m_reg, float& mn, float& alpha) {
    float pmax = p0[0]; for (int r = 1; r < 16; ++r) pmax = fmaxf(pmax, p0[r]); for (int r = 0; r < 16; ++r) pmax = fmaxf(pmax, p1[r]);
    { auto rr = __builtin_amdgcn_permlane32_swap(__float_as_uint(pmax), __float_as_uint(pmax), false, false);
      pmax = fmaxf(__uint_as_float(rr[0]), __uint_as_float(rr[1])); }
    constexpr float C2 = 1.4426950408889634f * SCALE;
    if (__builtin_expect(__all((pmax - m_reg) * SCALE <= THR), 1)) { mn = m_reg; alpha = 1.f; }
    else { mn = fmaxf(m_reg, pmax); alpha = __builtin_amdgcn_exp2f((m_reg - mn) * C2); m_reg = mn; }
    const float mnL = -mn * C2;
    for (int r = 0; r < 16; ++r) p0[r] = fmaf(p0[r], C2, mnL); for (int r = 0; r < 16; ++r) p1[r] = fmaf(p1[r], C2, mnL);
    for (int r = 0; r < 16; ++r) p0[r] = __builtin_amdgcn_exp2f(p0[r]);
}
__device__ __forceinline__ void finishSM(f32x16& p0, f32x16& p1, float alpha, float& l_reg, bf16x8& pa0, bf16x8& pa1, bf16x8& pa2, bf16x8& pa3) {
    for (int r = 0; r < 16; ++r) p1[r] = __builtin_amdgcn_exp2f(p1[r]);
    float ps = 0; for (int r = 0; r < 16; ++r) ps += p0[r]; for (int r = 0; r < 16; ++r) ps += p1[r];
    { auto rr = __builtin_amdgcn_permlane32_swap(__float_as_uint(ps), __float_as_uint(ps), false, false);
      ps = __uint_as_float(rr[0]) + __uint_as_float(rr[1]); }
    l_reg = l_reg * alpha + ps;
#define PK4(P, B_, OUT) do { unsigned a0 = cvtpk(P[B_+0], P[B_+1]), a1 = cvtpk(P[B_+2], P[B_+3]);                          \
        unsigned b0 = cvtpk(P[B_+4], P[B_+5]), b1 = cvtpk(P[B_+6], P[B_+7]);                                             \
        auto r0 = __builtin_amdgcn_permlane32_swap(a0, b0, false, false); auto r1 = __builtin_amdgcn_permlane32_swap(a1, b1, false, false); \
        u32x4 w = {r0[0], r1[0], r0[1], r1[1]}; OUT = *reinterpret_cast<bf16x8*>(&w); } while (0)
    PK4(p0, 0, pa0); PK4(p0, 8, pa1); PK4(p1, 0, pa2); PK4(p1, 8, pa3);
#undef PK4
}
template <int KB, bool SK>
__device__ __forceinline__ void qkt(f32x16& p0, f32x16& p1, const char* K_lds, int r32, int hi, const bf16x8* qr, bool act, const float* bias_t  ) {
    if (SK && !act) { const float NEG = -__builtin_inff();
#pragma unroll
        for (int r = 0; r < 16; ++r) { p0[r] = NEG; p1[r] = NEG; } return; }
#pragma unroll
    for (int g4 = 0; g4 < 4; ++g4) { const f32x4 b0 = *(const f32x4*)(bias_t + 8 * g4), b1 = *(const f32x4*)(bias_t + 32 + 8 * g4);
#pragma unroll
        for (int j = 0; j < 4; ++j) { p0[4 * g4 + j] = b0[j]; p1[4 * g4 + j] = b1[j]; } }
    const char* kb[4];
#pragma unroll
    for (int dd = 0; dd < 4; ++dd) kb[dd] = K_lds + KB * SHM_K + KSWZ(r32, (dd * 16 + hi * 8) * 2);
#pragma unroll
    for (int d0 = 0; d0 < 8; ++d0) { const char* a = kb[d0 & 3] + (d0 >> 2) * 128;
        bf16x8 b0 = *reinterpret_cast<const bf16x8*>(a);
        bf16x8 b1 = *reinterpret_cast<const bf16x8*>(a + 32 * 256);
        p0 = __builtin_amdgcn_mfma_f32_32x32x16_bf16(b0, qr[d0], p0, 0, 0, 0);
        p1 = __builtin_amdgcn_mfma_f32_32x32x16_bf16(b1, qr[d0], p1, 0, 0, 0); }
}
template <int VB, bool SK>
__device__ __forceinline__ void pv_tile(f32x16* o, int vb0, bf16x8 pa0, bf16x8 pa1, bf16x8 pa2, bf16x8 pa3, bool act) {
    if (SK && !act) return;
#define TRRD(dst, off) asm volatile("ds_read_b64_tr_b16 %0, %1 offset:%2" : "=&v"(dst) : "v"(vb0), "i"(off) : "memory")
#define PV_D0(d0) do { s16x4 l0, l1, l2, l3, h0, h1, h2, h3; constexpr int b_ = VB * SHM_V + v_rd_off(d0, 0, 0);     \
        TRRD(l0, b_); TRRD(h0, b_ + 2048); TRRD(l1, b_ + 4096); TRRD(h1, b_ + 6144); TRRD(l2, b_ + 8192); TRRD(h2, b_ + 10240); TRRD(l3, b_ + 12288); TRRD(h3, b_ + 14336); \
        asm volatile("s_waitcnt lgkmcnt(0)" ::: "memory"); SBAR();                 \
        o[d0] = __builtin_amdgcn_mfma_f32_32x32x16_bf16(pa0, (bf16x8){l0[0], l0[1], l0[2], l0[3], h0[0], h0[1], h0[2], h0[3]}, o[d0], 0, 0, 0);   \
        o[d0] = __builtin_amdgcn_mfma_f32_32x32x16_bf16(pa1, (bf16x8){l1[0], l1[1], l1[2], l1[3], h1[0], h1[1], h1[2], h1[3]}, o[d0], 0, 0, 0);   \
        o[d0] = __builtin_amdgcn_mfma_f32_32x32x16_bf16(pa2, (bf16x8){l2[0], l2[1], l2[2], l2[3], h2[0], h2[1], h2[2], h2[3]}, o[d0], 0, 0, 0);   \
        o[d0] = __builtin_amdgcn_mfma_f32_32x32x16_bf16(pa3, (bf16x8){l3[0], l3[1], l3[2], l3[3], h3[0], h3[1], h3[2], h3[3]}, o[d0], 0, 0, 0); } while (0)
    PV_D0(0); PV_D0(1); PV_D0(2); PV_D0(3);
#undef PV_D0
#undef TRRD
}

template <class TIn, class TOut> struct BlockRef { const TIn* Q; const TIn* K; const TIn* V; TOut* O; int P0; };
template <class TIn> struct Seam {
    bf16x8 qr[8];
    bf16x8 st_v0, st_v1, st_k0, st_k1; f32x4 sf0, sf1, sf2, sf3;
    f32x4 tq[16];
};
__device__ __forceinline__ int swa_jlo(int P0, int W) { const int lowk = P0 - W + 1; return lowk > 0 ? lowk / KVBLK : 0; }
#define ROW(p, k0, rr) ((p) + (size_t)((k0) + (rr)) * PKV + sc)
#define VMW() asm volatile("s_waitcnt vmcnt(0)" ::: "memory")
#define VMWN(n) asm volatile("s_waitcnt vmcnt(%0)" :: "i"(n) : "memory")
#define SLOAD_H(Kp, Vp, k0) do { S.st_v0 = load8<TIn>(ROW(Vp, k0, sr)); S.st_v1 = load8<TIn>(ROW(Vp, k0, 32 + sr));              \
                         S.st_k0 = load8<TIn>(ROW(Kp, k0, sr)); S.st_k1 = load8<TIn>(ROW(Kp, k0, 32 + sr)); } while (0)
#define SWRITE_HK(bf) do { *(bf16x8*)(K_lds + (bf) * SHM_K + kws) = S.st_k0; *(bf16x8*)(K_lds + (bf) * SHM_K + kws + 32 * 256) = S.st_k1; } while (0)
#define SWRITE_HV(bf) do { *(bf16x8*)(V_lds + (bf) * SHM_V + vst0) = S.st_v0; *(bf16x8*)(V_lds + (bf) * SHM_V + vst1) = S.st_v1; } while (0)
#define SWRITE_H(bf) do { SWRITE_HV(bf); SWRITE_HK(bf); } while (0)
#define SLOAD_F(p, k0) do { S.sf0 = *(const f32x4*)ROW(p, k0, sr); S.sf1 = *(const f32x4*)(ROW(p, k0, sr) + 4);                \
                            S.sf2 = *(const f32x4*)ROW(p, k0, 32 + sr); S.sf3 = *(const f32x4*)(ROW(p, k0, 32 + sr) + 4); } while (0)
#define SWRITE_KF(bf) do { *(bf16x8*)(K_lds + (bf) * SHM_K + kws) = pack8(S.sf0, S.sf1); *(bf16x8*)(K_lds + (bf) * SHM_K + kws + 32 * 256) = pack8(S.sf2, S.sf3); } while (0)
#define SWRITE_VF(bf) do { *(bf16x8*)(V_lds + (bf) * SHM_V + vst0) = pack8(S.sf0, S.sf1); *(bf16x8*)(V_lds + (bf) * SHM_V + vst1) = pack8(S.sf2, S.sf3); } while (0)
template <class TIn, class TOut>
__device__ __forceinline__ void causal_swa_prime(const BlockRef<TIn, TOut>& cur, int W, char* lds, Seam<TIn>& S, int tid_in) {
    constexpr bool F32 = same_t<TIn, float>::v;
    const int tid = tid_in, wid = __builtin_amdgcn_readfirstlane(tid >> 6), lane = tid & 63, r32 = lane & 31, hi = lane >> 5;
    const int sr = tid >> 4, sc = (tid & 15) * 8, kws = KSWZ(sr, sc * 2); char* K_lds = lds + 2 * SHM_V;
    const int kb0 = swa_jlo(cur.P0, W) * KVBLK;
    for (int d0 = 0; d0 < 8; ++d0) S.qr[d0] = load8<TIn>(cur.Q + (size_t)(wid * QBLK + r32) * PKV + d0 * 16 + hi * 8);
    if constexpr (F32) { SLOAD_F((const float*)cur.K, kb0); VMW(); SWRITE_KF(0); SBAR(); SLOAD_F((const float*)cur.V, kb0); }
    else { SLOAD_H(cur.K, cur.V, kb0); VMW(); SWRITE_HK(0); }
    __syncthreads();
}
template <class TIn, class TOut>
__device__ __forceinline__ void causal_swa_block(const BlockRef<TIn, TOut>& cur, const BlockRef<TIn, TOut>& nxt, int skv, int W, char* lds, Seam<TIn>& S, int bias_buf, int tid_in) {
    constexpr bool F32 = same_t<TIn, float>::v;
    const int tid = tid_in, wid = __builtin_amdgcn_readfirstlane(tid >> 6), lane = tid & 63, r32 = lane & 31, hi = lane >> 5;
    const int j_lo = swa_jlo(cur.P0, W);
    int j_hi = (cur.P0 + QB - 1) / KVBLK + 1; if (j_hi > skv / KVBLK) j_hi = skv / KVBLK;
    const int NT = j_hi - j_lo;
    const int kbn = swa_jlo(nxt.P0, W) * KVBLK;
    const int qlo = cur.P0 + wid * QBLK, qm = qlo + r32 - 4 * hi;
    char* V_lds = lds; char* K_lds = lds + 2 * SHM_V;
    float* ws = (float*)(lds + 2 * SHM_V + 2 * SHM_K) + wid * 64; float* li_l = ws, * al_l = ws + 32;
    const float* bias_l = (const float*)(lds + LDS_BIAS + bias_buf * 16384) + 4 * hi;
    float m_reg = -1e30f, l_reg = 0; f32x16 o[4] = {};
    const int sr = tid >> 4, sc = (tid & 15) * 8, vst0 = v_st(sr, sc), vst1 = v_st(32 + sr, sc), kws = KSWZ(sr, sc * 2);
    const int vb0 = (int)(uintptr_t)V_lds + v_rd_base(lane);
    const TIn* Kh = cur.K; const TIn* Vh = cur.V;
#define RESC(a) do { if (__any((a) < 1.f)) { if (hi == 0) al_l[r32] = (a); asm volatile("s_waitcnt lgkmcnt(0)" ::: "memory");              \
                     for (int d_ = 0; d_ < 4; ++d_) for (int r = 0; r < 16; ++r) o[d_][r] *= al_l[crow(r, hi)]; } } while (0)
#define KBASE(t) ((j_lo + (t)) * KVBLK)
#define BIAS_T(t) (bias_l + KBASE(t))
    const TIn* pf_src = (((tid >> 7) & 1) ? Vh : Kh) + (size_t)((tid & 127) >> 1) * PKV + (tid & 1) * 64;
#define L2_PREFETCH(kb_) do { if (tid < 256) __builtin_amdgcn_global_load_lds((const unsigned*)(pf_src + (size_t)(kb_) * PKV), (__attribute__((address_space(3))) unsigned*)(uintptr_t)__builtin_amdgcn_readfirstlane((unsigned)(uintptr_t)(lds + LDS_JUNK)), 4, 0, 0); } while (0)
#define ACT(t) (KBASE(t) <= qlo + QBLK - 1 && KBASE(t) + KVBLK - 1 >= qlo - W + 1)
#define MASKT(P0_, P1_, t) do { const int kb_ = KBASE(t); if ((!SK || ACT(t)) && (kb_ + KVBLK - 1 > qlo || kb_ <= qlo + QBLK - 1 - W)) mask_tile(P0_, P1_, qm - kb_, (unsigned)W); } while (0)
    constexpr int NQL = F32 ? 16 : 8;
    constexpr bool SK = WSKIP && !F32;
#define SEAM_K0() do { VMWN(NQL); if constexpr (F32) { SWRITE_KF(0); SBAR(); SLOAD_F((const float*)nxt.V, kbn); } else { SWRITE_HK(0); } SBAR(); } while (0)
    f32x16 pA0, pA1, pB0, pB1; float mnA, mnB, alA, alB; bf16x8 pa0, pa1, pa2, pa3;
    if constexpr (F32) { VMW(); SWRITE_VF(0); SBAR(); } else { SWRITE_HV(0); SBAR(); }
    if (NT > 1) { if constexpr (F32) SLOAD_F((const float*)Kh, KBASE(1)); else SLOAD_H(Kh, Vh, KBASE(1)); }
    SBAR(); qkt<0, SK>(pA0, pA1, K_lds, r32, hi, S.qr, ACT(0), BIAS_T(0));
    if constexpr (F32) { if (NT > 1) { VMW(); SWRITE_KF(1); SBAR(); SLOAD_F((const float*)Vh, KBASE(1)); } }
    MASKT(pA0, pA1, 0); partialSM(pA0, pA1, m_reg, mnA, alA);
    if (NT > 1) { VMW(); if constexpr (F32) { SWRITE_VF(1); SBAR(); if (NT > 2) SLOAD_F((const float*)Kh, KBASE(2)); } else SWRITE_H(1); }
    __syncthreads();
#define HALF_STEP(PX0, PX1, mnX, alX, PY0, PY1, alY, t, KB, VB, SB) do {                                                      \
        SBAR(); qkt<KB, SK>(PX0, PX1, K_lds, r32, hi, S.qr, ACT(t), BIAS_T(t));                                             \
        finishSM(PY0, PY1, alY, l_reg, pa0, pa1, pa2, pa3); SBAR();                                                           \
        if ((t) + 1 < NT) { if constexpr (F32) { VMW(); SWRITE_KF(SB); SBAR(); SLOAD_F((const float*)Vh, KBASE((t) + 1)); }  \
                            else { SLOAD_H(Kh, Vh, KBASE((t) + 1)); } SBAR(); }                                               \
        pv_tile<VB, SK>(o, vb0, pa0, pa1, pa2, pa3, ACT((t) - 1)); MASKT(PX0, PX1, (t)); partialSM(PX0, PX1, m_reg, mnX, alX);                                        \
        __syncthreads();                                                                                                      \
        if ((t) + 1 < NT) { VMW(); if constexpr (F32) { SWRITE_VF(SB); SBAR(); if ((t) + 2 < NT) SLOAD_F((const float*)Kh, KBASE((t) + 2)); } \
                            else { SWRITE_H(SB); } }                                                                          \
        RESC(alX); __syncthreads(); } while (0)
    for (int t = 1; t + 1 < NT; t += 2) {
        HALF_STEP(pB0, pB1, mnB, alB, pA0, pA1, alA, t, 1, 0, 0);
        HALF_STEP(pA0, pA1, mnA, alA, pB0, pB1, alB, t + 1, 0, 1, 1);
    }
    const bool even = (NT & 1) == 0;
    if (even) { SBAR(); qkt<1, SK>(pB0, pB1, K_lds, r32, hi, S.qr, ACT(NT - 1), BIAS_T(NT - 1)); SBAR(); }
#define QROW(e) (nxt.Q + (size_t)(wid * QBLK + r32) * PKV + ((e) >> 1) * 16 + hi * 8 + ((e) & 1) * 4)
    if constexpr (F32) { SLOAD_F((const float*)nxt.K, kbn); SBAR();
#pragma unroll
        for (int e = 0; e < 8; ++e) S.tq[e] = *(const f32x4*)QROW(e); }
    else { SLOAD_H(nxt.K, nxt.V, kbn); SBAR();
#pragma unroll
        for (int d0 = 0; d0 < 8; ++d0) S.qr[d0] = load8<TIn>(nxt.Q + (size_t)(wid * QBLK + r32) * PKV + d0 * 16 + hi * 8); }
    SBAR();
    finishSM(pA0, pA1, alA, l_reg, pa0, pa1, pa2, pa3); SBAR();
    if constexpr (F32) {
#pragma unroll
        for (int e = 8; e < 16; ++e) S.tq[e] = *(const f32x4*)QROW(e); SBAR(); }
#undef QROW
    pv_tile<0, SK>(o, vb0, pa0, pa1, pa2, pa3, ACT(even ? NT - 2 : NT - 1));
    if (even) { MASKT(pB0, pB1, NT - 1); partialSM(pB0, pB1, m_reg, mnB, alB); __syncthreads(); RESC(alB);
        finishSM(pB0, pB1, alB, l_reg, pa0, pa1, pa2, pa3); SBAR(); pv_tile<1, SK>(o, vb0, pa0, pa1, pa2, pa3, ACT(NT - 1)); }
    SBAR(); SEAM_K0();
    if (hi == 0) li_l[r32] = l_reg; asm volatile("s_waitcnt lgkmcnt(0)" ::: "memory");
    float rli[16];
#pragma unroll
    for (int r = 0; r < 16; ++r) rli[r] = __builtin_amdgcn_rcpf(li_l[crow(r, hi)]);
    TOut* Ow = cur.O + (size_t)(wid * QBLK) * PO;
#pragma unroll
    for (int r = 0; r < 16; ++r) { const int orow = crow(r, hi);
#pragma unroll
        for (int d0 = 0; d0 < 4; ++d0) { const float v = o[d0][r] * rli[r];
            if constexpr (same_t<TOut, float>::v) { Ow[(size_t)orow * PO + d0 * 32 + r32] = v; }
            else { const float vn = __shfl_xor(v, 1);
                   if ((r32 & 1) == 0) *(unsigned*)(Ow + (size_t)orow * PO + d0 * 32 + r32) = cvtpk(v, vn); } } }
    if constexpr (F32) {
#pragma unroll
        for (int d0 = 0; d0 < 8; ++d0) S.qr[d0] = pack8(S.tq[2 * d0], S.tq[2 * d0 + 1]); }
    __syncthreads();
#undef RESC
#undef KBASE
#undef BIAS_T
#undef L2_PREFETCH
#undef ACT
#undef MASKT
#undef SEAM_K0
#undef HALF_STEP
}
#undef ROW
#undef VMW
#undef VMWN
#undef SLOAD_H
#undef SWRITE_HK
#undef SWRITE_HV
#undef SWRITE_H
#undef SLOAD_F
#undef SWRITE_KF
#undef SWRITE_VF

}
#define GAS __attribute__((address_space(1)))
#define LAS __attribute__((address_space(3)))
typedef unsigned short bf16;
typedef unsigned v4u __attribute__((ext_vector_type(4)));
typedef float f32x4 __attribute__((ext_vector_type(4)));
typedef short bf16x8 __attribute__((ext_vector_type(8)));
typedef GAS unsigned gu32;
typedef GAS unsigned long long gu64;
#define RLX_AGENT __ATOMIC_RELAXED, __HIP_MEMORY_SCOPE_AGENT
#define LDS_WAIT() asm volatile("s_waitcnt lgkmcnt(0)" ::: "memory")
#define VM_WAIT() asm volatile("s_waitcnt vmcnt(0)" ::: "memory")
__device__ __forceinline__ unsigned long long rt() { return __builtin_amdgcn_s_memrealtime(); }
__device__ __forceinline__ unsigned f2bf(float f) { unsigned u = __builtin_bit_cast(unsigned, f); return (u + 0x7fffu + ((u >> 16) & 1u)) >> 16; }
__device__ __forceinline__ unsigned pk2(float lo, float hi) { return f2bf(lo) | (f2bf(hi) << 16); }

#define XB_TMO      128
#define XB_XCNT(j)  (256  + 64 * (j))
#define XB_XSUB(j)  (1280 + 64 * (j))
#define XB_XGEN(j)  (2304 + 64 * (j))
#define XB_TOP      3328
#define XB_TOPGEN   3392
#define XCD_BAR_WORDS 3456
#define XB_SPIN_CAP (1u << 18)

__device__ __forceinline__ unsigned xb_ld(unsigned* p)              { return __hip_atomic_load(p, __ATOMIC_RELAXED, __HIP_MEMORY_SCOPE_AGENT); }
__device__ __forceinline__ unsigned xb_add(unsigned* p, unsigned v) { return __hip_atomic_fetch_add(p, v, __ATOMIC_RELAXED, __HIP_MEMORY_SCOPE_AGENT); }
__device__ __forceinline__ unsigned xb_xcc_id() { return (unsigned)__builtin_amdgcn_s_getreg((3 << 11) | 20) & 0xFu; }
#define XB_SPIN(cond, bar) do { unsigned _sp = 0; while (cond) { __builtin_amdgcn_s_sleep(1); \
    if ((++_sp & 255u) == 0u) { if (xb_ld(&(bar)[XB_TMO])) break; if (_sp > XB_SPIN_CAP) { atomicAdd(&(bar)[XB_TMO], 1u); break; } } } } while (0)

struct XcdBarrier {
    unsigned* bar; unsigned x;
    volatile LAS unsigned* st;
};

__device__ __forceinline__ XcdBarrier xcd_barrier_post(unsigned* bar, volatile LAS unsigned* st) {
    XcdBarrier b; b.bar = bar; b.x = xb_xcc_id(); b.st = st;
    if (threadIdx.x == 0) (void)xb_add(&bar[XB_XCNT(b.x)], 1u);
    return b;
}
__device__ __forceinline__ void xcd_barrier_complete(unsigned* bar, unsigned x, unsigned& nloc, unsigned& nx) {
    const unsigned G = gridDim.x * gridDim.y * gridDim.z;
    unsigned sum, cnt, mine, sp = 0u;
    for (;;) {
        sum = 0u; cnt = 0u; mine = 0u;
#pragma unroll
        for (unsigned j = 0; j < 16; ++j) { const unsigned c = xb_ld(&bar[XB_XCNT(j)]); sum += c; cnt += (c > 0u) ? 1u : 0u; mine = (j == x) ? c : mine; }
        if (sum == G) break;
        __builtin_amdgcn_s_sleep(1);
        if ((++sp & 255u) == 0u) { if (xb_ld(&bar[XB_TMO])) break; if (sp > XB_SPIN_CAP) { atomicAdd(&bar[XB_TMO], 1u); break; } }
    }
    nloc = mine > 0u ? mine : 1u; nx = cnt > 0u ? cnt : 1u;
}

__device__ __forceinline__ void xcd_barrier(const XcdBarrier& b) {
    asm volatile("s_waitcnt vmcnt(0)" ::: "memory");
    __syncthreads();
    if (threadIdx.x == 0) {
        unsigned* bar = b.bar;
        __builtin_amdgcn_s_waitcnt(0);
        unsigned nloc = b.st[0], nx = b.st[1];
        if (nloc == 0u) { xcd_barrier_complete(bar, b.x, nloc, nx); b.st[0] = nloc; b.st[1] = nx; }
        const unsigned old = xb_add(&bar[XB_XSUB(b.x)], 1u);
        const unsigned gen = old / nloc;
        if (old + 1u == (gen + 1u) * nloc) {
            __builtin_amdgcn_fence(__ATOMIC_RELEASE, "agent");
            asm volatile("s_waitcnt vmcnt(0)" ::: "memory");
            const unsigned og = xb_add(&bar[XB_TOP], 1u);
            const unsigned tg = og / nx;
            if (og + 1u == (tg + 1u) * nx) xb_add(&bar[XB_TOPGEN], 1u);
            else XB_SPIN(xb_ld(&bar[XB_TOPGEN]) == tg, bar);
            __builtin_amdgcn_fence(__ATOMIC_ACQUIRE, "agent");
            xb_add(&bar[XB_XGEN(b.x)], 1u);
            asm volatile("s_waitcnt vmcnt(0)" ::: "memory");
        } else {
            XB_SPIN(xb_ld(&bar[XB_XGEN(b.x)]) == gen, bar);
            __builtin_amdgcn_fence(__ATOMIC_ACQUIRE, "agent");
            asm volatile("s_waitcnt vmcnt(0)" ::: "memory");
        }
    }
    __syncthreads();
}
#ifndef STAMP_K
#define STAMP_K -1
#endif
#ifndef DUP_MASK
#define DUP_MASK 0
#endif
constexpr int NWAVES = 8, NTHR = NWAVES * 64;
constexpr int T_TOK = 16384, SEQ = 4096, NBATCH = 4, DM = 1024;
constexpr int IN_COLS = 8216, NPROJ = 8192, NPROJ_PAD = 8448;
constexpr int C_GQ = 0, C_GK = 512, C_GV = 1024, C_GR = 2048, C_FQ = 3072, C_FK = 4096, C_FV = 5120, C_ZG = 6144, C_ZF = 7168;
constexpr int NE = 32, DFF = 1024, NCHUNK = 64;
constexpr float LN_EPS = 1e-5f;
constexpr float DN_ALPHA = 1.189207115002721f;
constexpr float FOX_INV_SCALE = 11.313708498984761f;
constexpr float GLA_QSCALE = 0.08838834764831845f;
constexpr int SLOT_ROWS = 73728;

constexpr size_t MiB = 1u << 20;
constexpr size_t WS_CTL = 0, CTL_ZERO_BYTES = 1 * MiB;
constexpr size_t WS_WIN = 2 * MiB;
constexpr size_t WS_WPROJ = 19 * MiB;
constexpr size_t WS_WOUT = 23 * MiB;
constexpr size_t WS_WGU = 25 * MiB;
constexpr size_t WS_WDN = 153 * MiB;
constexpr size_t WS_H0B = 217 * MiB;
constexpr size_t WS_SM = 249 * MiB;
constexpr size_t WS_FB = 251 * MiB;
constexpr size_t WS_DECAY = 252 * MiB;
constexpr size_t WS_KDEC = 253 * MiB;
constexpr size_t WS_AO = 269 * MiB;
constexpr size_t WS_MIXED = 333 * MiB;
constexpr size_t WS_H1F = 365 * MiB;
constexpr size_t WS_H1B = 429 * MiB;
constexpr size_t WS_TOKOF = 461 * MiB;
constexpr size_t WS_PAIR = 463 * MiB;
constexpr size_t WS_PROJ = 464 * MiB;
constexpr size_t WS_ACT = WS_PROJ;
constexpr size_t WS_YS = 720 * MiB;
constexpr size_t WS_FQKV = 864 * MiB;
constexpr size_t WS_ZIMG = 960 * MiB;
constexpr size_t WS_END = 1024 * MiB;
static_assert(WS_WIN + (size_t)NPROJ_PAD * 1024 * 2 <= WS_WPROJ && WS_WGU + (size_t)32 * 2048 * 1024 * 2 <= WS_WDN && WS_WDN + (size_t)32 * 1024 * 1024 * 2 <= WS_H0B, "ws map");
static_assert(WS_PROJ + (size_t)T_TOK * 8192 * 2 <= WS_YS && WS_ACT + (size_t)SLOT_ROWS * 1024 * 2 <= WS_YS && WS_YS + (size_t)SLOT_ROWS * 1024 * 2 <= WS_END, "ws map");
constexpr int CW_TMO = 0, CW_CODE = 1;
constexpr int CW_BAR = 4096;
constexpr int CW_CNT = 8192;
constexpr int CW_Q = 12288;

constexpr int RING_OFF = 0, RING_BYTES = 131072;
constexpr int LDSCTL_OFF = RING_BYTES, MISC_OFF = LDSCTL_OFF + 320;
constexpr int TBL_OFF = RING_BYTES + 512;
constexpr int TBL_CUM = TBL_OFF, TBL_CNT = TBL_OFF + 256, TBL_DESC = TBL_OFF + 384, TBL_IDX = TBL_OFF + 768;
constexpr int LDS_BYTES = 147456;
static_assert(TBL_IDX + pg8::MAXU * 256 * 4 <= LDS_BYTES && fox::LDS_BYTES <= RING_BYTES, "LDS map");

__device__ __forceinline__ float bfu(unsigned short h) { return __uint_as_float((unsigned)h << 16); }
__device__ __forceinline__ float logsig(float x) { return fminf(x, 0.f) - __logf(1.0f + __expf(-fabsf(x))); }
__device__ __forceinline__ float wave_sum(float v) {
#pragma unroll
    for (int o = 1; o < 64; o <<= 1) v += __shfl_xor(v, o);
    return v;
}

__device__ __forceinline__ void p0_tile_load(f32x4 (&v)[16], const float* W, int npitch, int srccol, int kb, int lane) {
    const int q = lane & 15, rg = lane >> 4, k0 = 64 * kb + 16 * rg;
    const GAS f32x4* src = (const GAS f32x4*)(W + (size_t)k0 * npitch + srccol + 4 * q);
#pragma unroll
    for (int i = 0; i < 16; ++i) v[i] = src[(size_t)i * (npitch / 4)];
}
__device__ __forceinline__ void p0_tile_store(const f32x4 (&v)[16], bf16* WT, int dstrow, int kb, int lane) {
    const int q = lane & 15, rg = lane >> 4, k0 = 64 * kb + 16 * rg;
#pragma unroll
    for (int j = 0; j < 4; ++j) { GAS v4u* dst = (GAS v4u*)(WT + (size_t)(dstrow + 4 * q + j) * 1024 + k0);
        v4u a, b;
        a.x = pk2(v[0][j], v[1][j]); a.y = pk2(v[2][j], v[3][j]); a.z = pk2(v[4][j], v[5][j]); a.w = pk2(v[6][j], v[7][j]);
        b.x = pk2(v[8][j], v[9][j]); b.y = pk2(v[10][j], v[11][j]); b.z = pk2(v[12][j], v[13][j]); b.w = pk2(v[14][j], v[15][j]);
        dst[0] = a; dst[1] = b; }
}
__device__ __forceinline__ void p0_transpose_tile(const float* W, int npitch, int srccol, bf16* WT, int dstrow, int kb, int lane) {
    const int q = lane & 15, rg = lane >> 4, k0 = 64 * kb + 16 * rg;
    const GAS f32x4* src = (const GAS f32x4*)(W + (size_t)k0 * npitch + srccol + 4 * q);
    f32x4 v[16];
#pragma unroll
    for (int i = 0; i < 16; ++i) v[i] = __builtin_nontemporal_load(src + (size_t)i * (npitch / 4));
#pragma unroll
    for (int j = 0; j < 4; ++j) { GAS v4u* dst = (GAS v4u*)(WT + (size_t)(dstrow + 4 * q + j) * 1024 + k0);
        v4u a, b;
        a.x = pk2(v[0][j], v[1][j]); a.y = pk2(v[2][j], v[3][j]); a.z = pk2(v[4][j], v[5][j]); a.w = pk2(v[6][j], v[7][j]);
        b.x = pk2(v[8][j], v[9][j]); b.y = pk2(v[10][j], v[11][j]); b.z = pk2(v[12][j], v[13][j]); b.w = pk2(v[14][j], v[15][j]);
        __builtin_nontemporal_store(a, dst); __builtin_nontemporal_store(b, dst + 1); }
}
__device__ __forceinline__ void* ldptr(const LAS unsigned long long* PT, int i) { const unsigned long long v = PT[i];
    const unsigned lo = __builtin_amdgcn_readfirstlane((unsigned)v), hi = __builtin_amdgcn_readfirstlane((unsigned)(v >> 32)); return (void*)(GAS unsigned char*)(uintptr_t)(((unsigned long long)hi << 32) | lo); }
constexpr int CV_PRJ = 3 * 256, CV_GU = 32 * 512, CV_DN = 32 * 256, CV_ITEMS = CV_PRJ + CV_GU + CV_DN;
constexpr int CV_P1 = 192 * 8 * 3;
__device__ __forceinline__ void conv_tile(int it, const LAS unsigned long long* PT, int ln) {
    unsigned char* const wsb = (unsigned char*)ldptr(PT, 22);
    if (it < CV_PRJ) { const int mm = it >> 8, r = it & 255, db = r >> 4, kb = r & 15;
        const float* W = (const float*)ldptr(PT, 8 + mm); bf16* WT = mm < 2 ? (bf16*)(wsb + WS_WPROJ) + (size_t)mm * 1024 * 1024 : (bf16*)(wsb + WS_WOUT);
        p0_transpose_tile(W, 1024, 64 * db, WT, 64 * db, kb, ln); return; }
    it -= CV_PRJ;
    if (it < CV_GU) { const int e = it >> 9, r = it & 511, db = r >> 4, kb = r & 15, pn = db >> 2, jb = db & 3;
        const int src = jb < 2 ? 128 * pn + 64 * jb : 1024 + 128 * pn + 64 * (jb - 2);
        p0_transpose_tile((const float*)ldptr(PT, 15) + (size_t)e * 1024 * 2048, 2048, src, (bf16*)(wsb + WS_WGU) + (size_t)e * 2048 * 1024, 64 * db, kb, ln); return; }
    it -= CV_GU;
    { const int e = it >> 8, r = it & 255, db = r >> 4, kb = r & 15;
        p0_transpose_tile((const float*)ldptr(PT, 17) + (size_t)e * 1024 * 1024, 1024, 64 * db, (bf16*)(wsb + WS_WDN) + (size_t)e * 1024 * 1024, 64 * db, kb, ln); }
}
__device__ __forceinline__ void ln_row(const f32x4 (&xin)[4], f32x4 (&y)[4], const float* g, const float* b, int lane) {
    float s = 0.f;
#pragma unroll
    for (int j = 0; j < 4; ++j) s += (xin[j].x + xin[j].y) + (xin[j].z + xin[j].w);
    const float mean = wave_sum(s) * (1.f / DM); float s2 = 0.f;
#pragma unroll
    for (int j = 0; j < 4; ++j) { y[j] = xin[j] - mean; s2 += (y[j].x * y[j].x + y[j].y * y[j].y) + (y[j].z * y[j].z + y[j].w * y[j].w); }
    const float rstd = 1.f / sqrtf(wave_sum(s2) * (1.f / DM) + LN_EPS);
#pragma unroll
    for (int j = 0; j < 4; ++j) { const f32x4 gv = *(const f32x4*)(g + 4 * lane + 256 * j), bv = *(const f32x4*)(b + 4 * lane + 256 * j); y[j] = y[j] * rstd * gv + bv; }
}
__device__ __forceinline__ void store_row_bf16(bf16* orow, const f32x4 (&y)[4], int lane) {
    GAS unsigned long long* o8 = (GAS unsigned long long*)orow + lane;
#pragma unroll
    for (int j = 0; j < 4; ++j) o8[64 * j] = (unsigned long long)pk2(y[j].x, y[j].y) | ((unsigned long long)pk2(y[j].z, y[j].w) << 32);
}

struct Args { const float* in[21]; float* out; unsigned char* ws; int ph_lo, ph_hi, li, pad; };
constexpr int NPH = 11;

__global__ void __launch_bounds__(NTHR, 2) mega_fwd(Args args) {
    extern __shared__ __attribute__((aligned(16))) unsigned char lds[];
    LAS unsigned char* const ldsl = (LAS unsigned char*)lds;
    volatile LAS unsigned* const MISC = (volatile LAS unsigned*)(ldsl + MISC_OFF);
    const int tid = threadIdx.x, lane = tid & 63, wave = __builtin_amdgcn_readfirstlane(tid >> 6);
    const int G = gridDim.x; const int bx = blockIdx.x; const int vcu = (G % 8 == 0) ? (bx % 8) * (G / 8) + bx / 8 : bx;
    for (int u = tid; u < (LDS_BYTES - LDSCTL_OFF) / 4; u += NTHR) ((LAS unsigned*)(ldsl + LDSCTL_OFF))[u] = 0u;
    __syncthreads();
    LAS unsigned long long* const PT = (LAS unsigned long long*)(ldsl + LDSCTL_OFF);
    if (tid == 0) {
#pragma unroll
        for (int i = 0; i < 21; ++i) PT[i] = (unsigned long long)(uintptr_t)args.in[i];
        PT[21] = (unsigned long long)(uintptr_t)args.out; PT[22] = (unsigned long long)(uintptr_t)args.ws; }
    __syncthreads();
#define INP(i) ((const float*)ldptr(PT, (i)))
#define WSB ((unsigned char*)ldptr(PT, 22))
    const int lo = args.ph_lo, hi = args.ph_hi;
    unsigned long long t_stamp_a = 0ull; const unsigned long long t_stamp_0 = (STAMP_K >= 0) ? __builtin_amdgcn_s_memrealtime() : 0ull;
    const bool use_bar = (hi - lo) > 1;
    if (use_bar) (void)xcd_barrier_post((unsigned*)(WSB + WS_CTL) + CW_BAR, MISC + 8);
#ifndef PH_MASK
#define PH_MASK 0x7FF
#endif
#define IN(k) ((((PH_MASK) >> (k)) & 1) && lo <= (k) && (k) < hi)
#ifndef DUP_MASK
#define DUP_MASK 0
#endif
#define DUP(k) for (int rep_ = 0; rep_ < 1 + (((DUP_MASK) >> (k)) & 1); ++rep_)
#define SEAM(k) do { if (STAMP_K == (k) && bx == 0 && tid == 0) { t_stamp_a = __builtin_amdgcn_s_memrealtime(); } if (IN(k) && IN((k) + 1)) { XcdBarrier b_; b_.bar = (unsigned*)(WSB + WS_CTL) + CW_BAR; b_.x = xb_xcc_id(); b_.st = MISC + 8; xcd_barrier(b_); if ((DUP_MASK >> 16) & 1) { xcd_barrier(b_); xcd_barrier(b_); } } if (STAMP_K == (k) + 100 && bx == 0 && tid == 0) { t_stamp_a = __builtin_amdgcn_s_memrealtime(); } } while (0)

    if (IN(0)) DUP(0) {
        bf16* const WIN_T = (bf16*)(WSB + WS_WIN); bf16* const WPROJ_T = (bf16*)(WSB + WS_WPROJ); bf16* const WOUT_T = (bf16*)(WSB + WS_WOUT); bf16* const WGU_T = (bf16*)(WSB + WS_WGU); bf16* const WDN_T = (bf16*)(WSB + WS_WDN); bf16* const H0B = (bf16*)(WSB + WS_H0B);
        const float* const x = INP(0); const float* const ln_in_g = INP(1); const float* const ln_in_b = INP(2); const float* const w_in = INP(3); const float* const w_gla_proj = INP(8); const float* const w_fox_proj = INP(9); const float* const w_out = INP(10); const float* const w_gate_up = INP(15); const float* const w_down = INP(17);
        const int gw = vcu * NWAVES + wave, NGW = G * NWAVES;
        constexpr int I_IN = 128 * 16;
        for (int it = gw; it < I_IN; it += NGW) { const int db = it >> 4, kb = it & 15, dst = 64 * db, src = dst + (dst < 2048 ? 0 : (dst < 6144 ? 16 : 24));
            p0_transpose_tile(w_in, IN_COLS, src, WIN_T, dst, kb, lane); }
        for (int i = vcu * NTHR + tid; i < 256 * 1024; i += G * NTHR) { const int r = i >> 10, k = i & 1023;
            float v = 0.f; if (r < 16) v = w_in[(size_t)k * IN_COLS + 2048 + r]; else if (r < 24) v = w_in[(size_t)k * IN_COLS + 6160 + (r - 16)];
            WIN_T[(size_t)(NPROJ + r) * 1024 + k] = (bf16)f2bf(v); }
        for (int m0 = gw; m0 < T_TOK; m0 += 4 * NGW) {
            f32x4 v[4][4], y[4];
#pragma unroll
            for (int r = 0; r < 4; ++r) { const GAS f32x4* xr = (const GAS f32x4*)(x + (size_t)(m0 + r * NGW) * DM) + lane;
#pragma unroll
                for (int j = 0; j < 4; ++j) v[r][j] = xr[64 * j]; }
#pragma unroll
            for (int r = 0; r < 4; ++r) { ln_row(v[r], y, ln_in_g, ln_in_b, lane); store_row_bf16(H0B + (size_t)(m0 + r * NGW) * DM, y, lane); } }
    }
    SEAM(0);

    if (IN(1)) DUP(1) {
        bf16* const H0B = (bf16*)(WSB + WS_H0B); bf16* const WIN_T = (bf16*)(WSB + WS_WIN); bf16* const PROJ = (bf16*)(WSB + WS_PROJ); float* const SM = (float*)(WSB + WS_SM);
        pg8::Gemm g{H0B, WIN_T, T_TOK, NPROJ_PAD, DM}; pg8::StaticOrder S; S.init(T_TOK, NPROJ_PAD, G, bx);
        pg8::EpiProj E{PROJ, SM, (bf16*)(WSB + WS_FQKV), (bf16*)(WSB + WS_ZIMG)};
        pg8::gemm_phase<pg8::EpiProj, pg8::StaticOrder, true, true, false>(ldsl + RING_OFF, g, S, E);
        if (bx >= 64 && rep_ == 0) {
            const int cw = ((bx - 64) * NWAVES + wave) * 3;
#pragma unroll 1
            for (int t = 0; t < 3; ++t) conv_tile(cw + t, PT, lane);
        }
    }
    SEAM(1);

    if (IN(2)) DUP(2) {
        float* const SM = (float*)(WSB + WS_SM); float* const FB = (float*)(WSB + WS_FB); float* const DECAY = (float*)(WSB + WS_DECAY); bf16* const KDEC = (bf16*)(WSB + WS_KDEC); bf16* const VT = (bf16*)(WSB + WS_MIXED); bf16* const PROJ = (bf16*)(WSB + WS_PROJ);
        const float* const w_gup = INP(4); const float* const b_gla_gate = INP(5); const float* const b_forget = INP(7);
        LAS float* sc = (LAS float*)(ldsl + RING_OFF);
        for (int bh = vcu; bh < 32; bh += G) {
            const int b = bh >> 3, h = bh & 7; const float bf_ = b_forget[h];
            float v[8]; float run = 0.f;
#pragma unroll
            for (int j = 0; j < 8; ++j) { const int s = tid * 8 + j; run += logsig(SM[(size_t)(b * SEQ + s) * 32 + 16 + h] + bf_); v[j] = run; }
            float incl = run;
#pragma unroll
            for (int o = 1; o < 64; o <<= 1) { const float t = __shfl_up(incl, o); if (lane >= o) incl += t; }
            if (lane == 63) sc[wave] = incl;
            __syncthreads();
            float woff = 0.f;
            for (int w = 0; w < wave; ++w) woff += sc[w];
            const float off = woff + (incl - run);
#pragma unroll
            for (int j = 0; j < 8; ++j) FB[(size_t)bh * SEQ + tid * 8 + j] = -(off + v[j]) * FOX_INV_SCALE;
            __syncthreads();
        }
        {
            LAS float* const GL = (LAS float*)(ldsl + RING_OFF + 4096);
            LAS unsigned short* const KL = (LAS unsigned short*)(ldsl + RING_OFF + 8192);
            LAS unsigned short* const VL = (LAS unsigned short*)(ldsl + RING_OFF + 8192 + 16384);
            const int j = tid & 127, cq = tid >> 7; const int h = vcu & 3; const int col = h * 128 + j;
            float wu[16];
#pragma unroll
            for (int r = 0; r < 16; ++r) wu[r] = w_gup[r * 512 + col];
            const float bg = b_gla_gate[col];
            v4u kq[2], vq[4]; f32x4 gq = {0.f, 0.f, 0.f, 0.f};
#define PREP_LOAD(it_) do { const int n_ = ((it_) >> 2) & 63, b_ = (it_) >> 8; const size_t t0_ = (size_t)b_ * SEQ + n_ * 64; \
                _Pragma("unroll") for (int i = 0; i < 2; ++i) { const int p = tid + NTHR * i; kq[i] = *(const GAS v4u*)(PROJ + (t0_ + (p >> 4)) * 8192 + C_GK + h * 128 + (p & 15) * 8); } \
                _Pragma("unroll") for (int i = 0; i < 4; ++i) { const int p = tid + NTHR * i; vq[i] = *(const GAS v4u*)(PROJ + (t0_ + (p >> 5)) * 8192 + C_GV + h * 256 + (p & 31) * 8); } \
                if (tid < 256) gq = *(const GAS f32x4*)(SM + (t0_ + (tid >> 2)) * 32 + 4 * (tid & 3)); } while (0)
            PREP_LOAD(vcu);
            for (int it = vcu; it < NBATCH * NCHUNK * 4; it += G) {
                const int n = (it >> 2) & 63, b = it >> 8;
#pragma unroll
                for (int i = 0; i < 2; ++i) { const int p = tid + NTHR * i; *(LAS v4u*)(KL + (p >> 4) * 128 + (p & 15) * 8) = kq[i]; }
#pragma unroll
                for (int i = 0; i < 4; ++i) { const int p = tid + NTHR * i; *(LAS v4u*)(VL + (p >> 5) * 256 + (p & 31) * 8) = vq[i]; }
                if (tid < 256) *(LAS f32x4*)(GL + (tid >> 2) * 16 + 4 * (tid & 3)) = gq;
                __syncthreads();
                if (it + G < NBATCH * NCHUNK * 4) PREP_LOAD(it + G);
                float cum[16]; float run = 0.f;
#pragma unroll
                for (int c = 0; c < 16; ++c) { const LAS float* gl = GL + (cq * 16 + c) * 16; float z = bg;
#pragma unroll
                    for (int r4 = 0; r4 < 4; ++r4) { const f32x4 g4 = *(const LAS f32x4*)(gl + 4 * r4); z += g4.x * wu[4 * r4] + g4.y * wu[4 * r4 + 1] + g4.z * wu[4 * r4 + 2] + g4.w * wu[4 * r4 + 3]; }
                    run += logsig(z) * (1.0f / 16.0f); cum[c] = run; }
                sc[cq * 128 + j] = run;
                __syncthreads();
                float off = 0.f, total = 0.f;
#pragma unroll
                for (int q = 0; q < 4; ++q) { const float t = sc[q * 128 + j]; total += t; if (q < cq) off += t; }
                {   unsigned pk[8];
#pragma unroll
                    for (int c = 0; c < 16; c += 2) { const int cc = cq * 16 + c;
                        pk[c >> 1] = pk2(bfu(KL[cc * 128 + j]) * __expf(total - (off + cum[c])), bfu(KL[(cc + 1) * 128 + j]) * __expf(total - (off + cum[c + 1]))); }
                    GAS v4u* dst = (GAS v4u*)(KDEC + (size_t)it * 8192 + j * 64 + cq * 16);
                    v4u w0, w1; w0.x = pk[0]; w0.y = pk[1]; w0.z = pk[2]; w0.w = pk[3]; w1.x = pk[4]; w1.y = pk[5]; w1.z = pk[6]; w1.w = pk[7]; dst[0] = w0; dst[1] = w1; }
                if (cq == 0) DECAY[(size_t)(b * NCHUNK + n) * 512 + col] = expf(total);
                {   const int dv = tid & 255, ch = tid >> 8; unsigned pk[16];
#pragma unroll
                    for (int c = 0; c < 32; c += 2) pk[c >> 1] = (unsigned)VL[(ch * 32 + c) * 256 + dv] | ((unsigned)VL[(ch * 32 + c + 1) * 256 + dv] << 16);
                    GAS v4u* dst = (GAS v4u*)(VT + (size_t)it * 16384 + dv * 64 + ch * 32);
#pragma unroll
                    for (int q = 0; q < 4; ++q) { v4u w; w.x = pk[4 * q]; w.y = pk[4 * q + 1]; w.z = pk[4 * q + 2]; w.w = pk[4 * q + 3]; dst[q] = w; } }
                __syncthreads();
            }
#undef PREP_LOAD
        }
    }
    SEAM(2);

    if (IN(3)) {
        float* const FB = (float*)(WSB + WS_FB); float* const DECAY = (float*)(WSB + WS_DECAY); bf16* const KDEC = (bf16*)(WSB + WS_KDEC); bf16* const VT = (bf16*)(WSB + WS_MIXED); bf16* const PROJ = (bf16*)(WSB + WS_PROJ); bf16* const AO = (bf16*)(WSB + WS_AO);
        const float* const g_gla_norm = INP(6);
        LAS int* const QW = (LAS int*)(ldsl + TBL_CUM);
        DUP(13) {
        gu32* const ctlq = (gu32*)(WSB + WS_CTL) + CW_Q + rep_ * 1024;
        int qoff = 0;
#define P2_FETCH(dst) do { if (tid == 0) { int code_ = -1, t_ = qoff; for (; t_ < 8; ++t_) { const int k_ = (bx + t_) & 7; const unsigned i_ = __hip_atomic_fetch_add(ctlq + 64 * k_, 1u, __ATOMIC_RELAXED, __HIP_MEMORY_SCOPE_AGENT); \
                if (i_ < 66u) { code_ = k_ * 66 + (int)i_; break; } } QW[0] = code_; QW[1] = t_; } \
            __syncthreads(); dst = __builtin_amdgcn_readfirstlane(QW[0]); qoff = __builtin_amdgcn_readfirstlane(QW[1]); __syncthreads(); } while (0)
        int code; P2_FETCH(code);
        bool primed = false; int bbuf = 0;
        fox::Seam<fox::bf16> Sm;
        char* const lg = (char*)lds;
        const fox::bf16* const Pq = (const fox::bf16*)(WSB + WS_FQKV); fox::bf16* const Oo = (fox::bf16*)(AO + (size_t)T_TOK * 1024);
#define P2_REF(r_, code_) do { const int k_ = (code_) / 66, a_ = (code_) % 66 - 2; const int qb_ = 15 - (a_ >> 2), bh_ = 4 * k_ + (a_ & 3), b_ = bh_ >> 3, h_ = bh_ & 7; \
            r_.K = Pq + ((size_t)32 + bh_) * (SEQ * 128); r_.V = Pq + ((size_t)64 + bh_) * (SEQ * 128); r_.Q = Pq + ((size_t)bh_ * SEQ + qb_ * 256) * 128; \
            r_.O = Oo + (size_t)(b_ * SEQ + qb_ * 256) * 1024 + h_ * 128; r_.P0 = qb_ * 256; } while (0)
#define P2_BIAS(code_, buf_) do { const int k_ = (code_) / 66, a_ = (code_) % 66 - 2; const int bh_ = 4 * k_ + (a_ & 3); LAS f32x4* bl_ = (LAS f32x4*)(ldsl + fox::LDS_BIAS + (buf_) * 16384); \
            const GAS f32x4* src_ = (const GAS f32x4*)(FB + (size_t)bh_ * SEQ); bl_[tidl] = src_[tidl]; bl_[tidl + NTHR] = src_[tidl + NTHR]; } while (0)
        while (code >= 0) {
          int tidl = tid; asm volatile("" : "+v"(tidl));
          if (code % 66 < 2) {
            primed = false;
            typedef float f32x16 __attribute__((ext_vector_type(16)));
            const int gitem = 2 * (code / 66) + code % 66;
            const int tid = tidl, lane = tid & 63, wave = __builtin_amdgcn_readfirstlane(tid >> 6);
            const int b = gitem >> 2, h = gitem & 3; const int r32 = lane & 31, hi = lane >> 5;
#define GLA_KT(bf_) (ldsl + RING_OFF + (bf_) * 18432)
#define GLA_QT(bf_) (ldsl + RING_OFF + 36864 + (bf_) * 16896)
#define GLA_DC(bf_) ((LAS float*)(ldsl + RING_OFF + 70656 + (bf_) * 512))
#define GLA_OS (ldsl + RING_OFF + 71680)
#define GLA_SS ((LAS float*)(ldsl + RING_OFF + 71680 + 33792))
            bf16* const ORAW = (bf16*)(WSB + WS_H1B); float* const SSQ = (float*)(WSB + WS_TOKOF);
            f32x16 Sacc[4];
#pragma unroll
            for (int m = 0; m < 4; ++m)
#pragma unroll
                for (int r = 0; r < 16; ++r) Sacc[m][r] = 0.f;
            const int p0 = tid, p1 = tid + 512;
            const unsigned kdst0 = (p0 >> 3) * 144 + (p0 & 7) * 16, kdst1 = (p1 >> 3) * 144 + (p1 & 7) * 16, qdst0 = (p0 >> 4) * 264 + (p0 & 15) * 16, qdst1 = (p1 >> 4) * 264 + (p1 & 15) * 16;
            v4u kst0, kst1, qst0, qst1; float dcs = 0.f; bf16x8 vf[4];
#define GLA_LOAD_STAGE(n_) do { const size_t item_ = (size_t)((b * NCHUNK + (n_)) * 4 + h); const size_t tok0_ = (size_t)b * SEQ + (size_t)(n_) * 64; \
                kst0 = *(const GAS v4u*)(KDEC + item_ * 8192 + (p0 >> 3) * 64 + (p0 & 7) * 8); kst1 = *(const GAS v4u*)(KDEC + item_ * 8192 + (p1 >> 3) * 64 + (p1 & 7) * 8); \
                qst0 = *(const GAS v4u*)(PROJ + (tok0_ + (p0 >> 4)) * 8192 + C_GQ + h * 128 + (p0 & 15) * 8); qst1 = *(const GAS v4u*)(PROJ + (tok0_ + (p1 >> 4)) * 8192 + C_GQ + h * 128 + (p1 & 15) * 8); \
                if (tid < 128) dcs = DECAY[(size_t)(b * NCHUNK + (n_)) * 512 + h * 128 + tid]; } while (0)
#define GLA_LOAD_V(n_) do { const bf16* vb_ = VT + (size_t)((b * NCHUNK + (n_)) * 4 + h) * 16384 + (size_t)(32 * wave + r32) * 64 + 8 * hi; \
                _Pragma("unroll") for (int ks = 0; ks < 4; ++ks) vf[ks] = *(const GAS bf16x8*)(vb_ + 16 * ks); } while (0)
            GLA_LOAD_STAGE(0); GLA_LOAD_V(0);
            for (int n = 0; n < NCHUNK; ++n) {
                const size_t tok0 = (size_t)b * SEQ + (size_t)n * 64; const int bf = n & 1;
                LAS unsigned char* const KT = GLA_KT(bf); LAS unsigned char* const QT = GLA_QT(bf); LAS float* const DC = GLA_DC(bf);
                *(LAS v4u*)(KT + kdst0) = kst0; *(LAS v4u*)(KT + kdst1) = kst1; *(LAS v4u*)(QT + qdst0) = qst0; *(LAS v4u*)(QT + qdst1) = qst1;
                if (tid < 128) DC[tid] = dcs;
                __syncthreads();
                if (n + 1 < NCHUNK) GLA_LOAD_STAGE(n + 1);
#pragma unroll
                for (int m = 0; m < 4; ++m)
#pragma unroll
                    for (int g4 = 0; g4 < 4; ++g4) { const f32x4 d4 = *(const LAS f32x4*)(DC + 32 * m + 8 * g4 + 4 * hi);
                        Sacc[m][4 * g4 + 0] *= d4.x; Sacc[m][4 * g4 + 1] *= d4.y; Sacc[m][4 * g4 + 2] *= d4.z; Sacc[m][4 * g4 + 3] *= d4.w; }
#pragma unroll
                for (int m = 0; m < 4; ++m)
#pragma unroll
                    for (int ks = 0; ks < 4; ++ks) { const bf16x8 kf = *(const LAS bf16x8*)(KT + (32 * m + r32) * 144 + (16 * ks + 8 * hi) * 2);
                        Sacc[m] = __builtin_amdgcn_mfma_f32_32x32x16_bf16(kf, vf[ks], Sacc[m], 0, 0, 0); }
                if (n + 1 < NCHUNK) GLA_LOAD_V(n + 1);
                f32x16 ot[2];
#pragma unroll
                for (int nt = 0; nt < 2; ++nt)
#pragma unroll
                    for (int r = 0; r < 16; ++r) ot[nt][r] = 0.f;
#pragma unroll
                for (int m = 0; m < 4; ++m)
#pragma unroll
                    for (int sx = 0; sx < 2; ++sx) {
                        v4u ap; ap.x = pg8::cvt_pk_bf16(Sacc[m][8 * sx + 0], Sacc[m][8 * sx + 1]); ap.y = pg8::cvt_pk_bf16(Sacc[m][8 * sx + 2], Sacc[m][8 * sx + 3]);
                        ap.z = pg8::cvt_pk_bf16(Sacc[m][8 * sx + 4], Sacc[m][8 * sx + 5]); ap.w = pg8::cvt_pk_bf16(Sacc[m][8 * sx + 6], Sacc[m][8 * sx + 7]);
                        const bf16x8 af = __builtin_bit_cast(bf16x8, ap);
#pragma unroll
                        for (int nt = 0; nt < 2; ++nt) { const LAS unsigned char* qp = QT + (32 * nt + r32) * 264 + (32 * m + 16 * sx + 4 * hi) * 2;
                            const unsigned long long qlo = *(const LAS unsigned long long*)qp, qhi = *(const LAS unsigned long long*)(qp + 16);
                            v4u bp; bp.x = (unsigned)qlo; bp.y = (unsigned)(qlo >> 32); bp.z = (unsigned)qhi; bp.w = (unsigned)(qhi >> 32);
                            ot[nt] = __builtin_amdgcn_mfma_f32_32x32x16_bf16(af, __builtin_bit_cast(bf16x8, bp), ot[nt], 0, 0, 0); } }
#pragma unroll
                for (int nt = 0; nt < 2; ++nt) { float a = 0.f; const int c = 32 * nt + r32;
#pragma unroll
                    for (int r = 0; r < 16; ++r) a += ot[nt][r] * ot[nt][r];
                    a += __shfl_xor(a, 32);
                    if (hi == 0) GLA_SS[c * 8 + wave] = a;
#pragma unroll
                    for (int g4 = 0; g4 < 4; ++g4)
                        *(LAS unsigned long long*)(GLA_OS + c * 528 + (32 * wave + 8 * g4 + 4 * hi) * 2) = (unsigned long long)pg8::cvt_pk_bf16(ot[nt][4 * g4 + 0], ot[nt][4 * g4 + 1]) | ((unsigned long long)pg8::cvt_pk_bf16(ot[nt][4 * g4 + 2], ot[nt][4 * g4 + 3]) << 32); }
                __syncthreads();
#pragma unroll
                for (int i = 0; i < 4; ++i) { const int c = (tid >> 5) + 16 * i, ch = tid & 31;
                    *(GAS v4u*)(ORAW + (tok0 + c) * 1024 + h * 256 + ch * 8) = *(const LAS v4u*)(GLA_OS + c * 528 + ch * 16); }
                if (tid < 64) { float t = 0.f;
#pragma unroll
                    for (int w = 0; w < 8; ++w) t += GLA_SS[tid * 8 + w];
                    SSQ[(tok0 + tid) * 4 + h] = t; }
            }
#undef GLA_KT
#undef GLA_QT
#undef GLA_DC
#undef GLA_OS
#undef GLA_SS
#undef GLA_LOAD_STAGE
#undef GLA_LOAD_V
            __syncthreads();
            P2_FETCH(code);
            asm volatile("" : "=v"(Sm.qr[0]), "=v"(Sm.qr[1]), "=v"(Sm.qr[2]), "=v"(Sm.qr[3]), "=v"(Sm.qr[4]), "=v"(Sm.qr[5]), "=v"(Sm.qr[6]), "=v"(Sm.qr[7]), "=v"(Sm.st_v0), "=v"(Sm.st_v1), "=v"(Sm.st_k0), "=v"(Sm.st_k1));
          } else {
            fox::BlockRef<fox::bf16, fox::bf16> cur; P2_REF(cur, code);
            if (!primed) { P2_BIAS(code, bbuf); fox::causal_swa_prime<fox::bf16, fox::bf16>(cur, SEQ, lg, Sm, tidl); }
            int ncode; P2_FETCH(ncode);
            const bool nx_att = ncode >= 0 && (ncode % 66) >= 2;
            fox::BlockRef<fox::bf16, fox::bf16> nx = cur; if (nx_att) { P2_REF(nx, ncode); P2_BIAS(ncode, bbuf ^ 1); }
            asm volatile("" : "+s"(nx.K), "+s"(nx.V), "+s"(nx.Q));
            fox::causal_swa_block<fox::bf16, fox::bf16>(cur, nx, SEQ, SEQ, lg, Sm, bbuf, tidl);
            if (rep_ == 0) {
                const int ntc = 4 * (16 - ((code % 66 - 2) >> 2)); const int ncv = (ntc * (CV_ITEMS - CV_P1) + 17407) / 17408;
                if (tid == 0) QW[2] = (int)__hip_atomic_fetch_add(ctlq + 64 * 8, (unsigned)ncv, __ATOMIC_RELAXED, __HIP_MEMORY_SCOPE_AGENT);
                __syncthreads();
                const int cv0 = __builtin_amdgcn_readfirstlane(QW[2]); int cv1 = cv0 + ncv; if (cv1 > CV_ITEMS - CV_P1) cv1 = CV_ITEMS - CV_P1;
                const int wv = __builtin_amdgcn_readfirstlane(tidl >> 6), ln = tidl & 63;
                for (int it0 = cv0 + wv; it0 < cv1; it0 += NWAVES) conv_tile(CV_P1 + it0, PT, ln);
            }
            primed = nx_att; bbuf ^= 1; code = ncode;
          }
        }
#undef P2_FETCH
#undef P2_REF
#undef P2_BIAS
        }
    }
    SEAM(3);

    if (IN(4)) DUP(4) {
        bf16* const AO = (bf16*)(WSB + WS_AO); bf16* const PROJ = (bf16*)(WSB + WS_PROJ); const bf16* const ORAW = (const bf16*)(WSB + WS_H1B); const float* const SSQ = (const float*)(WSB + WS_TOKOF);
        const float* const g_gla_norm = INP(6);
        const int gw = vcu * NWAVES + wave, NGW = G * NWAVES;
        const f32x4 gn = *(const f32x4*)(g_gla_norm + 4 * lane);
        for (int m0 = gw; m0 < T_TOK; m0 += 4 * NGW) {
            f32x4 hs4[4]; unsigned long long ow[4][4], rw[4][4];
#pragma unroll
            for (int r = 0; r < 4; ++r) { const size_t mm = (size_t)(m0 + r * NGW); hs4[r] = *(const f32x4*)(SSQ + mm * 4);
                const GAS unsigned long long* orow = (const GAS unsigned long long*)(ORAW + mm * 1024) + lane; const GAS unsigned long long* rrow = (const GAS unsigned long long*)(PROJ + mm * 8192 + C_GR) + lane;
#pragma unroll
                for (int j = 0; j < 4; ++j) { ow[r][j] = orow[64 * j]; rw[r][j] = rrow[64 * j]; } }
#pragma unroll
            for (int r = 0; r < 4; ++r) { GAS unsigned long long* drow = (GAS unsigned long long*)(AO + (size_t)(m0 + r * NGW) * 1024) + lane;
#pragma unroll
                for (int j = 0; j < 4; ++j) { const float tot = hs4[r][j] * (GLA_QSCALE * GLA_QSCALE); const float rs = GLA_QSCALE / sqrtf(tot * (1.0f / 256.0f) + LN_EPS);
                    const unsigned ol = (unsigned)ow[r][j], oh = (unsigned)(ow[r][j] >> 32), rl = (unsigned)rw[r][j], rh = (unsigned)(rw[r][j] >> 32);
                    const float r0 = pg8::bf_lo(rl), r1 = pg8::bf_hi(rl), r2 = pg8::bf_lo(rh), r3 = pg8::bf_hi(rh);
                    const float o0 = pg8::bf_lo(ol) * rs * gn.x * (r0 * pg8::sigm(r0)), o1 = pg8::bf_hi(ol) * rs * gn.y * (r1 * pg8::sigm(r1)), o2 = pg8::bf_lo(oh) * rs * gn.z * (r2 * pg8::sigm(r2)), o3 = pg8::bf_hi(oh) * rs * gn.w * (r3 * pg8::sigm(r3));
                    drow[64 * j] = (unsigned long long)pg8::cvt_pk_bf16(o0, o1) | ((unsigned long long)pg8::cvt_pk_bf16(o2, o3) << 32); } } }
    }
    SEAM(4);

    if (IN(5)) DUP(5) {
        bf16* const AO = (bf16*)(WSB + WS_AO); bf16* const WPROJ_T = (bf16*)(WSB + WS_WPROJ); bf16* const PROJ = (bf16*)(WSB + WS_PROJ); bf16* const MIXED = (bf16*)(WSB + WS_MIXED);
        pg8::Gemm g{AO, WPROJ_T, 2 * T_TOK, 2048, DM}; pg8::MixOrder S; S.init(T_TOK, DM, G, bx);
        pg8::EpiMix E{(const bf16*)(WSB + WS_ZIMG), MIXED};
        pg8::gemm_phase<pg8::EpiMix, pg8::MixOrder, true, true, false>(ldsl + RING_OFF, g, S, E);
    }
    SEAM(5);

    if (IN(6)) DUP(6) {
        bf16* const MIXED = (bf16*)(WSB + WS_MIXED); bf16* const WOUT_T = (bf16*)(WSB + WS_WOUT); float* const H1F = (float*)(WSB + WS_H1F);
        pg8::Gemm g{MIXED, WOUT_T, T_TOK, DM, DM}; pg8::StaticOrder S; S.init(T_TOK, DM, G, bx);
        pg8::EpiBf16<0> E{(bf16*)(WSB + WS_YS), DM, nullptr, 0, 0, 1.f};
        pg8::gemm_phase<pg8::EpiBf16<0>, pg8::StaticOrder, true, true, false>(ldsl + RING_OFF, g, S, E);
    }
    SEAM(6);

    if (IN(7)) {
        gu32* const ctl = (gu32*)(WSB + WS_CTL);
        bf16* const H1B = (bf16*)(WSB + WS_H1B); int* const TOKOF = (int*)(WSB + WS_TOKOF); int* const PAIR_E = (int*)(WSB + WS_PAIR); int* const PAIR_POS = PAIR_E + T_TOK * 4; float* const PAIR_G = (float*)(PAIR_POS + T_TOK * 4);
        const float* const x = INP(0); const float* const ln_in_g = INP(1); const float* const ln_in_b = INP(2); const float* const ln_mix_g = INP(11); const float* const ln_mix_b = INP(12);
        const float* const w_router = INP(13); const float* const b_router = INP(14); const bf16* const PRE = (const bf16*)(WSB + WS_YS);
        LAS float* const WRT = (LAS float*)(ldsl + RING_OFF);
        LAS float* const LOGT = (LAS float*)(ldsl + TBL_IDX) + wave * 64;
        LAS int* const HIST = (LAS int*)(ldsl + TBL_CNT); LAS int* const BASE = (LAS int*)(ldsl + TBL_CUM);
#pragma unroll 4
        for (int i = 0; i < 16; ++i) { const int p = tid + NTHR * i, e4 = p & 7, k = p >> 3; const f32x4 w = *(const GAS f32x4*)(w_router + 4 * p);
            WRT[(4 * e4 + 0) * 1024 + k] = w.x; WRT[(4 * e4 + 1) * 1024 + k] = w.y; WRT[(4 * e4 + 2) * 1024 + k] = w.z; WRT[(4 * e4 + 3) * 1024 + k] = w.w; }
        if (tid < 32) HIST[tid] = 0;
        __syncthreads();
        const int gw = vcu * NWAVES + wave, NGW = G * NWAVES;
        int te[4][4], tr[4][4]; float tgt[4][4];
        f32x4 vx[2][4]; unsigned long long vp[2][4];
#define ROW_LOAD(g_) do { _Pragma("unroll") for (int r = 0; r < 2; ++r) { const size_t mm = (size_t)(gw + (2 * (g_) + r) * NGW); const GAS f32x4* xr = (const GAS f32x4*)(x + mm * DM) + lane; const GAS unsigned long long* pr = (const GAS unsigned long long*)(PRE + mm * DM) + lane; \
            _Pragma("unroll") for (int j = 0; j < 4; ++j) { vx[r][j] = xr[64 * j]; vp[r][j] = pr[64 * j]; } } } while (0)
        ROW_LOAD(0);
#pragma unroll 1
        for (int g = 0; g < 4; ++g) {
            f32x4 z[2][4];
            {   f32x4 y[4];
#pragma unroll
                for (int r = 0; r < 2; ++r) { const size_t mm = (size_t)(gw + (2 * g + r) * NGW);
                    ln_row(vx[r], y, ln_in_g, ln_in_b, lane);
#pragma unroll
                    for (int j = 0; j < 4; ++j) { const unsigned wl = (unsigned)vp[r][j], wh = (unsigned)(vp[r][j] >> 32); y[j] = y[j] * DN_ALPHA + (f32x4){pg8::bf_lo(wl), pg8::bf_hi(wl), pg8::bf_lo(wh), pg8::bf_hi(wh)}; }
                    ln_row(y, z[r], ln_mix_g, ln_mix_b, lane);
                    store_row_bf16(H1B + mm * DM, z[r], lane); } }
            if (g < 3) ROW_LOAD(g + 1);
            float vals[64];
            typedef float f32x2r __attribute__((ext_vector_type(2)));
            f32x2r zz[4][4];
#pragma unroll
            for (int j = 0; j < 4; ++j) { zz[j][0] = (f32x2r){z[0][j].x, z[1][j].x}; zz[j][1] = (f32x2r){z[0][j].y, z[1][j].y}; zz[j][2] = (f32x2r){z[0][j].z, z[1][j].z}; zz[j][3] = (f32x2r){z[0][j].w, z[1][j].w}; }
#pragma unroll
            for (int e = 0; e < 32; ++e) { f32x2r a = {0.f, 0.f};
#pragma unroll
                for (int j = 0; j < 4; ++j) { const f32x4 w = *(const LAS f32x4*)(WRT + e * 1024 + 4 * lane + 256 * j);
                    a = __builtin_elementwise_fma(zz[j][0], (f32x2r){w.x, w.x}, a); a = __builtin_elementwise_fma(zz[j][1], (f32x2r){w.y, w.y}, a);
                    a = __builtin_elementwise_fma(zz[j][2], (f32x2r){w.z, w.z}, a); a = __builtin_elementwise_fma(zz[j][3], (f32x2r){w.w, w.w}, a); }
                vals[e] = a.x; vals[32 + e] = a.y; }
#define ROW_RED(S_, H_) _Pragma("unroll") for (int i = 0; i < (H_); ++i) { const bool up = (lane & (S_)) != 0; const float snd = up ? vals[i] : vals[i + (H_)], kp = up ? vals[i + (H_)] : vals[i]; vals[i] = kp + __shfl_xor(snd, (S_)); }
            ROW_RED(32, 32) ROW_RED(16, 16) ROW_RED(8, 8) ROW_RED(4, 4) ROW_RED(2, 2) ROW_RED(1, 1)
#undef ROW_RED
            float lv = vals[0] + b_router[lane & 31];
            int te_[4] = {0, 0, 0, 0}, tr_[4] = {0, 0, 0, 0}; float tg_[4] = {0.f, 0.f, 0.f, 0.f}, tv[4];
#pragma unroll
            for (int k = 0; k < 4; ++k) { float bv = lv; int bi = lane & 31;
#pragma unroll
                for (int s = 1; s < 32; s <<= 1) { const float ov = __shfl_xor(bv, s); const int oi = __shfl_xor(bi, s); const bool tk = (ov > bv) || (ov == bv && oi < bi); bv = tk ? ov : bv; bi = tk ? oi : bi; }
                tv[k] = bv; te_[k] = bi; if ((lane & 31) == bi) lv = -3.0e38f; }
            { float ssum = 0.f;
#pragma unroll
                for (int k = 0; k < 4; ++k) { tg_[k] = __expf(tv[k] - tv[0]); ssum += tg_[k]; }
                const float rs = 1.0f / ssum;
#pragma unroll
                for (int k = 0; k < 4; ++k) tg_[k] *= rs; }
            if ((lane & 31) == 0) {
#pragma unroll
                for (int k = 0; k < 4; ++k) tr_[k] = atomicAdd((int*)(HIST + te_[k]), 1); }
#pragma unroll
            for (int gg = 0; gg < 4; ++gg) if (gg == g) {
#pragma unroll
                for (int k = 0; k < 4; ++k) { te[gg][k] = te_[k]; tr[gg][k] = tr_[k]; tgt[gg][k] = tg_[k]; } }
        }
#undef ROW_LOAD
        __syncthreads();
        if (tid < 32) BASE[tid] = (int)__hip_atomic_fetch_add(ctl + CW_CNT + 64 * tid, (unsigned)HIST[tid], __ATOMIC_RELAXED, __HIP_MEMORY_SCOPE_AGENT);
        __syncthreads();
        if ((lane & 31) == 0) {
#pragma unroll
            for (int g = 0; g < 4; ++g) { const int t2 = gw + (2 * g + (lane >> 5)) * NGW;
#pragma unroll
                for (int k = 0; k < 4; ++k) { const int e = te[g][k], pos = BASE[e] + tr[g][k];
                    TOKOF[(size_t)e * T_TOK + pos] = t2; PAIR_E[t2 * 4 + k] = e; PAIR_POS[t2 * 4 + k] = pos; PAIR_G[t2 * 4 + k] = tgt[g][k]; } } }
    }
    SEAM(7);

#define GROUPED_PREP(NT_, GATHER_) do { \
        LAS int* CUM = (LAS int*)(ldsl + TBL_CUM); LAS int* CNT = (LAS int*)(ldsl + TBL_CNT); LAS int* DESC = (LAS int*)(ldsl + TBL_DESC); LAS int* IDX = (LAS int*)(ldsl + TBL_IDX); \
        if (tid == 0) { int c = 0; for (int e = 0; e < NE; ++e) { const int n = (int)__hip_atomic_load(ctl + CW_CNT + 64 * e, __ATOMIC_RELAXED, __HIP_MEMORY_SCOPE_AGENT); CNT[e] = n; CUM[e] = c; c += (n + 255) >> 8; } CUM[NE] = c; } \
        __syncthreads(); \
        if (tid < pg8::MAXU) { const int nwg = (NT_) * CUM[NE]; const long L = (long)tid * G + bx; int valid = 0, ab = 0, bb = 0, pn = 0, e = 0, pm = 0; \
            if (L < nwg) { int wgid = (int)L; { const int q = nwg / 8, r = nwg % 8, xcd = wgid % 8, off = wgid / 8; wgid = (xcd < r ? xcd * (q + 1) : r * (q + 1) + (xcd - r) * q) + off; } \
                while (e < NE - 1 && wgid >= (NT_) * CUM[e + 1]) ++e; \
                const int r2 = wgid - (NT_) * CUM[e], te_ = CUM[e + 1] - CUM[e]; pn = r2 / te_; pm = r2 % te_; ab = CUM[e] + pm; bb = e * (NT_) + pn; valid = 1; } \
            DESC[tid * 8 + 0] = valid; DESC[tid * 8 + 1] = ab; DESC[tid * 8 + 2] = bb; DESC[tid * 8 + 3] = pn; DESC[tid * 8 + 4] = e; DESC[tid * 8 + 5] = pm; } \
        __syncthreads(); \
        if (GATHER_) { for (int i = 0; i < pg8::MAXU; ++i) { if (DESC[i * 8] == 0) break; const int e = DESC[i * 8 + 4], pm = DESC[i * 8 + 5]; \
            if (tid < 256) { const int slot = pm * 256 + tid; IDX[i * 256 + tid] = slot < CNT[e] ? TOKOF[(size_t)e * T_TOK + slot] : 0; } } \
            __syncthreads(); } } while (0)
    if (IN(8)) DUP(8) {
        gu32* const ctl = (gu32*)(WSB + WS_CTL);
        int* const TOKOF = (int*)(WSB + WS_TOKOF); bf16* const H1B = (bf16*)(WSB + WS_H1B); bf16* const WGU_T = (bf16*)(WSB + WS_WGU); bf16* const ACT = (bf16*)(WSB + WS_ACT);
        const float* const b_gate_up = INP(16);
        GROUPED_PREP(8, true);
        pg8::Gemm g{H1B, WGU_T, T_TOK, 2048, DM}; pg8::GroupedOrder S{(const LAS int*)(ldsl + TBL_DESC), (const LAS int*)(ldsl + TBL_IDX)};
        pg8::EpiAct E{ACT, b_gate_up};
        pg8::gemm_phase<pg8::EpiAct, pg8::GroupedOrder, true, true, true>(ldsl + RING_OFF, g, S, E);
    }
#if (DUP_MASK >> 12) & 1
    if (IN(8)) {
        gu32* const ctl = (gu32*)(WSB + WS_CTL);
        int* const TOKOF = (int*)(WSB + WS_TOKOF); bf16* const H1B = (bf16*)(WSB + WS_H1B); bf16* const WGU_T = (bf16*)(WSB + WS_WGU); bf16* const ACT = (bf16*)(WSB + WS_ACT);
        const float* const b_gate_up = INP(16);
        GROUPED_PREP(8, true);
        pg8::Gemm g{H1B, WGU_T, T_TOK, 2048, DM}; pg8::GroupedOrder S{(const LAS int*)(ldsl + TBL_DESC), (const LAS int*)(ldsl + TBL_IDX)};
        pg8::EpiAct E{ACT, b_gate_up};
        pg8::gemm_phase<pg8::EpiAct, pg8::GroupedOrder, true, true, true>(ldsl + RING_OFF, g, S, E);
    }
#endif
    SEAM(8);
    if (IN(9)) DUP(9) {
        gu32* const ctl = (gu32*)(WSB + WS_CTL);
        bf16* const ACT = (bf16*)(WSB + WS_ACT); bf16* const WDN_T = (bf16*)(WSB + WS_WDN); bf16* const YS = (bf16*)(WSB + WS_YS);
        int* const TOKOF = nullptr;
        const float* const b_down = INP(18);
        GROUPED_PREP(4, false);
        pg8::Gemm g{ACT, WDN_T, SLOT_ROWS, 1024, DFF}; pg8::GroupedOrder S{(const LAS int*)(ldsl + TBL_DESC), (const LAS int*)(ldsl + TBL_IDX)};
        pg8::EpiDown E{YS, b_down};
        pg8::gemm_phase<pg8::EpiDown, pg8::GroupedOrder, true, true, false>(ldsl + RING_OFF, g, S, E);
    }
    SEAM(9);

    if (IN(10)) DUP(10) {
        gu32* const ctl = (gu32*)(WSB + WS_CTL);
        const bf16* const H1B = (const bf16*)(WSB + WS_H1B); int* const PAIR_E = (int*)(WSB + WS_PAIR); int* const PAIR_POS = PAIR_E + T_TOK * 4; float* const PAIR_G = (float*)(PAIR_POS + T_TOK * 4); bf16* const YS = (bf16*)(WSB + WS_YS);
        const float* const ln_ffn_g = INP(19); const float* const ln_ffn_b = INP(20);
        float* const out = (float*)ldptr(PT, 21);
        LAS int* CUM = (LAS int*)(ldsl + TBL_CUM);
        if (tid == 0) { int c = 0; for (int e = 0; e < NE; ++e) { const int n = (int)__hip_atomic_load(ctl + CW_CNT + 64 * e, __ATOMIC_RELAXED, __HIP_MEMORY_SCOPE_AGENT); CUM[e] = c; c += (n + 255) >> 8; } CUM[NE] = c; }
        __syncthreads();
        const int gw = vcu * NWAVES + wave, NGW = G * NWAVES;
        int pslot = 0; float pgate = 0.f;
        if (lane < 32) { const int q = (gw + (lane >> 2) * NGW) * 4 + (lane & 3); pslot = CUM[PAIR_E[q]] * 256 + PAIR_POS[q]; pgate = PAIR_G[q]; }
        for (int it = 0; it < 4; ++it) {
            f32x4 v[2][4], y[4]; unsigned long long yv[2][4][4]; float gk[2][4];
#pragma unroll
            for (int r = 0; r < 2; ++r) { const size_t mm = (size_t)(gw + (2 * it + r) * NGW); const GAS unsigned long long* hr = (const GAS unsigned long long*)(H1B + mm * DM) + lane;
#pragma unroll
                for (int j = 0; j < 4; ++j) { const unsigned long long w = hr[64 * j]; const unsigned wl = (unsigned)w, wh = (unsigned)(w >> 32); v[r][j] = (f32x4){pg8::bf_lo(wl), pg8::bf_hi(wl), pg8::bf_lo(wh), pg8::bf_hi(wh)}; }
#pragma unroll
                for (int k = 0; k < 4; ++k) { const int slot = __builtin_amdgcn_readfirstlane(__shfl(pslot, (2 * it + r) * 4 + k)); gk[r][k] = __shfl(pgate, (2 * it + r) * 4 + k);
                    const GAS unsigned long long* yr = (const GAS unsigned long long*)(YS + (size_t)slot * 1024) + lane;
#pragma unroll
                    for (int j = 0; j < 4; ++j) yv[r][k][j] = yr[64 * j]; } }
#pragma unroll
            for (int r = 0; r < 2; ++r) { const size_t mm = (size_t)(gw + (2 * it + r) * NGW);
#pragma unroll
                for (int j = 0; j < 4; ++j) v[r][j] = v[r][j] * DN_ALPHA;
#pragma unroll
                for (int k = 0; k < 4; ++k)
#pragma unroll
                    for (int j = 0; j < 4; ++j) { const unsigned long long w = yv[r][k][j]; const unsigned wl = (unsigned)w, wh = (unsigned)(w >> 32); const float g = gk[r][k];
                        v[r][j].x += g * pg8::bf_lo(wl); v[r][j].y += g * pg8::bf_hi(wl); v[r][j].z += g * pg8::bf_lo(wh); v[r][j].w += g * pg8::bf_hi(wh); }
                ln_row(v[r], y, ln_ffn_g, ln_ffn_b, lane);
                GAS f32x4* orow = (GAS f32x4*)(out + mm * DM) + lane;
#pragma unroll
                for (int j = 0; j < 4; ++j) orow[64 * j] = y[j]; } }
    }
    if (STAMP_K >= 0 && bx == 0 && tid == 0) { const unsigned long long t_end = __builtin_amdgcn_s_memrealtime(), dt = t_stamp_a - t_stamp_0; while (__builtin_amdgcn_s_memrealtime() - t_end < dt) __builtin_amdgcn_s_sleep(8); }
#undef IN
#undef INP
#undef WSB
#undef SEAM
#undef GROUPED_PREP
}

#ifndef MK_SPLIT
#define MK_SPLIT 0
#endif
extern "C" void kernel_launch(void* const* d_in, const int* in_sizes, int n_in, void* d_out, int out_size, void* d_ws, size_t ws_size, hipStream_t stream) {
    static int grid = 0;
    if (grid == 0) {
        if (n_in != 21 || in_sizes[0] != T_TOK * DM || out_size != T_TOK * DM || ws_size < WS_END) {
            fprintf(stderr, "kernel_launch: built for 21 inputs, x/out of %d floats, >= %zu bytes of workspace; got n_in %d, in0 %d, out %d, ws %zu; nothing launched\n", T_TOK * DM, (size_t)WS_END, n_in, n_in > 0 ? in_sizes[0] : -1, out_size, ws_size); grid = -1; return; }
        int dev = 0, cus = 0, per_cu = 0;
        if (hipGetDevice(&dev) != hipSuccess || hipDeviceGetAttribute(&cus, hipDeviceAttributeMultiprocessorCount, dev) != hipSuccess) { fprintf(stderr, "kernel_launch: device query failed\n"); grid = -1; return; }
        if (hipFuncSetAttribute((const void*)mega_fwd, hipFuncAttributeMaxDynamicSharedMemorySize, LDS_BYTES) != hipSuccess) { fprintf(stderr, "kernel_launch: hipFuncSetAttribute failed\n"); grid = -1; return; }
        if (hipOccupancyMaxActiveBlocksPerMultiprocessor(&per_cu, (const void*)mega_fwd, NTHR, LDS_BYTES) != hipSuccess || per_cu < 1) fprintf(stderr, "kernel_launch: occupancy query reports %d blocks per CU\n", per_cu);
        (void)hipGetLastError();
        grid = cus;
        if (grid != 256) { fprintf(stderr, "kernel_launch: this kernel's work split needs exactly 256 CUs, device has %d; nothing launched\n", grid); grid = -1; return; }
    }
    if (grid < 0) return;
    if (hipMemsetAsync((char*)d_ws + WS_CTL, 0, CTL_ZERO_BYTES, stream) != hipSuccess) { fprintf(stderr, "kernel_launch: hipMemsetAsync failed\n"); return; }
    Args a{};
    for (int i = 0; i < 21; ++i) a.in[i] = (const float*)d_in[i];
    a.out = (float*)d_out; a.ws = (unsigned char*)d_ws;
#if MK_SPLIT
    for (int p = 0; p < NPH; ++p) { a.ph_lo = p; a.ph_hi = p + 1; a.li = p; hipLaunchKernelGGL(mega_fwd, dim3(grid), dim3(NTHR), LDS_BYTES, stream, a); }
#else
    a.ph_lo = 0; a.ph_hi = NPH; a.li = 0;
    hipLaunchKernelGGL(mega_fwd, dim3(grid), dim3(NTHR), LDS_BYTES, stream, a);
#endif
    const hipError_t le = hipPeekAtLastError();
    if (le != hipSuccess) fprintf(stderr, "kernel_launch: launch failed: %s\n", hipGetErrorName(le));
}
```

```cpp
#define DUP_MASK 0
#include <hip/hip_runtime.h>
#include <hip/hip_bf16.h>
#include <cstdio>
#include <cstdint>
#include <cmath>
namespace pg8 {
#define PG8_LAS __attribute__((address_space(3)))
typedef unsigned short bf16_t;
typedef short bf16x8 __attribute__((ext_vector_type(8)));
typedef float f32x4 __attribute__((ext_vector_type(4)));
typedef unsigned u32x4 __attribute__((ext_vector_type(4)));
constexpr int BM = 256, BK = 64, HALF = 128, HTB = HALF * BK * 2  , STAGE_BYTES = 8 * HTB, NXCD = 8, WGM = 8;

__host__ __device__ __forceinline__ int lds_byte(int r, int c) { const int st = (r >> 4) * 2 + (c >> 5), rr = r & 15, cc = c & 31, ob = rr * 64 + cc * 2; return st * 1024 + (ob ^ (((ob >> 9) & 1) << 5)); }
__host__ __device__ __forceinline__ void stage_rc(int b, int& R, int& C) { const int st = b / 1024, sb = b % 1024, swz = sb ^ (((sb >> 9) & 1) << 5); R = (st >> 1) * 16 + swz / 64; C = (st & 1) * 32 + (swz % 64) / 2; }
__host__ __device__ __forceinline__ int perm32(int rho) { const int n = rho >> 4, i = rho & 15; return 8 * (i >> 2) + 4 * n + (i & 3); }

struct Unit { int pm, pn, ab, bb, aux; };
struct Gemm { const bf16_t* A; const bf16_t* Bt; int M, N, K; };

struct StaticOrder {
    int nM, nN, nwg, G, c;
    __host__ __device__ void init(int M, int N, int G_, int c_) { nM = M / BM; nN = N / BM; nwg = nM * nN; G = G_; c = c_; }
    __host__ __device__ bool next(int i, Unit& u) const {
        const long L = (long)i * G + c; if (L >= nwg) return false;
        int wgid = (int)L; { const int q = nwg / NXCD, r = nwg % NXCD, xcd = wgid % NXCD, off = wgid / NXCD; wgid = (xcd < r ? xcd * (q + 1) : r * (q + 1) + (xcd - r) * q) + off; }
        const int nig = WGM * nN, gid = wgid / nig, fm = gid * WGM, gsz = (nM - fm) < WGM ? (nM - fm) : WGM;
        u.pm = fm + ((wgid % nig) % gsz); u.pn = (wgid % nig) / gsz; u.ab = u.pm; u.bb = u.pn; u.aux = 0; return true;
    }
    __device__ __forceinline__ void a_ready(const Unit&) const {}
    __device__ __forceinline__ void done(const Unit&) const {}
    __device__ __forceinline__ const PG8_LAS int* rowidx(int) const { return nullptr; }
};

__device__ __forceinline__ unsigned cvt_pk_bf16(float lo, float hi) { unsigned r; asm volatile("v_cvt_pk_bf16_f32 %0, %1, %2" : "=v"(r) : "v"(lo), "v"(hi)); return r; }
typedef float f32x2 __attribute__((ext_vector_type(2)));
__device__ __forceinline__ f32x2 gelu_pk(f32x2 v) {
    const f32x2 av = __builtin_elementwise_abs(v), d = av * 0.2316418882f + 1.0f;
    f32x2 t; t.x = __builtin_amdgcn_rcpf(d.x); t.y = __builtin_amdgcn_rcpf(d.y);
    f32x2 q = t * 0.5307027145f + (-0.7265760135f); q = q * t + 0.7107068705f; q = q * t + (-0.142248368f); q = q * t + 0.127414796f; q = q * t;
    const f32x2 s = (v * v) * (-0.72134752044f);
    f32x2 e; e.x = __builtin_amdgcn_exp2f(s.x); e.y = __builtin_amdgcn_exp2f(s.y);
    const f32x2 m = v * (q * e), r = v - m;
    f32x2 o; o.x = v.x < 0.f ? m.x : r.x; o.y = v.y < 0.f ? m.y : r.y; return o;
}

template <int ACT  > struct EpiBf16 {
    static constexpr bool PERM = true, AFTER_DRAIN = false; static_assert(ACT == 0 || ACT == 1, "EpiBf16: ACT is 0 (none) or 1 (gelu_pk)");
    bf16_t* O; int ldc; const float* bias; int split_cols; size_t split_stride; float scale0;
    __device__ __forceinline__ void operator()(const f32x4 (&acc)[2][2][4][2], const Unit& u, int wr, int wc, int fr, int fq) const {
        const int row0 = u.pm * BM + wr * 64 + fr; int colt = u.pn * BM; bf16_t* base = O;
        float sc = 1.f; if (split_cols) { const int t = colt / split_cols; base += (size_t)t * split_stride; colt -= t * split_cols; if (t == 0) sc = scale0; }
        const int col0 = colt + wc * 32 + 8 * fq, bcol0 = u.pn * BM + wc * 32 + 8 * fq;
        f32x4 bv[2][2];
#pragma unroll
        for (int bj = 0; bj < 2; ++bj)
#pragma unroll
            for (int n = 0; n < 2; ++n) bv[bj][n] = bias ? *(const f32x4*)(bias + bcol0 + bj * HALF + 4 * n) : (f32x4){0.f, 0.f, 0.f, 0.f};
#pragma unroll
        for (int ai = 0; ai < 2; ++ai)
#pragma unroll
            for (int m = 0; m < 4; ++m) { bf16_t* rowp = base + (size_t)(row0 + ai * HALF + m * 16) * ldc + col0;
#pragma unroll
                for (int bj = 0; bj < 2; ++bj) { f32x4 v0 = acc[ai][bj][m][0] + bv[bj][0], v1 = acc[ai][bj][m][1] + bv[bj][1];
                    if (ACT == 1) { f32x2 a = gelu_pk((f32x2){v0[0], v0[1]}), b = gelu_pk((f32x2){v0[2], v0[3]}), c = gelu_pk((f32x2){v1[0], v1[1]}), d = gelu_pk((f32x2){v1[2], v1[3]});
                        v0 = (f32x4){a.x, a.y, b.x, b.y}; v1 = (f32x4){c.x, c.y, d.x, d.y}; }
                    v0 = v0 * sc; v1 = v1 * sc; u32x4 w; w.x = cvt_pk_bf16(v0[0], v0[1]); w.y = cvt_pk_bf16(v0[2], v0[3]); w.z = cvt_pk_bf16(v1[0], v1[1]); w.w = cvt_pk_bf16(v1[2], v1[3]);
                    *(u32x4*)(rowp + bj * HALF) = w; } }
    }
};

struct PanelStats {
    unsigned* xbuf;
    unsigned* cnt;
    unsigned* tmo;
    int ntn; float eps;
    unsigned code;
    __device__ __forceinline__ bool run(const f32x4 (&v)[2][2][4][2], const Unit& u, int wr, int wc, int fr, int fq, PG8_LAS unsigned char* lds, int wid, int lane) const {
        typedef float f32x2v __attribute__((ext_vector_type(2)));
        PG8_LAS f32x2v* P = (PG8_LAS f32x2v*)lds;
        PG8_LAS f32x2v* S = (PG8_LAS f32x2v*)(lds + 8192);
        PG8_LAS unsigned* flag = (PG8_LAS unsigned*)(lds + 8192 + 2048);
#pragma unroll
        for (int ai = 0; ai < 2; ++ai)
#pragma unroll
            for (int m = 0; m < 4; ++m) {
                float s = 0.f;
#pragma unroll
                for (int bj = 0; bj < 2; ++bj)
#pragma unroll
                    for (int n = 0; n < 2; ++n) { const f32x4 x = v[ai][bj][m][n]; s += (x[0] + x[1]) + (x[2] + x[3]); }
                s += __shfl_xor(s, 16); s += __shfl_xor(s, 32);
                const float mw = s * (1.0f / 64.0f); float q = 0.f;
#pragma unroll
                for (int bj = 0; bj < 2; ++bj)
#pragma unroll
                    for (int n = 0; n < 2; ++n) { const f32x4 d = v[ai][bj][m][n] - mw; q += (d[0] * d[0] + d[1] * d[1]) + (d[2] * d[2] + d[3] * d[3]); }
                q += __shfl_xor(q, 16); q += __shfl_xor(q, 32);
                if (fq == 0) P[(ai * HALF + wr * 64 + m * 16 + fr) * 4 + wc] = (f32x2v){mw, q};
            }
        asm volatile("s_waitcnt lgkmcnt(0)" ::: "memory"); __builtin_amdgcn_s_barrier(); asm volatile("" ::: "memory");
#if defined(BROKEN_EXCHANGE_NO_WAIT)
#warning BROKEN CONTROL BUILD: the row-statistics exchange does not wait; results are wrong by design
        if (blockIdx.x >= 64) { const long long t0_ = clock64(); while (clock64() - t0_ < 60000) __builtin_amdgcn_s_sleep(8); }
#endif
        const int row = wid * 32 + (lane & 31);
        if (lane < 32) {
            const f32x2v a = P[row * 4 + 0], b = P[row * 4 + 1], c = P[row * 4 + 2], d = P[row * 4 + 3];
            const float mt = (a.x + b.x + c.x + d.x) * 0.25f;
            const float da = a.x - mt, db = b.x - mt, dc = c.x - mt, dd = d.x - mt;
            const float m2 = (a.y + b.y) + (c.y + d.y) + 64.0f * ((da * da + db * db) + (dc * dc + dd * dd));
            unsigned long long* slot = (unsigned long long*)xbuf + ((size_t)(u.pm * BM + row) * 4 + u.pn);
            __hip_atomic_store(slot, ((unsigned long long)__float_as_uint(m2) << 32) | __float_as_uint(mt), __ATOMIC_RELAXED, __HIP_MEMORY_SCOPE_AGENT);
        }
        asm volatile("s_waitcnt vmcnt(0)" ::: "memory");
        if (lane == 0) __hip_atomic_fetch_add(cnt + 64 * u.pm, 1u, __ATOMIC_RELAXED, __HIP_MEMORY_SCOPE_AGENT);
        if (wid == 0) {
            bool dead = false; const unsigned long long t0 = __builtin_amdgcn_s_memrealtime(); const unsigned want = 8u * (unsigned)ntn;
            for (;;) {
#if defined(BROKEN_EXCHANGE_NO_WAIT)
                break;
#endif
                if ((unsigned)__builtin_amdgcn_readfirstlane(__hip_atomic_load(cnt + 64 * u.pm, __ATOMIC_RELAXED, __HIP_MEMORY_SCOPE_AGENT)) >= want) break;
                if (__builtin_amdgcn_s_memrealtime() - t0 > 2000000ull) {
                    if (lane == 0) { unsigned expect = 0u; __hip_atomic_compare_exchange_strong(tmo + 1, &expect, code | (unsigned)(u.pm & 0xff), __ATOMIC_RELAXED, __ATOMIC_RELAXED, __HIP_MEMORY_SCOPE_AGENT);
                                     __hip_atomic_store(tmo, 1u, __ATOMIC_RELAXED, __HIP_MEMORY_SCOPE_AGENT); }
                    dead = true; break; }
                __builtin_amdgcn_s_sleep(2);
            }
            __builtin_amdgcn_fence(__ATOMIC_ACQUIRE, "agent");
            if (lane == 0) flag[0] = dead ? 1u : 0u;
        }
        asm volatile("s_waitcnt vmcnt(0) lgkmcnt(0)" ::: "memory"); __builtin_amdgcn_s_barrier(); asm volatile("" ::: "memory");
        const bool bad = flag[0] != 0u;
        if (lane < 32) {
            const unsigned long long* slot = (const unsigned long long*)xbuf + (size_t)(u.pm * BM + row) * 4; float mt[4], m2[4]; float ms = 0.f;
#pragma unroll
            for (int t = 0; t < 4; ++t) { if (t < ntn) { const unsigned long long w = __hip_atomic_load(slot + t, __ATOMIC_RELAXED, __HIP_MEMORY_SCOPE_AGENT); mt[t] = __uint_as_float((unsigned)w); m2[t] = __uint_as_float((unsigned)(w >> 32)); } else { mt[t] = 0.f; m2[t] = 0.f; } ms += mt[t]; }
            const float mean = ms / (float)ntn; float q = 0.f;
#pragma unroll
            for (int t = 0; t < 4; ++t) if (t < ntn) { const float dm = mt[t] - mean; q += m2[t] + 256.0f * dm * dm; }
            S[row] = (f32x2v){mean, 1.0f / sqrtf(q / (256.0f * (float)ntn) + eps)};
        }
        asm volatile("s_waitcnt lgkmcnt(0)" ::: "memory"); __builtin_amdgcn_s_barrier(); asm volatile("" ::: "memory");
        return bad;
    }
};
struct EpiLnRes {
    static constexpr bool PERM = false, AFTER_DRAIN = true;
    const float* base; float* out; int ldc; const float* bias; PanelStats st; unsigned poison;
    __device__ __forceinline__ void fused(f32x4 (&acc)[2][2][4][2], const Unit& u, int wr, int wc, int fr, int fq, PG8_LAS unsigned char* lds, int wid, int lane) const {
        typedef float f32x2v __attribute__((ext_vector_type(2)));
        const PG8_LAS f32x2v* S = (const PG8_LAS f32x2v*)(lds + 8192);
        const int col0 = u.pn * BM + wc * 32 + 4 * fq;
#pragma unroll
        for (int bj = 0; bj < 2; ++bj)
#pragma unroll
            for (int n = 0; n < 2; ++n) { const f32x4 bv = bias ? *(const f32x4*)(bias + col0 + bj * HALF + n * 16) : (f32x4){0.f, 0.f, 0.f, 0.f};
#pragma unroll
                for (int ai = 0; ai < 2; ++ai)
#pragma unroll
                    for (int m = 0; m < 4; ++m) acc[ai][bj][m][n] += bv; }
        f32x4 pre[4][2][2];
#pragma unroll
        for (int m = 0; m < 4; ++m) { const size_t off = (size_t)(u.pm * BM + wr * 64 + m * 16 + fr) * ldc + col0;
#pragma unroll
            for (int bj = 0; bj < 2; ++bj)
#pragma unroll
                for (int n = 0; n < 2; ++n) pre[m][bj][n] = *(const f32x4*)(base + off + bj * HALF + n * 16); }
        const bool bad = st.run(acc, u, wr, wc, fr, fq, lds, wid, lane) || poison != 0u;
        const float qnan = __builtin_nanf("");
#pragma unroll
        for (int ai = 0; ai < 2; ++ai)
#pragma unroll
            for (int m = 0; m < 4; ++m) { const int r = ai * HALF + wr * 64 + m * 16 + fr; const f32x2v sr = S[r]; const size_t off = (size_t)(u.pm * BM + r) * ldc + col0;
#pragma unroll
                for (int bj = 0; bj < 2; ++bj)
#pragma unroll
                    for (int n = 0; n < 2; ++n) { const f32x4 bs = ai == 0 ? pre[m][bj][n] : *(const f32x4*)(base + off + bj * HALF + n * 16); f32x4 o = bs + (acc[ai][bj][m][n] - sr.x) * sr.y;
                        if (bad) o = (f32x4){qnan, qnan, qnan, qnan}; *(f32x4*)(out + off + bj * HALF + n * 16) = o; }
                if (m & 1) asm volatile("" ::: "memory"); }
    }
};
struct EpiLnResLn {
    static constexpr bool PERM = false, AFTER_DRAIN = true;
    const float* base; float* out; bf16_t* xn; int ldc; const float* bias; PanelStats st1, st2; unsigned poison;
    __device__ __forceinline__ void fused(f32x4 (&acc)[2][2][4][2], const Unit& u, int wr, int wc, int fr, int fq, PG8_LAS unsigned char* lds, int wid, int lane) const {
        typedef float f32x2v __attribute__((ext_vector_type(2))); typedef unsigned u32x2v __attribute__((ext_vector_type(2)));
        const PG8_LAS f32x2v* S = (const PG8_LAS f32x2v*)(lds + 8192);
        const int col0 = u.pn * BM + wc * 32 + 4 * fq;
#pragma unroll
        for (int bj = 0; bj < 2; ++bj)
#pragma unroll
            for (int n = 0; n < 2; ++n) { const f32x4 bv = bias ? *(const f32x4*)(bias + col0 + bj * HALF + n * 16) : (f32x4){0.f, 0.f, 0.f, 0.f};
#pragma unroll
                for (int ai = 0; ai < 2; ++ai)
#pragma unroll
                    for (int m = 0; m < 4; ++m) acc[ai][bj][m][n] += bv; }
        bool bad = st1.run(acc, u, wr, wc, fr, fq, lds, wid, lane) || poison != 0u;
        const float qnan = __builtin_nanf("");
#pragma unroll
        for (int ai = 0; ai < 2; ++ai)
#pragma unroll
            for (int m = 0; m < 4; ++m) { const int r = ai * HALF + wr * 64 + m * 16 + fr; const f32x2v sr = S[r]; const size_t off = (size_t)(u.pm * BM + r) * ldc + col0;
#pragma unroll
                for (int bj = 0; bj < 2; ++bj)
#pragma unroll
                    for (int n = 0; n < 2; ++n) { const f32x4 bs = *(const f32x4*)(base + off + bj * HALF + n * 16); acc[ai][bj][m][n] = bs + (acc[ai][bj][m][n] - sr.x) * sr.y; }
                asm volatile("" : "+v"(acc[ai][0][m][0]), "+v"(acc[ai][0][m][1]), "+v"(acc[ai][1][m][0]), "+v"(acc[ai][1][m][1]));
                if (m & 1) asm volatile("" ::: "memory"); }
        const bool bad1 = bad;
        bad = st2.run(acc, u, wr, wc, fr, fq, lds, wid, lane) || bad;
#pragma unroll
        for (int ai = 0; ai < 2; ++ai)
#pragma unroll
            for (int m = 0; m < 4; ++m) { const int r = ai * HALF + wr * 64 + m * 16 + fr; const f32x2v sr = S[r]; const size_t off = (size_t)(u.pm * BM + r) * ldc + col0;
#pragma unroll
                for (int bj = 0; bj < 2; ++bj)
#pragma unroll
                    for (int n = 0; n < 2; ++n) { const f32x4 x1 = acc[ai][bj][m][n]; *(f32x4*)(out + off + bj * HALF + n * 16) = bad1 ? (f32x4){qnan, qnan, qnan, qnan} : x1;
                        const f32x4 o = (x1 - sr.x) * sr.y; u32x2v w; w.x = cvt_pk_bf16(o[0], o[1]); w.y = cvt_pk_bf16(o[2], o[3]);
                        if (bad) { w.x = 0x7fc07fc0u; w.y = 0x7fc07fc0u; } *(u32x2v*)(xn + off + bj * HALF + n * 16) = w; }
                asm volatile("" ::: "memory"); }
    }
};

template <class E, class = void> struct epi_chains { static constexpr bool value = false; };
template <class E> struct epi_chains<E, decltype((void)E::CHAIN)> { static constexpr bool value = E::CHAIN; };
template <class Epi, class Sched, bool ALIGN_EPI = false, bool SP2 = false, bool GATHER = false>
__device__ __forceinline__ void gemm_phase(PG8_LAS unsigned char* lds, const Gemm g, const Sched& S, const Epi& E) {
    const int tid = threadIdx.x, wid = __builtin_amdgcn_readfirstlane(tid >> 6), lane = tid & 63, wr = wid >> 2, wc = wid & 3, fr = lane & 15, fq = lane >> 4;
    const int K = g.K, nt = K / BK;
    unsigned voffA[2], voffB[2]; int gR[2], gC[2];
#pragma unroll
    for (int i = 0; i < 2; ++i) { int R, C; stage_rc(tid * 16 + i * 8192, R, C); const int Rb = Epi::PERM ? ((R & ~31) + perm32(R & 31)) : R;
        voffA[i] = (unsigned)(R * K + C) * 2u; voffB[i] = (unsigned)(Rb * K + C) * 2u; gR[i] = R; gC[i] = C; }
    const size_t kstep = (size_t)(BK * 2);
    const size_t hstep = (size_t)HALF * K * 2;
    const size_t tstep = 2 * hstep;
    const unsigned ldsw = (unsigned)wid * 1024u;
    const int aoff = lds_byte(wr * 64 + fr, fq * 8), boff = lds_byte(wc * 32 + fr, fq * 8);
#define PG8_SA(b, h) (((b) * 2 + (h)) * HTB)
#define PG8_SB(b, h) ((4 + (b) * 2 + (h)) * HTB)
#define PG8_STAGE(bufoff, gbase, voff) do { _Pragma("unroll") for (int _i = 0; _i < 2; ++_i) \
        __builtin_amdgcn_global_load_lds((const unsigned*)((const char*)(gbase) + (voff)[_i]), (PG8_LAS unsigned*)(lds + (bufoff) + ldsw + _i * 8192), 16, 0, 0); } while (0)
#define PG8_STAGE_A(bufoff, gbase, h, nx) do { const unsigned _v0 = GATHER ? ((nx) ? vaN[h][0] : vaC[h][0]) : voffA[0], _v1 = GATHER ? ((nx) ? vaN[h][1] : vaC[h][1]) : voffA[1]; \
        const char* _gb = (const char*)(gbase) + (GATHER ? (size_t)0 : (size_t)(h) * hstep); \
        __builtin_amdgcn_global_load_lds((const unsigned*)(_gb + _v0), (PG8_LAS unsigned*)(lds + (bufoff) + ldsw), 16, 0, 0); \
        __builtin_amdgcn_global_load_lds((const unsigned*)(_gb + _v1), (PG8_LAS unsigned*)(lds + (bufoff) + ldsw + 8192), 16, 0, 0); } while (0)
#define PG8_LOADVA(va, uix) do { const PG8_LAS int* _ip = S.rowidx(uix); _Pragma("unroll") for (int _h = 0; _h < 2; ++_h) _Pragma("unroll") for (int _i = 0; _i < 2; ++_i) \
        va[_h][_i] = ((unsigned)_ip[_h * HALF + gR[_i]] * (unsigned)K + (unsigned)gC[_i]) * 2u; } while (0)
#define PG8_LDA(dst, b, h) do { _Pragma("unroll") for (int m = 0; m < 4; ++m) _Pragma("unroll") for (int k = 0; k < 2; ++k) dst[m][k] = *(const PG8_LAS bf16x8*)(lds + PG8_SA(b, h) + aoff + m * 2048 + k * 1024); } while (0)
#define PG8_LDB(dst, b, h) do { _Pragma("unroll") for (int n = 0; n < 2; ++n) _Pragma("unroll") for (int k = 0; k < 2; ++k) dst[n][k] = *(const PG8_LAS bf16x8*)(lds + PG8_SB(b, h) + boff + n * 2048 + k * 1024); } while (0)
#define PG8_MMA(ai, bj, At, Bt) do { __builtin_amdgcn_s_setprio(1); _Pragma("unroll") for (int m = 0; m < 4; ++m) _Pragma("unroll") for (int n = 0; n < 2; ++n) _Pragma("unroll") for (int k = 0; k < 2; ++k) \
        acc[ai][bj][m][n] = __builtin_amdgcn_mfma_f32_16x16x32_bf16(Bt[n][k], At[m][k], acc[ai][bj][m][n], 0, 0, 0); __builtin_amdgcn_s_setprio(0); } while (0)
#define PG8_WAIT_V(n) asm volatile("s_waitcnt vmcnt(" #n ")" ::: "memory")
#define PG8_WAIT_L(n) asm volatile("s_waitcnt lgkmcnt(" #n ")" ::: "memory")
#define PG8_BAR __builtin_amdgcn_s_barrier()
#define PG8_SCHED __builtin_amdgcn_sched_barrier(0)
    Unit cur, nxt; int ui = 0;
    static_assert(SP2, "only the SP2 loop is kept in this file");
    if (!S.next(0, cur)) return;
    f32x4 acc[2][2][4][2];
#pragma unroll
    for (int a = 0; a < 2; ++a)
#pragma unroll
        for (int b = 0; b < 2; ++b)
#pragma unroll
            for (int m = 0; m < 4; ++m)
#pragma unroll
                for (int n = 0; n < 2; ++n) acc[a][b][m][n] = (f32x4){0.f, 0.f, 0.f, 0.f};
    bf16x8 At[4][2], B0[2][2], B1[2][2];
    const char* cA = (const char*)g.A + (GATHER ? (size_t)0 : (size_t)cur.ab * tstep); const char* cB = (const char*)g.Bt + (size_t)cur.bb * tstep;
    unsigned vaC[2][2] = {{0u, 0u}, {0u, 0u}}, vaN[2][2] = {{0u, 0u}, {0u, 0u}};
    if constexpr (GATHER) { PG8_LOADVA(vaC, 0); }
    S.a_ready(cur);
    if constexpr (SP2) {
        PG8_STAGE(PG8_SB(0, 0), cB, voffB); PG8_STAGE(PG8_SB(0, 1), cB + hstep, voffB); PG8_STAGE_A(PG8_SA(0, 0), cA, 0, false); PG8_STAGE_A(PG8_SA(0, 1), cA, 1, false);
        if (wr == 1) PG8_BAR;
        PG8_WAIT_V(2); PG8_BAR;
        PG8_STAGE(PG8_SB(1, 0), cB + kstep, voffB); PG8_STAGE_A(PG8_SA(1, 0), cA + kstep, 0, false); PG8_STAGE(PG8_SB(1, 1), cB + hstep + kstep, voffB);
        PG8_WAIT_V(6); PG8_BAR;
    }
    for (;;) {
        const bool has_next = S.next(ui + 1, nxt);
        const char* nA = (has_next && !GATHER) ? (const char*)g.A + (size_t)nxt.ab * tstep : cA; const char* nB = has_next ? (const char*)g.Bt + (size_t)nxt.bb * tstep : cB;
        if constexpr (GATHER) { if (has_next) { PG8_LOADVA(vaN, ui + 1); } else { vaN[0][0] = vaC[0][0]; vaN[0][1] = vaC[0][1]; vaN[1][0] = vaC[1][0]; vaN[1][1] = vaC[1][1]; } }
        for (int t = 0; t < nt; t += 2) {
            const bool last = (t == nt - 2);
            const char* a1 = cA + (size_t)(t + 1) * kstep;
            const char* a2 = last ? nA : cA + (size_t)(t + 2) * kstep; const char* b2 = last ? nB : cB + (size_t)(t + 2) * kstep;
            const char* a3 = a2 + kstep; const char* b3 = b2 + kstep;
            if (last && has_next) S.a_ready(nxt);
            if constexpr (SP2) {
            PG8_LDB(B0, 0, 0); PG8_LDB(B1, 0, 1); PG8_SCHED; PG8_LDA(At, 0, 0); PG8_STAGE_A(PG8_SA(1, 1), a1, 1, false);
            PG8_WAIT_V(8); PG8_WAIT_L(0); PG8_BAR; PG8_MMA(0, 0, At, B0); PG8_MMA(0, 1, At, B1); PG8_BAR; PG8_SCHED;
            PG8_LDA(At, 0, 1); PG8_STAGE(PG8_SB(0, 0), b2, voffB); PG8_STAGE(PG8_SB(0, 1), b2 + hstep, voffB); PG8_STAGE_A(PG8_SA(0, 0), a2, 0, last);
            PG8_WAIT_V(8); PG8_WAIT_L(0); PG8_BAR; PG8_MMA(1, 0, At, B0); PG8_MMA(1, 1, At, B1); PG8_BAR; PG8_SCHED;
            PG8_LDB(B0, 1, 0); PG8_LDB(B1, 1, 1); PG8_SCHED; PG8_LDA(At, 1, 0); PG8_STAGE_A(PG8_SA(0, 1), a2, 1, last);
            PG8_WAIT_V(8); PG8_WAIT_L(0); PG8_BAR; PG8_MMA(0, 0, At, B0); PG8_MMA(0, 1, At, B1); PG8_BAR; PG8_SCHED;
            PG8_LDA(At, 1, 1); PG8_STAGE(PG8_SB(1, 0), b3, voffB); PG8_STAGE(PG8_SB(1, 1), b3 + hstep, voffB); PG8_STAGE_A(PG8_SA(1, 0), a3, 0, last);
            PG8_WAIT_V(8); PG8_WAIT_L(0); PG8_BAR; PG8_MMA(1, 0, At, B0); PG8_MMA(1, 1, At, B1); PG8_BAR; PG8_SCHED;
            }
        }
        if constexpr (ALIGN_EPI) { if (wr == 0) PG8_BAR; }
        if constexpr (!Epi::AFTER_DRAIN) { E(acc, cur, wr, wc, fr, fq); S.done(cur); }
        if (!has_next) break;
        if (!epi_chains<Epi>::value || cur.aux != 0) {
#pragma unroll
        for (int a = 0; a < 2; ++a)
#pragma unroll
            for (int b = 0; b < 2; ++b)
#pragma unroll
                for (int m = 0; m < 4; ++m)
#pragma unroll
                    for (int n = 0; n < 2; ++n) acc[a][b][m][n] = (f32x4){0.f, 0.f, 0.f, 0.f};
        }
        cur = nxt; cA = nA; cB = nB; ++ui;
        if constexpr (GATHER) { vaC[0][0] = vaN[0][0]; vaC[0][1] = vaN[0][1]; vaC[1][0] = vaN[1][0]; vaC[1][1] = vaN[1][1]; }
        if constexpr (ALIGN_EPI) { if (wr == 1) PG8_BAR; }
    }
    PG8_WAIT_V(0);
    if constexpr (!ALIGN_EPI) { if (wr == 0) PG8_BAR; }
    PG8_BAR;
    if constexpr (Epi::AFTER_DRAIN) { E.fused(acc, cur, wr, wc, fr, fq, lds, wid, lane); S.done(cur); }
#undef PG8_SA
#undef PG8_SB
#undef PG8_STAGE
#undef PG8_STAGE_A
#undef PG8_LOADVA
#undef PG8_LDA
#undef PG8_LDB
#undef PG8_MMA
#undef PG8_WAIT_V
#undef PG8_WAIT_L
#undef PG8_BAR
#undef PG8_SCHED
}
}
namespace pg8 {
__device__ __forceinline__ float bf_lo(unsigned w) { return __uint_as_float(w << 16); }
__device__ __forceinline__ float bf_hi(unsigned w) { return __uint_as_float(w & 0xffff0000u); }
__device__ __forceinline__ float sigm(float x) { return __builtin_amdgcn_rcpf(1.0f + __expf(-x)); }

struct EpiF32 {
    static constexpr bool PERM = false, AFTER_DRAIN = false;
    float* C; int ldc;
    __device__ __forceinline__ void operator()(const f32x4 (&acc)[2][2][4][2], const Unit& u, int wr, int wc, int fr, int fq) const {
        const int row0 = u.pm * BM + wr * 64 + fr, col0 = u.pn * BM + wc * 32 + 4 * fq;
#pragma unroll
        for (int ai = 0; ai < 2; ++ai)
#pragma unroll
            for (int m = 0; m < 4; ++m) { float* rowp = C + (size_t)(row0 + ai * HALF + m * 16) * ldc + col0;
#pragma unroll
                for (int bj = 0; bj < 2; ++bj)
#pragma unroll
                    for (int n = 0; n < 2; ++n) *(f32x4*)(rowp + bj * HALF + n * 16) = acc[ai][bj][m][n]; }
    }
};

struct EpiProj {
    static constexpr bool PERM = true, AFTER_DRAIN = false;
    bf16_t* O; float* SMp; bf16_t* QKV; bf16_t* ZIMG;
    __device__ __forceinline__ void operator()(const f32x4 (&acc)[2][2][4][2], const Unit& u, int wr, int wc, int fr, int fq) const {
        const int row0 = u.pm * BM + wr * 64 + fr;
        if (u.pn >= 12 && u.pn < 24) {
            const int which = (u.pn - 12) >> 2, hp = (u.pn - 12) & 3; bf16_t* base = QKV + (size_t)which * (32u * 4096u * 128u) + wc * 32 + 8 * fq;
#pragma unroll
            for (int ai = 0; ai < 2; ++ai)
#pragma unroll
                for (int m = 0; m < 4; ++m) { const int row = row0 + ai * HALF + m * 16; const int b = row >> 12, s = row & 4095;
#pragma unroll
                    for (int bj = 0; bj < 2; ++bj) { const f32x4 v0 = acc[ai][bj][m][0], v1 = acc[ai][bj][m][1];
                        u32x4 w; w.x = cvt_pk_bf16(v0[0], v0[1]); w.y = cvt_pk_bf16(v0[2], v0[3]); w.z = cvt_pk_bf16(v1[0], v1[1]); w.w = cvt_pk_bf16(v1[2], v1[3]);
                        *(u32x4*)(base + ((size_t)(b * 8 + 2 * hp + bj) * 4096 + s) * 128) = w; } }
        } else if (u.pn >= 24 && u.pn < 32) {
            bf16_t* zb = ZIMG + ((size_t)((u.pm * 4 + (u.pn & 3)) * 2 + ((u.pn - 24) >> 2)) * 16 * 512 + (wr * 4 + wc) * 64 + (fq * 16 + fr)) * 8;
#pragma unroll
            for (int ai = 0; ai < 2; ++ai)
#pragma unroll
                for (int m = 0; m < 4; ++m)
#pragma unroll
                    for (int bj = 0; bj < 2; ++bj) { const f32x4 v0 = acc[ai][bj][m][0], v1 = acc[ai][bj][m][1];
                        u32x4 w; w.x = cvt_pk_bf16(v0[0], v0[1]); w.y = cvt_pk_bf16(v0[2], v0[3]); w.z = cvt_pk_bf16(v1[0], v1[1]); w.w = cvt_pk_bf16(v1[2], v1[3]);
                        *(u32x4*)(zb + (size_t)((ai * 4 + m) * 2 + bj) * 512 * 8) = w; }
        } else if (u.pn < 12) {
            const int col0 = u.pn * BM + wc * 32 + 8 * fq;
#pragma unroll
            for (int ai = 0; ai < 2; ++ai)
#pragma unroll
                for (int m = 0; m < 4; ++m) { bf16_t* rowp = O + (size_t)(row0 + ai * HALF + m * 16) * 3072 + col0;
#pragma unroll
                    for (int bj = 0; bj < 2; ++bj) { const f32x4 v0 = acc[ai][bj][m][0], v1 = acc[ai][bj][m][1];
                        u32x4 w; w.x = cvt_pk_bf16(v0[0], v0[1]); w.y = cvt_pk_bf16(v0[2], v0[3]); w.z = cvt_pk_bf16(v1[0], v1[1]); w.w = cvt_pk_bf16(v1[2], v1[3]);
                        *(u32x4*)(rowp + bj * HALF) = w; } }
        } else if (wc == 0) {
#pragma unroll
            for (int ai = 0; ai < 2; ++ai)
#pragma unroll
                for (int m = 0; m < 4; ++m) { float* rp = SMp + (size_t)(row0 + ai * HALF + m * 16) * 32 + 8 * fq;
                    *(f32x4*)rp = acc[ai][0][m][0]; *(f32x4*)(rp + 4) = acc[ai][0][m][1]; }
        }
    }
};

struct EpiMix {
    static constexpr bool PERM = true, AFTER_DRAIN = false, CHAIN = true;
    const bf16_t* ZIMG; bf16_t* MIX;
    __device__ __forceinline__ void operator()(f32x4 (&acc)[2][2][4][2], const Unit& u, int wr, int wc, int fr, int fq) const {
        const int row0 = u.pm * BM + wr * 64 + fr, col0 = u.pn * BM + wc * 32 + 8 * fq; const int kind = u.aux;
        const bf16_t* zimg = ZIMG + ((size_t)((u.pm * 4 + u.pn) * 2) * 16 * 512 + (wr * 4 + wc) * 64 + (fq * 16 + fr)) * 8;
#pragma unroll
        for (int ai = 0; ai < 2; ++ai) {
            u32x4 zf[4][2], zg[4][2];
#pragma unroll
            for (int m = 0; m < 4; ++m)
#pragma unroll
                for (int bj = 0; bj < 2; ++bj) { const bf16_t* zp = zimg + (size_t)((ai * 4 + m) * 2 + bj) * 512 * 8;
                    zf[m][bj] = *(const u32x4*)(zp + 16 * 512 * 8); if (kind == 0) zg[m][bj] = *(const u32x4*)zp; }
#pragma unroll
            for (int m = 0; m < 4; ++m)
#pragma unroll
                for (int bj = 0; bj < 2; ++bj) {
                    const u32x4 a = zf[m][bj]; float ef[8] = {bf_lo(a.x), bf_hi(a.x), bf_lo(a.y), bf_hi(a.y), bf_lo(a.z), bf_hi(a.z), bf_lo(a.w), bf_hi(a.w)};
#pragma unroll
                    for (int j = 0; j < 8; ++j) ef[j] = 1.0f + __expf(-ef[j]);
                    if (kind == 0) {
                        const u32x4 g = zg[m][bj]; float eg[8] = {bf_lo(g.x), bf_hi(g.x), bf_lo(g.y), bf_hi(g.y), bf_lo(g.z), bf_hi(g.z), bf_lo(g.w), bf_hi(g.w)};
#pragma unroll
                        for (int j = 0; j < 8; ++j) { const float r = ef[j] * __builtin_amdgcn_rcpf(1.0f + __expf(-eg[j])); if (j < 4) acc[ai][bj][m][0][j] *= r; else acc[ai][bj][m][1][j - 4] *= r; }
                    } else {
                        float o[8];
#pragma unroll
                        for (int j = 0; j < 8; ++j) o[j] = (j < 4 ? acc[ai][bj][m][0][j] : acc[ai][bj][m][1][j - 4]) * __builtin_amdgcn_rcpf(ef[j]);
                        u32x4 w; w.x = cvt_pk_bf16(o[0], o[1]); w.y = cvt_pk_bf16(o[2], o[3]); w.z = cvt_pk_bf16(o[4], o[5]); w.w = cvt_pk_bf16(o[6], o[7]);
                        *(u32x4*)(MIX + (size_t)(row0 + ai * HALF + m * 16) * 1024 + col0 + bj * HALF) = w; } }
        }
    }
};

struct EpiAct {
    static constexpr bool PERM = true, AFTER_DRAIN = false;
    bf16_t* ACT; const float* bgu;
    __device__ __forceinline__ void operator()(const f32x4 (&acc)[2][2][4][2], const Unit& u, int wr, int wc, int fr, int fq) const {
        const int e = u.aux, c0 = wc * 32 + 8 * fq; const float* bg = bgu + (size_t)e * 2048 + u.pn * 128 + c0; const float* bu = bg + 1024;
        const f32x4 bg0 = *(const f32x4*)bg, bg1 = *(const f32x4*)(bg + 4), bu0 = *(const f32x4*)bu, bu1 = *(const f32x4*)(bu + 4);
#pragma unroll
        for (int ai = 0; ai < 2; ++ai)
#pragma unroll
            for (int m = 0; m < 4; ++m) { const size_t row = (size_t)u.ab * BM + ai * HALF + m * 16 + wr * 64 + fr;
                const f32x4 g0 = acc[ai][0][m][0] + bg0, g1 = acc[ai][0][m][1] + bg1, p0 = acc[ai][1][m][0] + bu0, p1 = acc[ai][1][m][1] + bu1;
                float o[8];
#pragma unroll
                for (int j = 0; j < 8; ++j) { const float gv = j < 4 ? g0[j & 3] : g1[j & 3], uv = j < 4 ? p0[j & 3] : p1[j & 3];
                    const float gate = fminf(gv, 7.0f), up = fminf(fmaxf(uv, -7.0f), 7.0f); o[j] = (up + 1.0f) * (gate * sigm(1.702f * gate)); }
                u32x4 w; w.x = cvt_pk_bf16(o[0], o[1]); w.y = cvt_pk_bf16(o[2], o[3]); w.z = cvt_pk_bf16(o[4], o[5]); w.w = cvt_pk_bf16(o[6], o[7]);
                *(u32x4*)(ACT + row * 1024 + u.pn * 128 + c0) = w; }
    }
};

struct EpiDown {
    static constexpr bool PERM = true, AFTER_DRAIN = false;
    bf16_t* YS; const float* bd;
    __device__ __forceinline__ void operator()(const f32x4 (&acc)[2][2][4][2], const Unit& u, int wr, int wc, int fr, int fq) const {
        const int e = u.aux, col0 = u.pn * BM + wc * 32 + 8 * fq;
        f32x4 bv[2][2];
#pragma unroll
        for (int bj = 0; bj < 2; ++bj)
#pragma unroll
            for (int n = 0; n < 2; ++n) bv[bj][n] = *(const f32x4*)(bd + (size_t)e * 1024 + col0 + bj * HALF + 4 * n);
#pragma unroll
        for (int ai = 0; ai < 2; ++ai)
#pragma unroll
            for (int m = 0; m < 4; ++m) { bf16_t* rowp = YS + ((size_t)u.ab * BM + ai * HALF + m * 16 + wr * 64 + fr) * 1024 + col0;
#pragma unroll
                for (int bj = 0; bj < 2; ++bj) { const f32x4 v0 = acc[ai][bj][m][0] + bv[bj][0], v1 = acc[ai][bj][m][1] + bv[bj][1];
                    u32x4 w; w.x = cvt_pk_bf16(v0[0], v0[1]); w.y = cvt_pk_bf16(v0[2], v0[3]); w.z = cvt_pk_bf16(v1[0], v1[1]); w.w = cvt_pk_bf16(v1[2], v1[3]);
                    *(u32x4*)(rowp + bj * HALF) = w; } }
    }
};

struct MixOrder {
    StaticOrder so;
    __device__ void init(int M, int N, int G_, int c_) { so.init(M, N, G_, c_); }
    __device__ __forceinline__ bool next(int i, Unit& u) const { if (!so.next(i >> 1, u)) return false; const int kind = i & 1; u.aux = kind; u.ab = kind * (so.nM) + u.pm; u.bb = kind * (so.nN) + u.pn; return true; }
    __device__ __forceinline__ void a_ready(const Unit&) const {}
    __device__ __forceinline__ void done(const Unit&) const {}
    __device__ __forceinline__ const PG8_LAS int* rowidx(int) const { return nullptr; }
};
constexpr int MAXU = 12;
struct GroupedOrder {
    const PG8_LAS int* desc; const PG8_LAS int* idx;
    __device__ __forceinline__ bool next(int i, Unit& u) const {
        if (i >= MAXU) return false; const PG8_LAS int* d = desc + i * 8;
        if (__builtin_amdgcn_readfirstlane(d[0]) == 0) return false;
        u.ab = __builtin_amdgcn_readfirstlane(d[1]); u.bb = __builtin_amdgcn_readfirstlane(d[2]); u.pn = __builtin_amdgcn_readfirstlane(d[3]); u.aux = __builtin_amdgcn_readfirstlane(d[4]); u.pm = u.ab; return true; }
    __device__ __forceinline__ void a_ready(const Unit&) const {}
    __device__ __forceinline__ void done(const Unit&) const {}
    __device__ __forceinline__ const PG8_LAS int* rowidx(int i) const { return idx + i * 256; }
};
}
namespace fox {
constexpr int D = 128, PKV = 128  , PO = 1024  ;
constexpr float THR = 8.f; constexpr bool WSKIP = false;
constexpr float SCALE = 0.08838834764831845f;
constexpr int NW = 8, QBLK = 32, KVBLK = 64, QB = NW * QBLK;
constexpr int SHM_V = KVBLK * D * 2, SHM_K = KVBLK * D * 2;
constexpr int LDS_BIAS = 2 * SHM_V + 2 * SHM_K + NW * 64 * 4;
constexpr int LDS_JUNK = LDS_BIAS + 2 * 4096 * 4;
constexpr int LDS_BYTES = LDS_JUNK + 256;

using bf16 = __hip_bfloat16;
typedef short bf16x8 __attribute__((ext_vector_type(8)));
typedef short s16x4 __attribute__((ext_vector_type(4)));
typedef float f32x16 __attribute__((ext_vector_type(16)));
typedef float f32x4 __attribute__((ext_vector_type(4)));
typedef unsigned u32x4 __attribute__((ext_vector_type(4)));
template <class A, class Bt> struct same_t { static constexpr bool v = false; };
template <class A> struct same_t<A, A> { static constexpr bool v = true; };

#define KSWZ(row, colB) ((row) * 256 + ((colB) ^ (((row) & 7) << 4)))
#define SBAR() __builtin_amdgcn_sched_barrier(0)
__device__ __forceinline__ int v_st(int k, int c) { const int kk = (k & ~0xC) | ((k & 4) << 1) | ((k & 8) >> 1); return ((kk >> 3) * 4 + (c >> 5)) * 512 + ((kk & 7) * 32 + (c & 31)) * 2; }
__device__ __forceinline__ int v_rd_base(int lane) { return ((lane & 3) << 3) | (((lane >> 2) & 3) << 6) | (((lane >> 4) & 1) << 5) | (((lane >> 5) & 1) << 8); }
constexpr int v_rd_off(int d0, int ks, int half) { return d0 * 512 + ks * 4096 + half * 2048; }
__device__ __forceinline__ int crow(int r, int hi) { return (r & 3) + 8 * (r >> 2) + 4 * hi; }
__device__ __forceinline__ unsigned cvtpk(float lo, float hi) {
    unsigned r; asm volatile("v_cvt_pk_bf16_f32 %0, %1, %2" : "=v"(r) : "v"(lo), "v"(hi)); return r;
}
__device__ __forceinline__ bf16x8 pack8(f32x4 a, f32x4 b) {
    u32x4 w = {cvtpk(a[0], a[1]), cvtpk(a[2], a[3]), cvtpk(b[0], b[1]), cvtpk(b[2], b[3])};
    return *reinterpret_cast<bf16x8*>(&w);
}
template <class T> __device__ __forceinline__ bf16x8 load8(const T* p) {
    if constexpr (same_t<T, float>::v) { return pack8(*(const f32x4*)p, *(const f32x4*)(p + 4)); }
    else { return *reinterpret_cast<const bf16x8*>(p); }
}
__device__ __forceinline__ void mask_tile(f32x16& p0, f32x16& p1, int dq, unsigned W) {
    const float NEG = -__builtin_inff();
#pragma unroll
    for (int r = 0; r < 16; ++r) {
        const int c = (r & 3) + 8 * (r >> 2);
        if ((unsigned)(dq - c) >= W) p0[r] = NEG;
        if ((unsigned)(dq - c - 32) >= W) p1[r] = NEG;
    }
}
__device__ __forceinline__ void partialSM(f32x16& p0, f32x16& p1, float& m_reg, float& mn, float& alpha) {
    float pmax = p0[0]; for (int r = 1; r < 16; ++r) pmax = fmaxf(pmax, p0[r]); for (int r = 0; r < 16; ++r) pmax = fmaxf(pmax, p1[r]);
    { auto rr = __builtin_amdgcn_permlane32_swap(__float_as_uint(pmax), __float_as_uint(pmax), false, false);
      pmax = fmaxf(__uint_as_float(rr[0]), __uint_as_float(rr[1])); }
    constexpr float C2 = 1.4426950408889634f * SCALE;
    if (__builtin_expect(__all((pmax - m_reg) * SCALE <= THR), 1)) { mn = m_reg; alpha = 1.f; }
    else { mn = fmaxf(m_reg, pmax); alpha = __builtin_amdgcn_exp2f((m_reg - mn) * C2); m_reg = mn; }
    const float mnL = -mn * C2;
    for (int r = 0; r < 16; ++r) p0[r] = fmaf(p0[r], C2, mnL); for (int r = 0; r < 16; ++r) p1[r] = fmaf(p1[r], C2, mnL);
    for (int r = 0; r < 16; ++r) p0[r] = __builtin_amdgcn_exp2f(p0[r]);
}
__device__ __forceinline__ void finishSM(f32x16& p0, f32x16& p1, float alpha, float& l_reg, bf16x8& pa0, bf16x8& pa1, bf16x8& pa2, bf16x8& pa3) {
    for (int r = 0; r < 16; ++r) p1[r] = __builtin_amdgcn_exp2f(p1[r]);
    float ps = 0; for (int r = 0; r < 16; ++r) ps += p0[r]; for (int r = 0; r < 16; ++r) ps += p1[r];
    { auto rr = __builtin_amdgcn_permlane32_swap(__float_as_uint(ps), __float_as_uint(ps), false, false);
      ps = __uint_as_float(rr[0]) + __uint_as_float(rr[1]); }
    l_reg = l_reg * alpha + ps;
#define PK4(P, B_, OUT) do { unsigned a0 = cvtpk(P[B_+0], P[B_+1]), a1 = cvtpk(P[B_+2], P[B_+3]);                          \
        unsigned b0 = cvtpk(P[B_+4], P[B_+5]), b1 = cvtpk(P[B_+6], P[B_+7]);                                             \
        auto r0 = __builtin_amdgcn_permlane32_swap(a0, b0, false, false); auto r1 = __builtin_amdgcn_permlane32_swap(a1, b1, false, false); \
        u32x4 w = {r0[0], r1[0], r0[1], r1[1]}; OUT = *reinterpret_cast<bf16x8*>(&w); } while (0)
    PK4(p0, 0, pa0); PK4(p0, 8, pa1); PK4(p1, 0, pa2); PK4(p1, 8, pa3);
#undef PK4
}
template <int KB, bool SK>
__device__ __forceinline__ void qkt(f32x16& p0, f32x16& p1, const char* K_lds, int r32, int hi, const bf16x8* qr, bool act, const float* bias_t  ) {
    if (SK && !act) { const float NEG = -__builtin_inff();
#pragma unroll
        for (int r = 0; r < 16; ++r) { p0[r] = NEG; p1[r] = NEG; } return; }
#pragma unroll
    for (int g4 = 0; g4 < 4; ++g4) { const f32x4 b0 = *(const f32x4*)(bias_t + 8 * g4), b1 = *(const f32x4*)(bias_t + 32 + 8 * g4);
#pragma unroll
        for (int j = 0; j < 4; ++j) { p0[4 * g4 + j] = b0[j]; p1[4 * g4 + j] = b1[j]; } }
    const char* kb[4];
#pragma unroll
    for (int dd = 0; dd < 4; ++dd) kb[dd] = K_lds + KB * SHM_K + KSWZ(r32, (dd * 16 + hi * 8) * 2);
#pragma unroll
    for (int d0 = 0; d0 < 8; ++d0) { const char* a = kb[d0 & 3] + (d0 >> 2) * 128;
        bf16x8 b0 = *reinterpret_cast<const bf16x8*>(a);
        bf16x8 b1 = *reinterpret_cast<const bf16x8*>(a + 32 * 256);
        p0 = __builtin_amdgcn_mfma_f32_32x32x16_bf16(b0, qr[d0], p0, 0, 0, 0);
        p1 = __builtin_amdgcn_mfma_f32_32x32x16_bf16(b1, qr[d0], p1, 0, 0, 0); }
}
template <int VB, bool SK>
__device__ __forceinline__ void pv_tile(f32x16* o, int vb0, bf16x8 pa0, bf16x8 pa1, bf16x8 pa2, bf16x8 pa3, bool act) {
    if (SK && !act) return;
#define TRRD(dst, off) asm volatile("ds_read_b64_tr_b16 %0, %1 offset:%2" : "=&v"(dst) : "v"(vb0), "i"(off) : "memory")
#define PV_D0(d0) do { s16x4 l0, l1, l2, l3, h0, h1, h2, h3; constexpr int b_ = VB * SHM_V + v_rd_off(d0, 0, 0);     \
        TRRD(l0, b_); TRRD(h0, b_ + 2048); TRRD(l1, b_ + 4096); TRRD(h1, b_ + 6144); TRRD(l2, b_ + 8192); TRRD(h2, b_ + 10240); TRRD(l3, b_ + 12288); TRRD(h3, b_ + 14336); \
        asm volatile("s_waitcnt lgkmcnt(0)" ::: "memory"); SBAR();                 \
        o[d0] = __builtin_amdgcn_mfma_f32_32x32x16_bf16(pa0, (bf16x8){l0[0], l0[1], l0[2], l0[3], h0[0], h0[1], h0[2], h0[3]}, o[d0], 0, 0, 0);   \
        o[d0] = __builtin_amdgcn_mfma_f32_32x32x16_bf16(pa1, (bf16x8){l1[0], l1[1], l1[2], l1[3], h1[0], h1[1], h1[2], h1[3]}, o[d0], 0, 0, 0);   \
        o[d0] = __builtin_amdgcn_mfma_f32_32x32x16_bf16(pa2, (bf16x8){l2[0], l2[1], l2[2], l2[3], h2[0], h2[1], h2[2], h2[3]}, o[d0], 0, 0, 0);   \
        o[d0] = __builtin_amdgcn_mfma_f32_32x32x16_bf16(pa3, (bf16x8){l3[0], l3[1], l3[2], l3[3], h3[0], h3[1], h3[2], h3[3]}, o[d0], 0, 0, 0); } while (0)
    PV_D0(0); PV_D0(1); PV_D0(2); PV_D0(3);
#undef PV_D0
#undef TRRD
}

template <class TIn, class TOut> struct BlockRef { const TIn* Q; const TIn* K; const TIn* V; TOut* O; int P0; };
template <class TIn> struct Seam {
    bf16x8 qr[8];
    bf16x8 st_v0, st_v1, st_k0, st_k1; f32x4 sf0, sf1, sf2, sf3;
    f32x4 tq[16];
};
__device__ __forceinline__ int swa_jlo(int P0, int W) { const int lowk = P0 - W + 1; return lowk > 0 ? lowk / KVBLK : 0; }
#define ROW(p, k0, rr) ((p) + (size_t)((k0) + (rr)) * PKV + sc)
#define VMW() asm volatile("s_waitcnt vmcnt(0)" ::: "memory")
#define VMWN(n) asm volatile("s_waitcnt vmcnt(%0)" :: "i"(n) : "memory")
#define SLOAD_H(Kp, Vp, k0) do { S.st_v0 = load8<TIn>(ROW(Vp, k0, sr)); S.st_v1 = load8<TIn>(ROW(Vp, k0, 32 + sr));              \
                         S.st_k0 = load8<TIn>(ROW(Kp, k0, sr)); S.st_k1 = load8<TIn>(ROW(Kp, k0, 32 + sr)); } while (0)
#define SWRITE_HK(bf) do { *(bf16x8*)(K_lds + (bf) * SHM_K + kws) = S.st_k0; *(bf16x8*)(K_lds + (bf) * SHM_K + kws + 32 * 256) = S.st_k1; } while (0)
#define SWRITE_HV(bf) do { *(bf16x8*)(V_lds + (bf) * SHM_V + vst0) = S.st_v0; *(bf16x8*)(V_lds + (bf) * SHM_V + vst1) = S.st_v1; } while (0)
#define SWRITE_H(bf) do { SWRITE_HV(bf); SWRITE_HK(bf); } while (0)
#define SLOAD_F(p, k0) do { S.sf0 = *(const f32x4*)ROW(p, k0, sr); S.sf1 = *(const f32x4*)(ROW(p, k0, sr) + 4);                \
                            S.sf2 = *(const f32x4*)ROW(p, k0, 32 + sr); S.sf3 = *(const f32x4*)(ROW(p, k0, 32 + sr) + 4); } while (0)
#define SWRITE_KF(bf) do { *(bf16x8*)(K_lds + (bf) * SHM_K + kws) = pack8(S.sf0, S.sf1); *(bf16x8*)(K_lds + (bf) * SHM_K + kws + 32 * 256) = pack8(S.sf2, S.sf3); } while (0)
#define SWRITE_VF(bf) do { *(bf16x8*)(V_lds + (bf) * SHM_V + vst0) = pack8(S.sf0, S.sf1); *(bf16x8*)(V_lds + (bf) * SHM_V + vst1) = pack8(S.sf2, S.sf3); } while (0)
template <class TIn, class TOut>
__device__ __forceinline__ void causal_swa_prime(const BlockRef<TIn, TOut>& cur, int W, char* lds, Seam<TIn>& S, int tid_in) {
    constexpr bool F32 = same_t<TIn, float>::v;
    const int tid = tid_in, wid = __builtin_amdgcn_readfirstlane(tid >> 6), lane = tid & 63, r32 = lane & 31, hi = lane >> 5;
    const int sr = tid >> 4, sc = (tid & 15) * 8, kws = KSWZ(sr, sc * 2); char* K_lds = lds + 2 * SHM_V;
    const int kb0 = swa_jlo(cur.P0, W) * KVBLK;
    for (int d0 = 0; d0 < 8; ++d0) S.qr[d0] = load8<TIn>(cur.Q + (size_t)(wid * QBLK + r32) * PKV + d0 * 16 + hi * 8);
    if constexpr (F32) { SLOAD_F((const float*)cur.K, kb0); VMW(); SWRITE_KF(0); SBAR(); SLOAD_F((const float*)cur.V, kb0); }
    else { SLOAD_H(cur.K, cur.V, kb0); VMW(); SWRITE_HK(0); }
    __syncthreads();
}
template <class TIn, class TOut>
__device__ __forceinline__ void causal_swa_block(const BlockRef<TIn, TOut>& cur, const BlockRef<TIn, TOut>& nxt, int skv, int W, char* lds, Seam<TIn>& S, int bias_buf, int tid_in) {
    constexpr bool F32 = same_t<TIn, float>::v;
    const int tid = tid_in, wid = __builtin_amdgcn_readfirstlane(tid >> 6), lane = tid & 63, r32 = lane & 31, hi = lane >> 5;
    const int j_lo = swa_jlo(cur.P0, W);
    int j_hi = (cur.P0 + QB - 1) / KVBLK + 1; if (j_hi > skv / KVBLK) j_hi = skv / KVBLK;
    const int NT = j_hi - j_lo;
    const int kbn = swa_jlo(nxt.P0, W) * KVBLK;
    const int qlo = cur.P0 + wid * QBLK, qm = qlo + r32 - 4 * hi;
    char* V_lds = lds; char* K_lds = lds + 2 * SHM_V;
    float* ws = (float*)(lds + 2 * SHM_V + 2 * SHM_K) + wid * 64; float* li_l = ws, * al_l = ws + 32;
    const float* bias_l = (const float*)(lds + LDS_BIAS + bias_buf * 16384) + 4 * hi;
    float m_reg = -1e30f, l_reg = 0; f32x16 o[4] = {};
    const int sr = tid >> 4, sc = (tid & 15) * 8, vst0 = v_st(sr, sc), vst1 = v_st(32 + sr, sc), kws = KSWZ(sr, sc * 2);
    const int vb0 = (int)(uintptr_t)V_lds + v_rd_base(lane);
    const TIn* Kh = cur.K; const TIn* Vh = cur.V;
#define RESC(a) do { if (__any((a) < 1.f)) { if (hi == 0) al_l[r32] = (a); asm volatile("s_waitcnt lgkmcnt(0)" ::: "memory");              \
                     for (int d_ = 0; d_ < 4; ++d_) for (int r = 0; r < 16; ++r) o[d_][r] *= al_l[crow(r, hi)]; } } while (0)
#define KBASE(t) ((j_lo + (t)) * KVBLK)
#define BIAS_T(t) (bias_l + KBASE(t))
    const TIn* pf_src = (((tid >> 7) & 1) ? Vh : Kh) + (size_t)((tid & 127) >> 1) * PKV + (tid & 1) * 64;
#define L2_PREFETCH(kb_) do { if (tid < 256) __builtin_amdgcn_global_load_lds((const unsigned*)(pf_src + (size_t)(kb_) * PKV), (__attribute__((address_space(3))) unsigned*)(uintptr_t)__builtin_amdgcn_readfirstlane((unsigned)(uintptr_t)(lds + LDS_JUNK)), 4, 0, 0); } while (0)
#define ACT(t) (KBASE(t) <= qlo + QBLK - 1 && KBASE(t) + KVBLK - 1 >= qlo - W + 1)
#define MASKT(P0_, P1_, t) do { const int kb_ = KBASE(t); if ((!SK || ACT(t)) && (kb_ + KVBLK - 1 > qlo || kb_ <= qlo + QBLK - 1 - W)) mask_tile(P0_, P1_, qm - kb_, (unsigned)W); } while (0)
    constexpr int NQL = F32 ? 16 : 8;
    constexpr bool SK = WSKIP && !F32;
#define SEAM_K0() do { VMWN(NQL); if constexpr (F32) { SWRITE_KF(0); SBAR(); SLOAD_F((const float*)nxt.V, kbn); } else { SWRITE_HK(0); } SBAR(); } while (0)
    f32x16 pA0, pA1, pB0, pB1; float mnA, mnB, alA, alB; bf16x8 pa0, pa1, pa2, pa3;
    if constexpr (F32) { VMW(); SWRITE_VF(0); SBAR(); } else { SWRITE_HV(0); SBAR(); }
    if (NT > 1) { if constexpr (F32) SLOAD_F((const float*)Kh, KBASE(1)); else SLOAD_H(Kh, Vh, KBASE(1)); }
    SBAR(); qkt<0, SK>(pA0, pA1, K_lds, r32, hi, S.qr, ACT(0), BIAS_T(0));
    if constexpr (F32) { if (NT > 1) { VMW(); SWRITE_KF(1); SBAR(); SLOAD_F((const float*)Vh, KBASE(1)); } }
    MASKT(pA0, pA1, 0); partialSM(pA0, pA1, m_reg, mnA, alA);
    if (NT > 1) { VMW(); if constexpr (F32) { SWRITE_VF(1); SBAR(); if (NT > 2) SLOAD_F((const float*)Kh, KBASE(2)); } else SWRITE_H(1); }
    __syncthreads();
#define HALF_STEP(PX0, PX1, mnX, alX, PY0, PY1, alY, t, KB, VB, SB) do {                                                      \
        SBAR(); qkt<KB, SK>(PX0, PX1, K_lds, r32, hi, S.qr, ACT(t), BIAS_T(t));                                             \
        finishSM(PY0, PY1, alY, l_reg, pa0, pa1, pa2, pa3); SBAR();                                                           \
        if ((t) + 1 < NT) { if constexpr (F32) { VMW(); SWRITE_KF(SB); SBAR(); SLOAD_F((const float*)Vh, KBASE((t) + 1)); }  \
                            else { SLOAD_H(Kh, Vh, KBASE((t) + 1)); } SBAR(); }                                               \
        pv_tile<VB, SK>(o, vb0, pa0, pa1, pa2, pa3, ACT((t) - 1)); MASKT(PX0, PX1, (t)); partialSM(PX0, PX1, m_reg, mnX, alX);                                        \
        __syncthreads();                                                                                                      \
        if ((t) + 1 < NT) { VMW(); if constexpr (F32) { SWRITE_VF(SB); SBAR(); if ((t) + 2 < NT) SLOAD_F((const float*)Kh, KBASE((t) + 2)); } \
                            else { SWRITE_H(SB); } }                                                                          \
        RESC(alX); __syncthreads(); } while (0)
    for (int t = 1; t + 1 < NT; t += 2) {
        HALF_STEP(pB0, pB1, mnB, alB, pA0, pA1, alA, t, 1, 0, 0);
        HALF_STEP(pA0, pA1, mnA, alA, pB0, pB1, alB, t + 1, 0, 1, 1);
    }
    const bool even = (NT & 1) == 0;
    if (even) { SBAR(); qkt<1, SK>(pB0, pB1, K_lds, r32, hi, S.qr, ACT(NT - 1), BIAS_T(NT - 1)); SBAR(); }
#define QROW(e) (nxt.Q + (size_t)(wid * QBLK + r32) * PKV + ((e) >> 1) * 16 + hi * 8 + ((e) & 1) * 4)
    if constexpr (F32) { SLOAD_F((const float*)nxt.K, kbn); SBAR();
#pragma unroll
        for (int e = 0; e < 8; ++e) S.tq[e] = *(const f32x4*)QROW(e); }
    else { SLOAD_H(nxt.K, nxt.V, kbn); SBAR();
#pragma unroll
        for (int d0 = 0; d0 < 8; ++d0) S.qr[d0] = load8<TIn>(nxt.Q + (size_t)(wid * QBLK + r32) * PKV + d0 * 16 + hi * 8); }
    SBAR();
    finishSM(pA0, pA1, alA, l_reg, pa0, pa1, pa2, pa3); SBAR();
    if constexpr (F32) {
#pragma unroll
        for (int e = 8; e < 16; ++e) S.tq[e] = *(const f32x4*)QROW(e); SBAR(); }
#undef QROW
    pv_tile<0, SK>(o, vb0, pa0, pa1, pa2, pa3, ACT(even ? NT - 2 : NT - 1));
    if (even) { MASKT(pB0, pB1, NT - 1); partialSM(pB0, pB1, m_reg, mnB, alB); __syncthreads(); RESC(alB);
        finishSM(pB0, pB1, alB, l_reg, pa0, pa1, pa2, pa3); SBAR(); pv_tile<1, SK>(o, vb0, pa0, pa1, pa2, pa3, ACT(NT - 1)); }
    SBAR(); SEAM_K0();
    if (hi == 0) li_l[r32] = l_reg; asm volatile("s_waitcnt lgkmcnt(0)" ::: "memory");
    float rli[16];
#pragma unroll
    for (int r = 0; r < 16; ++r) rli[r] = __builtin_amdgcn_rcpf(li_l[crow(r, hi)]);
    TOut* Ow = cur.O + (size_t)(wid * QBLK) * PO;
#pragma unroll
    for (int r = 0; r < 16; ++r) { const int orow = crow(r, hi);
#pragma unroll
        for (int d0 = 0; d0 < 4; ++d0) { const float v = o[d0][r] * rli[r];
            if constexpr (same_t<TOut, float>::v) { Ow[(size_t)orow * PO + d0 * 32 + r32] = v; }
            else { const float vn = __shfl_xor(v, 1);
                   if ((r32 & 1) == 0) *(unsigned*)(Ow + (size_t)orow * PO + d0 * 32 + r32) = cvtpk(v, vn); } } }
    if constexpr (F32) {
#pragma unroll
        for (int d0 = 0; d0 < 8; ++d0) S.qr[d0] = pack8(S.tq[2 * d0], S.tq[2 * d0 + 1]); }
    __syncthreads();
#undef RESC
#undef KBASE
#undef BIAS_T
#undef L2_PREFETCH
#undef ACT
#undef MASKT
#undef SEAM_K0
#undef HALF_STEP
}
#undef ROW
#undef VMW
#undef VMWN
#undef SLOAD_H
#undef SWRITE_HK
#undef SWRITE_HV
#undef SWRITE_H
#undef SLOAD_F
#undef SWRITE_KF
#undef SWRITE_VF

}
#define GAS __attribute__((address_space(1)))
#define LAS __attribute__((address_space(3)))
typedef unsigned short bf16;
typedef unsigned v4u __attribute__((ext_vector_type(4)));
typedef float f32x4 __attribute__((ext_vector_type(4)));
typedef short bf16x8 __attribute__((ext_vector_type(8)));
typedef GAS unsigned gu32;
typedef GAS unsigned long long gu64;
#define RLX_AGENT __ATOMIC_RELAXED, __HIP_MEMORY_SCOPE_AGENT
#define LDS_WAIT() asm volatile("s_waitcnt lgkmcnt(0)" ::: "memory")
#define VM_WAIT() asm volatile("s_waitcnt vmcnt(0)" ::: "memory")
__device__ __forceinline__ unsigned long long rt() { return __builtin_amdgcn_s_memrealtime(); }
__device__ __forceinline__ unsigned f2bf(float f) { unsigned u = __builtin_bit_cast(unsigned, f); return (u + 0x7fffu + ((u >> 16) & 1u)) >> 16; }
__device__ __forceinline__ unsigned pk2(float lo, float hi) { return f2bf(lo) | (f2bf(hi) << 16); }

#define XB_TMO      128
#define XB_XCNT(j)  (256  + 64 * (j))
#define XB_XSUB(j)  (1280 + 64 * (j))
#define XB_XGEN(j)  (2304 + 64 * (j))
#define XB_TOP      3328
#define XB_TOPGEN   3392
#define XCD_BAR_WORDS 3456
#define XB_SPIN_CAP (1u << 18)

__device__ __forceinline__ unsigned xb_ld(unsigned* p)              { return __hip_atomic_load(p, __ATOMIC_RELAXED, __HIP_MEMORY_SCOPE_AGENT); }
__device__ __forceinline__ unsigned xb_add(unsigned* p, unsigned v) { return __hip_atomic_fetch_add(p, v, __ATOMIC_RELAXED, __HIP_MEMORY_SCOPE_AGENT); }
__device__ __forceinline__ unsigned xb_xcc_id() { return (unsigned)__builtin_amdgcn_s_getreg((3 << 11) | 20) & 0xFu; }
#define XB_SPIN(cond, bar) do { unsigned _sp = 0; while (cond) { __builtin_amdgcn_s_sleep(1); \
    if ((++_sp & 255u) == 0u) { if (xb_ld(&(bar)[XB_TMO])) break; if (_sp > XB_SPIN_CAP) { atomicAdd(&(bar)[XB_TMO], 1u); break; } } } } while (0)

struct XcdBarrier {
    unsigned* bar; unsigned x;
    volatile LAS unsigned* st;
};

__device__ __forceinline__ XcdBarrier xcd_barrier_post(unsigned* bar, volatile LAS unsigned* st) {
    XcdBarrier b; b.bar = bar; b.x = xb_xcc_id(); b.st = st;
    if (threadIdx.x == 0) (void)xb_add(&bar[XB_XCNT(b.x)], 1u);
    return b;
}
__device__ __forceinline__ void xcd_barrier_complete(unsigned* bar, unsigned x, unsigned& nloc, unsigned& nx) {
    const unsigned G = gridDim.x * gridDim.y * gridDim.z;
    unsigned sum, cnt, mine, sp = 0u;
    for (;;) {
        sum = 0u; cnt = 0u; mine = 0u;
#pragma unroll
        for (unsigned j = 0; j < 16; ++j) { const unsigned c = xb_ld(&bar[XB_XCNT(j)]); sum += c; cnt += (c > 0u) ? 1u : 0u; mine = (j == x) ? c : mine; }
        if (sum == G) break;
        __builtin_amdgcn_s_sleep(1);
        if ((++sp & 255u) == 0u) { if (xb_ld(&bar[XB_TMO])) break; if (sp > XB_SPIN_CAP) { atomicAdd(&bar[XB_TMO], 1u); break; } }
    }
    nloc = mine > 0u ? mine : 1u; nx = cnt > 0u ? cnt : 1u;
}

__device__ __forceinline__ void xcd_barrier(const XcdBarrier& b) {
    asm volatile("s_waitcnt vmcnt(0)" ::: "memory");
    __syncthreads();
    if (threadIdx.x == 0) {
        unsigned* bar = b.bar;
        __builtin_amdgcn_s_waitcnt(0);
        unsigned nloc = b.st[0], nx = b.st[1];
        if (nloc == 0u) { xcd_barrier_complete(bar, b.x, nloc, nx); b.st[0] = nloc; b.st[1] = nx; }
        const unsigned old = xb_add(&bar[XB_XSUB(b.x)], 1u);
        const unsigned gen = old / nloc;
        if (old + 1u == (gen + 1u) * nloc) {
            __builtin_amdgcn_fence(__ATOMIC_RELEASE, "agent");
            asm volatile("s_waitcnt vmcnt(0)" ::: "memory");
            const unsigned og = xb_add(&bar[XB_TOP], 1u);
            const unsigned tg = og / nx;
            if (og + 1u == (tg + 1u) * nx) xb_add(&bar[XB_TOPGEN], 1u);
            else XB_SPIN(xb_ld(&bar[XB_TOPGEN]) == tg, bar);
            __builtin_amdgcn_fence(__ATOMIC_ACQUIRE, "agent");
            xb_add(&bar[XB_XGEN(b.x)], 1u);
            asm volatile("s_waitcnt vmcnt(0)" ::: "memory");
        } else {
            XB_SPIN(xb_ld(&bar[XB_XGEN(b.x)]) == gen, bar);
            __builtin_amdgcn_fence(__ATOMIC_ACQUIRE, "agent");
            asm volatile("s_waitcnt vmcnt(0)" ::: "memory");
        }
    }
    __syncthreads();
}
#ifndef STAMP_K
#define STAMP_K -1
#endif
#ifndef DUP_MASK
#define DUP_MASK 0
#endif
constexpr int NWAVES = 8, NTHR = NWAVES * 64;
constexpr int T_TOK = 16384, SEQ = 4096, NBATCH = 4, DM = 1024;
constexpr int IN_COLS = 8216, NPROJ = 8192, NPROJ_PAD = 8448;
constexpr int C_GQ = 0, C_GK = 512, C_GV = 1024, C_GR = 2048, PPITCH = 3072;
constexpr int NE = 32, DFF = 1024, NCHUNK = 64;
constexpr float LN_EPS = 1e-5f;
constexpr float DN_ALPHA = 1.189207115002721f;
constexpr float FOX_INV_SCALE = 11.313708498984761f;
constexpr float GLA_QSCALE = 0.08838834764831845f;
constexpr int SLOT_ROWS = 73728;

constexpr size_t MiB = 1u << 20;
constexpr size_t WS_CTL = 0, CTL_ZERO_BYTES = 1 * MiB;
constexpr size_t WS_WIN = 2 * MiB;
constexpr size_t WS_WPROJ = 19 * MiB;
constexpr size_t WS_WOUT = 23 * MiB;
constexpr size_t WS_WGU = 25 * MiB;
constexpr size_t WS_WDN = 153 * MiB;
constexpr size_t WS_H0B = 217 * MiB;
constexpr size_t WS_SM = 249 * MiB;
constexpr size_t WS_FB = 251 * MiB;
constexpr size_t WS_DECAY = 252 * MiB;
constexpr size_t WS_KDEC = 253 * MiB;
constexpr size_t WS_AO = 269 * MiB;
constexpr size_t WS_MIXED = 333 * MiB;
constexpr size_t WS_H1F = 365 * MiB;
constexpr size_t WS_H1B = 429 * MiB;
constexpr size_t WS_TOKOF = 461 * MiB;
constexpr size_t WS_PAIR = 463 * MiB;
constexpr size_t WS_PROJ = 464 * MiB;
constexpr size_t WS_YS = 560 * MiB;
constexpr size_t WS_FQKV = 704 * MiB;
constexpr size_t WS_ZIMG = 800 * MiB;
constexpr size_t WS_ACT = WS_FQKV;
constexpr size_t WS_END = 864 * MiB;
static_assert(WS_WIN + (size_t)NPROJ_PAD * 1024 * 2 <= WS_WPROJ && WS_WGU + (size_t)32 * 2048 * 1024 * 2 <= WS_WDN && WS_WDN + (size_t)32 * 1024 * 1024 * 2 <= WS_H0B, "ws map");
static_assert(WS_PROJ + (size_t)T_TOK * PPITCH * 2 <= WS_YS && WS_YS + (size_t)SLOT_ROWS * 1024 * 2 <= WS_FQKV && WS_FQKV + (size_t)3 * 32 * 4096 * 128 * 2 <= WS_ZIMG && WS_ZIMG + (size_t)64 * MiB <= WS_END && WS_ACT + (size_t)SLOT_ROWS * 1024 * 2 <= WS_END, "ws map");
constexpr int CW_TMO = 0, CW_CODE = 1;
constexpr int CW_BAR = 4096;
constexpr int CW_CNT = 8192;
constexpr int CW_Q = 12288;

constexpr int RING_OFF = 0, RING_BYTES = 131072;
constexpr int LDSCTL_OFF = RING_BYTES, MISC_OFF = LDSCTL_OFF + 320;
constexpr int TBL_OFF = RING_BYTES + 512;
constexpr int TBL_CUM = TBL_OFF, TBL_CNT = TBL_OFF + 256, TBL_DESC = TBL_OFF + 384, TBL_IDX = TBL_OFF + 768;
constexpr int LDS_BYTES = 147456;
static_assert(TBL_IDX + pg8::MAXU * 256 * 4 <= LDS_BYTES && fox::LDS_BYTES <= RING_BYTES, "LDS map");

__device__ __forceinline__ float bfu(unsigned short h) { return __uint_as_float((unsigned)h << 16); }
__device__ __forceinline__ float logsig(float x) { return fminf(x, 0.f) - __logf(1.0f + __expf(-fabsf(x))); }
__device__ __forceinline__ float wave_sum(float v) {
#pragma unroll
    for (int o = 1; o < 64; o <<= 1) v += __shfl_xor(v, o);
    return v;
}

__device__ __forceinline__ void p0_tile_load(f32x4 (&v)[16], const float* W, int npitch, int srccol, int kb, int lane) {
    const int q = lane & 15, rg = lane >> 4, k0 = 64 * kb + 16 * rg;
    const GAS f32x4* src = (const GAS f32x4*)(W + (size_t)k0 * npitch + srccol + 4 * q);
#pragma unroll
    for (int i = 0; i < 16; ++i) v[i] = src[(size_t)i * (npitch / 4)];
}
__device__ __forceinline__ void p0_tile_store(const f32x4 (&v)[16], bf16* WT, int dstrow, int kb, int lane) {
    const int q = lane & 15, rg = lane >> 4, k0 = 64 * kb + 16 * rg;
#pragma unroll
    for (int j = 0; j < 4; ++j) { GAS v4u* dst = (GAS v4u*)(WT + (size_t)(dstrow + 4 * q + j) * 1024 + k0);
        v4u a, b;
        a.x = pk2(v[0][j], v[1][j]); a.y = pk2(v[2][j], v[3][j]); a.z = pk2(v[4][j], v[5][j]); a.w = pk2(v[6][j], v[7][j]);
        b.x = pk2(v[8][j], v[9][j]); b.y = pk2(v[10][j], v[11][j]); b.z = pk2(v[12][j], v[13][j]); b.w = pk2(v[14][j], v[15][j]);
        dst[0] = a; dst[1] = b; }
}
__device__ __forceinline__ void p0_transpose_tile(const float* W, int npitch, int srccol, bf16* WT, int dstrow, int kb, int lane) {
    const int q = lane & 15, rg = lane >> 4, k0 = 64 * kb + 16 * rg;
    const GAS f32x4* src = (const GAS f32x4*)(W + (size_t)k0 * npitch + srccol + 4 * q);
    f32x4 v[16];
#pragma unroll
    for (int i = 0; i < 16; ++i) v[i] = __builtin_nontemporal_load(src + (size_t)i * (npitch / 4));
#pragma unroll
    for (int j = 0; j < 4; ++j) { GAS v4u* dst = (GAS v4u*)(WT + (size_t)(dstrow + 4 * q + j) * 1024 + k0);
        v4u a, b;
        a.x = pk2(v[0][j], v[1][j]); a.y = pk2(v[2][j], v[3][j]); a.z = pk2(v[4][j], v[5][j]); a.w = pk2(v[6][j], v[7][j]);
        b.x = pk2(v[8][j], v[9][j]); b.y = pk2(v[10][j], v[11][j]); b.z = pk2(v[12][j], v[13][j]); b.w = pk2(v[14][j], v[15][j]);
        __builtin_nontemporal_store(a, dst); __builtin_nontemporal_store(b, dst + 1); }
}
__device__ __forceinline__ void* ldptr(const LAS unsigned long long* PT, int i) { const unsigned long long v = PT[i];
    const unsigned lo = __builtin_amdgcn_readfirstlane((unsigned)v), hi = __builtin_amdgcn_readfirstlane((unsigned)(v >> 32)); return (void*)(GAS unsigned char*)(uintptr_t)(((unsigned long long)hi << 32) | lo); }
constexpr int CV_PRJ = 3 * 256, CV_GU = 32 * 512, CV_DN = 32 * 256, CV_ITEMS = CV_PRJ + CV_GU + CV_DN;
constexpr int CV_P1 = 192 * 8 * 3;
__device__ __forceinline__ void conv_tile(int it, const LAS unsigned long long* PT, int ln) {
    unsigned char* const wsb = (unsigned char*)ldptr(PT, 22);
    if (it < CV_PRJ) { const int mm = it >> 8, r = it & 255, db = r >> 4, kb = r & 15;
        const float* W = (const float*)ldptr(PT, 8 + mm); bf16* WT = mm < 2 ? (bf16*)(wsb + WS_WPROJ) + (size_t)mm * 1024 * 1024 : (bf16*)(wsb + WS_WOUT);
        p0_transpose_tile(W, 1024, 64 * db, WT, 64 * db, kb, ln); return; }
    it -= CV_PRJ;
    if (it < CV_GU) { const int e = it >> 9, r = it & 511, db = r >> 4, kb = r & 15, pn = db >> 2, jb = db & 3;
        const int src = jb < 2 ? 128 * pn + 64 * jb : 1024 + 128 * pn + 64 * (jb - 2);
        p0_transpose_tile((const float*)ldptr(PT, 15) + (size_t)e * 1024 * 2048, 2048, src, (bf16*)(wsb + WS_WGU) + (size_t)e * 2048 * 1024, 64 * db, kb, ln); return; }
    it -= CV_GU;
    { const int e = it >> 8, r = it & 255, db = r >> 4, kb = r & 15;
        p0_transpose_tile((const float*)ldptr(PT, 17) + (size_t)e * 1024 * 1024, 1024, 64 * db, (bf16*)(wsb + WS_WDN) + (size_t)e * 1024 * 1024, 64 * db, kb, ln); }
}
__device__ __forceinline__ void ln_row(const f32x4 (&xin)[4], f32x4 (&y)[4], const float* g, const float* b, int lane) {
    float s = 0.f;
#pragma unroll
    for (int j = 0; j < 4; ++j) s += (xin[j].x + xin[j].y) + (xin[j].z + xin[j].w);
    const float mean = wave_sum(s) * (1.f / DM); float s2 = 0.f;
#pragma unroll
    for (int j = 0; j < 4; ++j) { y[j] = xin[j] - mean; s2 += (y[j].x * y[j].x + y[j].y * y[j].y) + (y[j].z * y[j].z + y[j].w * y[j].w); }
    const float rstd = 1.f / sqrtf(wave_sum(s2) * (1.f / DM) + LN_EPS);
#pragma unroll
    for (int j = 0; j < 4; ++j) { const f32x4 gv = *(const f32x4*)(g + 4 * lane + 256 * j), bv = *(const f32x4*)(b + 4 * lane + 256 * j); y[j] = y[j] * rstd * gv + bv; }
}
__device__ __forceinline__ void store_row_bf16(bf16* orow, const f32x4 (&y)[4], int lane) {
    GAS unsigned long long* o8 = (GAS unsigned long long*)orow + lane;
#pragma unroll
    for (int j = 0; j < 4; ++j) o8[64 * j] = (unsigned long long)pk2(y[j].x, y[j].y) | ((unsigned long long)pk2(y[j].z, y[j].w) << 32);
}

struct Args { const float* in[21]; float* out; unsigned char* ws; int ph_lo, ph_hi, li, pad; };
constexpr int NPH = 11;

__global__ void __launch_bounds__(NTHR, 2) mega_fwd(Args args) {
    extern __shared__ __attribute__((aligned(16))) unsigned char lds[];
    LAS unsigned char* const ldsl = (LAS unsigned char*)lds;
    volatile LAS unsigned* const MISC = (volatile LAS unsigned*)(ldsl + MISC_OFF);
    const int tid = threadIdx.x, lane = tid & 63, wave = __builtin_amdgcn_readfirstlane(tid >> 6);
    const int G = gridDim.x; const int bx = blockIdx.x; const int vcu = (G % 8 == 0) ? (bx % 8) * (G / 8) + bx / 8 : bx;
    for (int u = tid; u < (LDS_BYTES - LDSCTL_OFF) / 4; u += NTHR) ((LAS unsigned*)(ldsl + LDSCTL_OFF))[u] = 0u;
    __syncthreads();
    LAS unsigned long long* const PT = (LAS unsigned long long*)(ldsl + LDSCTL_OFF);
    if (tid == 0) {
#pragma unroll
        for (int i = 0; i < 21; ++i) PT[i] = (unsigned long long)(uintptr_t)args.in[i];
        PT[21] = (unsigned long long)(uintptr_t)args.out; PT[22] = (unsigned long long)(uintptr_t)args.ws; }
    __syncthreads();
#define INP(i) ((const float*)ldptr(PT, (i)))
#define WSB ((unsigned char*)ldptr(PT, 22))
    const int lo = args.ph_lo, hi = args.ph_hi;
    unsigned long long t_stamp_a = 0ull; const unsigned long long t_stamp_0 = (STAMP_K >= 0) ? __builtin_amdgcn_s_memrealtime() : 0ull;
    const bool use_bar = (hi - lo) > 1;
    if (use_bar) (void)xcd_barrier_post((unsigned*)(WSB + WS_CTL) + CW_BAR, MISC + 8);
#ifndef PH_MASK
#define PH_MASK 0x7FF
#endif
#define IN(k) ((((PH_MASK) >> (k)) & 1) && lo <= (k) && (k) < hi)
#ifndef DUP_MASK
#define DUP_MASK 0
#endif
#define DUP(k) for (int rep_ = 0; rep_ < 1 + (((DUP_MASK) >> (k)) & 1); ++rep_)
#define SEAM(k) do { if (STAMP_K == (k) && bx == 0 && tid == 0) { t_stamp_a = __builtin_amdgcn_s_memrealtime(); } if (IN(k) && IN((k) + 1)) { XcdBarrier b_; b_.bar = (unsigned*)(WSB + WS_CTL) + CW_BAR; b_.x = xb_xcc_id(); b_.st = MISC + 8; xcd_barrier(b_); if ((DUP_MASK >> 16) & 1) { xcd_barrier(b_); xcd_barrier(b_); } } if (STAMP_K == (k) + 100 && bx == 0 && tid == 0) { t_stamp_a = __builtin_amdgcn_s_memrealtime(); } } while (0)

    if (IN(0)) DUP(0) {
        bf16* const WIN_T = (bf16*)(WSB + WS_WIN); bf16* const WPROJ_T = (bf16*)(WSB + WS_WPROJ); bf16* const WOUT_T = (bf16*)(WSB + WS_WOUT); bf16* const WGU_T = (bf16*)(WSB + WS_WGU); bf16* const WDN_T = (bf16*)(WSB + WS_WDN); bf16* const H0B = (bf16*)(WSB + WS_H0B);
        const float* const x = INP(0); const float* const ln_in_g = INP(1); const float* const ln_in_b = INP(2); const float* const w_in = INP(3); const float* const w_gla_proj = INP(8); const float* const w_fox_proj = INP(9); const float* const w_out = INP(10); const float* const w_gate_up = INP(15); const float* const w_down = INP(17);
        const int gw = vcu * NWAVES + wave, NGW = G * NWAVES;
        constexpr int I_IN = 128 * 16;
        for (int it = gw; it < I_IN; it += NGW) { const int db = it >> 4, kb = it & 15, dst = 64 * db, src = dst + (dst < 2048 ? 0 : (dst < 6144 ? 16 : 24));
            p0_transpose_tile(w_in, IN_COLS, src, WIN_T, dst, kb, lane); }
        for (int i = vcu * NTHR + tid; i < 256 * 1024; i += G * NTHR) { const int r = i >> 10, k = i & 1023;
            float v = 0.f; if (r < 16) v = w_in[(size_t)k * IN_COLS + 2048 + r]; else if (r < 24) v = w_in[(size_t)k * IN_COLS + 6160 + (r - 16)];
            WIN_T[(size_t)(NPROJ + r) * 1024 + k] = (bf16)f2bf(v); }
        for (int m0 = gw; m0 < T_TOK; m0 += 4 * NGW) {
            f32x4 v[4][4], y[4];
#pragma unroll
            for (int r = 0; r < 4; ++r) { const GAS f32x4* xr = (const GAS f32x4*)(x + (size_t)(m0 + r * NGW) * DM) + lane;
#pragma unroll
                for (int j = 0; j < 4; ++j) v[r][j] = xr[64 * j]; }
#pragma unroll
            for (int r = 0; r < 4; ++r) { ln_row(v[r], y, ln_in_g, ln_in_b, lane); store_row_bf16(H0B + (size_t)(m0 + r * NGW) * DM, y, lane); } }
    }
    SEAM(0);

    if (IN(1)) DUP(1) {
        bf16* const H0B = (bf16*)(WSB + WS_H0B); bf16* const WIN_T = (bf16*)(WSB + WS_WIN); bf16* const PROJ = (bf16*)(WSB + WS_PROJ); float* const SM = (float*)(WSB + WS_SM);
        pg8::Gemm g{H0B, WIN_T, T_TOK, NPROJ_PAD, DM}; pg8::StaticOrder S; S.init(T_TOK, NPROJ_PAD, G, bx);
        pg8::EpiProj E{PROJ, SM, (bf16*)(WSB + WS_FQKV), (bf16*)(WSB + WS_ZIMG)};
        pg8::gemm_phase<pg8::EpiProj, pg8::StaticOrder, true, true, false>(ldsl + RING_OFF, g, S, E);
        if (bx >= 64 && rep_ == 0) {
            const int cw = ((bx - 64) * NWAVES + wave) * 3;
#pragma unroll 1
            for (int t = 0; t < 3; ++t) conv_tile(cw + t, PT, lane);
        }
    }
    SEAM(1);

    if (IN(2)) DUP(2) {
        float* const SM = (float*)(WSB + WS_SM); float* const FB = (float*)(WSB + WS_FB); float* const DECAY = (float*)(WSB + WS_DECAY); bf16* const KDEC = (bf16*)(WSB + WS_KDEC); bf16* const VT = (bf16*)(WSB + WS_MIXED); bf16* const PROJ = (bf16*)(WSB + WS_PROJ);
        const float* const w_gup = INP(4); const float* const b_gla_gate = INP(5); const float* const b_forget = INP(7);
        LAS float* sc = (LAS float*)(ldsl + RING_OFF);
        for (int bh = vcu; bh < 32; bh += G) {
            const int b = bh >> 3, h = bh & 7; const float bf_ = b_forget[h];
            float v[8]; float run = 0.f;
#pragma unroll
            for (int j = 0; j < 8; ++j) { const int s = tid * 8 + j; run += logsig(SM[(size_t)(b * SEQ + s) * 32 + 16 + h] + bf_); v[j] = run; }
            float incl = run;
#pragma unroll
            for (int o = 1; o < 64; o <<= 1) { const float t = __shfl_up(incl, o); if (lane >= o) incl += t; }
            if (lane == 63) sc[wave] = incl;
            __syncthreads();
            float woff = 0.f;
            for (int w = 0; w < wave; ++w) woff += sc[w];
            const float off = woff + (incl - run);
#pragma unroll
            for (int j = 0; j < 8; ++j) FB[(size_t)bh * SEQ + tid * 8 + j] = -(off + v[j]) * FOX_INV_SCALE;
            __syncthreads();
        }
        {
            LAS float* const GL = (LAS float*)(ldsl + RING_OFF + 4096);
            LAS unsigned short* const KL = (LAS unsigned short*)(ldsl + RING_OFF + 8192);
            LAS unsigned short* const VL = (LAS unsigned short*)(ldsl + RING_OFF + 8192 + 16384);
            const int j = tid & 127, cq = tid >> 7; const int h = vcu & 3; const int col = h * 128 + j;
            float wu[16];
#pragma unroll
            for (int r = 0; r < 16; ++r) wu[r] = w_gup[r * 512 + col];
            const float bg = b_gla_gate[col];
            v4u kq[2], vq[4]; f32x4 gq = {0.f, 0.f, 0.f, 0.f};
#define PREP_LOAD(it_) do { const int n_ = ((it_) >> 2) & 63, b_ = (it_) >> 8; const size_t t0_ = (size_t)b_ * SEQ + n_ * 64; \
                _Pragma("unroll") for (int i = 0; i < 2; ++i) { const int p = tid + NTHR * i; kq[i] = *(const GAS v4u*)(PROJ + (t0_ + (p >> 4)) * PPITCH + C_GK + h * 128 + (p & 15) * 8); } \
                _Pragma("unroll") for (int i = 0; i < 4; ++i) { const int p = tid + NTHR * i; vq[i] = *(const GAS v4u*)(PROJ + (t0_ + (p >> 5)) * PPITCH + C_GV + h * 256 + (p & 31) * 8); } \
                if (tid < 256) gq = *(const GAS f32x4*)(SM + (t0_ + (tid >> 2)) * 32 + 4 * (tid & 3)); } while (0)
            PREP_LOAD(vcu);
            for (int it = vcu; it < NBATCH * NCHUNK * 4; it += G) {
                const int n = (it >> 2) & 63, b = it >> 8;
#pragma unroll
                for (int i = 0; i < 2; ++i) { const int p = tid + NTHR * i; *(LAS v4u*)(KL + (p >> 4) * 128 + (p & 15) * 8) = kq[i]; }
#pragma unroll
                for (int i = 0; i < 4; ++i) { const int p = tid + NTHR * i; *(LAS v4u*)(VL + (p >> 5) * 256 + (p & 31) * 8) = vq[i]; }
                if (tid < 256) *(LAS f32x4*)(GL + (tid >> 2) * 16 + 4 * (tid & 3)) = gq;
                __syncthreads();
                if (it + G < NBATCH * NCHUNK * 4) PREP_LOAD(it + G);
                float cum[16]; float run = 0.f;
#pragma unroll
                for (int c = 0; c < 16; ++c) { const LAS float* gl = GL + (cq * 16 + c) * 16; float z = bg;
#pragma unroll
                    for (int r4 = 0; r4 < 4; ++r4) { const f32x4 g4 = *(const LAS f32x4*)(gl + 4 * r4); z += g4.x * wu[4 * r4] + g4.y * wu[4 * r4 + 1] + g4.z * wu[4 * r4 + 2] + g4.w * wu[4 * r4 + 3]; }
                    run += logsig(z) * (1.0f / 16.0f); cum[c] = run; }
                sc[cq * 128 + j] = run;
                __syncthreads();
                float off = 0.f, total = 0.f;
#pragma unroll
                for (int q = 0; q < 4; ++q) { const float t = sc[q * 128 + j]; total += t; if (q < cq) off += t; }
                {   unsigned pk[8];
#pragma unroll
                    for (int c = 0; c < 16; c += 2) { const int cc = cq * 16 + c;
                        pk[c >> 1] = pk2(bfu(KL[cc * 128 + j]) * __expf(total - (off + cum[c])), bfu(KL[(cc + 1) * 128 + j]) * __expf(total - (off + cum[c + 1]))); }
                    GAS v4u* dst = (GAS v4u*)(KDEC + (size_t)it * 8192 + j * 64 + cq * 16);
                    v4u w0, w1; w0.x = pk[0]; w0.y = pk[1]; w0.z = pk[2]; w0.w = pk[3]; w1.x = pk[4]; w1.y = pk[5]; w1.z = pk[6]; w1.w = pk[7]; dst[0] = w0; dst[1] = w1; }
                if (cq == 0) DECAY[(size_t)(b * NCHUNK + n) * 512 + col] = expf(total);
                {   const int dv = tid & 255, ch = tid >> 8; unsigned pk[16];
#pragma unroll
                    for (int c = 0; c < 32; c += 2) pk[c >> 1] = (unsigned)VL[(ch * 32 + c) * 256 + dv] | ((unsigned)VL[(ch * 32 + c + 1) * 256 + dv] << 16);
                    GAS v4u* dst = (GAS v4u*)(VT + (size_t)it * 16384 + dv * 64 + ch * 32);
#pragma unroll
                    for (int q = 0; q < 4; ++q) { v4u w; w.x = pk[4 * q]; w.y = pk[4 * q + 1]; w.z = pk[4 * q + 2]; w.w = pk[4 * q + 3]; dst[q] = w; } }
                __syncthreads();
            }
#undef PREP_LOAD
        }
    }
    SEAM(2);

    if (IN(3)) {
        float* const FB = (float*)(WSB + WS_FB); float* const DECAY = (float*)(WSB + WS_DECAY); bf16* const KDEC = (bf16*)(WSB + WS_KDEC); bf16* const VT = (bf16*)(WSB + WS_MIXED); bf16* const PROJ = (bf16*)(WSB + WS_PROJ); bf16* const AO = (bf16*)(WSB + WS_AO);
        const float* const g_gla_norm = INP(6);
        LAS int* const QW = (LAS int*)(ldsl + TBL_CUM);
        DUP(13) {
        gu32* const ctlq = (gu32*)(WSB + WS_CTL) + CW_Q + rep_ * 1024;
        int qoff = 0;
#define P2_FETCH(dst) do { if (tid == 0) { int code_ = -1, t_ = qoff; for (; t_ < 8; ++t_) { const int k_ = (bx + t_) & 7; const unsigned i_ = __hip_atomic_fetch_add(ctlq + 64 * k_, 1u, __ATOMIC_RELAXED, __HIP_MEMORY_SCOPE_AGENT); \
                if (i_ < 66u) { code_ = k_ * 66 + (int)i_; break; } } QW[0] = code_; QW[1] = t_; } \
            __syncthreads(); dst = __builtin_amdgcn_readfirstlane(QW[0]); qoff = __builtin_amdgcn_readfirstlane(QW[1]); __syncthreads(); } while (0)
        int code; P2_FETCH(code);
        bool primed = false; int bbuf = 0;
        fox::Seam<fox::bf16> Sm;
        char* const lg = (char*)lds;
        const fox::bf16* const Pq = (const fox::bf16*)(WSB + WS_FQKV); fox::bf16* const Oo = (fox::bf16*)(AO + (size_t)T_TOK * 1024);
#define P2_REF(r_, code_) do { const int k_ = (code_) / 66, a_ = (code_) % 66 - 2; const int qb_ = 15 - (a_ >> 2), bh_ = 4 * k_ + (a_ & 3), b_ = bh_ >> 3, h_ = bh_ & 7; \
            r_.K = Pq + ((size_t)32 + bh_) * (SEQ * 128); r_.V = Pq + ((size_t)64 + bh_) * (SEQ * 128); r_.Q = Pq + ((size_t)bh_ * SEQ + qb_ * 256) * 128; \
            r_.O = Oo + (size_t)(b_ * SEQ + qb_ * 256) * 1024 + h_ * 128; r_.P0 = qb_ * 256; } while (0)
#define P2_BIAS(code_, buf_) do { const int k_ = (code_) / 66, a_ = (code_) % 66 - 2; const int bh_ = 4 * k_ + (a_ & 3); LAS f32x4* bl_ = (LAS f32x4*)(ldsl + fox::LDS_BIAS + (buf_) * 16384); \
            const GAS f32x4* src_ = (const GAS f32x4*)(FB + (size_t)bh_ * SEQ); bl_[tidl] = src_[tidl]; bl_[tidl + NTHR] = src_[tidl + NTHR]; } while (0)
        while (code >= 0) {
          int tidl = tid; asm volatile("" : "+v"(tidl));
          if (code % 66 < 2) {
            primed = false;
            typedef float f32x16 __attribute__((ext_vector_type(16)));
            const int gitem = 2 * (code / 66) + code % 66;
            const int tid = tidl, lane = tid & 63, wave = __builtin_amdgcn_readfirstlane(tid >> 6);
            const int b = gitem >> 2, h = gitem & 3; const int r32 = lane & 31, hi = lane >> 5;
#define GLA_KT(bf_) (ldsl + RING_OFF + (bf_) * 18432)
#define GLA_QT(bf_) (ldsl + RING_OFF + 36864 + (bf_) * 16896)
#define GLA_DC(bf_) ((LAS float*)(ldsl + RING_OFF + 70656 + (bf_) * 512))
#define GLA_OS (ldsl + RING_OFF + 71680)
#define GLA_SS ((LAS float*)(ldsl + RING_OFF + 71680 + 33792))
            bf16* const ORAW = (bf16*)(WSB + WS_H1B); float* const SSQ = (float*)(WSB + WS_TOKOF);
            f32x16 Sacc[4];
#pragma unroll
            for (int m = 0; m < 4; ++m)
#pragma unroll
                for (int r = 0; r < 16; ++r) Sacc[m][r] = 0.f;
            const int p0 = tid, p1 = tid + 512;
            const unsigned kdst0 = (p0 >> 3) * 144 + (p0 & 7) * 16, kdst1 = (p1 >> 3) * 144 + (p1 & 7) * 16, qdst0 = (p0 >> 4) * 264 + (p0 & 15) * 16, qdst1 = (p1 >> 4) * 264 + (p1 & 15) * 16;
            v4u kst0, kst1, qst0, qst1; float dcs = 0.f; bf16x8 vf[4];
#define GLA_LOAD_STAGE(n_) do { const size_t item_ = (size_t)((b * NCHUNK + (n_)) * 4 + h); const size_t tok0_ = (size_t)b * SEQ + (size_t)(n_) * 64; \
                kst0 = *(const GAS v4u*)(KDEC + item_ * 8192 + (p0 >> 3) * 64 + (p0 & 7) * 8); kst1 = *(const GAS v4u*)(KDEC + item_ * 8192 + (p1 >> 3) * 64 + (p1 & 7) * 8); \
                qst0 = *(const GAS v4u*)(PROJ + (tok0_ + (p0 >> 4)) * PPITCH + C_GQ + h * 128 + (p0 & 15) * 8); qst1 = *(const GAS v4u*)(PROJ + (tok0_ + (p1 >> 4)) * PPITCH + C_GQ + h * 128 + (p1 & 15) * 8); \
                if (tid < 128) dcs = DECAY[(size_t)(b * NCHUNK + (n_)) * 512 + h * 128 + tid]; } while (0)
#define GLA_LOAD_V(n_) do { const bf16* vb_ = VT + (size_t)((b * NCHUNK + (n_)) * 4 + h) * 16384 + (size_t)(32 * wave + r32) * 64 + 8 * hi; \
                _Pragma("unroll") for (int ks = 0; ks < 4; ++ks) vf[ks] = *(const GAS bf16x8*)(vb_ + 16 * ks); } while (0)
            GLA_LOAD_STAGE(0); GLA_LOAD_V(0);
            for (int n = 0; n < NCHUNK; ++n) {
                const size_t tok0 = (size_t)b * SEQ + (size_t)n * 64; const int bf = n & 1;
                LAS unsigned char* const KT = GLA_KT(bf); LAS unsigned char* const QT = GLA_QT(bf); LAS float* const DC = GLA_DC(bf);
                *(LAS v4u*)(KT + kdst0) = kst0; *(LAS v4u*)(KT + kdst1) = kst1; *(LAS v4u*)(QT + qdst0) = qst0; *(LAS v4u*)(QT + qdst1) = qst1;
                if (tid < 128) DC[tid] = dcs;
                __syncthreads();
                if (n + 1 < NCHUNK) GLA_LOAD_STAGE(n + 1);
#pragma unroll
                for (int m = 0; m < 4; ++m)
#pragma unroll
                    for (int g4 = 0; g4 < 4; ++g4) { const f32x4 d4 = *(const LAS f32x4*)(DC + 32 * m + 8 * g4 + 4 * hi);
                        Sacc[m][4 * g4 + 0] *= d4.x; Sacc[m][4 * g4 + 1] *= d4.y; Sacc[m][4 * g4 + 2] *= d4.z; Sacc[m][4 * g4 + 3] *= d4.w; }
#pragma unroll
                for (int m = 0; m < 4; ++m)
#pragma unroll
                    for (int ks = 0; ks < 4; ++ks) { const bf16x8 kf = *(const LAS bf16x8*)(KT + (32 * m + r32) * 144 + (16 * ks + 8 * hi) * 2);
                        Sacc[m] = __builtin_amdgcn_mfma_f32_32x32x16_bf16(kf, vf[ks], Sacc[m], 0, 0, 0); }
                if (n + 1 < NCHUNK) GLA_LOAD_V(n + 1);
                f32x16 ot[2];
#pragma unroll
                for (int nt = 0; nt < 2; ++nt)
#pragma unroll
                    for (int r = 0; r < 16; ++r) ot[nt][r] = 0.f;
#pragma unroll
                for (int m = 0; m < 4; ++m)
#pragma unroll
                    for (int sx = 0; sx < 2; ++sx) {
                        v4u ap; ap.x = pg8::cvt_pk_bf16(Sacc[m][8 * sx + 0], Sacc[m][8 * sx + 1]); ap.y = pg8::cvt_pk_bf16(Sacc[m][8 * sx + 2], Sacc[m][8 * sx + 3]);
                        ap.z = pg8::cvt_pk_bf16(Sacc[m][8 * sx + 4], Sacc[m][8 * sx + 5]); ap.w = pg8::cvt_pk_bf16(Sacc[m][8 * sx + 6], Sacc[m][8 * sx + 7]);
                        const bf16x8 af = __builtin_bit_cast(bf16x8, ap);
#pragma unroll
                        for (int nt = 0; nt < 2; ++nt) { const LAS unsigned char* qp = QT + (32 * nt + r32) * 264 + (32 * m + 16 * sx + 4 * hi) * 2;
                            const unsigned long long qlo = *(const LAS unsigned long long*)qp, qhi = *(const LAS unsigned long long*)(qp + 16);
                            v4u bp; bp.x = (unsigned)qlo; bp.y = (unsigned)(qlo >> 32); bp.z = (unsigned)qhi; bp.w = (unsigned)(qhi >> 32);
                            ot[nt] = __builtin_amdgcn_mfma_f32_32x32x16_bf16(af, __builtin_bit_cast(bf16x8, bp), ot[nt], 0, 0, 0); } }
#pragma unroll
                for (int nt = 0; nt < 2; ++nt) { float a = 0.f; const int c = 32 * nt + r32;
#pragma unroll
                    for (int r = 0; r < 16; ++r) a += ot[nt][r] * ot[nt][r];
                    a += __shfl_xor(a, 32);
                    if (hi == 0) GLA_SS[c * 8 + wave] = a;
#pragma unroll
                    for (int g4 = 0; g4 < 4; ++g4)
                        *(LAS unsigned long long*)(GLA_OS + c * 528 + (32 * wave + 8 * g4 + 4 * hi) * 2) = (unsigned long long)pg8::cvt_pk_bf16(ot[nt][4 * g4 + 0], ot[nt][4 * g4 + 1]) | ((unsigned long long)pg8::cvt_pk_bf16(ot[nt][4 * g4 + 2], ot[nt][4 * g4 + 3]) << 32); }
                __syncthreads();
#pragma unroll
                for (int i = 0; i < 4; ++i) { const int c = (tid >> 5) + 16 * i, ch = tid & 31;
                    *(GAS v4u*)(ORAW + (tok0 + c) * 1024 + h * 256 + ch * 8) = *(const LAS v4u*)(GLA_OS + c * 528 + ch * 16); }
                if (tid < 64) { float t = 0.f;
#pragma unroll
                    for (int w = 0; w < 8; ++w) t += GLA_SS[tid * 8 + w];
                    SSQ[(tok0 + tid) * 4 + h] = t; }
            }
#undef GLA_KT
#undef GLA_QT
#undef GLA_DC
#undef GLA_OS
#undef GLA_SS
#undef GLA_LOAD_STAGE
#undef GLA_LOAD_V
            __syncthreads();
            P2_FETCH(code);
            asm volatile("" : "=v"(Sm.qr[0]), "=v"(Sm.qr[1]), "=v"(Sm.qr[2]), "=v"(Sm.qr[3]), "=v"(Sm.qr[4]), "=v"(Sm.qr[5]), "=v"(Sm.qr[6]), "=v"(Sm.qr[7]), "=v"(Sm.st_v0), "=v"(Sm.st_v1), "=v"(Sm.st_k0), "=v"(Sm.st_k1));
          } else {
            fox::BlockRef<fox::bf16, fox::bf16> cur; P2_REF(cur, code);
            if (!primed) { P2_BIAS(code, bbuf); fox::causal_swa_prime<fox::bf16, fox::bf16>(cur, SEQ, lg, Sm, tidl); }
            int ncode; P2_FETCH(ncode);
            const bool nx_att = ncode >= 0 && (ncode % 66) >= 2;
            fox::BlockRef<fox::bf16, fox::bf16> nx = cur; if (nx_att) { P2_REF(nx, ncode); P2_BIAS(ncode, bbuf ^ 1); }
            asm volatile("" : "+s"(nx.K), "+s"(nx.V), "+s"(nx.Q));
            fox::causal_swa_block<fox::bf16, fox::bf16>(cur, nx, SEQ, SEQ, lg, Sm, bbuf, tidl);
            if (rep_ == 0) {
                const int ntc = 4 * (16 - ((code % 66 - 2) >> 2)); const int ncv = (ntc * (CV_ITEMS - CV_P1) + 17407) / 17408;
                if (tid == 0) QW[2] = (int)__hip_atomic_fetch_add(ctlq + 64 * 8, (unsigned)ncv, __ATOMIC_RELAXED, __HIP_MEMORY_SCOPE_AGENT);
                __syncthreads();
                const int cv0 = __builtin_amdgcn_readfirstlane(QW[2]); int cv1 = cv0 + ncv; if (cv1 > CV_ITEMS - CV_P1) cv1 = CV_ITEMS - CV_P1;
                const int wv = __builtin_amdgcn_readfirstlane(tidl >> 6), ln = tidl & 63;
                for (int it0 = cv0 + wv; it0 < cv1; it0 += NWAVES) conv_tile(CV_P1 + it0, PT, ln);
            }
            primed = nx_att; bbuf ^= 1; code = ncode;
          }
        }
#undef P2_FETCH
#undef P2_REF
#undef P2_BIAS
        }
    }
    SEAM(3);

    if (IN(4)) DUP(4) {
        bf16* const AO = (bf16*)(WSB + WS_AO); bf16* const PROJ = (bf16*)(WSB + WS_PROJ); const bf16* const ORAW = (const bf16*)(WSB + WS_H1B); const float* const SSQ = (const float*)(WSB + WS_TOKOF);
        const float* const g_gla_norm = INP(6);
        const int gw = vcu * NWAVES + wave, NGW = G * NWAVES;
        const f32x4 gn = *(const f32x4*)(g_gla_norm + 4 * lane);
        for (int m0 = gw; m0 < T_TOK; m0 += 4 * NGW) {
            f32x4 hs4[4]; unsigned long long ow[4][4], rw[4][4];
#pragma unroll
            for (int r = 0; r < 4; ++r) { const size_t mm = (size_t)(m0 + r * NGW); hs4[r] = *(const f32x4*)(SSQ + mm * 4);
                const GAS unsigned long long* orow = (const GAS unsigned long long*)(ORAW + mm * 1024) + lane; const GAS unsigned long long* rrow = (const GAS unsigned long long*)(PROJ + mm * PPITCH + C_GR) + lane;
#pragma unroll
                for (int j = 0; j < 4; ++j) { ow[r][j] = orow[64 * j]; rw[r][j] = rrow[64 * j]; } }
#pragma unroll
            for (int r = 0; r < 4; ++r) { GAS unsigned long long* drow = (GAS unsigned long long*)(AO + (size_t)(m0 + r * NGW) * 1024) + lane;
#pragma unroll
                for (int j = 0; j < 4; ++j) { const float tot = hs4[r][j] * (GLA_QSCALE * GLA_QSCALE); const float rs = GLA_QSCALE / sqrtf(tot * (1.0f / 256.0f) + LN_EPS);
                    const unsigned ol = (unsigned)ow[r][j], oh = (unsigned)(ow[r][j] >> 32), rl = (unsigned)rw[r][j], rh = (unsigned)(rw[r][j] >> 32);
                    const float r0 = pg8::bf_lo(rl), r1 = pg8::bf_hi(rl), r2 = pg8::bf_lo(rh), r3 = pg8::bf_hi(rh);
                    const float o0 = pg8::bf_lo(ol) * rs * gn.x * (r0 * pg8::sigm(r0)), o1 = pg8::bf_hi(ol) * rs * gn.y * (r1 * pg8::sigm(r1)), o2 = pg8::bf_lo(oh) * rs * gn.z * (r2 * pg8::sigm(r2)), o3 = pg8::bf_hi(oh) * rs * gn.w * (r3 * pg8::sigm(r3));
                    drow[64 * j] = (unsigned long long)pg8::cvt_pk_bf16(o0, o1) | ((unsigned long long)pg8::cvt_pk_bf16(o2, o3) << 32); } } }
    }
    SEAM(4);

    if (IN(5)) DUP(5) {
        bf16* const AO = (bf16*)(WSB + WS_AO); bf16* const WPROJ_T = (bf16*)(WSB + WS_WPROJ); bf16* const PROJ = (bf16*)(WSB + WS_PROJ); bf16* const MIXED = (bf16*)(WSB + WS_MIXED);
        pg8::Gemm g{AO, WPROJ_T, 2 * T_TOK, 2048, DM}; pg8::MixOrder S; S.init(T_TOK, DM, G, bx);
        pg8::EpiMix E{(const bf16*)(WSB + WS_ZIMG), MIXED};
        pg8::gemm_phase<pg8::EpiMix, pg8::MixOrder, true, true, false>(ldsl + RING_OFF, g, S, E);
    }
    SEAM(5);

    if (IN(6)) DUP(6) {
        bf16* const MIXED = (bf16*)(WSB + WS_MIXED); bf16* const WOUT_T = (bf16*)(WSB + WS_WOUT); float* const H1F = (float*)(WSB + WS_H1F);
        pg8::Gemm g{MIXED, WOUT_T, T_TOK, DM, DM}; pg8::StaticOrder S; S.init(T_TOK, DM, G, bx);
        pg8::EpiBf16<0> E{(bf16*)(WSB + WS_YS), DM, nullptr, 0, 0, 1.f};
        pg8::gemm_phase<pg8::EpiBf16<0>, pg8::StaticOrder, true, true, false>(ldsl + RING_OFF, g, S, E);
    }
    SEAM(6);

    if (IN(7)) {
        gu32* const ctl = (gu32*)(WSB + WS_CTL);
        bf16* const H1B = (bf16*)(WSB + WS_H1B); int* const TOKOF = (int*)(WSB + WS_TOKOF); int* const PAIR_E = (int*)(WSB + WS_PAIR); int* const PAIR_POS = PAIR_E + T_TOK * 4; float* const PAIR_G = (float*)(PAIR_POS + T_TOK * 4);
        const float* const x = INP(0); const float* const ln_in_g = INP(1); const float* const ln_in_b = INP(2); const float* const ln_mix_g = INP(11); const float* const ln_mix_b = INP(12);
        const float* const w_router = INP(13); const float* const b_router = INP(14); const bf16* const PRE = (const bf16*)(WSB + WS_YS);
        LAS float* const WRT = (LAS float*)(ldsl + RING_OFF);
        LAS float* const LOGT = (LAS float*)(ldsl + TBL_IDX) + wave * 64;
        LAS int* const HIST = (LAS int*)(ldsl + TBL_CNT); LAS int* const BASE = (LAS int*)(ldsl + TBL_CUM);
#pragma unroll 4
        for (int i = 0; i < 16; ++i) { const int p = tid + NTHR * i, e4 = p & 7, k = p >> 3; const f32x4 w = *(const GAS f32x4*)(w_router + 4 * p);
            WRT[(4 * e4 + 0) * 1024 + k] = w.x; WRT[(4 * e4 + 1) * 1024 + k] = w.y; WRT[(4 * e4 + 2) * 1024 + k] = w.z; WRT[(4 * e4 + 3) * 1024 + k] = w.w; }
        if (tid < 32) HIST[tid] = 0;
        __syncthreads();
        const int gw = vcu * NWAVES + wave, NGW = G * NWAVES;
        int te[4][4], tr[4][4]; float tgt[4][4];
        f32x4 vx[2][4]; unsigned long long vp[2][4];
#define ROW_LOAD(g_) do { _Pragma("unroll") for (int r = 0; r < 2; ++r) { const size_t mm = (size_t)(gw + (2 * (g_) + r) * NGW); const GAS f32x4* xr = (const GAS f32x4*)(x + mm * DM) + lane; const GAS unsigned long long* pr = (const GAS unsigned long long*)(PRE + mm * DM) + lane; \
            _Pragma("unroll") for (int j = 0; j < 4; ++j) { vx[r][j] = xr[64 * j]; vp[r][j] = pr[64 * j]; } } } while (0)
        ROW_LOAD(0);
#pragma unroll 1
        for (int g = 0; g < 4; ++g) {
            f32x4 z[2][4];
            {   f32x4 y[4];
#pragma unroll
                for (int r = 0; r < 2; ++r) { const size_t mm = (size_t)(gw + (2 * g + r) * NGW);
                    ln_row(vx[r], y, ln_in_g, ln_in_b, lane);
#pragma unroll
                    for (int j = 0; j < 4; ++j) { const unsigned wl = (unsigned)vp[r][j], wh = (unsigned)(vp[r][j] >> 32); y[j] = y[j] * DN_ALPHA + (f32x4){pg8::bf_lo(wl), pg8::bf_hi(wl), pg8::bf_lo(wh), pg8::bf_hi(wh)}; }
                    ln_row(y, z[r], ln_mix_g, ln_mix_b, lane);
                    store_row_bf16(H1B + mm * DM, z[r], lane); } }
            if (g < 3) ROW_LOAD(g + 1);
            float vals[64];
            typedef float f32x2r __attribute__((ext_vector_type(2)));
            f32x2r zz[4][4];
#pragma unroll
            for (int j = 0; j < 4; ++j) { zz[j][0] = (f32x2r){z[0][j].x, z[1][j].x}; zz[j][1] = (f32x2r){z[0][j].y, z[1][j].y}; zz[j][2] = (f32x2r){z[0][j].z, z[1][j].z}; zz[j][3] = (f32x2r){z[0][j].w, z[1][j].w}; }
#pragma unroll
            for (int e = 0; e < 32; ++e) { f32x2r a = {0.f, 0.f};
#pragma unroll
                for (int j = 0; j < 4; ++j) { const f32x4 w = *(const LAS f32x4*)(WRT + e * 1024 + 4 * lane + 256 * j);
                    a = __builtin_elementwise_fma(zz[j][0], (f32x2r){w.x, w.x}, a); a = __builtin_elementwise_fma(zz[j][1], (f32x2r){w.y, w.y}, a);
                    a = __builtin_elementwise_fma(zz[j][2], (f32x2r){w.z, w.z}, a); a = __builtin_elementwise_fma(zz[j][3], (f32x2r){w.w, w.w}, a); }
                vals[e] = a.x; vals[32 + e] = a.y; }
#define ROW_RED(S_, H_) _Pragma("unroll") for (int i = 0; i < (H_); ++i) { const bool up = (lane & (S_)) != 0; const float snd = up ? vals[i] : vals[i + (H_)], kp = up ? vals[i + (H_)] : vals[i]; vals[i] = kp + __shfl_xor(snd, (S_)); }
            ROW_RED(32, 32) ROW_RED(16, 16) ROW_RED(8, 8) ROW_RED(4, 4) ROW_RED(2, 2) ROW_RED(1, 1)
#undef ROW_RED
            float lv = vals[0] + b_router[lane & 31];
            int te_[4] = {0, 0, 0, 0}, tr_[4] = {0, 0, 0, 0}; float tg_[4] = {0.f, 0.f, 0.f, 0.f}, tv[4];
#pragma unroll
            for (int k = 0; k < 4; ++k) { float bv = lv; int bi = lane & 31;
#pragma unroll
                for (int s = 1; s < 32; s <<= 1) { const float ov = __shfl_xor(bv, s); const int oi = __shfl_xor(bi, s); const bool tk = (ov > bv) || (ov == bv && oi < bi); bv = tk ? ov : bv; bi = tk ? oi : bi; }
                tv[k] = bv; te_[k] = bi; if ((lane & 31) == bi) lv = -3.0e38f; }
            { float ssum = 0.f;
#pragma unroll
                for (int k = 0; k < 4; ++k) { tg_[k] = __expf(tv[k] - tv[0]); ssum += tg_[k]; }
                const float rs = 1.0f / ssum;
#pragma unroll
                for (int k = 0; k < 4; ++k) tg_[k] *= rs; }
            if ((lane & 31) == 0) {
#pragma unroll
                for (int k = 0; k < 4; ++k) tr_[k] = atomicAdd((int*)(HIST + te_[k]), 1); }
#pragma unroll
            for (int gg = 0; gg < 4; ++gg) if (gg == g) {
#pragma unroll
                for (int k = 0; k < 4; ++k) { te[gg][k] = te_[k]; tr[gg][k] = tr_[k]; tgt[gg][k] = tg_[k]; } }
        }
#undef ROW_LOAD
        __syncthreads();
        if (tid < 32) BASE[tid] = (int)__hip_atomic_fetch_add(ctl + CW_CNT + 64 * tid, (unsigned)HIST[tid], __ATOMIC_RELAXED, __HIP_MEMORY_SCOPE_AGENT);
        __syncthreads();
        if ((lane & 31) == 0) {
#pragma unroll
            for (int g = 0; g < 4; ++g) { const int t2 = gw + (2 * g + (lane >> 5)) * NGW;
#pragma unroll
                for (int k = 0; k < 4; ++k) { const int e = te[g][k], pos = BASE[e] + tr[g][k];
                    TOKOF[(size_t)e * T_TOK + pos] = t2; PAIR_E[t2 * 4 + k] = e; PAIR_POS[t2 * 4 + k] = pos; PAIR_G[t2 * 4 + k] = tgt[g][k]; } } }
    }
    SEAM(7);

#define GROUPED_PREP(NT_, GATHER_) do { \
        LAS int* CUM = (LAS int*)(ldsl + TBL_CUM); LAS int* CNT = (LAS int*)(ldsl + TBL_CNT); LAS int* DESC = (LAS int*)(ldsl + TBL_DESC); LAS int* IDX = (LAS int*)(ldsl + TBL_IDX); \
        if (tid == 0) { int c = 0; for (int e = 0; e < NE; ++e) { const int n = (int)__hip_atomic_load(ctl + CW_CNT + 64 * e, __ATOMIC_RELAXED, __HIP_MEMORY_SCOPE_AGENT); CNT[e] = n; CUM[e] = c; c += (n + 255) >> 8; } CUM[NE] = c; } \
        __syncthreads(); \
        if (tid < pg8::MAXU) { const int nwg = (NT_) * CUM[NE]; const long L = (long)tid * G + bx; int valid = 0, ab = 0, bb = 0, pn = 0, e = 0, pm = 0; \
            if (L < nwg) { int wgid = (int)L; { const int q = nwg / 8, r = nwg % 8, xcd = wgid % 8, off = wgid / 8; wgid = (xcd < r ? xcd * (q + 1) : r * (q + 1) + (xcd - r) * q) + off; } \
                while (e < NE - 1 && wgid >= (NT_) * CUM[e + 1]) ++e; \
                const int r2 = wgid - (NT_) * CUM[e], te_ = CUM[e + 1] - CUM[e]; pn = r2 / te_; pm = r2 % te_; ab = CUM[e] + pm; bb = e * (NT_) + pn; valid = 1; } \
            DESC[tid * 8 + 0] = valid; DESC[tid * 8 + 1] = ab; DESC[tid * 8 + 2] = bb; DESC[tid * 8 + 3] = pn; DESC[tid * 8 + 4] = e; DESC[tid * 8 + 5] = pm; } \
        __syncthreads(); \
        if (GATHER_) { for (int i = 0; i < pg8::MAXU; ++i) { if (DESC[i * 8] == 0) break; const int e = DESC[i * 8 + 4], pm = DESC[i * 8 + 5]; \
            if (tid < 256) { const int slot = pm * 256 + tid; IDX[i * 256 + tid] = slot < CNT[e] ? TOKOF[(size_t)e * T_TOK + slot] : 0; } } \
            __syncthreads(); } } while (0)
    if (IN(8)) DUP(8) {
        gu32* const ctl = (gu32*)(WSB + WS_CTL);
        int* const TOKOF = (int*)(WSB + WS_TOKOF); bf16* const H1B = (bf16*)(WSB + WS_H1B); bf16* const WGU_T = (bf16*)(WSB + WS_WGU); bf16* const ACT = (bf16*)(WSB + WS_ACT);
        const float* const b_gate_up = INP(16);
        GROUPED_PREP(8, true);
        pg8::Gemm g{H1B, WGU_T, T_TOK, 2048, DM}; pg8::GroupedOrder S{(const LAS int*)(ldsl + TBL_DESC), (const LAS int*)(ldsl + TBL_IDX)};
        pg8::EpiAct E{ACT, b_gate_up};
        pg8::gemm_phase<pg8::EpiAct, pg8::GroupedOrder, true, true, true>(ldsl + RING_OFF, g, S, E);
    }
#if (DUP_MASK >> 12) & 1
    if (IN(8)) {
        gu32* const ctl = (gu32*)(WSB + WS_CTL);
        int* const TOKOF = (int*)(WSB + WS_TOKOF); bf16* const H1B = (bf16*)(WSB + WS_H1B); bf16* const WGU_T = (bf16*)(WSB + WS_WGU); bf16* const ACT = (bf16*)(WSB + WS_ACT);
        const float* const b_gate_up = INP(16);
        GROUPED_PREP(8, true);
        pg8::Gemm g{H1B, WGU_T, T_TOK, 2048, DM}; pg8::GroupedOrder S{(const LAS int*)(ldsl + TBL_DESC), (const LAS int*)(ldsl + TBL_IDX)};
        pg8::EpiAct E{ACT, b_gate_up};
        pg8::gemm_phase<pg8::EpiAct, pg8::GroupedOrder, true, true, true>(ldsl + RING_OFF, g, S, E);
    }
#endif
    SEAM(8);
    if (IN(9)) DUP(9) {
        gu32* const ctl = (gu32*)(WSB + WS_CTL);
        bf16* const ACT = (bf16*)(WSB + WS_ACT); bf16* const WDN_T = (bf16*)(WSB + WS_WDN); bf16* const YS = (bf16*)(WSB + WS_YS);
        int* const TOKOF = nullptr;
        const float* const b_down = INP(18);
        GROUPED_PREP(4, false);
        pg8::Gemm g{ACT, WDN_T, SLOT_ROWS, 1024, DFF}; pg8::GroupedOrder S{(const LAS int*)(ldsl + TBL_DESC), (const LAS int*)(ldsl + TBL_IDX)};
        pg8::EpiDown E{YS, b_down};
        pg8::gemm_phase<pg8::EpiDown, pg8::GroupedOrder, true, true, false>(ldsl + RING_OFF, g, S, E);
    }
    SEAM(9);

    if (IN(10)) DUP(10) {
        gu32* const ctl = (gu32*)(WSB + WS_CTL);
        const bf16* const H1B = (const bf16*)(WSB + WS_H1B); int* const PAIR_E = (int*)(WSB + WS_PAIR); int* const PAIR_POS = PAIR_E + T_TOK * 4; float* const PAIR_G = (float*)(PAIR_POS + T_TOK * 4); bf16* const YS = (bf16*)(WSB + WS_YS);
        const float* const ln_ffn_g = INP(19); const float* const ln_ffn_b = INP(20);
        float* const out = (float*)ldptr(PT, 21);
        LAS int* CUM = (LAS int*)(ldsl + TBL_CUM);
        if (tid == 0) { int c = 0; for (int e = 0; e < NE; ++e) { const int n = (int)__hip_atomic_load(ctl + CW_CNT + 64 * e, __ATOMIC_RELAXED, __HIP_MEMORY_SCOPE_AGENT); CUM[e] = c; c += (n + 255) >> 8; } CUM[NE] = c; }
        __syncthreads();
        const int gw = vcu * NWAVES + wave, NGW = G * NWAVES;
        int pslot = 0; float pgate = 0.f;
        if (lane < 32) { const int q = (gw + (lane >> 2) * NGW) * 4 + (lane & 3); pslot = CUM[PAIR_E[q]] * 256 + PAIR_POS[q]; pgate = PAIR_G[q]; }
        for (int it = 0; it < 4; ++it) {
            f32x4 v[2][4], y[4]; unsigned long long yv[2][4][4]; float gk[2][4];
#pragma unroll
            for (int r = 0; r < 2; ++r) { const size_t mm = (size_t)(gw + (2 * it + r) * NGW); const GAS unsigned long long* hr = (const GAS unsigned long long*)(H1B + mm * DM) + lane;
#pragma unroll
                for (int j = 0; j < 4; ++j) { const unsigned long long w = hr[64 * j]; const unsigned wl = (unsigned)w, wh = (unsigned)(w >> 32); v[r][j] = (f32x4){pg8::bf_lo(wl), pg8::bf_hi(wl), pg8::bf_lo(wh), pg8::bf_hi(wh)}; }
#pragma unroll
                for (int k = 0; k < 4; ++k) { const int slot = __builtin_amdgcn_readfirstlane(__shfl(pslot, (2 * it + r) * 4 + k)); gk[r][k] = __shfl(pgate, (2 * it + r) * 4 + k);
                    const GAS unsigned long long* yr = (const GAS unsigned long long*)(YS + (size_t)slot * 1024) + lane;
#pragma unroll
                    for (int j = 0; j < 4; ++j) yv[r][k][j] = yr[64 * j]; } }
#pragma unroll
            for (int r = 0; r < 2; ++r) { const size_t mm = (size_t)(gw + (2 * it + r) * NGW);
#pragma unroll
                for (int j = 0; j < 4; ++j) v[r][j] = v[r][j] * DN_ALPHA;
#pragma unroll
                for (int k = 0; k < 4; ++k)
#pragma unroll
                    for (int j = 0; j < 4; ++j) { const unsigned long long w = yv[r][k][j]; const unsigned wl = (unsigned)w, wh = (unsigned)(w >> 32); const float g = gk[r][k];
                        v[r][j].x += g * pg8::bf_lo(wl); v[r][j].y += g * pg8::bf_hi(wl); v[r][j].z += g * pg8::bf_lo(wh); v[r][j].w += g * pg8::bf_hi(wh); }
                ln_row(v[r], y, ln_ffn_g, ln_ffn_b, lane);
                GAS f32x4* orow = (GAS f32x4*)(out + mm * DM) + lane;
#pragma unroll
                for (int j = 0; j < 4; ++j) orow[64 * j] = y[j]; } }
    }
    if (STAMP_K >= 0 && bx == 0 && tid == 0) { const unsigned long long t_end = __builtin_amdgcn_s_memrealtime(), dt = t_stamp_a - t_stamp_0; while (__builtin_amdgcn_s_memrealtime() - t_end < dt) __builtin_amdgcn_s_sleep(8); }
#undef IN
#undef INP
#undef WSB
#undef SEAM
#undef GROUPED_PREP
}

#ifndef MK_SPLIT
#define MK_SPLIT 0
#endif
extern "C" void kernel_launch(void* const* d_in, const int* in_sizes, int n_in, void* d_out, int out_size, void* d_ws, size_t ws_size, hipStream_t stream) {
    static int grid = 0;
    if (grid == 0) {
        if (n_in != 21 || in_sizes[0] != T_TOK * DM || out_size != T_TOK * DM || ws_size < WS_END) {
            fprintf(stderr, "kernel_launch: built for 21 inputs, x/out of %d floats, >= %zu bytes of workspace; got n_in %d, in0 %d, out %d, ws %zu; nothing launched\n", T_TOK * DM, (size_t)WS_END, n_in, n_in > 0 ? in_sizes[0] : -1, out_size, ws_size); grid = -1; return; }
        int dev = 0, cus = 0, per_cu = 0;
        if (hipGetDevice(&dev) != hipSuccess || hipDeviceGetAttribute(&cus, hipDeviceAttributeMultiprocessorCount, dev) != hipSuccess) { fprintf(stderr, "kernel_launch: device query failed\n"); grid = -1; return; }
        if (hipFuncSetAttribute((const void*)mega_fwd, hipFuncAttributeMaxDynamicSharedMemorySize, LDS_BYTES) != hipSuccess) { fprintf(stderr, "kernel_launch: hipFuncSetAttribute failed\n"); grid = -1; return; }
        if (hipOccupancyMaxActiveBlocksPerMultiprocessor(&per_cu, (const void*)mega_fwd, NTHR, LDS_BYTES) != hipSuccess || per_cu < 1) fprintf(stderr, "kernel_launch: occupancy query reports %d blocks per CU\n", per_cu);
        (void)hipGetLastError();
        grid = cus;
        if (grid != 256) { fprintf(stderr, "kernel_launch: this kernel's work split needs exactly 256 CUs, device has %d; nothing launched\n", grid); grid = -1; return; }
    }
    if (grid < 0) return;
    if (hipMemsetAsync((char*)d_ws + WS_CTL, 0, CTL_ZERO_BYTES, stream) != hipSuccess) { fprintf(stderr, "kernel_launch: hipMemsetAsync failed\n"); return; }
    Args a{};
    for (int i = 0; i < 21; ++i) a.in[i] = (const float*)d_in[i];
    a.out = (float*)d_out; a.ws = (unsigned char*)d_ws;
#if MK_SPLIT
    for (int p = 0; p < NPH; ++p) { a.ph_lo = p; a.ph_hi = p + 1; a.li = p; hipLaunchKernelGGL(mega_fwd, dim3(grid), dim3(NTHR), LDS_BYTES, stream, a); }
#else
    a.ph_lo = 0; a.ph_hi = NPH; a.li = 0;
    hipLaunchKernelGGL(mega_fwd, dim3(grid), dim3(NTHR), LDS_BYTES, stream, a);
#endif
    const hipError_t le = hipPeekAtLastError();
    if (le != hipSuccess) fprintf(stderr, "kernel_launch: launch failed: %s\n", hipGetErrorName(le));
}
```

```cpp
#define DUP_MASK 0
#include <hip/hip_runtime.h>
#include <hip/hip_bf16.h>
#include <cstdio>
#include <cstdint>
#include <cmath>
namespace pg8 {
#define PG8_LAS __attribute__((address_space(3)))
typedef unsigned short bf16_t;
typedef short bf16x8 __attribute__((ext_vector_type(8)));
typedef float f32x4 __attribute__((ext_vector_type(4)));
typedef unsigned u32x4 __attribute__((ext_vector_type(4)));
constexpr int BM = 256, BK = 64, HALF = 128, HTB = HALF * BK * 2  , STAGE_BYTES = 8 * HTB, NXCD = 8, WGM = 8;

__host__ __device__ __forceinline__ int lds_byte(int r, int c) { const int st = (r >> 4) * 2 + (c >> 5), rr = r & 15, cc = c & 31, ob = rr * 64 + cc * 2; return st * 1024 + (ob ^ (((ob >> 9) & 1) << 5)); }
__host__ __device__ __forceinline__ void stage_rc(int b, int& R, int& C) { const int st = b / 1024, sb = b % 1024, swz = sb ^ (((sb >> 9) & 1) << 5); R = (st >> 1) * 16 + swz / 64; C = (st & 1) * 32 + (swz % 64) / 2; }
__host__ __device__ __forceinline__ int perm32(int rho) { const int n = rho >> 4, i = rho & 15; return 8 * (i >> 2) + 4 * n + (i & 3); }

struct Unit { int pm, pn, ab, bb, aux; };
struct Gemm { const bf16_t* A; const bf16_t* Bt; int M, N, K; };

struct StaticOrder {
    int nM, nN, nwg, G, c;
    __host__ __device__ void init(int M, int N, int G_, int c_) { nM = M / BM; nN = N / BM; nwg = nM * nN; G = G_; c = c_; }
    __host__ __device__ bool next(int i, Unit& u) const {
        const long L = (long)i * G + c; if (L >= nwg) return false;
        int wgid = (int)L; { const int q = nwg / NXCD, r = nwg % NXCD, xcd = wgid % NXCD, off = wgid / NXCD; wgid = (xcd < r ? xcd * (q + 1) : r * (q + 1) + (xcd - r) * q) + off; }
        const int nig = WGM * nN, gid = wgid / nig, fm = gid * WGM, gsz = (nM - fm) < WGM ? (nM - fm) : WGM;
        u.pm = fm + ((wgid % nig) % gsz); u.pn = (wgid % nig) / gsz; u.ab = u.pm; u.bb = u.pn; u.aux = 0; return true;
    }
    __device__ __forceinline__ void a_ready(const Unit&) const {}
    __device__ __forceinline__ void done(const Unit&) const {}
    __device__ __forceinline__ const PG8_LAS int* rowidx(int) const { return nullptr; }
};

__device__ __forceinline__ unsigned cvt_pk_bf16(float lo, float hi) { unsigned r; asm volatile("v_cvt_pk_bf16_f32 %0, %1, %2" : "=v"(r) : "v"(lo), "v"(hi)); return r; }
typedef float f32x2 __attribute__((ext_vector_type(2)));
__device__ __forceinline__ f32x2 gelu_pk(f32x2 v) {
    const f32x2 av = __builtin_elementwise_abs(v), d = av * 0.2316418882f + 1.0f;
    f32x2 t; t.x = __builtin_amdgcn_rcpf(d.x); t.y = __builtin_amdgcn_rcpf(d.y);
    f32x2 q = t * 0.5307027145f + (-0.7265760135f); q = q * t + 0.7107068705f; q = q * t + (-0.142248368f); q = q * t + 0.127414796f; q = q * t;
    const f32x2 s = (v * v) * (-0.72134752044f);
    f32x2 e; e.x = __builtin_amdgcn_exp2f(s.x); e.y = __builtin_amdgcn_exp2f(s.y);
    const f32x2 m = v * (q * e), r = v - m;
    f32x2 o; o.x = v.x < 0.f ? m.x : r.x; o.y = v.y < 0.f ? m.y : r.y; return o;
}

template <int ACT  > struct EpiBf16 {
    static constexpr bool PERM = true, AFTER_DRAIN = false; static_assert(ACT == 0 || ACT == 1, "EpiBf16: ACT is 0 (none) or 1 (gelu_pk)");
    bf16_t* O; int ldc; const float* bias; int split_cols; size_t split_stride; float scale0;
    __device__ __forceinline__ void operator()(const f32x4 (&acc)[2][2][4][2], const Unit& u, int wr, int wc, int fr, int fq) const {
        const int row0 = u.pm * BM + wr * 64 + fr; int colt = u.pn * BM; bf16_t* base = O;
        float sc = 1.f; if (split_cols) { const int t = colt / split_cols; base += (size_t)t * split_stride; colt -= t * split_cols; if (t == 0) sc = scale0; }
        const int col0 = colt + wc * 32 + 8 * fq, bcol0 = u.pn * BM + wc * 32 + 8 * fq;
        f32x4 bv[2][2];
#pragma unroll
        for (int bj = 0; bj < 2; ++bj)
#pragma unroll
            for (int n = 0; n < 2; ++n) bv[bj][n] = bias ? *(const f32x4*)(bias + bcol0 + bj * HALF + 4 * n) : (f32x4){0.f, 0.f, 0.f, 0.f};
#pragma unroll
        for (int ai = 0; ai < 2; ++ai)
#pragma unroll
            for (int m = 0; m < 4; ++m) { bf16_t* rowp = base + (size_t)(row0 + ai * HALF + m * 16) * ldc + col0;
#pragma unroll
                for (int bj = 0; bj < 2; ++bj) { f32x4 v0 = acc[ai][bj][m][0] + bv[bj][0], v1 = acc[ai][bj][m][1] + bv[bj][1];
                    if (ACT == 1) { f32x2 a = gelu_pk((f32x2){v0[0], v0[1]}), b = gelu_pk((f32x2){v0[2], v0[3]}), c = gelu_pk((f32x2){v1[0], v1[1]}), d = gelu_pk((f32x2){v1[2], v1[3]});
                        v0 = (f32x4){a.x, a.y, b.x, b.y}; v1 = (f32x4){c.x, c.y, d.x, d.y}; }
                    v0 = v0 * sc; v1 = v1 * sc; u32x4 w; w.x = cvt_pk_bf16(v0[0], v0[1]); w.y = cvt_pk_bf16(v0[2], v0[3]); w.z = cvt_pk_bf16(v1[0], v1[1]); w.w = cvt_pk_bf16(v1[2], v1[3]);
                    *(u32x4*)(rowp + bj * HALF) = w; } }
    }
};

struct PanelStats {
    unsigned* xbuf;
    unsigned* cnt;
    unsigned* tmo;
    int ntn; float eps;
    unsigned code;
    __device__ __forceinline__ bool run(const f32x4 (&v)[2][2][4][2], const Unit& u, int wr, int wc, int fr, int fq, PG8_LAS unsigned char* lds, int wid, int lane) const {
        typedef float f32x2v __attribute__((ext_vector_type(2)));
        PG8_LAS f32x2v* P = (PG8_LAS f32x2v*)lds;
        PG8_LAS f32x2v* S = (PG8_LAS f32x2v*)(lds + 8192);
        PG8_LAS unsigned* flag = (PG8_LAS unsigned*)(lds + 8192 + 2048);
#pragma unroll
        for (int ai = 0; ai < 2; ++ai)
#pragma unroll
            for (int m = 0; m < 4; ++m) {
                float s = 0.f;
#pragma unroll
                for (int bj = 0; bj < 2; ++bj)
#pragma unroll
                    for (int n = 0; n < 2; ++n) { const f32x4 x = v[ai][bj][m][n]; s += (x[0] + x[1]) + (x[2] + x[3]); }
                s += __shfl_xor(s, 16); s += __shfl_xor(s, 32);
                const float mw = s * (1.0f / 64.0f); float q = 0.f;
#pragma unroll
                for (int bj = 0; bj < 2; ++bj)
#pragma unroll
                    for (int n = 0; n < 2; ++n) { const f32x4 d = v[ai][bj][m][n] - mw; q += (d[0] * d[0] + d[1] * d[1]) + (d[2] * d[2] + d[3] * d[3]); }
                q += __shfl_xor(q, 16); q += __shfl_xor(q, 32);
                if (fq == 0) P[(ai * HALF + wr * 64 + m * 16 + fr) * 4 + wc] = (f32x2v){mw, q};
            }
        asm volatile("s_waitcnt lgkmcnt(0)" ::: "memory"); __builtin_amdgcn_s_barrier(); asm volatile("" ::: "memory");
#if defined(BROKEN_EXCHANGE_NO_WAIT)
#warning BROKEN CONTROL BUILD: the row-statistics exchange does not wait; results are wrong by design
        if (blockIdx.x >= 64) { const long long t0_ = clock64(); while (clock64() - t0_ < 60000) __builtin_amdgcn_s_sleep(8); }
#endif
        const int row = wid * 32 + (lane & 31);
        if (lane < 32) {
            const f32x2v a = P[row * 4 + 0], b = P[row * 4 + 1], c = P[row * 4 + 2], d = P[row * 4 + 3];
            const float mt = (a.x + b.x + c.x + d.x) * 0.25f;
            const float da = a.x - mt, db = b.x - mt, dc = c.x - mt, dd = d.x - mt;
            const float m2 = (a.y + b.y) + (c.y + d.y) + 64.0f * ((da * da + db * db) + (dc * dc + dd * dd));
            unsigned long long* slot = (unsigned long long*)xbuf + ((size_t)(u.pm * BM + row) * 4 + u.pn);
            __hip_atomic_store(slot, ((unsigned long long)__float_as_uint(m2) << 32) | __float_as_uint(mt), __ATOMIC_RELAXED, __HIP_MEMORY_SCOPE_AGENT);
        }
        asm volatile("s_waitcnt vmcnt(0)" ::: "memory");
        if (lane == 0) __hip_atomic_fetch_add(cnt + 64 * u.pm, 1u, __ATOMIC_RELAXED, __HIP_MEMORY_SCOPE_AGENT);
        if (wid == 0) {
            bool dead = false; const unsigned long long t0 = __builtin_amdgcn_s_memrealtime(); const unsigned want = 8u * (unsigned)ntn;
            for (;;) {
#if defined(BROKEN_EXCHANGE_NO_WAIT)
                break;
#endif
                if ((unsigned)__builtin_amdgcn_readfirstlane(__hip_atomic_load(cnt + 64 * u.pm, __ATOMIC_RELAXED, __HIP_MEMORY_SCOPE_AGENT)) >= want) break;
                if (__builtin_amdgcn_s_memrealtime() - t0 > 2000000ull) {
                    if (lane == 0) { unsigned expect = 0u; __hip_atomic_compare_exchange_strong(tmo + 1, &expect, code | (unsigned)(u.pm & 0xff), __ATOMIC_RELAXED, __ATOMIC_RELAXED, __HIP_MEMORY_SCOPE_AGENT);
                                     __hip_atomic_store(tmo, 1u, __ATOMIC_RELAXED, __HIP_MEMORY_SCOPE_AGENT); }
                    dead = true; break; }
                __builtin_amdgcn_s_sleep(2);
            }
            __builtin_amdgcn_fence(__ATOMIC_ACQUIRE, "agent");
            if (lane == 0) flag[0] = dead ? 1u : 0u;
        }
        asm volatile("s_waitcnt vmcnt(0) lgkmcnt(0)" ::: "memory"); __builtin_amdgcn_s_barrier(); asm volatile("" ::: "memory");
        const bool bad = flag[0] != 0u;
        if (lane < 32) {
            const unsigned long long* slot = (const unsigned long long*)xbuf + (size_t)(u.pm * BM + row) * 4; float mt[4], m2[4]; float ms = 0.f;
#pragma unroll
            for (int t = 0; t < 4; ++t) { if (t < ntn) { const unsigned long long w = __hip_atomic_load(slot + t, __ATOMIC_RELAXED, __HIP_MEMORY_SCOPE_AGENT); mt[t] = __uint_as_float((unsigned)w); m2[t] = __uint_as_float((unsigned)(w >> 32)); } else { mt[t] = 0.f; m2[t] = 0.f; } ms += mt[t]; }
            const float mean = ms / (float)ntn; float q = 0.f;
#pragma unroll
            for (int t = 0; t < 4; ++t) if (t < ntn) { const float dm = mt[t] - mean; q += m2[t] + 256.0f * dm * dm; }
            S[row] = (f32x2v){mean, 1.0f / sqrtf(q / (256.0f * (float)ntn) + eps)};
        }
        asm volatile("s_waitcnt lgkmcnt(0)" ::: "memory"); __builtin_amdgcn_s_barrier(); asm volatile("" ::: "memory");
        return bad;
    }
};
struct EpiLnRes {
    static constexpr bool PERM = false, AFTER_DRAIN = true;
    const float* base; float* out; int ldc; const float* bias; PanelStats st; unsigned poison;
    __device__ __forceinline__ void fused(f32x4 (&acc)[2][2][4][2], const Unit& u, int wr, int wc, int fr, int fq, PG8_LAS unsigned char* lds, int wid, int lane) const {
        typedef float f32x2v __attribute__((ext_vector_type(2)));
        const PG8_LAS f32x2v* S = (const PG8_LAS f32x2v*)(lds + 8192);
        const int col0 = u.pn * BM + wc * 32 + 4 * fq;
#pragma unroll
        for (int bj = 0; bj < 2; ++bj)
#pragma unroll
            for (int n = 0; n < 2; ++n) { const f32x4 bv = bias ? *(const f32x4*)(bias + col0 + bj * HALF + n * 16) : (f32x4){0.f, 0.f, 0.f, 0.f};
#pragma unroll
                for (int ai = 0; ai < 2; ++ai)
#pragma unroll
                    for (int m = 0; m < 4; ++m) acc[ai][bj][m][n] += bv; }
        f32x4 pre[4][2][2];
#pragma unroll
        for (int m = 0; m < 4; ++m) { const size_t off = (size_t)(u.pm * BM + wr * 64 + m * 16 + fr) * ldc + col0;
#pragma unroll
            for (int bj = 0; bj < 2; ++bj)
#pragma unroll
                for (int n = 0; n < 2; ++n) pre[m][bj][n] = *(const f32x4*)(base + off + bj * HALF + n * 16); }
        const bool bad = st.run(acc, u, wr, wc, fr, fq, lds, wid, lane) || poison != 0u;
        const float qnan = __builtin_nanf("");
#pragma unroll
        for (int ai = 0; ai < 2; ++ai)
#pragma unroll
            for (int m = 0; m < 4; ++m) { const int r = ai * HALF + wr * 64 + m * 16 + fr; const f32x2v sr = S[r]; const size_t off = (size_t)(u.pm * BM + r) * ldc + col0;
#pragma unroll
                for (int bj = 0; bj < 2; ++bj)
#pragma unroll
                    for (int n = 0; n < 2; ++n) { const f32x4 bs = ai == 0 ? pre[m][bj][n] : *(const f32x4*)(base + off + bj * HALF + n * 16); f32x4 o = bs + (acc[ai][bj][m][n] - sr.x) * sr.y;
                        if (bad) o = (f32x4){qnan, qnan, qnan, qnan}; *(f32x4*)(out + off + bj * HALF + n * 16) = o; }
                if (m & 1) asm volatile("" ::: "memory"); }
    }
};
struct EpiLnResLn {
    static constexpr bool PERM = false, AFTER_DRAIN = true;
    const float* base; float* out; bf16_t* xn; int ldc; const float* bias; PanelStats st1, st2; unsigned poison;
    __device__ __forceinline__ void fused(f32x4 (&acc)[2][2][4][2], const Unit& u, int wr, int wc, int fr, int fq, PG8_LAS unsigned char* lds, int wid, int lane) const {
        typedef float f32x2v __attribute__((ext_vector_type(2))); typedef unsigned u32x2v __attribute__((ext_vector_type(2)));
        const PG8_LAS f32x2v* S = (const PG8_LAS f32x2v*)(lds + 8192);
        const int col0 = u.pn * BM + wc * 32 + 4 * fq;
#pragma unroll
        for (int bj = 0; bj < 2; ++bj)
#pragma unroll
            for (int n = 0; n < 2; ++n) { const f32x4 bv = bias ? *(const f32x4*)(bias + col0 + bj * HALF + n * 16) : (f32x4){0.f, 0.f, 0.f, 0.f};
#pragma unroll
                for (int ai = 0; ai < 2; ++ai)
#pragma unroll
                    for (int m = 0; m < 4; ++m) acc[ai][bj][m][n] += bv; }
        bool bad = st1.run(acc, u, wr, wc, fr, fq, lds, wid, lane) || poison != 0u;
        const float qnan = __builtin_nanf("");
#pragma unroll
        for (int ai = 0; ai < 2; ++ai)
#pragma unroll
            for (int m = 0; m < 4; ++m) { const int r = ai * HALF + wr * 64 + m * 16 + fr; const f32x2v sr = S[r]; const size_t off = (size_t)(u.pm * BM + r) * ldc + col0;
#pragma unroll
                for (int bj = 0; bj < 2; ++bj)
#pragma unroll
                    for (int n = 0; n < 2; ++n) { const f32x4 bs = *(const f32x4*)(base + off + bj * HALF + n * 16); acc[ai][bj][m][n] = bs + (acc[ai][bj][m][n] - sr.x) * sr.y; }
                asm volatile("" : "+v"(acc[ai][0][m][0]), "+v"(acc[ai][0][m][1]), "+v"(acc[ai][1][m][0]), "+v"(acc[ai][1][m][1]));
                if (m & 1) asm volatile("" ::: "memory"); }
        const bool bad1 = bad;
        bad = st2.run(acc, u, wr, wc, fr, fq, lds, wid, lane) || bad;
#pragma unroll
        for (int ai = 0; ai < 2; ++ai)
#pragma unroll
            for (int m = 0; m < 4; ++m) { const int r = ai * HALF + wr * 64 + m * 16 + fr; const f32x2v sr = S[r]; const size_t off = (size_t)(u.pm * BM + r) * ldc + col0;
#pragma unroll
                for (int bj = 0; bj < 2; ++bj)
#pragma unroll
                    for (int n = 0; n < 2; ++n) { const f32x4 x1 = acc[ai][bj][m][n]; *(f32x4*)(out + off + bj * HALF + n * 16) = bad1 ? (f32x4){qnan, qnan, qnan, qnan} : x1;
                        const f32x4 o = (x1 - sr.x) * sr.y; u32x2v w; w.x = cvt_pk_bf16(o[0], o[1]); w.y = cvt_pk_bf16(o[2], o[3]);
                        if (bad) { w.x = 0x7fc07fc0u; w.y = 0x7fc07fc0u; } *(u32x2v*)(xn + off + bj * HALF + n * 16) = w; }
                asm volatile("" ::: "memory"); }
    }
};

template <class E, class = void> struct epi_chains { static constexpr bool value = false; };
template <class E> struct epi_chains<E, decltype((void)E::CHAIN)> { static constexpr bool value = E::CHAIN; };
template <class Epi, class Sched, bool ALIGN_EPI = false, bool SP2 = false, bool GATHER = false>
__device__ __forceinline__ void gemm_phase(PG8_LAS unsigned char* lds, const Gemm g, const Sched& S, const Epi& E) {
    const int tid = threadIdx.x, wid = __builtin_amdgcn_readfirstlane(tid >> 6), lane = tid & 63, wr = wid >> 2, wc = wid & 3, fr = lane & 15, fq = lane >> 4;
    const int K = g.K, nt = K / BK;
    unsigned voffA[2], voffB[2]; int gR[2], gC[2];
#pragma unroll
    for (int i = 0; i < 2; ++i) { int R, C; stage_rc(tid * 16 + i * 8192, R, C); const int Rb = Epi::PERM ? ((R & ~31) + perm32(R & 31)) : R;
        voffA[i] = (unsigned)(R * K + C) * 2u; voffB[i] = (unsigned)(Rb * K + C) * 2u; gR[i] = R; gC[i] = C; }
    const size_t kstep = (size_t)(BK * 2);
    const size_t hstep = (size_t)HALF * K * 2;
    const size_t tstep = 2 * hstep;
    const unsigned ldsw = (unsigned)wid * 1024u;
    const int aoff = lds_byte(wr * 64 + fr, fq * 8), boff = lds_byte(wc * 32 + fr, fq * 8);
#define PG8_SA(b, h) (((b) * 2 + (h)) * HTB)
#define PG8_SB(b, h) ((4 + (b) * 2 + (h)) * HTB)
#define PG8_STAGE(bufoff, gbase, voff) do { _Pragma("unroll") for (int _i = 0; _i < 2; ++_i) \
        __builtin_amdgcn_global_load_lds((const unsigned*)((const char*)(gbase) + (voff)[_i]), (PG8_LAS unsigned*)(lds + (bufoff) + ldsw + _i * 8192), 16, 0, 0); } while (0)
#define PG8_STAGE_A(bufoff, gbase, h, nx) do { const unsigned _v0 = GATHER ? ((nx) ? vaN[h][0] : vaC[h][0]) : voffA[0], _v1 = GATHER ? ((nx) ? vaN[h][1] : vaC[h][1]) : voffA[1]; \
        const char* _gb = (const char*)(gbase) + (GATHER ? (size_t)0 : (size_t)(h) * hstep); \
        __builtin_amdgcn_global_load_lds((const unsigned*)(_gb + _v0), (PG8_LAS unsigned*)(lds + (bufoff) + ldsw), 16, 0, 0); \
        __builtin_amdgcn_global_load_lds((const unsigned*)(_gb + _v1), (PG8_LAS unsigned*)(lds + (bufoff) + ldsw + 8192), 16, 0, 0); } while (0)
#define PG8_LOADVA(va, uix) do { const PG8_LAS int* _ip = S.rowidx(uix); _Pragma("unroll") for (int _h = 0; _h < 2; ++_h) _Pragma("unroll") for (int _i = 0; _i < 2; ++_i) \
        va[_h][_i] = ((unsigned)_ip[_h * HALF + gR[_i]] * (unsigned)K + (unsigned)gC[_i]) * 2u; } while (0)
#define PG8_LDA(dst, b, h) do { _Pragma("unroll") for (int m = 0; m < 4; ++m) _Pragma("unroll") for (int k = 0; k < 2; ++k) dst[m][k] = *(const PG8_LAS bf16x8*)(lds + PG8_SA(b, h) + aoff + m * 2048 + k * 1024); } while (0)
#define PG8_LDB(dst, b, h) do { _Pragma("unroll") for (int n = 0; n < 2; ++n) _Pragma("unroll") for (int k = 0; k < 2; ++k) dst[n][k] = *(const PG8_LAS bf16x8*)(lds + PG8_SB(b, h) + boff + n * 2048 + k * 1024); } while (0)
#define PG8_MMA(ai, bj, At, Bt) do { __builtin_amdgcn_s_setprio(1); _Pragma("unroll") for (int m = 0; m < 4; ++m) _Pragma("unroll") for (int n = 0; n < 2; ++n) _Pragma("unroll") for (int k = 0; k < 2; ++k) \
        acc[ai][bj][m][n] = __builtin_amdgcn_mfma_f32_16x16x32_bf16(Bt[n][k], At[m][k], acc[ai][bj][m][n], 0, 0, 0); __builtin_amdgcn_s_setprio(0); } while (0)
#define PG8_WAIT_V(n) asm volatile("s_waitcnt vmcnt(" #n ")" ::: "memory")
#define PG8_WAIT_L(n) asm volatile("s_waitcnt lgkmcnt(" #n ")" ::: "memory")
#define PG8_BAR __builtin_amdgcn_s_barrier()
#define PG8_SCHED __builtin_amdgcn_sched_barrier(0)
    Unit cur, nxt; int ui = 0;
    static_assert(SP2, "only the SP2 loop is kept in this file");
    if (!S.next(0, cur)) return;
    f32x4 acc[2][2][4][2];
#pragma unroll
    for (int a = 0; a < 2; ++a)
#pragma unroll
        for (int b = 0; b < 2; ++b)
#pragma unroll
            for (int m = 0; m < 4; ++m)
#pragma unroll
                for (int n = 0; n < 2; ++n) acc[a][b][m][n] = (f32x4){0.f, 0.f, 0.f, 0.f};
    bf16x8 At[4][2], B0[2][2], B1[2][2];
    const char* cA = (const char*)g.A + (GATHER ? (size_t)0 : (size_t)cur.ab * tstep); const char* cB = (const char*)g.Bt + (size_t)cur.bb * tstep;
    unsigned vaC[2][2] = {{0u, 0u}, {0u, 0u}}, vaN[2][2] = {{0u, 0u}, {0u, 0u}};
    if constexpr (GATHER) { PG8_LOADVA(vaC, 0); }
    S.a_ready(cur);
    if constexpr (SP2) {
        PG8_STAGE(PG8_SB(0, 0), cB, voffB); PG8_STAGE(PG8_SB(0, 1), cB + hstep, voffB); PG8_STAGE_A(PG8_SA(0, 0), cA, 0, false); PG8_STAGE_A(PG8_SA(0, 1), cA, 1, false);
        if (wr == 1) PG8_BAR;
        PG8_WAIT_V(2); PG8_BAR;
        PG8_STAGE(PG8_SB(1, 0), cB + kstep, voffB); PG8_STAGE_A(PG8_SA(1, 0), cA + kstep, 0, false); PG8_STAGE(PG8_SB(1, 1), cB + hstep + kstep, voffB);
        PG8_WAIT_V(6); PG8_BAR;
    }
    for (;;) {
        const bool has_next = S.next(ui + 1, nxt);
        const char* nA = (has_next && !GATHER) ? (const char*)g.A + (size_t)nxt.ab * tstep : cA; const char* nB = has_next ? (const char*)g.Bt + (size_t)nxt.bb * tstep : cB;
        if constexpr (GATHER) { if (has_next) { PG8_LOADVA(vaN, ui + 1); } else { vaN[0][0] = vaC[0][0]; vaN[0][1] = vaC[0][1]; vaN[1][0] = vaC[1][0]; vaN[1][1] = vaC[1][1]; } }
        for (int t = 0; t < nt; t += 2) {
            const bool last = (t == nt - 2);
            const char* a1 = cA + (size_t)(t + 1) * kstep;
            const char* a2 = last ? nA : cA + (size_t)(t + 2) * kstep; const char* b2 = last ? nB : cB + (size_t)(t + 2) * kstep;
            const char* a3 = a2 + kstep; const char* b3 = b2 + kstep;
            if (last && has_next) S.a_ready(nxt);
            if constexpr (SP2) {
            PG8_LDB(B0, 0, 0); PG8_LDB(B1, 0, 1); PG8_SCHED; PG8_LDA(At, 0, 0); PG8_STAGE_A(PG8_SA(1, 1), a1, 1, false);
            PG8_WAIT_V(8); PG8_WAIT_L(0); PG8_BAR; PG8_MMA(0, 0, At, B0); PG8_MMA(0, 1, At, B1); PG8_BAR; PG8_SCHED;
            PG8_LDA(At, 0, 1); PG8_STAGE(PG8_SB(0, 0), b2, voffB); PG8_STAGE(PG8_SB(0, 1), b2 + hstep, voffB); PG8_STAGE_A(PG8_SA(0, 0), a2, 0, last);
            PG8_WAIT_V(8); PG8_WAIT_L(0); PG8_BAR; PG8_MMA(1, 0, At, B0); PG8_MMA(1, 1, At, B1); PG8_BAR; PG8_SCHED;
            PG8_LDB(B0, 1, 0); PG8_LDB(B1, 1, 1); PG8_SCHED; PG8_LDA(At, 1, 0); PG8_STAGE_A(PG8_SA(0, 1), a2, 1, last);
            PG8_WAIT_V(8); PG8_WAIT_L(0); PG8_BAR; PG8_MMA(0, 0, At, B0); PG8_MMA(0, 1, At, B1); PG8_BAR; PG8_SCHED;
            PG8_LDA(At, 1, 1); PG8_STAGE(PG8_SB(1, 0), b3, voffB); PG8_STAGE(PG8_SB(1, 1), b3 + hstep, voffB); PG8_STAGE_A(PG8_SA(1, 0), a3, 0, last);
            PG8_WAIT_V(8); PG8_WAIT_L(0); PG8_BAR; PG8_MMA(1, 0, At, B0); PG8_MMA(1, 1, At, B1); PG8_BAR; PG8_SCHED;
            }
        }
        if constexpr (ALIGN_EPI) { if (wr == 0) PG8_BAR; }
        if constexpr (!Epi::AFTER_DRAIN) { E(acc, cur, wr, wc, fr, fq); S.done(cur); }
        if (!has_next) break;
        if (!epi_chains<Epi>::value || cur.aux != 0) {
#pragma unroll
        for (int a = 0; a < 2; ++a)
#pragma unroll
            for (int b = 0; b < 2; ++b)
#pragma unroll
                for (int m = 0; m < 4; ++m)
#pragma unroll
                    for (int n = 0; n < 2; ++n) acc[a][b][m][n] = (f32x4){0.f, 0.f, 0.f, 0.f};
        }
        cur = nxt; cA = nA; cB = nB; ++ui;
        if constexpr (GATHER) { vaC[0][0] = vaN[0][0]; vaC[0][1] = vaN[0][1]; vaC[1][0] = vaN[1][0]; vaC[1][1] = vaN[1][1]; }
        if constexpr (ALIGN_EPI) { if (wr == 1) PG8_BAR; }
    }
    PG8_WAIT_V(0);
    if constexpr (!ALIGN_EPI) { if (wr == 0) PG8_BAR; }
    PG8_BAR;
    if constexpr (Epi::AFTER_DRAIN) { E.fused(acc, cur, wr, wc, fr, fq, lds, wid, lane); S.done(cur); }
#undef PG8_SA
#undef PG8_SB
#undef PG8_STAGE
#undef PG8_STAGE_A
#undef PG8_LOADVA
#undef PG8_LDA
#undef PG8_LDB
#undef PG8_MMA
#undef PG8_WAIT_V
#undef PG8_WAIT_L
#undef PG8_BAR
#undef PG8_SCHED
}
}
namespace pg8 {
__device__ __forceinline__ float bf_lo(unsigned w) { return __uint_as_float(w << 16); }
__device__ __forceinline__ float bf_hi(unsigned w) { return __uint_as_float(w & 0xffff0000u); }
__device__ __forceinline__ float sigm(float x) { return __builtin_amdgcn_rcpf(1.0f + __expf(-x)); }

struct EpiF32 {
    static constexpr bool PERM = false, AFTER_DRAIN = false;
    float* C; int ldc;
    __device__ __forceinline__ void operator()(const f32x4 (&acc)[2][2][4][2], const Unit& u, int wr, int wc, int fr, int fq) const {
        const int row0 = u.pm * BM + wr * 64 + fr, col0 = u.pn * BM + wc * 32 + 4 * fq;
#pragma unroll
        for (int ai = 0; ai < 2; ++ai)
#pragma unroll
            for (int m = 0; m < 4; ++m) { float* rowp = C + (size_t)(row0 + ai * HALF + m * 16) * ldc + col0;
#pragma unroll
                for (int bj = 0; bj < 2; ++bj)
#pragma unroll
                    for (int n = 0; n < 2; ++n) *(f32x4*)(rowp + bj * HALF + n * 16) = acc[ai][bj][m][n]; }
    }
};

struct EpiProj {
    static constexpr bool PERM = true, AFTER_DRAIN = false;
    bf16_t* O; float* SMp; bf16_t* QKV; bf16_t* ZIMG;
    __device__ __forceinline__ void operator()(const f32x4 (&acc)[2][2][4][2], const Unit& u, int wr, int wc, int fr, int fq) const {
        const int row0 = u.pm * BM + wr * 64 + fr;
        if (u.pn >= 12 && u.pn < 24) {
            const int which = (u.pn - 12) >> 2, hp = (u.pn - 12) & 3; const float qsc = which == 0 ? 0.08838834764831845f * 1.4426950408889634f : 1.0f;     bf16_t* base = QKV + (size_t)which * (32u * 4096u * 128u) + wc * 32 + 8 * fq;
#pragma unroll
            for (int ai = 0; ai < 2; ++ai)
#pragma unroll
                for (int m = 0; m < 4; ++m) { const int row = row0 + ai * HALF + m * 16; const int b = row >> 12, s = row & 4095;
#pragma unroll
                    for (int bj = 0; bj < 2; ++bj) { const f32x4 v0 = acc[ai][bj][m][0] * qsc, v1 = acc[ai][bj][m][1] * qsc;
                        u32x4 w; w.x = cvt_pk_bf16(v0[0], v0[1]); w.y = cvt_pk_bf16(v0[2], v0[3]); w.z = cvt_pk_bf16(v1[0], v1[1]); w.w = cvt_pk_bf16(v1[2], v1[3]);
                        *(u32x4*)(base + ((size_t)(b * 8 + 2 * hp + bj) * 4096 + s) * 128) = w; } }
        } else if (u.pn >= 24 && u.pn < 32) {
            bf16_t* zb = ZIMG + ((size_t)((u.pm * 4 + (u.pn & 3)) * 2 + ((u.pn - 24) >> 2)) * 16 * 512 + (wr * 4 + wc) * 64 + (fq * 16 + fr)) * 8;
#pragma unroll
            for (int ai = 0; ai < 2; ++ai)
#pragma unroll
                for (int m = 0; m < 4; ++m)
#pragma unroll
                    for (int bj = 0; bj < 2; ++bj) { const f32x4 v0 = acc[ai][bj][m][0], v1 = acc[ai][bj][m][1];
                        u32x4 w; w.x = cvt_pk_bf16(v0[0], v0[1]); w.y = cvt_pk_bf16(v0[2], v0[3]); w.z = cvt_pk_bf16(v1[0], v1[1]); w.w = cvt_pk_bf16(v1[2], v1[3]);
                        *(u32x4*)(zb + (size_t)((ai * 4 + m) * 2 + bj) * 512 * 8) = w; }
        } else if (u.pn < 12) {
            const int col0 = u.pn * BM + wc * 32 + 8 * fq;
#pragma unroll
            for (int ai = 0; ai < 2; ++ai)
#pragma unroll
                for (int m = 0; m < 4; ++m) { bf16_t* rowp = O + (size_t)(row0 + ai * HALF + m * 16) * 3072 + col0;
#pragma unroll
                    for (int bj = 0; bj < 2; ++bj) { const f32x4 v0 = acc[ai][bj][m][0], v1 = acc[ai][bj][m][1];
                        u32x4 w; w.x = cvt_pk_bf16(v0[0], v0[1]); w.y = cvt_pk_bf16(v0[2], v0[3]); w.z = cvt_pk_bf16(v1[0], v1[1]); w.w = cvt_pk_bf16(v1[2], v1[3]);
                        *(u32x4*)(rowp + bj * HALF) = w; } }
        } else if (wc == 0) {
#pragma unroll
            for (int ai = 0; ai < 2; ++ai)
#pragma unroll
                for (int m = 0; m < 4; ++m) { float* rp = SMp + (size_t)(row0 + ai * HALF + m * 16) * 32 + 8 * fq;
                    *(f32x4*)rp = acc[ai][0][m][0]; *(f32x4*)(rp + 4) = acc[ai][0][m][1]; }
        }
    }
};

struct EpiMix {
    static constexpr bool PERM = true, AFTER_DRAIN = false, CHAIN = true;
    const bf16_t* ZIMG; bf16_t* MIX;
    __device__ __forceinline__ void operator()(f32x4 (&acc)[2][2][4][2], const Unit& u, int wr, int wc, int fr, int fq) const {
        const int row0 = u.pm * BM + wr * 64 + fr, col0 = u.pn * BM + wc * 32 + 8 * fq; const int kind = u.aux;
        const bf16_t* zimg = ZIMG + ((size_t)((u.pm * 4 + u.pn) * 2) * 16 * 512 + (wr * 4 + wc) * 64 + (fq * 16 + fr)) * 8;
#pragma unroll
        for (int ai = 0; ai < 2; ++ai) {
            u32x4 zf[4][2], zg[4][2];
#pragma unroll
            for (int m = 0; m < 4; ++m)
#pragma unroll
                for (int bj = 0; bj < 2; ++bj) { const bf16_t* zp = zimg + (size_t)((ai * 4 + m) * 2 + bj) * 512 * 8;
                    zf[m][bj] = *(const u32x4*)(zp + 16 * 512 * 8); if (kind == 0) zg[m][bj] = *(const u32x4*)zp; }
#pragma unroll
            for (int m = 0; m < 4; ++m)
#pragma unroll
                for (int bj = 0; bj < 2; ++bj) {
                    const u32x4 a = zf[m][bj]; float ef[8] = {bf_lo(a.x), bf_hi(a.x), bf_lo(a.y), bf_hi(a.y), bf_lo(a.z), bf_hi(a.z), bf_lo(a.w), bf_hi(a.w)};
#pragma unroll
                    for (int j = 0; j < 8; ++j) ef[j] = 1.0f + __expf(-ef[j]);
                    if (kind == 0) {
                        const u32x4 g = zg[m][bj]; float eg[8] = {bf_lo(g.x), bf_hi(g.x), bf_lo(g.y), bf_hi(g.y), bf_lo(g.z), bf_hi(g.z), bf_lo(g.w), bf_hi(g.w)};
#pragma unroll
                        for (int j = 0; j < 8; ++j) { const float r = ef[j] * __builtin_amdgcn_rcpf(1.0f + __expf(-eg[j])); if (j < 4) acc[ai][bj][m][0][j] *= r; else acc[ai][bj][m][1][j - 4] *= r; }
                    } else {
                        float o[8];
#pragma unroll
                        for (int j = 0; j < 8; ++j) o[j] = (j < 4 ? acc[ai][bj][m][0][j] : acc[ai][bj][m][1][j - 4]) * __builtin_amdgcn_rcpf(ef[j]);
                        u32x4 w; w.x = cvt_pk_bf16(o[0], o[1]); w.y = cvt_pk_bf16(o[2], o[3]); w.z = cvt_pk_bf16(o[4], o[5]); w.w = cvt_pk_bf16(o[6], o[7]);
                        *(u32x4*)(MIX + (size_t)(row0 + ai * HALF + m * 16) * 1024 + col0 + bj * HALF) = w; } }
        }
    }
};

struct EpiAct {
    static constexpr bool PERM = true, AFTER_DRAIN = false;
    bf16_t* ACT; const float* bgu;
    __device__ __forceinline__ void operator()(const f32x4 (&acc)[2][2][4][2], const Unit& u, int wr, int wc, int fr, int fq) const {
        const int e = u.aux, c0 = wc * 32 + 8 * fq; const float* bg = bgu + (size_t)e * 2048 + u.pn * 128 + c0; const float* bu = bg + 1024;
        const f32x4 bg0 = *(const f32x4*)bg, bg1 = *(const f32x4*)(bg + 4), bu0 = *(const f32x4*)bu, bu1 = *(const f32x4*)(bu + 4);
#pragma unroll
        for (int ai = 0; ai < 2; ++ai)
#pragma unroll
            for (int m = 0; m < 4; ++m) { const size_t row = (size_t)u.ab * BM + ai * HALF + m * 16 + wr * 64 + fr;
                const f32x4 g0 = acc[ai][0][m][0] + bg0, g1 = acc[ai][0][m][1] + bg1, p0 = acc[ai][1][m][0] + bu0, p1 = acc[ai][1][m][1] + bu1;
                float o[8];
#pragma unroll
                for (int j = 0; j < 8; ++j) { const float gv = j < 4 ? g0[j & 3] : g1[j & 3], uv = j < 4 ? p0[j & 3] : p1[j & 3];
                    const float gate = fminf(gv, 7.0f), up = fminf(fmaxf(uv, -7.0f), 7.0f); o[j] = (up + 1.0f) * (gate * sigm(1.702f * gate)); }
                u32x4 w; w.x = cvt_pk_bf16(o[0], o[1]); w.y = cvt_pk_bf16(o[2], o[3]); w.z = cvt_pk_bf16(o[4], o[5]); w.w = cvt_pk_bf16(o[6], o[7]);
                *(u32x4*)(ACT + row * 1024 + u.pn * 128 + c0) = w; }
    }
};

struct EpiDown {
    static constexpr bool PERM = true, AFTER_DRAIN = false;
    bf16_t* YS; const float* bd;
    __device__ __forceinline__ void operator()(const f32x4 (&acc)[2][2][4][2], const Unit& u, int wr, int wc, int fr, int fq) const {
        const int e = u.aux, col0 = u.pn * BM + wc * 32 + 8 * fq;
        f32x4 bv[2][2];
#pragma unroll
        for (int bj = 0; bj < 2; ++bj)
#pragma unroll
            for (int n = 0; n < 2; ++n) bv[bj][n] = *(const f32x4*)(bd + (size_t)e * 1024 + col0 + bj * HALF + 4 * n);
#pragma unroll
        for (int ai = 0; ai < 2; ++ai)
#pragma unroll
            for (int m = 0; m < 4; ++m) { bf16_t* rowp = YS + ((size_t)u.ab * BM + ai * HALF + m * 16 + wr * 64 + fr) * 1024 + col0;
#pragma unroll
                for (int bj = 0; bj < 2; ++bj) { const f32x4 v0 = acc[ai][bj][m][0] + bv[bj][0], v1 = acc[ai][bj][m][1] + bv[bj][1];
                    u32x4 w; w.x = cvt_pk_bf16(v0[0], v0[1]); w.y = cvt_pk_bf16(v0[2], v0[3]); w.z = cvt_pk_bf16(v1[0], v1[1]); w.w = cvt_pk_bf16(v1[2], v1[3]);
                    *(u32x4*)(rowp + bj * HALF) = w; } }
    }
};

struct MixOrder {
    StaticOrder so;
    __device__ void init(int M, int N, int G_, int c_) { so.init(M, N, G_, c_); }
    __device__ __forceinline__ bool next(int i, Unit& u) const { if (!so.next(i >> 1, u)) return false; const int kind = i & 1; u.aux = kind; u.ab = kind * (so.nM) + u.pm; u.bb = kind * (so.nN) + u.pn; return true; }
    __device__ __forceinline__ void a_ready(const Unit&) const {}
    __device__ __forceinline__ void done(const Unit&) const {}
    __device__ __forceinline__ const PG8_LAS int* rowidx(int) const { return nullptr; }
};
constexpr int MAXU = 12;
struct GroupedOrder {
    const PG8_LAS int* desc; const PG8_LAS int* idx;
    __device__ __forceinline__ bool next(int i, Unit& u) const {
        if (i >= MAXU) return false; const PG8_LAS int* d = desc + i * 8;
        if (__builtin_amdgcn_readfirstlane(d[0]) == 0) return false;
        u.ab = __builtin_amdgcn_readfirstlane(d[1]); u.bb = __builtin_amdgcn_readfirstlane(d[2]); u.pn = __builtin_amdgcn_readfirstlane(d[3]); u.aux = __builtin_amdgcn_readfirstlane(d[4]); u.pm = u.ab; return true; }
    __device__ __forceinline__ void a_ready(const Unit&) const {}
    __device__ __forceinline__ void done(const Unit&) const {}
    __device__ __forceinline__ const PG8_LAS int* rowidx(int i) const { return idx + i * 256; }
};
}
namespace fox {
constexpr int D = 128, PKV = 128  , PO = 1024  ;
constexpr float THR = 8.f; constexpr bool WSKIP = false;
constexpr float SCALE = 0.08838834764831845f;
constexpr int NW = 8, QBLK = 32, KVBLK = 64, QB = NW * QBLK;
constexpr int SHM_V = KVBLK * D * 2, SHM_K = KVBLK * D * 2;
constexpr int LDS_BIAS = 2 * SHM_V + 2 * SHM_K + NW * 64 * 4;
constexpr int LDS_JUNK = LDS_BIAS + 2 * 4096 * 4;
constexpr int LDS_BYTES = LDS_JUNK + 256;

using bf16 = __hip_bfloat16;
typedef short bf16x8 __attribute__((ext_vector_type(8)));
typedef short s16x4 __attribute__((ext_vector_type(4)));
typedef float f32x16 __attribute__((ext_vector_type(16)));
typedef float f32x4 __attribute__((ext_vector_type(4)));
typedef unsigned u32x4 __attribute__((ext_vector_type(4)));
template <class A, class Bt> struct same_t { static constexpr bool v = false; };
template <class A> struct same_t<A, A> { static constexpr bool v = true; };

#define KSWZ(row, colB) ((row) * 256 + ((colB) ^ (((row) & 7) << 4)))
#define SBAR() __builtin_amdgcn_sched_barrier(0)
__device__ __forceinline__ int v_st(int k, int c) { const int kk = (k & ~0xC) | ((k & 4) << 1) | ((k & 8) >> 1); return ((kk >> 3) * 4 + (c >> 5)) * 512 + ((kk & 7) * 32 + (c & 31)) * 2; }
__device__ __forceinline__ int v_rd_base(int lane) { return ((lane & 3) << 3) | (((lane >> 2) & 3) << 6) | (((lane >> 4) & 1) << 5) | (((lane >> 5) & 1) << 8); }
constexpr int v_rd_off(int d0, int ks, int half) { return d0 * 512 + ks * 4096 + half * 2048; }
__device__ __forceinline__ int crow(int r, int hi) { return (r & 3) + 8 * (r >> 2) + 4 * hi; }
__device__ __forceinline__ unsigned cvtpk(float lo, float hi) {
    unsigned r; asm volatile("v_cvt_pk_bf16_f32 %0, %1, %2" : "=v"(r) : "v"(lo), "v"(hi)); return r;
}
__device__ __forceinline__ bf16x8 pack8(f32x4 a, f32x4 b) {
    u32x4 w = {cvtpk(a[0], a[1]), cvtpk(a[2], a[3]), cvtpk(b[0], b[1]), cvtpk(b[2], b[3])};
    return *reinterpret_cast<bf16x8*>(&w);
}
template <class T> __device__ __forceinline__ bf16x8 load8(const T* p) {
    if constexpr (same_t<T, float>::v) { return pack8(*(const f32x4*)p, *(const f32x4*)(p + 4)); }
    else { return *reinterpret_cast<const bf16x8*>(p); }
}
__device__ __forceinline__ void mask_tile(f32x16& p0, f32x16& p1, int dq, unsigned W) {
    const float NEG = -__builtin_inff();
#pragma unroll
    for (int r = 0; r < 16; ++r) {
        const int c = (r & 3) + 8 * (r >> 2);
        if ((unsigned)(dq - c) >= W) p0[r] = NEG;
        if ((unsigned)(dq - c - 32) >= W) p1[r] = NEG;
    }
}
__device__ __forceinline__ void partialSM(f32x16& p0, f32x16& p1, float& m_reg, float& mn, float& alpha) {
    float pmax = p0[0]; for (int r = 1; r < 16; ++r) pmax = fmaxf(pmax, p0[r]); for (int r = 0; r < 16; ++r) pmax = fmaxf(pmax, p1[r]);
    { auto rr = __builtin_amdgcn_permlane32_swap(__float_as_uint(pmax), __float_as_uint(pmax), false, false);
      pmax = fmaxf(__uint_as_float(rr[0]), __uint_as_float(rr[1])); }
    constexpr float C2 = 1.4426950408889634f * SCALE;
    if (__builtin_expect(__all((pmax - m_reg) * SCALE <= THR), 1)) { mn = m_reg; alpha = 1.f; }
    else { mn = fmaxf(m_reg, pmax); alpha = __builtin_amdgcn_exp2f((m_reg - mn) * C2); m_reg = mn; }
    const float mnL = -mn * C2;
    for (int r = 0; r < 16; ++r) p0[r] = fmaf(p0[r], C2, mnL); for (int r = 0; r < 16; ++r) p1[r] = fmaf(p1[r], C2, mnL);
    for (int r = 0; r < 16; ++r) p0[r] = __builtin_amdgcn_exp2f(p0[r]);
}
__device__ __forceinline__ void finishSM(f32x16& p0, f32x16& p1, float alpha, float& l_reg, bf16x8& pa0, bf16x8& pa1, bf16x8& pa2, bf16x8& pa3) {
    for (int r = 0; r < 16; ++r) p1[r] = __builtin_amdgcn_exp2f(p1[r]);
    float ps = 0; for (int r = 0; r < 16; ++r) ps += p0[r]; for (int r = 0; r < 16; ++r) ps += p1[r];
    { auto rr = __builtin_amdgcn_permlane32_swap(__float_as_uint(ps), __float_as_uint(ps), false, false);
      ps = __uint_as_float(rr[0]) + __uint_as_float(rr[1]); }
    l_reg = l_reg * alpha + ps;
#define PK4(P, B_, OUT) do { unsigned a0 = cvtpk(P[B_+0], P[B_+1]), a1 = cvtpk(P[B_+2], P[B_+3]);                          \
        unsigned b0 = cvtpk(P[B_+4], P[B_+5]), b1 = cvtpk(P[B_+6], P[B_+7]);                                             \
        auto r0 = __builtin_amdgcn_permlane32_swap(a0, b0, false, false); auto r1 = __builtin_amdgcn_permlane32_swap(a1, b1, false, false); \
        u32x4 w = {r0[0], r1[0], r0[1], r1[1]}; OUT = *reinterpret_cast<bf16x8*>(&w); } while (0)
    PK4(p0, 0, pa0); PK4(p0, 8, pa1); PK4(p1, 0, pa2); PK4(p1, 8, pa3);
#undef PK4
}
template <int KB, bool SK>
__device__ __forceinline__ void qkt(f32x16& p0, f32x16& p1, const char* K_lds, int r32, int hi, const bf16x8* qr, bool act, const float* bias_t  ) {
    if (SK && !act) { const float NEG = -__builtin_inff();
#pragma unroll
        for (int r = 0; r < 16; ++r) { p0[r] = NEG; p1[r] = NEG; } return; }
#pragma unroll
    for (int g4 = 0; g4 < 4; ++g4) { const f32x4 b0 = *(const f32x4*)(bias_t + 8 * g4), b1 = *(const f32x4*)(bias_t + 32 + 8 * g4);
#pragma unroll
        for (int j = 0; j < 4; ++j) { p0[4 * g4 + j] = b0[j]; p1[4 * g4 + j] = b1[j]; } }
    const char* kb[4];
#pragma unroll
    for (int dd = 0; dd < 4; ++dd) kb[dd] = K_lds + KB * SHM_K + KSWZ(r32, (dd * 16 + hi * 8) * 2);
#pragma unroll
    for (int d0 = 0; d0 < 8; ++d0) { const char* a = kb[d0 & 3] + (d0 >> 2) * 128;
        bf16x8 b0 = *reinterpret_cast<const bf16x8*>(a);
        bf16x8 b1 = *reinterpret_cast<const bf16x8*>(a + 32 * 256);
        p0 = __builtin_amdgcn_mfma_f32_32x32x16_bf16(b0, qr[d0], p0, 0, 0, 0);
        p1 = __builtin_amdgcn_mfma_f32_32x32x16_bf16(b1, qr[d0], p1, 0, 0, 0); }
}
template <int VB, bool SK>
__device__ __forceinline__ void pv_tile(f32x16* o, int vb0, bf16x8 pa0, bf16x8 pa1, bf16x8 pa2, bf16x8 pa3, bool act) {
    if (SK && !act) return;
#define TRRD(dst, off) asm volatile("ds_read_b64_tr_b16 %0, %1 offset:%2" : "=&v"(dst) : "v"(vb0), "i"(off) : "memory")
#define PV_D0(d0) do { s16x4 l0, l1, l2, l3, h0, h1, h2, h3; constexpr int b_ = VB * SHM_V + v_rd_off(d0, 0, 0);     \
        TRRD(l0, b_); TRRD(h0, b_ + 2048); TRRD(l1, b_ + 4096); TRRD(h1, b_ + 6144); TRRD(l2, b_ + 8192); TRRD(h2, b_ + 10240); TRRD(l3, b_ + 12288); TRRD(h3, b_ + 14336); \
        asm volatile("s_waitcnt lgkmcnt(0)" ::: "memory"); SBAR();                 \
        o[d0] = __builtin_amdgcn_mfma_f32_32x32x16_bf16(pa0, (bf16x8){l0[0], l0[1], l0[2], l0[3], h0[0], h0[1], h0[2], h0[3]}, o[d0], 0, 0, 0);   \
        o[d0] = __builtin_amdgcn_mfma_f32_32x32x16_bf16(pa1, (bf16x8){l1[0], l1[1], l1[2], l1[3], h1[0], h1[1], h1[2], h1[3]}, o[d0], 0, 0, 0);   \
        o[d0] = __builtin_amdgcn_mfma_f32_32x32x16_bf16(pa2, (bf16x8){l2[0], l2[1], l2[2], l2[3], h2[0], h2[1], h2[2], h2[3]}, o[d0], 0, 0, 0);   \
        o[d0] = __builtin_amdgcn_mfma_f32_32x32x16_bf16(pa3, (bf16x8){l3[0], l3[1], l3[2], l3[3], h3[0], h3[1], h3[2], h3[3]}, o[d0], 0, 0, 0); } while (0)
    PV_D0(0); PV_D0(1); PV_D0(2); PV_D0(3);
#undef PV_D0
#undef TRRD
}

template <class TIn, class TOut> struct BlockRef { const TIn* Q; const TIn* K; const TIn* V; TOut* O; int P0; };
template <class TIn> struct Seam {
    bf16x8 qr[8];
    bf16x8 st_v0, st_v1, st_k0, st_k1; f32x4 sf0, sf1, sf2, sf3;
    f32x4 tq[16];
};
__device__ __forceinline__ int swa_jlo(int P0, int W) { const int lowk = P0 - W + 1; return lowk > 0 ? lowk / KVBLK : 0; }
#define ROW(p, k0, rr) ((p) + (size_t)((k0) + (rr)) * PKV + sc)
#define VMW() asm volatile("s_waitcnt vmcnt(0)" ::: "memory")
#define VMWN(n) asm volatile("s_waitcnt vmcnt(%0)" :: "i"(n) : "memory")
#define SLOAD_H(Kp, Vp, k0) do { S.st_v0 = load8<TIn>(ROW(Vp, k0, sr)); S.st_v1 = load8<TIn>(ROW(Vp, k0, 32 + sr));              \
                         S.st_k0 = load8<TIn>(ROW(Kp, k0, sr)); S.st_k1 = load8<TIn>(ROW(Kp, k0, 32 + sr)); } while (0)
#define SWRITE_HK(bf) do { *(bf16x8*)(K_lds + (bf) * SHM_K + kws) = S.st_k0; *(bf16x8*)(K_lds + (bf) * SHM_K + kws + 32 * 256) = S.st_k1; } while (0)
#define SWRITE_HV(bf) do { *(bf16x8*)(V_lds + (bf) * SHM_V + vst0) = S.st_v0; *(bf16x8*)(V_lds + (bf) * SHM_V + vst1) = S.st_v1; } while (0)
#define SWRITE_H(bf) do { SWRITE_HV(bf); SWRITE_HK(bf); } while (0)
#define SLOAD_F(p, k0) do { S.sf0 = *(const f32x4*)ROW(p, k0, sr); S.sf1 = *(const f32x4*)(ROW(p, k0, sr) + 4);                \
                            S.sf2 = *(const f32x4*)ROW(p, k0, 32 + sr); S.sf3 = *(const f32x4*)(ROW(p, k0, 32 + sr) + 4); } while (0)
#define SWRITE_KF(bf) do { *(bf16x8*)(K_lds + (bf) * SHM_K + kws) = pack8(S.sf0, S.sf1); *(bf16x8*)(K_lds + (bf) * SHM_K + kws + 32 * 256) = pack8(S.sf2, S.sf3); } while (0)
#define SWRITE_VF(bf) do { *(bf16x8*)(V_lds + (bf) * SHM_V + vst0) = pack8(S.sf0, S.sf1); *(bf16x8*)(V_lds + (bf) * SHM_V + vst1) = pack8(S.sf2, S.sf3); } while (0)
template <class TIn, class TOut>
__device__ __forceinline__ void causal_swa_prime(const BlockRef<TIn, TOut>& cur, int W, char* lds, Seam<TIn>& S, int tid_in) {
    constexpr bool F32 = same_t<TIn, float>::v;
    const int tid = tid_in, wid = __builtin_amdgcn_readfirstlane(tid >> 6), lane = tid & 63, r32 = lane & 31, hi = lane >> 5;
    const int sr = tid >> 4, sc = (tid & 15) * 8, kws = KSWZ(sr, sc * 2); char* K_lds = lds + 2 * SHM_V;
    const int kb0 = swa_jlo(cur.P0, W) * KVBLK;
    for (int d0 = 0; d0 < 8; ++d0) S.qr[d0] = load8<TIn>(cur.Q + (size_t)(wid * QBLK + r32) * PKV + d0 * 16 + hi * 8);
    if constexpr (F32) { SLOAD_F((const float*)cur.K, kb0); VMW(); SWRITE_KF(0); SBAR(); SLOAD_F((const float*)cur.V, kb0); }
    else { SLOAD_H(cur.K, cur.V, kb0); VMW(); SWRITE_HK(0); }
    __syncthreads();
}
template <class TIn, class TOut>
__device__ __forceinline__ void causal_swa_block(const BlockRef<TIn, TOut>& cur, const BlockRef<TIn, TOut>& nxt, int skv, int W, char* lds, Seam<TIn>& S, int bias_buf, int tid_in) {
    constexpr bool F32 = same_t<TIn, float>::v;
    const int tid = tid_in, wid = __builtin_amdgcn_readfirstlane(tid >> 6), lane = tid & 63, r32 = lane & 31, hi = lane >> 5;
    const int j_lo = swa_jlo(cur.P0, W);
    int j_hi = (cur.P0 + QB - 1) / KVBLK + 1; if (j_hi > skv / KVBLK) j_hi = skv / KVBLK;
    const int NT = j_hi - j_lo;
    const int kbn = swa_jlo(nxt.P0, W) * KVBLK;
    const int qlo = cur.P0 + wid * QBLK, qm = qlo + r32 - 4 * hi;
    char* V_lds = lds; char* K_lds = lds + 2 * SHM_V;
    float* ws = (float*)(lds + 2 * SHM_V + 2 * SHM_K) + wid * 64; float* li_l = ws, * al_l = ws + 32;
    const float* bias_l = (const float*)(lds + LDS_BIAS + bias_buf * 16384) + 4 * hi;
    float m_reg = -1e30f, l_reg = 0; f32x16 o[4] = {};
    const int sr = tid >> 4, sc = (tid & 15) * 8, vst0 = v_st(sr, sc), vst1 = v_st(32 + sr, sc), kws = KSWZ(sr, sc * 2);
    const int vb0 = (int)(uintptr_t)V_lds + v_rd_base(lane);
    const TIn* Kh = cur.K; const TIn* Vh = cur.V;
#define RESC(a) do { if (__any((a) < 1.f)) { if (hi == 0) al_l[r32] = (a); asm volatile("s_waitcnt lgkmcnt(0)" ::: "memory");              \
                     for (int d_ = 0; d_ < 4; ++d_) for (int r = 0; r < 16; ++r) o[d_][r] *= al_l[crow(r, hi)]; } } while (0)
#define KBASE(t) ((j_lo + (t)) * KVBLK)
#define BIAS_T(t) (bias_l + KBASE(t))
    const TIn* pf_src = (((tid >> 7) & 1) ? Vh : Kh) + (size_t)((tid & 127) >> 1) * PKV + (tid & 1) * 64;
#define L2_PREFETCH(kb_) do { if (tid < 256) __builtin_amdgcn_global_load_lds((const unsigned*)(pf_src + (size_t)(kb_) * PKV), (__attribute__((address_space(3))) unsigned*)(uintptr_t)__builtin_amdgcn_readfirstlane((unsigned)(uintptr_t)(lds + LDS_JUNK)), 4, 0, 0); } while (0)
#define ACT(t) (KBASE(t) <= qlo + QBLK - 1 && KBASE(t) + KVBLK - 1 >= qlo - W + 1)
#define MASKT(P0_, P1_, t) do { const int kb_ = KBASE(t); if ((!SK || ACT(t)) && (kb_ + KVBLK - 1 > qlo || kb_ <= qlo + QBLK - 1 - W)) mask_tile(P0_, P1_, qm - kb_, (unsigned)W); } while (0)
    constexpr int NQL = F32 ? 16 : 8;
    constexpr bool SK = WSKIP && !F32;
#define SEAM_K0() do { VMWN(NQL); if constexpr (F32) { SWRITE_KF(0); SBAR(); SLOAD_F((const float*)nxt.V, kbn); } else { SWRITE_HK(0); } SBAR(); } while (0)
    f32x16 pA0, pA1, pB0, pB1; float mnA, mnB, alA, alB; bf16x8 pa0, pa1, pa2, pa3;
    if constexpr (F32) { VMW(); SWRITE_VF(0); SBAR(); } else { SWRITE_HV(0); SBAR(); }
    if (NT > 1) { if constexpr (F32) SLOAD_F((const float*)Kh, KBASE(1)); else SLOAD_H(Kh, Vh, KBASE(1)); }
    SBAR(); qkt<0, SK>(pA0, pA1, K_lds, r32, hi, S.qr, ACT(0), BIAS_T(0));
    if constexpr (F32) { if (NT > 1) { VMW(); SWRITE_KF(1); SBAR(); SLOAD_F((const float*)Vh, KBASE(1)); } }
    MASKT(pA0, pA1, 0); partialSM(pA0, pA1, m_reg, mnA, alA);
    if (NT > 1) { VMW(); if constexpr (F32) { SWRITE_VF(1); SBAR(); if (NT > 2) SLOAD_F((const float*)Kh, KBASE(2)); } else SWRITE_H(1); }
    __syncthreads();
#define HALF_STEP(PX0, PX1, mnX, alX, PY0, PY1, alY, t, KB, VB, SB) do {                                                      \
        SBAR(); qkt<KB, SK>(PX0, PX1, K_lds, r32, hi, S.qr, ACT(t), BIAS_T(t));                                             \
        finishSM(PY0, PY1, alY, l_reg, pa0, pa1, pa2, pa3); SBAR();                                                           \
        if ((t) + 1 < NT) { if constexpr (F32) { VMW(); SWRITE_KF(SB); SBAR(); SLOAD_F((const float*)Vh, KBASE((t) + 1)); }  \
                            else { SLOAD_H(Kh, Vh, KBASE((t) + 1)); } SBAR(); }                                               \
        pv_tile<VB, SK>(o, vb0, pa0, pa1, pa2, pa3, ACT((t) - 1)); MASKT(PX0, PX1, (t)); partialSM(PX0, PX1, m_reg, mnX, alX);                                        \
        __syncthreads();                                                                                                      \
        if ((t) + 1 < NT) { VMW(); if constexpr (F32) { SWRITE_VF(SB); SBAR(); if ((t) + 2 < NT) SLOAD_F((const float*)Kh, KBASE((t) + 2)); } \
                            else { SWRITE_H(SB); } }                                                                          \
        RESC(alX); __syncthreads(); } while (0)
    for (int t = 1; t + 1 < NT; t += 2) {
        HALF_STEP(pB0, pB1, mnB, alB, pA0, pA1, alA, t, 1, 0, 0);
        HALF_STEP(pA0, pA1, mnA, alA, pB0, pB1, alB, t + 1, 0, 1, 1);
    }
    const bool even = (NT & 1) == 0;
    if (even) { SBAR(); qkt<1, SK>(pB0, pB1, K_lds, r32, hi, S.qr, ACT(NT - 1), BIAS_T(NT - 1)); SBAR(); }
#define QROW(e) (nxt.Q + (size_t)(wid * QBLK + r32) * PKV + ((e) >> 1) * 16 + hi * 8 + ((e) & 1) * 4)
    if constexpr (F32) { SLOAD_F((const float*)nxt.K, kbn); SBAR();
#pragma unroll
        for (int e = 0; e < 8; ++e) S.tq[e] = *(const f32x4*)QROW(e); }
    else { SLOAD_H(nxt.K, nxt.V, kbn); SBAR();
#pragma unroll
        for (int d0 = 0; d0 < 8; ++d0) S.qr[d0] = load8<TIn>(nxt.Q + (size_t)(wid * QBLK + r32) * PKV + d0 * 16 + hi * 8); }
    SBAR();
    finishSM(pA0, pA1, alA, l_reg, pa0, pa1, pa2, pa3); SBAR();
    if constexpr (F32) {
#pragma unroll
        for (int e = 8; e < 16; ++e) S.tq[e] = *(const f32x4*)QROW(e); SBAR(); }
#undef QROW
    pv_tile<0, SK>(o, vb0, pa0, pa1, pa2, pa3, ACT(even ? NT - 2 : NT - 1));
    if (even) { MASKT(pB0, pB1, NT - 1); partialSM(pB0, pB1, m_reg, mnB, alB); __syncthreads(); RESC(alB);
        finishSM(pB0, pB1, alB, l_reg, pa0, pa1, pa2, pa3); SBAR(); pv_tile<1, SK>(o, vb0, pa0, pa1, pa2, pa3, ACT(NT - 1)); }
    SBAR(); SEAM_K0();
    if (hi == 0) li_l[r32] = l_reg; asm volatile("s_waitcnt lgkmcnt(0)" ::: "memory");
    float rli[16];
#pragma unroll
    for (int r = 0; r < 16; ++r) rli[r] = __builtin_amdgcn_rcpf(li_l[crow(r, hi)]);
    TOut* Ow = cur.O + (size_t)(wid * QBLK) * PO;
#pragma unroll
    for (int r = 0; r < 16; ++r) { const int orow = crow(r, hi);
#pragma unroll
        for (int d0 = 0; d0 < 4; ++d0) { const float v = o[d0][r] * rli[r];
            if constexpr (same_t<TOut, float>::v) { Ow[(size_t)orow * PO + d0 * 32 + r32] = v; }
            else { const float vn = __shfl_xor(v, 1);
                   if ((r32 & 1) == 0) *(unsigned*)(Ow + (size_t)orow * PO + d0 * 32 + r32) = cvtpk(v, vn); } } }
    if constexpr (F32) {
#pragma unroll
        for (int d0 = 0; d0 < 8; ++d0) S.qr[d0] = pack8(S.tq[2 * d0], S.tq[2 * d0 + 1]); }
    __syncthreads();
#undef RESC
#undef KBASE
#undef BIAS_T
#undef L2_PREFETCH
#undef ACT
#undef MASKT
#undef SEAM_K0
#undef HALF_STEP
}
#undef ROW
#undef VMW
#undef VMWN
#undef SLOAD_H
#undef SWRITE_HK
#undef SWRITE_HV
#undef SWRITE_H
#undef SLOAD_F
#undef SWRITE_KF
#undef SWRITE_VF

}
namespace fa128 {
typedef short bf16x8 __attribute__((ext_vector_type(8)));
typedef short s16x4 __attribute__((ext_vector_type(4)));
typedef short v4i16_t __attribute__((ext_vector_type(4)));
typedef float f32x16 __attribute__((ext_vector_type(16)));
typedef float f32x4 __attribute__((ext_vector_type(4)));
typedef unsigned u32x4 __attribute__((ext_vector_type(4)));
typedef __attribute__((address_space(3))) const char* lds_cptr;
constexpr int NW = 8, QBLK = 32, QB = 256, KVBLK = 64, PKV = 128  , PO = 1024  ;
constexpr int NSLOT = 3, SLOTB = 16384;
constexpr int LDS_K = 0, LDS_V = NSLOT * SLOTB, LDS_BIAS = 2 * NSLOT * SLOTB, LDS_BYTES = LDS_BIAS + 2 * 4096 * 4;
constexpr float C2 = 0.08838834764831845f * 1.4426950408889634f;
__device__ __forceinline__ int crow(int r, int hi) { return (r & 3) + 8 * (r >> 2) + 4 * hi; }
__device__ __forceinline__ void glds16(const void* gsrc, unsigned lds_dst) { unsigned keep;
    asm volatile("s_mov_b32 %0, m0\n\ts_mov_b32 m0, %2\n\ts_nop 0\n\tglobal_load_lds_dwordx4 %1, off\n\ts_mov_b32 m0, %0" : "=&s"(keep) : "v"(gsrc), "s"(lds_dst) : "memory"); }
typedef float f32x2_t __attribute__((ext_vector_type(2))); typedef __bf16 bf16x2_t __attribute__((ext_vector_type(2)));
__device__ __forceinline__ unsigned cvtpk_s(float lo, float hi) { f32x2_t v = {lo, hi}; bf16x2_t b = __builtin_convertvector(v, bf16x2_t); return __builtin_bit_cast(unsigned, b); }
__device__ __forceinline__ s16x4 vtr(lds_cptr p) { return __builtin_bit_cast(s16x4, __builtin_amdgcn_ds_read_tr16_b64_v4i16((__attribute__((address_space(3))) v4i16_t*)p)); }
#define FA_WAIT_BAR(N) asm volatile("s_waitcnt vmcnt(" #N ") lgkmcnt(0)\n\ts_barrier" ::: "memory")
#define FA_SBAR() __builtin_amdgcn_sched_barrier(0)
__device__ __forceinline__ void cmask(f32x16& p0, f32x16& p1, int jb, int qrel, int hi) {
    const float NEG = -__builtin_inff(); const int kb = 64 * jb + 4 * hi;
#pragma unroll
    for (int r = 0; r < 16; ++r) { const int kv = kb + (r & 3) + 8 * (r >> 2); if (kv > qrel) p0[r] = NEG; if (kv + 32 > qrel) p1[r] = NEG; }
}
__device__ __forceinline__ float rowmax(const f32x16& p0, const f32x16& p1) {
    float a = p0[0], b = p1[0];
#pragma unroll
    for (int r = 1; r < 16; ++r) { a = __builtin_fmaxf(a, p0[r]); b = __builtin_fmaxf(b, p1[r]); }
    float m = __builtin_fmaxf(a, b);
    auto rr = __builtin_amdgcn_permlane32_swap(__float_as_uint(m), __float_as_uint(m), false, false);
    return __builtin_fmaxf(__uint_as_float(rr[0]), __uint_as_float(rr[1]));
}
template <int THRL>
__device__ __forceinline__ void attn_unit(const unsigned short* Qb, const unsigned short* __restrict__ Kh, const unsigned short* __restrict__ Vh, unsigned short* Ob, int qb,
                                          __attribute__((address_space(3))) unsigned char* ring, const __attribute__((address_space(3))) float* biasl, __attribute__((address_space(3))) float* wsf, int tid) {
    typedef __attribute__((address_space(3))) const bf16x8* lds_b8;
    const int lane = tid & 63, r32 = lane & 31, hi = lane >> 5; const int wid = __builtin_amdgcn_readfirstlane(tid >> 6);
    const int NT = 4 * qb + 4;
    const unsigned lds0 = (unsigned)(uintptr_t)ring;
    const unsigned short* ksrc = Kh + (size_t)lane * PKV + wid * 8;
    const unsigned short* vsrc = Vh + (size_t)(16 * (wid & 3) + (lane >> 2)) * PKV + (wid >> 2) * 32 + (lane & 3) * 8;
    const unsigned kdst = lds0 + LDS_K + wid * 1024, vdst = lds0 + LDS_V + wid * 1024;
#define FA_DMA_K(t, slot) do { glds16(ksrc + (size_t)(t) * KVBLK * PKV, (unsigned)__builtin_amdgcn_readfirstlane(kdst + (slot))); glds16(ksrc + (size_t)(t) * KVBLK * PKV + 64, (unsigned)__builtin_amdgcn_readfirstlane(kdst + (slot) + 8192)); } while (0)
#define FA_DMA_V(t, slot) do { glds16(vsrc + (size_t)(t) * KVBLK * PKV, (unsigned)__builtin_amdgcn_readfirstlane(vdst + (slot))); glds16(vsrc + (size_t)(t) * KVBLK * PKV + 64, (unsigned)__builtin_amdgcn_readfirstlane(vdst + (slot) + 8192)); } while (0)
    const lds_cptr ring3 = (lds_cptr)ring; const lds_cptr kp0 = ring3 + LDS_K + hi * 1024 + r32 * 16; const lds_cptr vp0 = ring3 + LDS_V + ((lane >> 4) & 1) * 32 + (lane & 3) * 8 + (4 * hi + ((lane & 15) >> 2)) * 64;
    FA_DMA_K(0, 0); FA_DMA_V(0, 0); FA_DMA_K(1, SLOTB);
    bf16x8 qr[8];
#pragma unroll
    for (int d0 = 0; d0 < 8; ++d0) qr[d0] = *reinterpret_cast<const bf16x8*>(Qb + (size_t)(wid * QBLK + r32) * PKV + d0 * 16 + hi * 8);
    float mhat = 0.f, l_reg = 0.f; f32x16 o[4];
#pragma unroll
    for (int d = 0; d < 4; ++d)
#pragma unroll
        for (int r = 0; r < 16; ++r) o[d][r] = 0.f;
    const int qrel = wid * QBLK + r32; bool resc = false;
    f32x16 pA0, pA1, pB0, pB1; u32x4 pw0, pw1, pw2, pw3;
    int sl_prev = 0, sl_cur = 0, sl_next = SLOTB, sl_nn = 2 * SLOTB;
#define FA_ROT() do { sl_prev = sl_cur; sl_cur = sl_next; sl_next = sl_nn; sl_nn = (sl_nn == (NSLOT - 1) * SLOTB) ? 0 : sl_nn + SLOTB; } while (0)
#define FA_QKT(C0, C1, t) do { const __attribute__((address_space(3))) float* bt_ = biasl + (t) * KVBLK + 4 * hi; \
        _Pragma("unroll") for (int g4 = 0; g4 < 4; ++g4) { const f32x4 b0_ = *(const __attribute__((address_space(3))) f32x4*)(bt_ + 8 * g4), b1_ = *(const __attribute__((address_space(3))) f32x4*)(bt_ + 32 + 8 * g4); \
            _Pragma("unroll") for (int j = 0; j < 4; ++j) { C0[4 * g4 + j] = b0_[j] - mhat; C1[4 * g4 + j] = b1_[j] - mhat; } } \
        const lds_cptr kp_ = kp0 + sl_cur; \
        _Pragma("unroll") for (int d0 = 0; d0 < 8; ++d0) { const bf16x8 k0_ = *(lds_b8)(kp_ + d0 * 2048), k1_ = *(lds_b8)(kp_ + d0 * 2048 + 512); \
            C0 = __builtin_amdgcn_mfma_f32_32x32x16_bf16(k0_, qr[d0], C0, 0, 0, 0); C1 = __builtin_amdgcn_mfma_f32_32x32x16_bf16(k1_, qr[d0], C1, 0, 0, 0); } } while (0)
#define FA_CMASK(P0, P1, t) do { const int jb_ = (t) - (NT - 4); if (jb_ >= 0) cmask(P0, P1, jb_, qrel, hi); } while (0)
#define FA_PACK(P0, P1) do { float sacc_ = 0.f; _Pragma("unroll") for (int r = 0; r < 16; ++r) sacc_ += P0[r] + P1[r]; l_reg += sacc_; \
        pw0 = (u32x4){cvtpk_s(P0[0], P0[1]), cvtpk_s(P0[2], P0[3]), cvtpk_s(P0[4], P0[5]), cvtpk_s(P0[6], P0[7])}; pw1 = (u32x4){cvtpk_s(P0[8], P0[9]), cvtpk_s(P0[10], P0[11]), cvtpk_s(P0[12], P0[13]), cvtpk_s(P0[14], P0[15])}; \
        pw2 = (u32x4){cvtpk_s(P1[0], P1[1]), cvtpk_s(P1[2], P1[3]), cvtpk_s(P1[4], P1[5]), cvtpk_s(P1[6], P1[7])}; pw3 = (u32x4){cvtpk_s(P1[8], P1[9]), cvtpk_s(P1[10], P1[11]), cvtpk_s(P1[12], P1[13]), cvtpk_s(P1[14], P1[15])}; } while (0)
#define FA_PAF(k) __builtin_bit_cast(bf16x8, pw##k)
#define FA_PV_EXP(slot_, X0, X1, DOEXP) do { const lds_cptr vp_ = vp0 + (slot_); \
        _Pragma("unroll") for (int d0 = 0; d0 < 4; ++d0) { \
            const s16x4 l0_ = vtr(vp_ + d0 * 4096), h0_ = vtr(vp_ + d0 * 4096 + 512), l1_ = vtr(vp_ + d0 * 4096 + 1024), h1_ = vtr(vp_ + d0 * 4096 + 1024 + 512); \
            const s16x4 l2_ = vtr(vp_ + d0 * 4096 + 2048), h2_ = vtr(vp_ + d0 * 4096 + 2048 + 512), l3_ = vtr(vp_ + d0 * 4096 + 3072), h3_ = vtr(vp_ + d0 * 4096 + 3072 + 512); \
            o[d0] = __builtin_amdgcn_mfma_f32_32x32x16_bf16(FA_PAF(0), (bf16x8){l0_[0], l0_[1], l0_[2], l0_[3], h0_[0], h0_[1], h0_[2], h0_[3]}, o[d0], 0, 0, 0); \
            o[d0] = __builtin_amdgcn_mfma_f32_32x32x16_bf16(FA_PAF(1), (bf16x8){l1_[0], l1_[1], l1_[2], l1_[3], h1_[0], h1_[1], h1_[2], h1_[3]}, o[d0], 0, 0, 0); \
            o[d0] = __builtin_amdgcn_mfma_f32_32x32x16_bf16(FA_PAF(2), (bf16x8){l2_[0], l2_[1], l2_[2], l2_[3], h2_[0], h2_[1], h2_[2], h2_[3]}, o[d0], 0, 0, 0); \
            o[d0] = __builtin_amdgcn_mfma_f32_32x32x16_bf16(FA_PAF(3), (bf16x8){l3_[0], l3_[1], l3_[2], l3_[3], h3_[0], h3_[1], h3_[2], h3_[3]}, o[d0], 0, 0, 0); \
            if (DOEXP) { _Pragma("unroll") for (int r = 0; r < 4; ++r) { X0[4 * d0 + r] = __builtin_amdgcn_exp2f(X0[4 * d0 + r]); X1[4 * d0 + r] = __builtin_amdgcn_exp2f(X1[4 * d0 + r]); } } } } while (0)
#define FA_DECIDE(C0, C1) do { const float rm_ = rowmax(C0, C1); resc = false; \
        if (__builtin_expect(__any(rm_ > (float)THRL), 0)) { const float dl_ = __builtin_fmaxf(rm_, 0.f); mhat += dl_; \
            _Pragma("unroll") for (int r = 0; r < 16; ++r) { C0[r] -= dl_; C1[r] -= dl_; } \
            const float f_ = __builtin_amdgcn_exp2f(-dl_); l_reg *= f_; if (hi == 0) wsf[r32] = f_; resc = true; } } while (0)
#define FA_RESC() do { if (resc) { asm volatile("s_waitcnt lgkmcnt(0)" ::: "memory"); \
        _Pragma("unroll") for (int d_ = 0; d_ < 4; ++d_) _Pragma("unroll") for (int r = 0; r < 16; ++r) o[d_][r] *= wsf[crow(r, hi)]; } } while (0)
#define FA_ENDW(t) do { if ((t) + 2 < NT) { FA_WAIT_BAR(4); } else if ((t) + 1 < NT) { FA_WAIT_BAR(2); } else { FA_WAIT_BAR(0); } } while (0)
#define FA_STEP(C0, C1, P0, P1, t) do { \
        if ((t) + 2 < NT) FA_DMA_K((t) + 2, sl_nn);            \
        FA_SBAR(); FA_QKT(C0, C1, t); FA_PACK(P0, P1); FA_SBAR(); \
        if ((t) + 1 < NT) FA_DMA_V((t) + 1, sl_next);          \
        FA_CMASK(C0, C1, t); FA_DECIDE(C0, C1); FA_SBAR(); \
        FA_PV_EXP(sl_prev, C0, C1, true); FA_SBAR(); \
        FA_ENDW(t); FA_RESC(); FA_ROT(); } while (0)
    FA_WAIT_BAR(0);
    if (2 < NT) FA_DMA_K(2, sl_nn);
    FA_QKT(pA0, pA1, 0); FA_CMASK(pA0, pA1, 0);
    { const float rm = rowmax(pA0, pA1); mhat = rm;
#pragma unroll
        for (int r = 0; r < 16; ++r) { pA0[r] = __builtin_amdgcn_exp2f(pA0[r] - rm); pA1[r] = __builtin_amdgcn_exp2f(pA1[r] - rm); } }
    FA_DMA_V(1, sl_next);
    FA_ENDW(0); FA_ROT();
    int t = 1;
    for (; t + 1 < NT; t += 2) { FA_STEP(pB0, pB1, pA0, pA1, t); FA_STEP(pA0, pA1, pB0, pB1, t + 1); }
    FA_STEP(pB0, pB1, pA0, pA1, NT - 1);
    FA_PACK(pB0, pB1); FA_SBAR(); FA_PV_EXP(sl_prev, pB0, pB1, false);
    { auto rr = __builtin_amdgcn_permlane32_swap(__float_as_uint(l_reg), __float_as_uint(l_reg), false, false); l_reg = __uint_as_float(rr[0]) + __uint_as_float(rr[1]); }
    if (hi == 0) wsf[32 + r32] = l_reg; asm volatile("s_waitcnt lgkmcnt(0)" ::: "memory");
    unsigned short* Ow = Ob + (size_t)(wid * QBLK) * PO;
#pragma unroll
    for (int r = 0; r < 16; ++r) { const int orow = crow(r, hi); const float rl = __builtin_amdgcn_rcpf(wsf[32 + orow]);
#pragma unroll
        for (int d0 = 0; d0 < 4; ++d0) { const float v = o[d0][r] * rl; const float vn = __shfl_xor(v, 1);
            if ((r32 & 1) == 0) *(unsigned*)(Ow + (size_t)orow * PO + d0 * 32 + r32) = cvtpk_s(v, vn); } }
    asm volatile("s_waitcnt lgkmcnt(0)\n\ts_barrier" ::: "memory");
#undef FA_DMA_K
#undef FA_DMA_V
#undef FA_ROT
#undef FA_QKT
#undef FA_CMASK
#undef FA_PACK
#undef FA_PAF
#undef FA_PV_EXP
#undef FA_DECIDE
#undef FA_RESC
#undef FA_ENDW
#undef FA_STEP
}
#undef FA_WAIT_BAR
#undef FA_SBAR
}
#define GAS __attribute__((address_space(1)))
#define LAS __attribute__((address_space(3)))
typedef unsigned short bf16;
typedef unsigned v4u __attribute__((ext_vector_type(4)));
typedef float f32x4 __attribute__((ext_vector_type(4)));
typedef short bf16x8 __attribute__((ext_vector_type(8)));
typedef GAS unsigned gu32;
typedef GAS unsigned long long gu64;
#define RLX_AGENT __ATOMIC_RELAXED, __HIP_MEMORY_SCOPE_AGENT
#define LDS_WAIT() asm volatile("s_waitcnt lgkmcnt(0)" ::: "memory")
#define VM_WAIT() asm volatile("s_waitcnt vmcnt(0)" ::: "memory")
__device__ __forceinline__ unsigned long long rt() { return __builtin_amdgcn_s_memrealtime(); }
__device__ __forceinline__ unsigned f2bf(float f) { unsigned u = __builtin_bit_cast(unsigned, f); return (u + 0x7fffu + ((u >> 16) & 1u)) >> 16; }
__device__ __forceinline__ unsigned pk2(float lo, float hi) { return f2bf(lo) | (f2bf(hi) << 16); }

#define XB_TMO      128
#define XB_XCNT(j)  (256  + 64 * (j))
#define XB_XSUB(j)  (1280 + 64 * (j))
#define XB_XGEN(j)  (2304 + 64 * (j))
#define XB_TOP      3328
#define XB_TOPGEN   3392
#define XCD_BAR_WORDS 3456
#define XB_SPIN_CAP (1u << 18)

__device__ __forceinline__ unsigned xb_ld(unsigned* p)              { return __hip_atomic_load(p, __ATOMIC_RELAXED, __HIP_MEMORY_SCOPE_AGENT); }
__device__ __forceinline__ unsigned xb_add(unsigned* p, unsigned v) { return __hip_atomic_fetch_add(p, v, __ATOMIC_RELAXED, __HIP_MEMORY_SCOPE_AGENT); }
__device__ __forceinline__ unsigned xb_xcc_id() { return (unsigned)__builtin_amdgcn_s_getreg((3 << 11) | 20) & 0xFu; }
#define XB_SPIN(cond, bar) do { unsigned _sp = 0; while (cond) { __builtin_amdgcn_s_sleep(1); \
    if ((++_sp & 255u) == 0u) { if (xb_ld(&(bar)[XB_TMO])) break; if (_sp > XB_SPIN_CAP) { atomicAdd(&(bar)[XB_TMO], 1u); break; } } } } while (0)

struct XcdBarrier {
    unsigned* bar; unsigned x;
    volatile LAS unsigned* st;
};

__device__ __forceinline__ XcdBarrier xcd_barrier_post(unsigned* bar, volatile LAS unsigned* st) {
    XcdBarrier b; b.bar = bar; b.x = xb_xcc_id(); b.st = st;
    if (threadIdx.x == 0) (void)xb_add(&bar[XB_XCNT(b.x)], 1u);
    return b;
}
__device__ __forceinline__ void xcd_barrier_complete(unsigned* bar, unsigned x, unsigned& nloc, unsigned& nx) {
    const unsigned G = gridDim.x * gridDim.y * gridDim.z;
    unsigned sum, cnt, mine, sp = 0u;
    for (;;) {
        sum = 0u; cnt = 0u; mine = 0u;
#pragma unroll
        for (unsigned j = 0; j < 16; ++j) { const unsigned c = xb_ld(&bar[XB_XCNT(j)]); sum += c; cnt += (c > 0u) ? 1u : 0u; mine = (j == x) ? c : mine; }
        if (sum == G) break;
        __builtin_amdgcn_s_sleep(1);
        if ((++sp & 255u) == 0u) { if (xb_ld(&bar[XB_TMO])) break; if (sp > XB_SPIN_CAP) { atomicAdd(&bar[XB_TMO], 1u); break; } }
    }
    nloc = mine > 0u ? mine : 1u; nx = cnt > 0u ? cnt : 1u;
}

__device__ __forceinline__ void xcd_barrier(const XcdBarrier& b) {
    asm volatile("s_waitcnt vmcnt(0)" ::: "memory");
    __syncthreads();
    if (threadIdx.x == 0) {
        unsigned* bar = b.bar;
        __builtin_amdgcn_s_waitcnt(0);
        unsigned nloc = b.st[0], nx = b.st[1];
        if (nloc == 0u) { xcd_barrier_complete(bar, b.x, nloc, nx); b.st[0] = nloc; b.st[1] = nx; }
        const unsigned old = xb_add(&bar[XB_XSUB(b.x)], 1u);
        const unsigned gen = old / nloc;
        if (old + 1u == (gen + 1u) * nloc) {
            __builtin_amdgcn_fence(__ATOMIC_RELEASE, "agent");
            asm volatile("s_waitcnt vmcnt(0)" ::: "memory");
            const unsigned og = xb_add(&bar[XB_TOP], 1u);
            const unsigned tg = og / nx;
            if (og + 1u == (tg + 1u) * nx) xb_add(&bar[XB_TOPGEN], 1u);
            else XB_SPIN(xb_ld(&bar[XB_TOPGEN]) == tg, bar);
            __builtin_amdgcn_fence(__ATOMIC_ACQUIRE, "agent");
            xb_add(&bar[XB_XGEN(b.x)], 1u);
            asm volatile("s_waitcnt vmcnt(0)" ::: "memory");
        } else {
            XB_SPIN(xb_ld(&bar[XB_XGEN(b.x)]) == gen, bar);
            __builtin_amdgcn_fence(__ATOMIC_ACQUIRE, "agent");
            asm volatile("s_waitcnt vmcnt(0)" ::: "memory");
        }
    }
    __syncthreads();
}
#ifndef STAMP_K
#define STAMP_K -1
#endif
#ifndef DUP_MASK
#define DUP_MASK 0
#endif
constexpr int NWAVES = 8, NTHR = NWAVES * 64;
constexpr int T_TOK = 16384, SEQ = 4096, NBATCH = 4, DM = 1024;
constexpr int IN_COLS = 8216, NPROJ = 8192, NPROJ_PAD = 8448;
constexpr int C_GQ = 0, C_GK = 512, C_GV = 1024, C_GR = 2048, PPITCH = 3072;
constexpr int NE = 32, DFF = 1024, NCHUNK = 64;
constexpr float LN_EPS = 1e-5f;
constexpr float DN_ALPHA = 1.189207115002721f;
constexpr float FOX_INV_SCALE = 1.4426950408889634f;
constexpr float GLA_QSCALE = 0.08838834764831845f;
constexpr int SLOT_ROWS = 73728;

constexpr size_t MiB = 1u << 20;
constexpr size_t WS_CTL = 0, CTL_ZERO_BYTES = 1 * MiB;
constexpr size_t WS_WIN = 2 * MiB;
constexpr size_t WS_WPROJ = 19 * MiB;
constexpr size_t WS_WOUT = 23 * MiB;
constexpr size_t WS_WGU = 25 * MiB;
constexpr size_t WS_WDN = 153 * MiB;
constexpr size_t WS_H0B = 217 * MiB;
constexpr size_t WS_SM = 249 * MiB;
constexpr size_t WS_FB = 251 * MiB;
constexpr size_t WS_DECAY = 252 * MiB;
constexpr size_t WS_KDEC = 253 * MiB;
constexpr size_t WS_AO = 269 * MiB;
constexpr size_t WS_MIXED = 333 * MiB;
constexpr size_t WS_H1F = 365 * MiB;
constexpr size_t WS_H1B = 429 * MiB;
constexpr size_t WS_TOKOF = 461 * MiB;
constexpr size_t WS_PAIR = 463 * MiB;
constexpr size_t WS_PROJ = 464 * MiB;
constexpr size_t WS_YS = 560 * MiB;
constexpr size_t WS_FQKV = 704 * MiB;
constexpr size_t WS_ZIMG = 800 * MiB;
constexpr size_t WS_ACT = WS_FQKV;
constexpr size_t WS_END = 864 * MiB;
static_assert(WS_WIN + (size_t)NPROJ_PAD * 1024 * 2 <= WS_WPROJ && WS_WGU + (size_t)32 * 2048 * 1024 * 2 <= WS_WDN && WS_WDN + (size_t)32 * 1024 * 1024 * 2 <= WS_H0B, "ws map");
static_assert(WS_PROJ + (size_t)T_TOK * PPITCH * 2 <= WS_YS && WS_YS + (size_t)SLOT_ROWS * 1024 * 2 <= WS_FQKV && WS_FQKV + (size_t)3 * 32 * 4096 * 128 * 2 <= WS_ZIMG && WS_ZIMG + (size_t)64 * MiB <= WS_END && WS_ACT + (size_t)SLOT_ROWS * 1024 * 2 <= WS_END, "ws map");
constexpr int CW_TMO = 0, CW_CODE = 1;
constexpr int CW_BAR = 4096;
constexpr int CW_CNT = 8192;
constexpr int CW_Q = 12288;

constexpr int RING_OFF = 0, RING_BYTES = 131072;
constexpr int LDSCTL_OFF = RING_BYTES, MISC_OFF = LDSCTL_OFF + 320;
constexpr int TBL_OFF = RING_BYTES + 512;
constexpr int TBL_CUM = TBL_OFF, TBL_CNT = TBL_OFF + 256, TBL_DESC = TBL_OFF + 384, TBL_IDX = TBL_OFF + 768;
constexpr int LDS_BYTES = 147456;
static_assert(TBL_IDX + pg8::MAXU * 256 * 4 <= LDS_BYTES && fa128::LDS_BYTES <= RING_BYTES, "LDS map");

__device__ __forceinline__ float bfu(unsigned short h) { return __uint_as_float((unsigned)h << 16); }
__device__ __forceinline__ float logsig(float x) { return fminf(x, 0.f) - __logf(1.0f + __expf(-fabsf(x))); }
__device__ __forceinline__ float wave_sum(float v) {
#pragma unroll
    for (int o = 1; o < 64; o <<= 1) v += __shfl_xor(v, o);
    return v;
}

__device__ __forceinline__ void p0_tile_load(f32x4 (&v)[16], const float* W, int npitch, int srccol, int kb, int lane) {
    const int q = lane & 15, rg = lane >> 4, k0 = 64 * kb + 16 * rg;
    const GAS f32x4* src = (const GAS f32x4*)(W + (size_t)k0 * npitch + srccol + 4 * q);
#pragma unroll
    for (int i = 0; i < 16; ++i) v[i] = src[(size_t)i * (npitch / 4)];
}
__device__ __forceinline__ void p0_tile_store(const f32x4 (&v)[16], bf16* WT, int dstrow, int kb, int lane) {
    const int q = lane & 15, rg = lane >> 4, k0 = 64 * kb + 16 * rg;
#pragma unroll
    for (int j = 0; j < 4; ++j) { GAS v4u* dst = (GAS v4u*)(WT + (size_t)(dstrow + 4 * q + j) * 1024 + k0);
        v4u a, b;
        a.x = pk2(v[0][j], v[1][j]); a.y = pk2(v[2][j], v[3][j]); a.z = pk2(v[4][j], v[5][j]); a.w = pk2(v[6][j], v[7][j]);
        b.x = pk2(v[8][j], v[9][j]); b.y = pk2(v[10][j], v[11][j]); b.z = pk2(v[12][j], v[13][j]); b.w = pk2(v[14][j], v[15][j]);
        dst[0] = a; dst[1] = b; }
}
__device__ __forceinline__ void p0_transpose_tile(const float* W, int npitch, int srccol, bf16* WT, int dstrow, int kb, int lane) {
    const int q = lane & 15, rg = lane >> 4, k0 = 64 * kb + 16 * rg;
    const GAS f32x4* src = (const GAS f32x4*)(W + (size_t)k0 * npitch + srccol + 4 * q);
    f32x4 v[16];
#pragma unroll
    for (int i = 0; i < 16; ++i) v[i] = __builtin_nontemporal_load(src + (size_t)i * (npitch / 4));
#pragma unroll
    for (int j = 0; j < 4; ++j) { GAS v4u* dst = (GAS v4u*)(WT + (size_t)(dstrow + 4 * q + j) * 1024 + k0);
        v4u a, b;
        a.x = pk2(v[0][j], v[1][j]); a.y = pk2(v[2][j], v[3][j]); a.z = pk2(v[4][j], v[5][j]); a.w = pk2(v[6][j], v[7][j]);
        b.x = pk2(v[8][j], v[9][j]); b.y = pk2(v[10][j], v[11][j]); b.z = pk2(v[12][j], v[13][j]); b.w = pk2(v[14][j], v[15][j]);
        __builtin_nontemporal_store(a, dst); __builtin_nontemporal_store(b, dst + 1); }
}
__device__ __forceinline__ void* ldptr(const LAS unsigned long long* PT, int i) { const unsigned long long v = PT[i];
    const unsigned lo = __builtin_amdgcn_readfirstlane((unsigned)v), hi = __builtin_amdgcn_readfirstlane((unsigned)(v >> 32)); return (void*)(GAS unsigned char*)(uintptr_t)(((unsigned long long)hi << 32) | lo); }
constexpr int CV_PRJ = 3 * 256, CV_GU = 32 * 512, CV_DN = 32 * 256, CV_ITEMS = CV_PRJ + CV_GU + CV_DN;
constexpr int CV_P1 = 192 * 8 * 3;
__device__ __forceinline__ void conv_tile(int it, const LAS unsigned long long* PT, int ln) {
    unsigned char* const wsb = (unsigned char*)ldptr(PT, 22);
    if (it < CV_PRJ) { const int mm = it >> 8, r = it & 255, db = r >> 4, kb = r & 15;
        const float* W = (const float*)ldptr(PT, 8 + mm); bf16* WT = mm < 2 ? (bf16*)(wsb + WS_WPROJ) + (size_t)mm * 1024 * 1024 : (bf16*)(wsb + WS_WOUT);
        p0_transpose_tile(W, 1024, 64 * db, WT, 64 * db, kb, ln); return; }
    it -= CV_PRJ;
    if (it < CV_GU) { const int e = it >> 9, r = it & 511, db = r >> 4, kb = r & 15, pn = db >> 2, jb = db & 3;
        const int src = jb < 2 ? 128 * pn + 64 * jb : 1024 + 128 * pn + 64 * (jb - 2);
        p0_transpose_tile((const float*)ldptr(PT, 15) + (size_t)e * 1024 * 2048, 2048, src, (bf16*)(wsb + WS_WGU) + (size_t)e * 2048 * 1024, 64 * db, kb, ln); return; }
    it -= CV_GU;
    { const int e = it >> 8, r = it & 255, db = r >> 4, kb = r & 15;
        p0_transpose_tile((const float*)ldptr(PT, 17) + (size_t)e * 1024 * 1024, 1024, 64 * db, (bf16*)(wsb + WS_WDN) + (size_t)e * 1024 * 1024, 64 * db, kb, ln); }
}
__device__ __forceinline__ void ln_row(const f32x4 (&xin)[4], f32x4 (&y)[4], const float* g, const float* b, int lane) {
    float s = 0.f;
#pragma unroll
    for (int j = 0; j < 4; ++j) s += (xin[j].x + xin[j].y) + (xin[j].z + xin[j].w);
    const float mean = wave_sum(s) * (1.f / DM); float s2 = 0.f;
#pragma unroll
    for (int j = 0; j < 4; ++j) { y[j] = xin[j] - mean; s2 += (y[j].x * y[j].x + y[j].y * y[j].y) + (y[j].z * y[j].z + y[j].w * y[j].w); }
    const float rstd = 1.f / sqrtf(wave_sum(s2) * (1.f / DM) + LN_EPS);
#pragma unroll
    for (int j = 0; j < 4; ++j) { const f32x4 gv = *(const f32x4*)(g + 4 * lane + 256 * j), bv = *(const f32x4*)(b + 4 * lane + 256 * j); y[j] = y[j] * rstd * gv + bv; }
}
__device__ __forceinline__ void store_row_bf16(bf16* orow, const f32x4 (&y)[4], int lane) {
    GAS unsigned long long* o8 = (GAS unsigned long long*)orow + lane;
#pragma unroll
    for (int j = 0; j < 4; ++j) o8[64 * j] = (unsigned long long)pk2(y[j].x, y[j].y) | ((unsigned long long)pk2(y[j].z, y[j].w) << 32);
}

struct Args { const float* in[21]; float* out; unsigned char* ws; int ph_lo, ph_hi, li, pad; };
constexpr int NPH = 11;

__global__ void __launch_bounds__(NTHR, 2) mega_fwd(Args args) {
    extern __shared__ __attribute__((aligned(16))) unsigned char lds[];
    LAS unsigned char* const ldsl = (LAS unsigned char*)lds;
    volatile LAS unsigned* const MISC = (volatile LAS unsigned*)(ldsl + MISC_OFF);
    const int tid = threadIdx.x, lane = tid & 63, wave = __builtin_amdgcn_readfirstlane(tid >> 6);
    const int G = gridDim.x; const int bx = blockIdx.x; const int vcu = (G % 8 == 0) ? (bx % 8) * (G / 8) + bx / 8 : bx;
    for (int u = tid; u < (LDS_BYTES - LDSCTL_OFF) / 4; u += NTHR) ((LAS unsigned*)(ldsl + LDSCTL_OFF))[u] = 0u;
    __syncthreads();
    LAS unsigned long long* const PT = (LAS unsigned long long*)(ldsl + LDSCTL_OFF);
    if (tid == 0) {
#pragma unroll
        for (int i = 0; i < 21; ++i) PT[i] = (unsigned long long)(uintptr_t)args.in[i];
        PT[21] = (unsigned long long)(uintptr_t)args.out; PT[22] = (unsigned long long)(uintptr_t)args.ws; }
    __syncthreads();
#define INP(i) ((const float*)ldptr(PT, (i)))
#define WSB ((unsigned char*)ldptr(PT, 22))
    const int lo = args.ph_lo, hi = args.ph_hi;
    unsigned long long t_stamp_a = 0ull; const unsigned long long t_stamp_0 = (STAMP_K >= 0) ? __builtin_amdgcn_s_memrealtime() : 0ull;
    const bool use_bar = (hi - lo) > 1;
    if (use_bar) (void)xcd_barrier_post((unsigned*)(WSB + WS_CTL) + CW_BAR, MISC + 8);
#ifndef PH_MASK
#define PH_MASK 0x7FF
#endif
#define IN(k) ((((PH_MASK) >> (k)) & 1) && lo <= (k) && (k) < hi)
#ifndef DUP_MASK
#define DUP_MASK 0
#endif
#define DUP(k) for (int rep_ = 0; rep_ < 1 + (((DUP_MASK) >> (k)) & 1); ++rep_)
#define SEAM(k) do { if (STAMP_K == (k) && bx == 0 && tid == 0) { t_stamp_a = __builtin_amdgcn_s_memrealtime(); } if (IN(k) && IN((k) + 1)) { XcdBarrier b_; b_.bar = (unsigned*)(WSB + WS_CTL) + CW_BAR; b_.x = xb_xcc_id(); b_.st = MISC + 8; xcd_barrier(b_); if ((DUP_MASK >> 16) & 1) { xcd_barrier(b_); xcd_barrier(b_); } } if (STAMP_K == (k) + 100 && bx == 0 && tid == 0) { t_stamp_a = __builtin_amdgcn_s_memrealtime(); } } while (0)

    if (IN(0)) DUP(0) {
        bf16* const WIN_T = (bf16*)(WSB + WS_WIN); bf16* const WPROJ_T = (bf16*)(WSB + WS_WPROJ); bf16* const WOUT_T = (bf16*)(WSB + WS_WOUT); bf16* const WGU_T = (bf16*)(WSB + WS_WGU); bf16* const WDN_T = (bf16*)(WSB + WS_WDN); bf16* const H0B = (bf16*)(WSB + WS_H0B);
        const float* const x = INP(0); const float* const ln_in_g = INP(1); const float* const ln_in_b = INP(2); const float* const w_in = INP(3); const float* const w_gla_proj = INP(8); const float* const w_fox_proj = INP(9); const float* const w_out = INP(10); const float* const w_gate_up = INP(15); const float* const w_down = INP(17);
        const int gw = vcu * NWAVES + wave, NGW = G * NWAVES;
        constexpr int I_IN = 128 * 16;
        for (int it = gw; it < I_IN; it += NGW) { const int db = it >> 4, kb = it & 15, dst = 64 * db, src = dst + (dst < 2048 ? 0 : (dst < 6144 ? 16 : 24));
            p0_transpose_tile(w_in, IN_COLS, src, WIN_T, dst, kb, lane); }
        for (int i = vcu * NTHR + tid; i < 256 * 1024; i += G * NTHR) { const int r = i >> 10, k = i & 1023;
            float v = 0.f; if (r < 16) v = w_in[(size_t)k * IN_COLS + 2048 + r]; else if (r < 24) v = w_in[(size_t)k * IN_COLS + 6160 + (r - 16)];
            WIN_T[(size_t)(NPROJ + r) * 1024 + k] = (bf16)f2bf(v); }
        for (int m0 = gw; m0 < T_TOK; m0 += 4 * NGW) {
            f32x4 v[4][4], y[4];
#pragma unroll
            for (int r = 0; r < 4; ++r) { const GAS f32x4* xr = (const GAS f32x4*)(x + (size_t)(m0 + r * NGW) * DM) + lane;
#pragma unroll
                for (int j = 0; j < 4; ++j) v[r][j] = xr[64 * j]; }
#pragma unroll
            for (int r = 0; r < 4; ++r) { ln_row(v[r], y, ln_in_g, ln_in_b, lane); store_row_bf16(H0B + (size_t)(m0 + r * NGW) * DM, y, lane); } }
    }
    SEAM(0);

    if (IN(1)) DUP(1) {
        bf16* const H0B = (bf16*)(WSB + WS_H0B); bf16* const WIN_T = (bf16*)(WSB + WS_WIN); bf16* const PROJ = (bf16*)(WSB + WS_PROJ); float* const SM = (float*)(WSB + WS_SM);
        pg8::Gemm g{H0B, WIN_T, T_TOK, NPROJ_PAD, DM}; pg8::StaticOrder S; S.init(T_TOK, NPROJ_PAD, G, bx);
        pg8::EpiProj E{PROJ, SM, (bf16*)(WSB + WS_FQKV), (bf16*)(WSB + WS_ZIMG)};
        pg8::gemm_phase<pg8::EpiProj, pg8::StaticOrder, true, true, false>(ldsl + RING_OFF, g, S, E);
        if (bx >= 64 && rep_ == 0) {
            const int cw = ((bx - 64) * NWAVES + wave) * 3;
#pragma unroll 1
            for (int t = 0; t < 3; ++t) conv_tile(cw + t, PT, lane);
        }
    }
    SEAM(1);

    if (IN(2)) DUP(2) {
        float* const SM = (float*)(WSB + WS_SM); float* const FB = (float*)(WSB + WS_FB); float* const DECAY = (float*)(WSB + WS_DECAY); bf16* const KDEC = (bf16*)(WSB + WS_KDEC); bf16* const VT = (bf16*)(WSB + WS_MIXED); bf16* const PROJ = (bf16*)(WSB + WS_PROJ);
        const float* const w_gup = INP(4); const float* const b_gla_gate = INP(5); const float* const b_forget = INP(7);
        LAS float* sc = (LAS float*)(ldsl + RING_OFF);
        for (int bh = vcu; bh < 32; bh += G) {
            const int b = bh >> 3, h = bh & 7; const float bf_ = b_forget[h];
            float v[8]; float run = 0.f;
#pragma unroll
            for (int j = 0; j < 8; ++j) { const int s = tid * 8 + j; run += logsig(SM[(size_t)(b * SEQ + s) * 32 + 16 + h] + bf_); v[j] = run; }
            float incl = run;
#pragma unroll
            for (int o = 1; o < 64; o <<= 1) { const float t = __shfl_up(incl, o); if (lane >= o) incl += t; }
            if (lane == 63) sc[wave] = incl;
            __syncthreads();
            float woff = 0.f;
            for (int w = 0; w < wave; ++w) woff += sc[w];
            const float off = woff + (incl - run);
#pragma unroll
            for (int j = 0; j < 8; ++j) FB[(size_t)bh * SEQ + tid * 8 + j] = -(off + v[j]) * FOX_INV_SCALE;
            __syncthreads();
        }
        {
            LAS float* const GL = (LAS float*)(ldsl + RING_OFF + 4096);
            LAS unsigned short* const KL = (LAS unsigned short*)(ldsl + RING_OFF + 8192);
            LAS unsigned short* const VL = (LAS unsigned short*)(ldsl + RING_OFF + 8192 + 16384);
            const int j = tid & 127, cq = tid >> 7; const int h = vcu & 3; const int col = h * 128 + j;
            float wu[16];
#pragma unroll
            for (int r = 0; r < 16; ++r) wu[r] = w_gup[r * 512 + col];
            const float bg = b_gla_gate[col];
            v4u kq[2], vq[4]; f32x4 gq = {0.f, 0.f, 0.f, 0.f};
#define PREP_LOAD(it_) do { const int n_ = ((it_) >> 2) & 63, b_ = (it_) >> 8; const size_t t0_ = (size_t)b_ * SEQ + n_ * 64; \
                _Pragma("unroll") for (int i = 0; i < 2; ++i) { const int p = tid + NTHR * i; kq[i] = *(const GAS v4u*)(PROJ + (t0_ + (p >> 4)) * PPITCH + C_GK + h * 128 + (p & 15) * 8); } \
                _Pragma("unroll") for (int i = 0; i < 4; ++i) { const int p = tid + NTHR * i; vq[i] = *(const GAS v4u*)(PROJ + (t0_ + (p >> 5)) * PPITCH + C_GV + h * 256 + (p & 31) * 8); } \
                if (tid < 256) gq = *(const GAS f32x4*)(SM + (t0_ + (tid >> 2)) * 32 + 4 * (tid & 3)); } while (0)
            PREP_LOAD(vcu);
            for (int it = vcu; it < NBATCH * NCHUNK * 4; it += G) {
                const int n = (it >> 2) & 63, b = it >> 8;
#pragma unroll
                for (int i = 0; i < 2; ++i) { const int p = tid + NTHR * i; *(LAS v4u*)(KL + (p >> 4) * 128 + (p & 15) * 8) = kq[i]; }
#pragma unroll
                for (int i = 0; i < 4; ++i) { const int p = tid + NTHR * i; *(LAS v4u*)(VL + (p >> 5) * 256 + (p & 31) * 8) = vq[i]; }
                if (tid < 256) *(LAS f32x4*)(GL + (tid >> 2) * 16 + 4 * (tid & 3)) = gq;
                __syncthreads();
                if (it + G < NBATCH * NCHUNK * 4) PREP_LOAD(it + G);
                float cum[16]; float run = 0.f;
#pragma unroll
                for (int c = 0; c < 16; ++c) { const LAS float* gl = GL + (cq * 16 + c) * 16; float z = bg;
#pragma unroll
                    for (int r4 = 0; r4 < 4; ++r4) { const f32x4 g4 = *(const LAS f32x4*)(gl + 4 * r4); z += g4.x * wu[4 * r4] + g4.y * wu[4 * r4 + 1] + g4.z * wu[4 * r4 + 2] + g4.w * wu[4 * r4 + 3]; }
                    run += logsig(z) * (1.0f / 16.0f); cum[c] = run; }
                sc[cq * 128 + j] = run;
                __syncthreads();
                float off = 0.f, total = 0.f;
#pragma unroll
                for (int q = 0; q < 4; ++q) { const float t = sc[q * 128 + j]; total += t; if (q < cq) off += t; }
                {   unsigned pk[8];
#pragma unroll
                    for (int c = 0; c < 16; c += 2) { const int cc = cq * 16 + c;
                        pk[c >> 1] = pk2(bfu(KL[cc * 128 + j]) * __expf(total - (off + cum[c])), bfu(KL[(cc + 1) * 128 + j]) * __expf(total - (off + cum[c + 1]))); }
                    GAS v4u* dst = (GAS v4u*)(KDEC + (size_t)it * 8192 + j * 64 + cq * 16);
                    v4u w0, w1; w0.x = pk[0]; w0.y = pk[1]; w0.z = pk[2]; w0.w = pk[3]; w1.x = pk[4]; w1.y = pk[5]; w1.z = pk[6]; w1.w = pk[7]; dst[0] = w0; dst[1] = w1; }
                if (cq == 0) DECAY[(size_t)(b * NCHUNK + n) * 512 + col] = expf(total);
                {   const int dv = tid & 255, ch = tid >> 8; unsigned pk[16];
#pragma unroll
                    for (int c = 0; c < 32; c += 2) pk[c >> 1] = (unsigned)VL[(ch * 32 + c) * 256 + dv] | ((unsigned)VL[(ch * 32 + c + 1) * 256 + dv] << 16);
                    GAS v4u* dst = (GAS v4u*)(VT + (size_t)it * 16384 + dv * 64 + ch * 32);
#pragma unroll
                    for (int q = 0; q < 4; ++q) { v4u w; w.x = pk[4 * q]; w.y = pk[4 * q + 1]; w.z = pk[4 * q + 2]; w.w = pk[4 * q + 3]; dst[q] = w; } }
                __syncthreads();
            }
#undef PREP_LOAD
        }
    }
    SEAM(2);

    if (IN(3)) {
        float* const FB = (float*)(WSB + WS_FB); float* const DECAY = (float*)(WSB + WS_DECAY); bf16* const KDEC = (bf16*)(WSB + WS_KDEC); bf16* const VT = (bf16*)(WSB + WS_MIXED); bf16* const PROJ = (bf16*)(WSB + WS_PROJ); bf16* const AO = (bf16*)(WSB + WS_AO);
        const float* const g_gla_norm = INP(6);
        LAS int* const QW = (LAS int*)(ldsl + TBL_CUM);
        DUP(13) {
        gu32* const ctlq = (gu32*)(WSB + WS_CTL) + CW_Q + rep_ * 1024;
        int qoff = 0;
#define P2_FETCH(dst) do { if (tid == 0) { int code_ = -1, t_ = qoff; for (; t_ < 8; ++t_) { const int k_ = (bx + t_) & 7; const unsigned i_ = __hip_atomic_fetch_add(ctlq + 64 * k_, 1u, __ATOMIC_RELAXED, __HIP_MEMORY_SCOPE_AGENT); \
                if (i_ < 66u) { code_ = k_ * 66 + (int)i_; break; } } QW[0] = code_; QW[1] = t_; } \
            __syncthreads(); dst = __builtin_amdgcn_readfirstlane(QW[0]); qoff = __builtin_amdgcn_readfirstlane(QW[1]); __syncthreads(); } while (0)
        int code; P2_FETCH(code);
        bool primed = false; int bbuf = 0;
        const unsigned short* const Pq = (const unsigned short*)(WSB + WS_FQKV); unsigned short* const Oo = (unsigned short*)(AO + (size_t)T_TOK * 1024);
#define P2_BIAS(code_, buf_) do { const int k_ = (code_) / 66, a_ = (code_) % 66 - 2; const int bh_ = 4 * k_ + (a_ & 3); LAS f32x4* bl_ = (LAS f32x4*)(ldsl + fa128::LDS_BIAS + (buf_) * 16384); \
            const GAS f32x4* src_ = (const GAS f32x4*)(FB + (size_t)bh_ * SEQ); bl_[tidl] = src_[tidl]; bl_[tidl + NTHR] = src_[tidl + NTHR]; } while (0)
        while (code >= 0) {
          int tidl = tid; asm volatile("" : "+v"(tidl));
          if (code % 66 < 2) {
            primed = false;
            typedef float f32x16 __attribute__((ext_vector_type(16)));
            const int gitem = 2 * (code / 66) + code % 66;
            const int tid = tidl, lane = tid & 63, wave = __builtin_amdgcn_readfirstlane(tid >> 6);
            const int b = gitem >> 2, h = gitem & 3; const int r32 = lane & 31, hi = lane >> 5;
#define GLA_KT(bf_) (ldsl + RING_OFF + (bf_) * 18432)
#define GLA_QT(bf_) (ldsl + RING_OFF + 36864 + (bf_) * 16896)
#define GLA_DC(bf_) ((LAS float*)(ldsl + RING_OFF + 70656 + (bf_) * 512))
#define GLA_OS (ldsl + RING_OFF + 71680)
#define GLA_SS ((LAS float*)(ldsl + RING_OFF + 71680 + 33792))
            bf16* const ORAW = (bf16*)(WSB + WS_H1B); float* const SSQ = (float*)(WSB + WS_TOKOF);
            f32x16 Sacc[4];
#pragma unroll
            for (int m = 0; m < 4; ++m)
#pragma unroll
                for (int r = 0; r < 16; ++r) Sacc[m][r] = 0.f;
            const int p0 = tid, p1 = tid + 512;
            const unsigned kdst0 = (p0 >> 3) * 144 + (p0 & 7) * 16, kdst1 = (p1 >> 3) * 144 + (p1 & 7) * 16, qdst0 = (p0 >> 4) * 264 + (p0 & 15) * 16, qdst1 = (p1 >> 4) * 264 + (p1 & 15) * 16;
            v4u kst0, kst1, qst0, qst1; float dcs = 0.f; bf16x8 vf[4];
#define GLA_LOAD_STAGE(n_) do { const size_t item_ = (size_t)((b * NCHUNK + (n_)) * 4 + h); const size_t tok0_ = (size_t)b * SEQ + (size_t)(n_) * 64; \
                kst0 = *(const GAS v4u*)(KDEC + item_ * 8192 + (p0 >> 3) * 64 + (p0 & 7) * 8); kst1 = *(const GAS v4u*)(KDEC + item_ * 8192 + (p1 >> 3) * 64 + (p1 & 7) * 8); \
                qst0 = *(const GAS v4u*)(PROJ + (tok0_ + (p0 >> 4)) * PPITCH + C_GQ + h * 128 + (p0 & 15) * 8); qst1 = *(const GAS v4u*)(PROJ + (tok0_ + (p1 >> 4)) * PPITCH + C_GQ + h * 128 + (p1 & 15) * 8); \
                if (tid < 128) dcs = DECAY[(size_t)(b * NCHUNK + (n_)) * 512 + h * 128 + tid]; } while (0)
#define GLA_LOAD_V(n_) do { const bf16* vb_ = VT + (size_t)((b * NCHUNK + (n_)) * 4 + h) * 16384 + (size_t)(32 * wave + r32) * 64 + 8 * hi; \
                _Pragma("unroll") for (int ks = 0; ks < 4; ++ks) vf[ks] = *(const GAS bf16x8*)(vb_ + 16 * ks); } while (0)
            GLA_LOAD_STAGE(0); GLA_LOAD_V(0);
            for (int n = 0; n < NCHUNK; ++n) {
                const size_t tok0 = (size_t)b * SEQ + (size_t)n * 64; const int bf = n & 1;
                LAS unsigned char* const KT = GLA_KT(bf); LAS unsigned char* const QT = GLA_QT(bf); LAS float* const DC = GLA_DC(bf);
                *(LAS v4u*)(KT + kdst0) = kst0; *(LAS v4u*)(KT + kdst1) = kst1; *(LAS v4u*)(QT + qdst0) = qst0; *(LAS v4u*)(QT + qdst1) = qst1;
                if (tid < 128) DC[tid] = dcs;
                __syncthreads();
                if (n + 1 < NCHUNK) GLA_LOAD_STAGE(n + 1);
#pragma unroll
                for (int m = 0; m < 4; ++m)
#pragma unroll
                    for (int g4 = 0; g4 < 4; ++g4) { const f32x4 d4 = *(const LAS f32x4*)(DC + 32 * m + 8 * g4 + 4 * hi);
                        Sacc[m][4 * g4 + 0] *= d4.x; Sacc[m][4 * g4 + 1] *= d4.y; Sacc[m][4 * g4 + 2] *= d4.z; Sacc[m][4 * g4 + 3] *= d4.w; }
#pragma unroll
                for (int m = 0; m < 4; ++m)
#pragma unroll
                    for (int ks = 0; ks < 4; ++ks) { const bf16x8 kf = *(const LAS bf16x8*)(KT + (32 * m + r32) * 144 + (16 * ks + 8 * hi) * 2);
                        Sacc[m] = __builtin_amdgcn_mfma_f32_32x32x16_bf16(kf, vf[ks], Sacc[m], 0, 0, 0); }
                if (n + 1 < NCHUNK) GLA_LOAD_V(n + 1);
                f32x16 ot[2];
#pragma unroll
                for (int nt = 0; nt < 2; ++nt)
#pragma unroll
                    for (int r = 0; r < 16; ++r) ot[nt][r] = 0.f;
#pragma unroll
                for (int m = 0; m < 4; ++m)
#pragma unroll
                    for (int sx = 0; sx < 2; ++sx) {
                        v4u ap; ap.x = pg8::cvt_pk_bf16(Sacc[m][8 * sx + 0], Sacc[m][8 * sx + 1]); ap.y = pg8::cvt_pk_bf16(Sacc[m][8 * sx + 2], Sacc[m][8 * sx + 3]);
                        ap.z = pg8::cvt_pk_bf16(Sacc[m][8 * sx + 4], Sacc[m][8 * sx + 5]); ap.w = pg8::cvt_pk_bf16(Sacc[m][8 * sx + 6], Sacc[m][8 * sx + 7]);
                        const bf16x8 af = __builtin_bit_cast(bf16x8, ap);
#pragma unroll
                        for (int nt = 0; nt < 2; ++nt) { const LAS unsigned char* qp = QT + (32 * nt + r32) * 264 + (32 * m + 16 * sx + 4 * hi) * 2;
                            const unsigned long long qlo = *(const LAS unsigned long long*)qp, qhi = *(const LAS unsigned long long*)(qp + 16);
                            v4u bp; bp.x = (unsigned)qlo; bp.y = (unsigned)(qlo >> 32); bp.z = (unsigned)qhi; bp.w = (unsigned)(qhi >> 32);
                            ot[nt] = __builtin_amdgcn_mfma_f32_32x32x16_bf16(af, __builtin_bit_cast(bf16x8, bp), ot[nt], 0, 0, 0); } }
#pragma unroll
                for (int nt = 0; nt < 2; ++nt) { float a = 0.f; const int c = 32 * nt + r32;
#pragma unroll
                    for (int r = 0; r < 16; ++r) a += ot[nt][r] * ot[nt][r];
                    a += __shfl_xor(a, 32);
                    if (hi == 0) GLA_SS[c * 8 + wave] = a;
#pragma unroll
                    for (int g4 = 0; g4 < 4; ++g4)
                        *(LAS unsigned long long*)(GLA_OS + c * 528 + (32 * wave + 8 * g4 + 4 * hi) * 2) = (unsigned long long)pg8::cvt_pk_bf16(ot[nt][4 * g4 + 0], ot[nt][4 * g4 + 1]) | ((unsigned long long)pg8::cvt_pk_bf16(ot[nt][4 * g4 + 2], ot[nt][4 * g4 + 3]) << 32); }
                __syncthreads();
#pragma unroll
                for (int i = 0; i < 4; ++i) { const int c = (tid >> 5) + 16 * i, ch = tid & 31;
                    *(GAS v4u*)(ORAW + (tok0 + c) * 1024 + h * 256 + ch * 8) = *(const LAS v4u*)(GLA_OS + c * 528 + ch * 16); }
                if (tid < 64) { float t = 0.f;
#pragma unroll
                    for (int w = 0; w < 8; ++w) t += GLA_SS[tid * 8 + w];
                    SSQ[(tok0 + tid) * 4 + h] = t; }
            }
#undef GLA_KT
#undef GLA_QT
#undef GLA_DC
#undef GLA_OS
#undef GLA_SS
#undef GLA_LOAD_STAGE
#undef GLA_LOAD_V
            __syncthreads();
            P2_FETCH(code);
          } else {
            const int k_ = code / 66, a_ = code % 66 - 2; const int qb_ = 15 - (a_ >> 2), bh_ = 4 * k_ + (a_ & 3);
            if (!primed) { P2_BIAS(code, bbuf); }
            int ncode; P2_FETCH(ncode);
            const bool nx_att = ncode >= 0 && (ncode % 66) >= 2;
            if (nx_att) { P2_BIAS(ncode, bbuf ^ 1); }
            fa128::attn_unit<8>(Pq + ((size_t)bh_ * SEQ + qb_ * 256) * 128, Pq + ((size_t)32 + bh_) * (SEQ * 128), Pq + ((size_t)64 + bh_) * (SEQ * 128), Oo + (size_t)((bh_ >> 3) * SEQ + qb_ * 256) * 1024 + (bh_ & 7) * 128, qb_,
                                ldsl + RING_OFF, (const LAS float*)(ldsl + fa128::LDS_BIAS + bbuf * 16384), (LAS float*)(ldsl + TBL_IDX) + __builtin_amdgcn_readfirstlane(tidl >> 6) * 64, tidl);
            if (rep_ == 0) {
                const int ntc = 4 * (16 - ((code % 66 - 2) >> 2)); const int ncv = (ntc * (CV_ITEMS - CV_P1) + 17407) / 17408;
                if (tid == 0) QW[2] = (int)__hip_atomic_fetch_add(ctlq + 64 * 8, (unsigned)ncv, __ATOMIC_RELAXED, __HIP_MEMORY_SCOPE_AGENT);
                __syncthreads();
                const int cv0 = __builtin_amdgcn_readfirstlane(QW[2]); int cv1 = cv0 + ncv; if (cv1 > CV_ITEMS - CV_P1) cv1 = CV_ITEMS - CV_P1;
                const int wv = __builtin_amdgcn_readfirstlane(tidl >> 6), ln = tidl & 63;
                for (int it0 = cv0 + wv; it0 < cv1; it0 += NWAVES) conv_tile(CV_P1 + it0, PT, ln);
            }
            primed = nx_att; bbuf ^= 1; code = ncode;
          }
        }
#undef P2_FETCH
#undef P2_BIAS
        }
    }
    SEAM(3);

    if (IN(4)) DUP(4) {
        bf16* const AO = (bf16*)(WSB + WS_AO); bf16* const PROJ = (bf16*)(WSB + WS_PROJ); const bf16* const ORAW = (const bf16*)(WSB + WS_H1B); const float* const SSQ = (const float*)(WSB + WS_TOKOF);
        const float* const g_gla_norm = INP(6);
        const int gw = vcu * NWAVES + wave, NGW = G * NWAVES;
        const f32x4 gn = *(const f32x4*)(g_gla_norm + 4 * lane);
        for (int m0 = gw; m0 < T_TOK; m0 += 4 * NGW) {
            f32x4 hs4[4]; unsigned long long ow[4][4], rw[4][4];
#pragma unroll
            for (int r = 0; r < 4; ++r) { const size_t mm = (size_t)(m0 + r * NGW); hs4[r] = *(const f32x4*)(SSQ + mm * 4);
                const GAS unsigned long long* orow = (const GAS unsigned long long*)(ORAW + mm * 1024) + lane; const GAS unsigned long long* rrow = (const GAS unsigned long long*)(PROJ + mm * PPITCH + C_GR) + lane;
#pragma unroll
                for (int j = 0; j < 4; ++j) { ow[r][j] = orow[64 * j]; rw[r][j] = rrow[64 * j]; } }
#pragma unroll
            for (int r = 0; r < 4; ++r) { GAS unsigned long long* drow = (GAS unsigned long long*)(AO + (size_t)(m0 + r * NGW) * 1024) + lane;
#pragma unroll
                for (int j = 0; j < 4; ++j) { const float tot = hs4[r][j] * (GLA_QSCALE * GLA_QSCALE); const float rs = GLA_QSCALE / sqrtf(tot * (1.0f / 256.0f) + LN_EPS);
                    const unsigned ol = (unsigned)ow[r][j], oh = (unsigned)(ow[r][j] >> 32), rl = (unsigned)rw[r][j], rh = (unsigned)(rw[r][j] >> 32);
                    const float r0 = pg8::bf_lo(rl), r1 = pg8::bf_hi(rl), r2 = pg8::bf_lo(rh), r3 = pg8::bf_hi(rh);
                    const float o0 = pg8::bf_lo(ol) * rs * gn.x * (r0 * pg8::sigm(r0)), o1 = pg8::bf_hi(ol) * rs * gn.y * (r1 * pg8::sigm(r1)), o2 = pg8::bf_lo(oh) * rs * gn.z * (r2 * pg8::sigm(r2)), o3 = pg8::bf_hi(oh) * rs * gn.w * (r3 * pg8::sigm(r3));
                    drow[64 * j] = (unsigned long long)pg8::cvt_pk_bf16(o0, o1) | ((unsigned long long)pg8::cvt_pk_bf16(o2, o3) << 32); } } }
    }
    SEAM(4);

    if (IN(5)) DUP(5) {
        bf16* const AO = (bf16*)(WSB + WS_AO); bf16* const WPROJ_T = (bf16*)(WSB + WS_WPROJ); bf16* const PROJ = (bf16*)(WSB + WS_PROJ); bf16* const MIXED = (bf16*)(WSB + WS_MIXED);
        pg8::Gemm g{AO, WPROJ_T, 2 * T_TOK, 2048, DM}; pg8::MixOrder S; S.init(T_TOK, DM, G, bx);
        pg8::EpiMix E{(const bf16*)(WSB + WS_ZIMG), MIXED};
        pg8::gemm_phase<pg8::EpiMix, pg8::MixOrder, true, true, false>(ldsl + RING_OFF, g, S, E);
    }
    SEAM(5);

    if (IN(6)) DUP(6) {
        bf16* const MIXED = (bf16*)(WSB + WS_MIXED); bf16* const WOUT_T = (bf16*)(WSB + WS_WOUT); float* const H1F = (float*)(WSB + WS_H1F);
        pg8::Gemm g{MIXED, WOUT_T, T_TOK, DM, DM}; pg8::StaticOrder S; S.init(T_TOK, DM, G, bx);
        pg8::EpiBf16<0> E{(bf16*)(WSB + WS_YS), DM, nullptr, 0, 0, 1.f};
        pg8::gemm_phase<pg8::EpiBf16<0>, pg8::StaticOrder, true, true, false>(ldsl + RING_OFF, g, S, E);
    }
    SEAM(6);

    if (IN(7)) {
        gu32* const ctl = (gu32*)(WSB + WS_CTL);
        bf16* const H1B = (bf16*)(WSB + WS_H1B); int* const TOKOF = (int*)(WSB + WS_TOKOF); int* const PAIR_E = (int*)(WSB + WS_PAIR); int* const PAIR_POS = PAIR_E + T_TOK * 4; float* const PAIR_G = (float*)(PAIR_POS + T_TOK * 4);
        const float* const x = INP(0); const float* const ln_in_g = INP(1); const float* const ln_in_b = INP(2); const float* const ln_mix_g = INP(11); const float* const ln_mix_b = INP(12);
        const float* const w_router = INP(13); const float* const b_router = INP(14); const bf16* const PRE = (const bf16*)(WSB + WS_YS);
        LAS float* const WRT = (LAS float*)(ldsl + RING_OFF);
        LAS float* const LOGT = (LAS float*)(ldsl + TBL_IDX) + wave * 64;
        LAS int* const HIST = (LAS int*)(ldsl + TBL_CNT); LAS int* const BASE = (LAS int*)(ldsl + TBL_CUM);
#pragma unroll 4
        for (int i = 0; i < 16; ++i) { const int p = tid + NTHR * i, e4 = p & 7, k = p >> 3; const f32x4 w = *(const GAS f32x4*)(w_router + 4 * p);
            WRT[(4 * e4 + 0) * 1024 + k] = w.x; WRT[(4 * e4 + 1) * 1024 + k] = w.y; WRT[(4 * e4 + 2) * 1024 + k] = w.z; WRT[(4 * e4 + 3) * 1024 + k] = w.w; }
        if (tid < 32) HIST[tid] = 0;
        __syncthreads();
        const int gw = vcu * NWAVES + wave, NGW = G * NWAVES;
        int te[4][4], tr[4][4]; float tgt[4][4];
        f32x4 vx[2][4]; unsigned long long vp[2][4];
#define ROW_LOAD(g_) do { _Pragma("unroll") for (int r = 0; r < 2; ++r) { const size_t mm = (size_t)(gw + (2 * (g_) + r) * NGW); const GAS f32x4* xr = (const GAS f32x4*)(x + mm * DM) + lane; const GAS unsigned long long* pr = (const GAS unsigned long long*)(PRE + mm * DM) + lane; \
            _Pragma("unroll") for (int j = 0; j < 4; ++j) { vx[r][j] = xr[64 * j]; vp[r][j] = pr[64 * j]; } } } while (0)
        ROW_LOAD(0);
#pragma unroll 1
        for (int g = 0; g < 4; ++g) {
            f32x4 z[2][4];
            {   f32x4 y[4];
#pragma unroll
                for (int r = 0; r < 2; ++r) { const size_t mm = (size_t)(gw + (2 * g + r) * NGW);
                    ln_row(vx[r], y, ln_in_g, ln_in_b, lane);
#pragma unroll
                    for (int j = 0; j < 4; ++j) { const unsigned wl = (unsigned)vp[r][j], wh = (unsigned)(vp[r][j] >> 32); y[j] = y[j] * DN_ALPHA + (f32x4){pg8::bf_lo(wl), pg8::bf_hi(wl), pg8::bf_lo(wh), pg8::bf_hi(wh)}; }
                    ln_row(y, z[r], ln_mix_g, ln_mix_b, lane);
                    store_row_bf16(H1B + mm * DM, z[r], lane); } }
            if (g < 3) ROW_LOAD(g + 1);
            float vals[64];
            typedef float f32x2r __attribute__((ext_vector_type(2)));
            f32x2r zz[4][4];
#pragma unroll
            for (int j = 0; j < 4; ++j) { zz[j][0] = (f32x2r){z[0][j].x, z[1][j].x}; zz[j][1] = (f32x2r){z[0][j].y, z[1][j].y}; zz[j][2] = (f32x2r){z[0][j].z, z[1][j].z}; zz[j][3] = (f32x2r){z[0][j].w, z[1][j].w}; }
#pragma unroll
            for (int e = 0; e < 32; ++e) { f32x2r a = {0.f, 0.f};
#pragma unroll
                for (int j = 0; j < 4; ++j) { const f32x4 w = *(const LAS f32x4*)(WRT + e * 1024 + 4 * lane + 256 * j);
                    a = __builtin_elementwise_fma(zz[j][0], (f32x2r){w.x, w.x}, a); a = __builtin_elementwise_fma(zz[j][1], (f32x2r){w.y, w.y}, a);
                    a = __builtin_elementwise_fma(zz[j][2], (f32x2r){w.z, w.z}, a); a = __builtin_elementwise_fma(zz[j][3], (f32x2r){w.w, w.w}, a); }
                vals[e] = a.x; vals[32 + e] = a.y; }
#define ROW_RED(S_, H_) _Pragma("unroll") for (int i = 0; i < (H_); ++i) { const bool up = (lane & (S_)) != 0; const float snd = up ? vals[i] : vals[i + (H_)], kp = up ? vals[i + (H_)] : vals[i]; vals[i] = kp + __shfl_xor(snd, (S_)); }
            ROW_RED(32, 32) ROW_RED(16, 16) ROW_RED(8, 8) ROW_RED(4, 4) ROW_RED(2, 2) ROW_RED(1, 1)
#undef ROW_RED
            float lv = vals[0] + b_router[lane & 31];
            int te_[4] = {0, 0, 0, 0}, tr_[4] = {0, 0, 0, 0}; float tg_[4] = {0.f, 0.f, 0.f, 0.f}, tv[4];
#pragma unroll
            for (int k = 0; k < 4; ++k) { float bv = lv; int bi = lane & 31;
#pragma unroll
                for (int s = 1; s < 32; s <<= 1) { const float ov = __shfl_xor(bv, s); const int oi = __shfl_xor(bi, s); const bool tk = (ov > bv) || (ov == bv && oi < bi); bv = tk ? ov : bv; bi = tk ? oi : bi; }
                tv[k] = bv; te_[k] = bi; if ((lane & 31) == bi) lv = -3.0e38f; }
            { float ssum = 0.f;
#pragma unroll
                for (int k = 0; k < 4; ++k) { tg_[k] = __expf(tv[k] - tv[0]); ssum += tg_[k]; }
                const float rs = 1.0f / ssum;
#pragma unroll
                for (int k = 0; k < 4; ++k) tg_[k] *= rs; }
            if ((lane & 31) == 0) {
#pragma unroll
                for (int k = 0; k < 4; ++k) tr_[k] = atomicAdd((int*)(HIST + te_[k]), 1); }
#pragma unroll
            for (int gg = 0; gg < 4; ++gg) if (gg == g) {
#pragma unroll
                for (int k = 0; k < 4; ++k) { te[gg][k] = te_[k]; tr[gg][k] = tr_[k]; tgt[gg][k] = tg_[k]; } }
        }
#undef ROW_LOAD
        __syncthreads();
        if (tid < 32) BASE[tid] = (int)__hip_atomic_fetch_add(ctl + CW_CNT + 64 * tid, (unsigned)HIST[tid], __ATOMIC_RELAXED, __HIP_MEMORY_SCOPE_AGENT);
        __syncthreads();
        if ((lane & 31) == 0) {
#pragma unroll
            for (int g = 0; g < 4; ++g) { const int t2 = gw + (2 * g + (lane >> 5)) * NGW;
#pragma unroll
                for (int k = 0; k < 4; ++k) { const int e = te[g][k], pos = BASE[e] + tr[g][k];
                    TOKOF[(size_t)e * T_TOK + pos] = t2; PAIR_E[t2 * 4 + k] = e; PAIR_POS[t2 * 4 + k] = pos; PAIR_G[t2 * 4 + k] = tgt[g][k]; } } }
    }
    SEAM(7);

#define GROUPED_PREP(NT_, GATHER_) do { \
        LAS int* CUM = (LAS int*)(ldsl + TBL_CUM); LAS int* CNT = (LAS int*)(ldsl + TBL_CNT); LAS int* DESC = (LAS int*)(ldsl + TBL_DESC); LAS int* IDX = (LAS int*)(ldsl + TBL_IDX); \
        if (tid == 0) { int c = 0; for (int e = 0; e < NE; ++e) { const int n = (int)__hip_atomic_load(ctl + CW_CNT + 64 * e, __ATOMIC_RELAXED, __HIP_MEMORY_SCOPE_AGENT); CNT[e] = n; CUM[e] = c; c += (n + 255) >> 8; } CUM[NE] = c; } \
        __syncthreads(); \
        if (tid < pg8::MAXU) { const int nwg = (NT_) * CUM[NE]; const long L = (long)tid * G + bx; int valid = 0, ab = 0, bb = 0, pn = 0, e = 0, pm = 0; \
            if (L < nwg) { int wgid = (int)L; { const int q = nwg / 8, r = nwg % 8, xcd = wgid % 8, off = wgid / 8; wgid = (xcd < r ? xcd * (q + 1) : r * (q + 1) + (xcd - r) * q) + off; } \
                while (e < NE - 1 && wgid >= (NT_) * CUM[e + 1]) ++e; \
                const int r2 = wgid - (NT_) * CUM[e], te_ = CUM[e + 1] - CUM[e]; pn = r2 / te_; pm = r2 % te_; ab = CUM[e] + pm; bb = e * (NT_) + pn; valid = 1; } \
            DESC[tid * 8 + 0] = valid; DESC[tid * 8 + 1] = ab; DESC[tid * 8 + 2] = bb; DESC[tid * 8 + 3] = pn; DESC[tid * 8 + 4] = e; DESC[tid * 8 + 5] = pm; } \
        __syncthreads(); \
        if (GATHER_) { for (int i = 0; i < pg8::MAXU; ++i) { if (DESC[i * 8] == 0) break; const int e = DESC[i * 8 + 4], pm = DESC[i * 8 + 5]; \
            if (tid < 256) { const int slot = pm * 256 + tid; IDX[i * 256 + tid] = slot < CNT[e] ? TOKOF[(size_t)e * T_TOK + slot] : 0; } } \
            __syncthreads(); } } while (0)
    if (IN(8)) DUP(8) {
        gu32* const ctl = (gu32*)(WSB + WS_CTL);
        int* const TOKOF = (int*)(WSB + WS_TOKOF); bf16* const H1B = (bf16*)(WSB + WS_H1B); bf16* const WGU_T = (bf16*)(WSB + WS_WGU); bf16* const ACT = (bf16*)(WSB + WS_ACT);
        const float* const b_gate_up = INP(16);
        GROUPED_PREP(8, true);
        pg8::Gemm g{H1B, WGU_T, T_TOK, 2048, DM}; pg8::GroupedOrder S{(const LAS int*)(ldsl + TBL_DESC), (const LAS int*)(ldsl + TBL_IDX)};
        pg8::EpiAct E{ACT, b_gate_up};
        pg8::gemm_phase<pg8::EpiAct, pg8::GroupedOrder, true, true, true>(ldsl + RING_OFF, g, S, E);
    }
#if (DUP_MASK >> 12) & 1
    if (IN(8)) {
        gu32* const ctl = (gu32*)(WSB + WS_CTL);
        int* const TOKOF = (int*)(WSB + WS_TOKOF); bf16* const H1B = (bf16*)(WSB + WS_H1B); bf16* const WGU_T = (bf16*)(WSB + WS_WGU); bf16* const ACT = (bf16*)(WSB + WS_ACT);
        const float* const b_gate_up = INP(16);
        GROUPED_PREP(8, true);
        pg8::Gemm g{H1B, WGU_T, T_TOK, 2048, DM}; pg8::GroupedOrder S{(const LAS int*)(ldsl + TBL_DESC), (const LAS int*)(ldsl + TBL_IDX)};
        pg8::EpiAct E{ACT, b_gate_up};
        pg8::gemm_phase<pg8::EpiAct, pg8::GroupedOrder, true, true, true>(ldsl + RING_OFF, g, S, E);
    }
#endif
    SEAM(8);
    if (IN(9)) DUP(9) {
        gu32* const ctl = (gu32*)(WSB + WS_CTL);
        bf16* const ACT = (bf16*)(WSB + WS_ACT); bf16* const WDN_T = (bf16*)(WSB + WS_WDN); bf16* const YS = (bf16*)(WSB + WS_YS);
        int* const TOKOF = nullptr;
        const float* const b_down = INP(18);
        GROUPED_PREP(4, false);
        pg8::Gemm g{ACT, WDN_T, SLOT_ROWS, 1024, DFF}; pg8::GroupedOrder S{(const LAS int*)(ldsl + TBL_DESC), (const LAS int*)(ldsl + TBL_IDX)};
        pg8::EpiDown E{YS, b_down};
        pg8::gemm_phase<pg8::EpiDown, pg8::GroupedOrder, true, true, false>(ldsl + RING_OFF, g, S, E);
    }
    SEAM(9);

    if (IN(10)) DUP(10) {
        gu32* const ctl = (gu32*)(WSB + WS_CTL);
        const bf16* const H1B = (const bf16*)(WSB + WS_H1B); int* const PAIR_E = (int*)(WSB + WS_PAIR); int* const PAIR_POS = PAIR_E + T_TOK * 4; float* const PAIR_G = (float*)(PAIR_POS + T_TOK * 4); bf16* const YS = (bf16*)(WSB + WS_YS);
        const float* const ln_ffn_g = INP(19); const float* const ln_ffn_b = INP(20);
        float* const out = (float*)ldptr(PT, 21);
        LAS int* CUM = (LAS int*)(ldsl + TBL_CUM);
        if (tid == 0) { int c = 0; for (int e = 0; e < NE; ++e) { const int n = (int)__hip_atomic_load(ctl + CW_CNT + 64 * e, __ATOMIC_RELAXED, __HIP_MEMORY_SCOPE_AGENT); CUM[e] = c; c += (n + 255) >> 8; } CUM[NE] = c; }
        __syncthreads();
        const int gw = vcu * NWAVES + wave, NGW = G * NWAVES;
        int pslot = 0; float pgate = 0.f;
        if (lane < 32) { const int q = (gw + (lane >> 2) * NGW) * 4 + (lane & 3); pslot = CUM[PAIR_E[q]] * 256 + PAIR_POS[q]; pgate = PAIR_G[q]; }
        for (int it = 0; it < 4; ++it) {
            f32x4 v[2][4], y[4]; unsigned long long yv[2][4][4]; float gk[2][4];
#pragma unroll
            for (int r = 0; r < 2; ++r) { const size_t mm = (size_t)(gw + (2 * it + r) * NGW); const GAS unsigned long long* hr = (const GAS unsigned long long*)(H1B + mm * DM) + lane;
#pragma unroll
                for (int j = 0; j < 4; ++j) { const unsigned long long w = hr[64 * j]; const unsigned wl = (unsigned)w, wh = (unsigned)(w >> 32); v[r][j] = (f32x4){pg8::bf_lo(wl), pg8::bf_hi(wl), pg8::bf_lo(wh), pg8::bf_hi(wh)}; }
#pragma unroll
                for (int k = 0; k < 4; ++k) { const int slot = __builtin_amdgcn_readfirstlane(__shfl(pslot, (2 * it + r) * 4 + k)); gk[r][k] = __shfl(pgate, (2 * it + r) * 4 + k);
                    const GAS unsigned long long* yr = (const GAS unsigned long long*)(YS + (size_t)slot * 1024) + lane;
#pragma unroll
                    for (int j = 0; j < 4; ++j) yv[r][k][j] = yr[64 * j]; } }
#pragma unroll
            for (int r = 0; r < 2; ++r) { const size_t mm = (size_t)(gw + (2 * it + r) * NGW);
#pragma unroll
                for (int j = 0; j < 4; ++j) v[r][j] = v[r][j] * DN_ALPHA;
#pragma unroll
                for (int k = 0; k < 4; ++k)
#pragma unroll
                    for (int j = 0; j < 4; ++j) { const unsigned long long w = yv[r][k][j]; const unsigned wl = (unsigned)w, wh = (unsigned)(w >> 32); const float g = gk[r][k];
                        v[r][j].x += g * pg8::bf_lo(wl); v[r][j].y += g * pg8::bf_hi(wl); v[r][j].z += g * pg8::bf_lo(wh); v[r][j].w += g * pg8::bf_hi(wh); }
                ln_row(v[r], y, ln_ffn_g, ln_ffn_b, lane);
                GAS f32x4* orow = (GAS f32x4*)(out + mm * DM) + lane;
#pragma unroll
                for (int j = 0; j < 4; ++j) orow[64 * j] = y[j]; } }
    }
    if (STAMP_K >= 0 && bx == 0 && tid == 0) { const unsigned long long t_end = __builtin_amdgcn_s_memrealtime(), dt = t_stamp_a - t_stamp_0; while (__builtin_amdgcn_s_memrealtime() - t_end < dt) __builtin_amdgcn_s_sleep(8); }
#undef IN
#undef INP
#undef WSB
#undef SEAM
#undef GROUPED_PREP
}

#ifndef MK_SPLIT
#define MK_SPLIT 0
#endif
extern "C" void kernel_launch(void* const* d_in, const int* in_sizes, int n_in, void* d_out, int out_size, void* d_ws, size_t ws_size, hipStream_t stream) {
    static int grid = 0;
    if (grid == 0) {
        if (n_in != 21 || in_sizes[0] != T_TOK * DM || out_size != T_TOK * DM || ws_size < WS_END) {
            fprintf(stderr, "kernel_launch: built for 21 inputs, x/out of %d floats, >= %zu bytes of workspace; got n_in %d, in0 %d, out %d, ws %zu; nothing launched\n", T_TOK * DM, (size_t)WS_END, n_in, n_in > 0 ? in_sizes[0] : -1, out_size, ws_size); grid = -1; return; }
        int dev = 0, cus = 0, per_cu = 0;
        if (hipGetDevice(&dev) != hipSuccess || hipDeviceGetAttribute(&cus, hipDeviceAttributeMultiprocessorCount, dev) != hipSuccess) { fprintf(stderr, "kernel_launch: device query failed\n"); grid = -1; return; }
        if (hipFuncSetAttribute((const void*)mega_fwd, hipFuncAttributeMaxDynamicSharedMemorySize, LDS_BYTES) != hipSuccess) { fprintf(stderr, "kernel_launch: hipFuncSetAttribute failed\n"); grid = -1; return; }
        if (hipOccupancyMaxActiveBlocksPerMultiprocessor(&per_cu, (const void*)mega_fwd, NTHR, LDS_BYTES) != hipSuccess || per_cu < 1) fprintf(stderr, "kernel_launch: occupancy query reports %d blocks per CU\n", per_cu);
        (void)hipGetLastError();
        grid = cus;
        if (grid != 256) { fprintf(stderr, "kernel_launch: this kernel's work split needs exactly 256 CUs, device has %d; nothing launched\n", grid); grid = -1; return; }
    }
    if (grid < 0) return;
    if (hipMemsetAsync((char*)d_ws + WS_CTL, 0, CTL_ZERO_BYTES, stream) != hipSuccess) { fprintf(stderr, "kernel_launch: hipMemsetAsync failed\n"); return; }
    Args a{};
    for (int i = 0; i < 21; ++i) a.in[i] = (const float*)d_in[i];
    a.out = (float*)d_out; a.ws = (unsigned char*)d_ws;
#if MK_SPLIT
    for (int p = 0; p < NPH; ++p) { a.ph_lo = p; a.ph_hi = p + 1; a.li = p; hipLaunchKernelGGL(mega_fwd, dim3(grid), dim3(NTHR), LDS_BYTES, stream, a); }
#else
    a.ph_lo = 0; a.ph_hi = NPH; a.li = 0;
    hipLaunchKernelGGL(mega_fwd, dim3(grid), dim3(NTHR), LDS_BYTES, stream, a);
#endif
    const hipError_t le = hipPeekAtLastError();
    if (le != hipSuccess) fprintf(stderr, "kernel_launch: launch failed: %s\n", hipGetErrorName(le));
}
```

```cpp
#define DUP_MASK 0
#include <hip/hip_runtime.h>
#include <hip/hip_bf16.h>
#include <cstdio>
#include <cstdint>
#include <cmath>
namespace pg8 {
#define PG8_LAS __attribute__((address_space(3)))
typedef unsigned short bf16_t;
typedef short bf16x8 __attribute__((ext_vector_type(8)));
typedef float f32x4 __attribute__((ext_vector_type(4)));
typedef unsigned u32x4 __attribute__((ext_vector_type(4)));
constexpr int BM = 256, BK = 64, HALF = 128, HTB = HALF * BK * 2  , STAGE_BYTES = 8 * HTB, NXCD = 8, WGM = 8;

__host__ __device__ __forceinline__ int lds_byte(int r, int c) { const int st = (r >> 4) * 2 + (c >> 5), rr = r & 15, cc = c & 31, ob = rr * 64 + cc * 2; return st * 1024 + (ob ^ (((ob >> 9) & 1) << 5)); }
__host__ __device__ __forceinline__ void stage_rc(int b, int& R, int& C) { const int st = b / 1024, sb = b % 1024, swz = sb ^ (((sb >> 9) & 1) << 5); R = (st >> 1) * 16 + swz / 64; C = (st & 1) * 32 + (swz % 64) / 2; }
__host__ __device__ __forceinline__ int perm32(int rho) { const int n = rho >> 4, i = rho & 15; return 8 * (i >> 2) + 4 * n + (i & 3); }

struct Unit { int pm, pn, ab, bb, aux; };
struct Gemm { const bf16_t* A; const bf16_t* Bt; int M, N, K; };

struct StaticOrder {
    int nM, nN, nwg, G, c;
    __host__ __device__ void init(int M, int N, int G_, int c_) { nM = M / BM; nN = N / BM; nwg = nM * nN; G = G_; c = c_; }
    __host__ __device__ bool next(int i, Unit& u) const {
        const long L = (long)i * G + c; if (L >= nwg) return false;
        int wgid = (int)L; { const int q = nwg / NXCD, r = nwg % NXCD, xcd = wgid % NXCD, off = wgid / NXCD; wgid = (xcd < r ? xcd * (q + 1) : r * (q + 1) + (xcd - r) * q) + off; }
        const int nig = WGM * nN, gid = wgid / nig, fm = gid * WGM, gsz = (nM - fm) < WGM ? (nM - fm) : WGM;
        u.pm = fm + ((wgid % nig) % gsz); u.pn = (wgid % nig) / gsz; u.ab = u.pm; u.bb = u.pn; u.aux = 0; return true;
    }
    __device__ __forceinline__ void a_ready(const Unit&) const {}
    __device__ __forceinline__ void done(const Unit&) const {}
    __device__ __forceinline__ const PG8_LAS int* rowidx(int) const { return nullptr; }
};

__device__ __forceinline__ unsigned cvt_pk_bf16(float lo, float hi) { unsigned r; asm volatile("v_cvt_pk_bf16_f32 %0, %1, %2" : "=v"(r) : "v"(lo), "v"(hi)); return r; }
typedef float f32x2 __attribute__((ext_vector_type(2)));
__device__ __forceinline__ f32x2 gelu_pk(f32x2 v) {
    const f32x2 av = __builtin_elementwise_abs(v), d = av * 0.2316418882f + 1.0f;
    f32x2 t; t.x = __builtin_amdgcn_rcpf(d.x); t.y = __builtin_amdgcn_rcpf(d.y);
    f32x2 q = t * 0.5307027145f + (-0.7265760135f); q = q * t + 0.7107068705f; q = q * t + (-0.142248368f); q = q * t + 0.127414796f; q = q * t;
    const f32x2 s = (v * v) * (-0.72134752044f);
    f32x2 e; e.x = __builtin_amdgcn_exp2f(s.x); e.y = __builtin_amdgcn_exp2f(s.y);
    const f32x2 m = v * (q * e), r = v - m;
    f32x2 o; o.x = v.x < 0.f ? m.x : r.x; o.y = v.y < 0.f ? m.y : r.y; return o;
}

template <int ACT  > struct EpiBf16 {
    static constexpr bool PERM = true, AFTER_DRAIN = false; static_assert(ACT == 0 || ACT == 1, "EpiBf16: ACT is 0 (none) or 1 (gelu_pk)");
    bf16_t* O; int ldc; const float* bias; int split_cols; size_t split_stride; float scale0;
    __device__ __forceinline__ void operator()(const f32x4 (&acc)[2][2][4][2], const Unit& u, int wr, int wc, int fr, int fq) const {
        const int row0 = u.pm * BM + wr * 64 + fr; int colt = u.pn * BM; bf16_t* base = O;
        float sc = 1.f; if (split_cols) { const int t = colt / split_cols; base += (size_t)t * split_stride; colt -= t * split_cols; if (t == 0) sc = scale0; }
        const int col0 = colt + wc * 32 + 8 * fq, bcol0 = u.pn * BM + wc * 32 + 8 * fq;
        f32x4 bv[2][2];
#pragma unroll
        for (int bj = 0; bj < 2; ++bj)
#pragma unroll
            for (int n = 0; n < 2; ++n) bv[bj][n] = bias ? *(const f32x4*)(bias + bcol0 + bj * HALF + 4 * n) : (f32x4){0.f, 0.f, 0.f, 0.f};
#pragma unroll
        for (int ai = 0; ai < 2; ++ai)
#pragma unroll
            for (int m = 0; m < 4; ++m) { bf16_t* rowp = base + (size_t)(row0 + ai * HALF + m * 16) * ldc + col0;
#pragma unroll
                for (int bj = 0; bj < 2; ++bj) { f32x4 v0 = acc[ai][bj][m][0] + bv[bj][0], v1 = acc[ai][bj][m][1] + bv[bj][1];
                    if (ACT == 1) { f32x2 a = gelu_pk((f32x2){v0[0], v0[1]}), b = gelu_pk((f32x2){v0[2], v0[3]}), c = gelu_pk((f32x2){v1[0], v1[1]}), d = gelu_pk((f32x2){v1[2], v1[3]});
                        v0 = (f32x4){a.x, a.y, b.x, b.y}; v1 = (f32x4){c.x, c.y, d.x, d.y}; }
                    v0 = v0 * sc; v1 = v1 * sc; u32x4 w; w.x = cvt_pk_bf16(v0[0], v0[1]); w.y = cvt_pk_bf16(v0[2], v0[3]); w.z = cvt_pk_bf16(v1[0], v1[1]); w.w = cvt_pk_bf16(v1[2], v1[3]);
                    *(u32x4*)(rowp + bj * HALF) = w; } }
    }
};

struct PanelStats {
    unsigned* xbuf;
    unsigned* cnt;
    unsigned* tmo;
    int ntn; float eps;
    unsigned code;
    __device__ __forceinline__ bool run(const f32x4 (&v)[2][2][4][2], const Unit& u, int wr, int wc, int fr, int fq, PG8_LAS unsigned char* lds, int wid, int lane) const {
        typedef float f32x2v __attribute__((ext_vector_type(2)));
        PG8_LAS f32x2v* P = (PG8_LAS f32x2v*)lds;
        PG8_LAS f32x2v* S = (PG8_LAS f32x2v*)(lds + 8192);
        PG8_LAS unsigned* flag = (PG8_LAS unsigned*)(lds + 8192 + 2048);
#pragma unroll
        for (int ai = 0; ai < 2; ++ai)
#pragma unroll
            for (int m = 0; m < 4; ++m) {
                float s = 0.f;
#pragma unroll
                for (int bj = 0; bj < 2; ++bj)
#pragma unroll
                    for (int n = 0; n < 2; ++n) { const f32x4 x = v[ai][bj][m][n]; s += (x[0] + x[1]) + (x[2] + x[3]); }
                s += __shfl_xor(s, 16); s += __shfl_xor(s, 32);
                const float mw = s * (1.0f / 64.0f); float q = 0.f;
#pragma unroll
                for (int bj = 0; bj < 2; ++bj)
#pragma unroll
                    for (int n = 0; n < 2; ++n) { const f32x4 d = v[ai][bj][m][n] - mw; q += (d[0] * d[0] + d[1] * d[1]) + (d[2] * d[2] + d[3] * d[3]); }
                q += __shfl_xor(q, 16); q += __shfl_xor(q, 32);
                if (fq == 0) P[(ai * HALF + wr * 64 + m * 16 + fr) * 4 + wc] = (f32x2v){mw, q};
            }
        asm volatile("s_waitcnt lgkmcnt(0)" ::: "memory"); __builtin_amdgcn_s_barrier(); asm volatile("" ::: "memory");
#if defined(BROKEN_EXCHANGE_NO_WAIT)
#warning BROKEN CONTROL BUILD: the row-statistics exchange does not wait; results are wrong by design
        if (blockIdx.x >= 64) { const long long t0_ = clock64(); while (clock64() - t0_ < 60000) __builtin_amdgcn_s_sleep(8); }
#endif
        const int row = wid * 32 + (lane & 31);
        if (lane < 32) {
            const f32x2v a = P[row * 4 + 0], b = P[row * 4 + 1], c = P[row * 4 + 2], d = P[row * 4 + 3];
            const float mt = (a.x + b.x + c.x + d.x) * 0.25f;
            const float da = a.x - mt, db = b.x - mt, dc = c.x - mt, dd = d.x - mt;
            const float m2 = (a.y + b.y) + (c.y + d.y) + 64.0f * ((da * da + db * db) + (dc * dc + dd * dd));
            unsigned long long* slot = (unsigned long long*)xbuf + ((size_t)(u.pm * BM + row) * 4 + u.pn);
            __hip_atomic_store(slot, ((unsigned long long)__float_as_uint(m2) << 32) | __float_as_uint(mt), __ATOMIC_RELAXED, __HIP_MEMORY_SCOPE_AGENT);
        }
        asm volatile("s_waitcnt vmcnt(0)" ::: "memory");
        if (lane == 0) __hip_atomic_fetch_add(cnt + 64 * u.pm, 1u, __ATOMIC_RELAXED, __HIP_MEMORY_SCOPE_AGENT);
        if (wid == 0) {
            bool dead = false; const unsigned long long t0 = __builtin_amdgcn_s_memrealtime(); const unsigned want = 8u * (unsigned)ntn;
            for (;;) {
#if defined(BROKEN_EXCHANGE_NO_WAIT)
                break;
#endif
                if ((unsigned)__builtin_amdgcn_readfirstlane(__hip_atomic_load(cnt + 64 * u.pm, __ATOMIC_RELAXED, __HIP_MEMORY_SCOPE_AGENT)) >= want) break;
                if (__builtin_amdgcn_s_memrealtime() - t0 > 2000000ull) {
                    if (lane == 0) { unsigned expect = 0u; __hip_atomic_compare_exchange_strong(tmo + 1, &expect, code | (unsigned)(u.pm & 0xff), __ATOMIC_RELAXED, __ATOMIC_RELAXED, __HIP_MEMORY_SCOPE_AGENT);
                                     __hip_atomic_store(tmo, 1u, __ATOMIC_RELAXED, __HIP_MEMORY_SCOPE_AGENT); }
                    dead = true; break; }
                __builtin_amdgcn_s_sleep(2);
            }
            __builtin_amdgcn_fence(__ATOMIC_ACQUIRE, "agent");
            if (lane == 0) flag[0] = dead ? 1u : 0u;
        }
        asm volatile("s_waitcnt vmcnt(0) lgkmcnt(0)" ::: "memory"); __builtin_amdgcn_s_barrier(); asm volatile("" ::: "memory");
        const bool bad = flag[0] != 0u;
        if (lane < 32) {
            const unsigned long long* slot = (const unsigned long long*)xbuf + (size_t)(u.pm * BM + row) * 4; float mt[4], m2[4]; float ms = 0.f;
#pragma unroll
            for (int t = 0; t < 4; ++t) { if (t < ntn) { const unsigned long long w = __hip_atomic_load(slot + t, __ATOMIC_RELAXED, __HIP_MEMORY_SCOPE_AGENT); mt[t] = __uint_as_float((unsigned)w); m2[t] = __uint_as_float((unsigned)(w >> 32)); } else { mt[t] = 0.f; m2[t] = 0.f; } ms += mt[t]; }
            const float mean = ms / (float)ntn; float q = 0.f;
#pragma unroll
            for (int t = 0; t < 4; ++t) if (t < ntn) { const float dm = mt[t] - mean; q += m2[t] + 256.0f * dm * dm; }
            S[row] = (f32x2v){mean, 1.0f / sqrtf(q / (256.0f * (float)ntn) + eps)};
        }
        asm volatile("s_waitcnt lgkmcnt(0)" ::: "memory"); __builtin_amdgcn_s_barrier(); asm volatile("" ::: "memory");
        return bad;
    }
};
struct EpiLnRes {
    static constexpr bool PERM = false, AFTER_DRAIN = true;
    const float* base; float* out; int ldc; const float* bias; PanelStats st; unsigned poison;
    __device__ __forceinline__ void fused(f32x4 (&acc)[2][2][4][2], const Unit& u, int wr, int wc, int fr, int fq, PG8_LAS unsigned char* lds, int wid, int lane) const {
        typedef float f32x2v __attribute__((ext_vector_type(2)));
        const PG8_LAS f32x2v* S = (const PG8_LAS f32x2v*)(lds + 8192);
        const int col0 = u.pn * BM + wc * 32 + 4 * fq;
#pragma unroll
        for (int bj = 0; bj < 2; ++bj)
#pragma unroll
            for (int n = 0; n < 2; ++n) { const f32x4 bv = bias ? *(const f32x4*)(bias + col0 + bj * HALF + n * 16) : (f32x4){0.f, 0.f, 0.f, 0.f};
#pragma unroll
                for (int ai = 0; ai < 2; ++ai)
#pragma unroll
                    for (int m = 0; m < 4; ++m) acc[ai][bj][m][n] += bv; }
        f32x4 pre[4][2][2];
#pragma unroll
        for (int m = 0; m < 4; ++m) { const size_t off = (size_t)(u.pm * BM + wr * 64 + m * 16 + fr) * ldc + col0;
#pragma unroll
            for (int bj = 0; bj < 2; ++bj)
#pragma unroll
                for (int n = 0; n < 2; ++n) pre[m][bj][n] = *(const f32x4*)(base + off + bj * HALF + n * 16); }
        const bool bad = st.run(acc, u, wr, wc, fr, fq, lds, wid, lane) || poison != 0u;
        const float qnan = __builtin_nanf("");
#pragma unroll
        for (int ai = 0; ai < 2; ++ai)
#pragma unroll
            for (int m = 0; m < 4; ++m) { const int r = ai * HALF + wr * 64 + m * 16 + fr; const f32x2v sr = S[r]; const size_t off = (size_t)(u.pm * BM + r) * ldc + col0;
#pragma unroll
                for (int bj = 0; bj < 2; ++bj)
#pragma unroll
                    for (int n = 0; n < 2; ++n) { const f32x4 bs = ai == 0 ? pre[m][bj][n] : *(const f32x4*)(base + off + bj * HALF + n * 16); f32x4 o = bs + (acc[ai][bj][m][n] - sr.x) * sr.y;
                        if (bad) o = (f32x4){qnan, qnan, qnan, qnan}; *(f32x4*)(out + off + bj * HALF + n * 16) = o; }
                if (m & 1) asm volatile("" ::: "memory"); }
    }
};
struct EpiLnResLn {
    static constexpr bool PERM = false, AFTER_DRAIN = true;
    const float* base; float* out; bf16_t* xn; int ldc; const float* bias; PanelStats st1, st2; unsigned poison;
    __device__ __forceinline__ void fused(f32x4 (&acc)[2][2][4][2], const Unit& u, int wr, int wc, int fr, int fq, PG8_LAS unsigned char* lds, int wid, int lane) const {
        typedef float f32x2v __attribute__((ext_vector_type(2))); typedef unsigned u32x2v __attribute__((ext_vector_type(2)));
        const PG8_LAS f32x2v* S = (const PG8_LAS f32x2v*)(lds + 8192);
        const int col0 = u.pn * BM + wc * 32 + 4 * fq;
#pragma unroll
        for (int bj = 0; bj < 2; ++bj)
#pragma unroll
            for (int n = 0; n < 2; ++n) { const f32x4 bv = bias ? *(const f32x4*)(bias + col0 + bj * HALF + n * 16) : (f32x4){0.f, 0.f, 0.f, 0.f};
#pragma unroll
                for (int ai = 0; ai < 2; ++ai)
#pragma unroll
                    for (int m = 0; m < 4; ++m) acc[ai][bj][m][n] += bv; }
        bool bad = st1.run(acc, u, wr, wc, fr, fq, lds, wid, lane) || poison != 0u;
        const float qnan = __builtin_nanf("");
#pragma unroll
        for (int ai = 0; ai < 2; ++ai)
#pragma unroll
            for (int m = 0; m < 4; ++m) { const int r = ai * HALF + wr * 64 + m * 16 + fr; const f32x2v sr = S[r]; const size_t off = (size_t)(u.pm * BM + r) * ldc + col0;
#pragma unroll
                for (int bj = 0; bj < 2; ++bj)
#pragma unroll
                    for (int n = 0; n < 2; ++n) { const f32x4 bs = *(const f32x4*)(base + off + bj * HALF + n * 16); acc[ai][bj][m][n] = bs + (acc[ai][bj][m][n] - sr.x) * sr.y; }
                asm volatile("" : "+v"(acc[ai][0][m][0]), "+v"(acc[ai][0][m][1]), "+v"(acc[ai][1][m][0]), "+v"(acc[ai][1][m][1]));
                if (m & 1) asm volatile("" ::: "memory"); }
        const bool bad1 = bad;
        bad = st2.run(acc, u, wr, wc, fr, fq, lds, wid, lane) || bad;
#pragma unroll
        for (int ai = 0; ai < 2; ++ai)
#pragma unroll
            for (int m = 0; m < 4; ++m) { const int r = ai * HALF + wr * 64 + m * 16 + fr; const f32x2v sr = S[r]; const size_t off = (size_t)(u.pm * BM + r) * ldc + col0;
#pragma unroll
                for (int bj = 0; bj < 2; ++bj)
#pragma unroll
                    for (int n = 0; n < 2; ++n) { const f32x4 x1 = acc[ai][bj][m][n]; *(f32x4*)(out + off + bj * HALF + n * 16) = bad1 ? (f32x4){qnan, qnan, qnan, qnan} : x1;
                        const f32x4 o = (x1 - sr.x) * sr.y; u32x2v w; w.x = cvt_pk_bf16(o[0], o[1]); w.y = cvt_pk_bf16(o[2], o[3]);
                        if (bad) { w.x = 0x7fc07fc0u; w.y = 0x7fc07fc0u; } *(u32x2v*)(xn + off + bj * HALF + n * 16) = w; }
                asm volatile("" ::: "memory"); }
    }
};

template <class E, class = void> struct epi_chains { static constexpr bool value = false; };
template <class E> struct epi_chains<E, decltype((void)E::CHAIN)> { static constexpr bool value = E::CHAIN; };
template <class Epi, class Sched, bool ALIGN_EPI = false, bool SP2 = false, bool GATHER = false>
__device__ __forceinline__ void gemm_phase(PG8_LAS unsigned char* lds, const Gemm g, const Sched& S, const Epi& E) {
    const int tid = threadIdx.x, wid = __builtin_amdgcn_readfirstlane(tid >> 6), lane = tid & 63, wr = wid >> 2, wc = wid & 3, fr = lane & 15, fq = lane >> 4;
    const int K = g.K, nt = K / BK;
    unsigned voffA[2], voffB[2]; int gR[2], gC[2];
#pragma unroll
    for (int i = 0; i < 2; ++i) { int R, C; stage_rc(tid * 16 + i * 8192, R, C); const int Rb = Epi::PERM ? ((R & ~31) + perm32(R & 31)) : R;
        voffA[i] = (unsigned)(R * K + C) * 2u; voffB[i] = (unsigned)(Rb * K + C) * 2u; gR[i] = R; gC[i] = C; }
    const size_t kstep = (size_t)(BK * 2);
    const size_t hstep = (size_t)HALF * K * 2;
    const size_t tstep = 2 * hstep;
    const unsigned ldsw = (unsigned)wid * 1024u;
    const int aoff = lds_byte(wr * 64 + fr, fq * 8), boff = lds_byte(wc * 32 + fr, fq * 8);
#define PG8_SA(b, h) (((b) * 2 + (h)) * HTB)
#define PG8_SB(b, h) ((4 + (b) * 2 + (h)) * HTB)
#define PG8_STAGE(bufoff, gbase, voff) do { _Pragma("unroll") for (int _i = 0; _i < 2; ++_i) \
        __builtin_amdgcn_global_load_lds((const unsigned*)((const char*)(gbase) + (voff)[_i]), (PG8_LAS unsigned*)(lds + (bufoff) + ldsw + _i * 8192), 16, 0, 0); } while (0)
#define PG8_STAGE_A(bufoff, gbase, h, nx) do { const unsigned _v0 = GATHER ? ((nx) ? vaN[h][0] : vaC[h][0]) : voffA[0], _v1 = GATHER ? ((nx) ? vaN[h][1] : vaC[h][1]) : voffA[1]; \
        const char* _gb = (const char*)(gbase) + (GATHER ? (size_t)0 : (size_t)(h) * hstep); \
        __builtin_amdgcn_global_load_lds((const unsigned*)(_gb + _v0), (PG8_LAS unsigned*)(lds + (bufoff) + ldsw), 16, 0, 0); \
        __builtin_amdgcn_global_load_lds((const unsigned*)(_gb + _v1), (PG8_LAS unsigned*)(lds + (bufoff) + ldsw + 8192), 16, 0, 0); } while (0)
#define PG8_LOADVA(va, uix) do { const PG8_LAS int* _ip = S.rowidx(uix); _Pragma("unroll") for (int _h = 0; _h < 2; ++_h) _Pragma("unroll") for (int _i = 0; _i < 2; ++_i) \
        va[_h][_i] = ((unsigned)_ip[_h * HALF + gR[_i]] * (unsigned)K + (unsigned)gC[_i]) * 2u; } while (0)
#define PG8_LDA(dst, b, h) do { _Pragma("unroll") for (int m = 0; m < 4; ++m) _Pragma("unroll") for (int k = 0; k < 2; ++k) dst[m][k] = *(const PG8_LAS bf16x8*)(lds + PG8_SA(b, h) + aoff + m * 2048 + k * 1024); } while (0)
#define PG8_LDB(dst, b, h) do { _Pragma("unroll") for (int n = 0; n < 2; ++n) _Pragma("unroll") for (int k = 0; k < 2; ++k) dst[n][k] = *(const PG8_LAS bf16x8*)(lds + PG8_SB(b, h) + boff + n * 2048 + k * 1024); } while (0)
#define PG8_MMA(ai, bj, At, Bt) do { __builtin_amdgcn_s_setprio(1); _Pragma("unroll") for (int m = 0; m < 4; ++m) _Pragma("unroll") for (int n = 0; n < 2; ++n) _Pragma("unroll") for (int k = 0; k < 2; ++k) \
        acc[ai][bj][m][n] = __builtin_amdgcn_mfma_f32_16x16x32_bf16(Bt[n][k], At[m][k], acc[ai][bj][m][n], 0, 0, 0); __builtin_amdgcn_s_setprio(0); } while (0)
#define PG8_WAIT_V(n) asm volatile("s_waitcnt vmcnt(" #n ")" ::: "memory")
#define PG8_WAIT_L(n) asm volatile("s_waitcnt lgkmcnt(" #n ")" ::: "memory")
#define PG8_BAR __builtin_amdgcn_s_barrier()
#define PG8_SCHED __builtin_amdgcn_sched_barrier(0)
    Unit cur, nxt; int ui = 0;
    static_assert(SP2, "only the SP2 loop is kept in this file");
    if (!S.next(0, cur)) return;
    f32x4 acc[2][2][4][2];
#pragma unroll
    for (int a = 0; a < 2; ++a)
#pragma unroll
        for (int b = 0; b < 2; ++b)
#pragma unroll
            for (int m = 0; m < 4; ++m)
#pragma unroll
                for (int n = 0; n < 2; ++n) acc[a][b][m][n] = (f32x4){0.f, 0.f, 0.f, 0.f};
    bf16x8 At[4][2], B0[2][2], B1[2][2];
    const char* cA = (const char*)g.A + (GATHER ? (size_t)0 : (size_t)cur.ab * tstep); const char* cB = (const char*)g.Bt + (size_t)cur.bb * tstep;
    unsigned vaC[2][2] = {{0u, 0u}, {0u, 0u}}, vaN[2][2] = {{0u, 0u}, {0u, 0u}};
    if constexpr (GATHER) { PG8_LOADVA(vaC, 0); }
    S.a_ready(cur);
    if constexpr (SP2) {
        PG8_STAGE(PG8_SB(0, 0), cB, voffB); PG8_STAGE(PG8_SB(0, 1), cB + hstep, voffB); PG8_STAGE_A(PG8_SA(0, 0), cA, 0, false); PG8_STAGE_A(PG8_SA(0, 1), cA, 1, false);
        if (wr == 1) PG8_BAR;
        PG8_WAIT_V(2); PG8_BAR;
        PG8_STAGE(PG8_SB(1, 0), cB + kstep, voffB); PG8_STAGE_A(PG8_SA(1, 0), cA + kstep, 0, false); PG8_STAGE(PG8_SB(1, 1), cB + hstep + kstep, voffB);
        PG8_WAIT_V(6); PG8_BAR;
    }
    for (;;) {
        const bool has_next = S.next(ui + 1, nxt);
        const char* nA = (has_next && !GATHER) ? (const char*)g.A + (size_t)nxt.ab * tstep : cA; const char* nB = has_next ? (const char*)g.Bt + (size_t)nxt.bb * tstep : cB;
        if constexpr (GATHER) { if (has_next) { PG8_LOADVA(vaN, ui + 1); } else { vaN[0][0] = vaC[0][0]; vaN[0][1] = vaC[0][1]; vaN[1][0] = vaC[1][0]; vaN[1][1] = vaC[1][1]; } }
        for (int t = 0; t < nt; t += 2) {
            const bool last = (t == nt - 2);
            const char* a1 = cA + (size_t)(t + 1) * kstep;
            const char* a2 = last ? nA : cA + (size_t)(t + 2) * kstep; const char* b2 = last ? nB : cB + (size_t)(t + 2) * kstep;
            const char* a3 = a2 + kstep; const char* b3 = b2 + kstep;
            if (last && has_next) S.a_ready(nxt);
            if constexpr (SP2) {
            PG8_LDB(B0, 0, 0); PG8_LDB(B1, 0, 1); PG8_SCHED; PG8_LDA(At, 0, 0); PG8_STAGE_A(PG8_SA(1, 1), a1, 1, false);
            PG8_WAIT_V(8); PG8_WAIT_L(0); PG8_BAR; PG8_MMA(0, 0, At, B0); PG8_MMA(0, 1, At, B1); PG8_BAR; PG8_SCHED;
            PG8_LDA(At, 0, 1); PG8_STAGE(PG8_SB(0, 0), b2, voffB); PG8_STAGE(PG8_SB(0, 1), b2 + hstep, voffB); PG8_STAGE_A(PG8_SA(0, 0), a2, 0, last);
            PG8_WAIT_V(8); PG8_WAIT_L(0); PG8_BAR; PG8_MMA(1, 0, At, B0); PG8_MMA(1, 1, At, B1); PG8_BAR; PG8_SCHED;
            PG8_LDB(B0, 1, 0); PG8_LDB(B1, 1, 1); PG8_SCHED; PG8_LDA(At, 1, 0); PG8_STAGE_A(PG8_SA(0, 1), a2, 1, last);
            PG8_WAIT_V(8); PG8_WAIT_L(0); PG8_BAR; PG8_MMA(0, 0, At, B0); PG8_MMA(0, 1, At, B1); PG8_BAR; PG8_SCHED;
            PG8_LDA(At, 1, 1); PG8_STAGE(PG8_SB(1, 0), b3, voffB); PG8_STAGE(PG8_SB(1, 1), b3 + hstep, voffB); PG8_STAGE_A(PG8_SA(1, 0), a3, 0, last);
            PG8_WAIT_V(8); PG8_WAIT_L(0); PG8_BAR; PG8_MMA(1, 0, At, B0); PG8_MMA(1, 1, At, B1); PG8_BAR; PG8_SCHED;
            }
        }
        if constexpr (ALIGN_EPI) { if (wr == 0) PG8_BAR; }
        if constexpr (!Epi::AFTER_DRAIN) { E(acc, cur, wr, wc, fr, fq); S.done(cur); }
        if (!has_next) break;
        if (!epi_chains<Epi>::value || cur.aux != 0) {
#pragma unroll
        for (int a = 0; a < 2; ++a)
#pragma unroll
            for (int b = 0; b < 2; ++b)
#pragma unroll
                for (int m = 0; m < 4; ++m)
#pragma unroll
                    for (int n = 0; n < 2; ++n) acc[a][b][m][n] = (f32x4){0.f, 0.f, 0.f, 0.f};
        }
        cur = nxt; cA = nA; cB = nB; ++ui;
        if constexpr (GATHER) { vaC[0][0] = vaN[0][0]; vaC[0][1] = vaN[0][1]; vaC[1][0] = vaN[1][0]; vaC[1][1] = vaN[1][1]; }
        if constexpr (ALIGN_EPI) { if (wr == 1) PG8_BAR; }
    }
    PG8_WAIT_V(0);
    if constexpr (!ALIGN_EPI) { if (wr == 0) PG8_BAR; }
    PG8_BAR;
    if constexpr (Epi::AFTER_DRAIN) { E.fused(acc, cur, wr, wc, fr, fq, lds, wid, lane); S.done(cur); }
#undef PG8_SA
#undef PG8_SB
#undef PG8_STAGE
#undef PG8_STAGE_A
#undef PG8_LOADVA
#undef PG8_LDA
#undef PG8_LDB
#undef PG8_MMA
#undef PG8_WAIT_V
#undef PG8_WAIT_L
#undef PG8_BAR
#undef PG8_SCHED
}
}
namespace pg8 {
__device__ __forceinline__ float bf_lo(unsigned w) { return __uint_as_float(w << 16); }
__device__ __forceinline__ float bf_hi(unsigned w) { return __uint_as_float(w & 0xffff0000u); }
__device__ __forceinline__ float sigm(float x) { return __builtin_amdgcn_rcpf(1.0f + __expf(-x)); }

struct EpiF32 {
    static constexpr bool PERM = false, AFTER_DRAIN = false;
    float* C; int ldc;
    __device__ __forceinline__ void operator()(const f32x4 (&acc)[2][2][4][2], const Unit& u, int wr, int wc, int fr, int fq) const {
        const int row0 = u.pm * BM + wr * 64 + fr, col0 = u.pn * BM + wc * 32 + 4 * fq;
#pragma unroll
        for (int ai = 0; ai < 2; ++ai)
#pragma unroll
            for (int m = 0; m < 4; ++m) { float* rowp = C + (size_t)(row0 + ai * HALF + m * 16) * ldc + col0;
#pragma unroll
                for (int bj = 0; bj < 2; ++bj)
#pragma unroll
                    for (int n = 0; n < 2; ++n) *(f32x4*)(rowp + bj * HALF + n * 16) = acc[ai][bj][m][n]; }
    }
};

struct EpiProj {
    static constexpr bool PERM = true, AFTER_DRAIN = false;
    bf16_t* O; float* SMp; bf16_t* QKV; bf16_t* ZIMG;
    __device__ __forceinline__ void operator()(const f32x4 (&acc)[2][2][4][2], const Unit& u, int wr, int wc, int fr, int fq) const {
        const int row0 = u.pm * BM + wr * 64 + fr;
        if (u.pn >= 12 && u.pn < 24) {
            const int which = (u.pn - 12) >> 2, hp = (u.pn - 12) & 3; const float qsc = which == 0 ? 0.08838834764831845f * 1.4426950408889634f : 1.0f;     bf16_t* base = QKV + (size_t)which * (32u * 4096u * 128u) + wc * 32 + 8 * fq;
#pragma unroll
            for (int ai = 0; ai < 2; ++ai)
#pragma unroll
                for (int m = 0; m < 4; ++m) { const int row = row0 + ai * HALF + m * 16; const int b = row >> 12, s = row & 4095;
#pragma unroll
                    for (int bj = 0; bj < 2; ++bj) { const f32x4 v0 = acc[ai][bj][m][0] * qsc, v1 = acc[ai][bj][m][1] * qsc;
                        u32x4 w; w.x = cvt_pk_bf16(v0[0], v0[1]); w.y = cvt_pk_bf16(v0[2], v0[3]); w.z = cvt_pk_bf16(v1[0], v1[1]); w.w = cvt_pk_bf16(v1[2], v1[3]);
                        *(u32x4*)(base + ((size_t)(b * 8 + 2 * hp + bj) * 4096 + s) * 128) = w; } }
        } else if (u.pn >= 24 && u.pn < 32) {
            bf16_t* zb = ZIMG + ((size_t)((u.pm * 4 + (u.pn & 3)) * 2 + ((u.pn - 24) >> 2)) * 16 * 512 + (wr * 4 + wc) * 64 + (fq * 16 + fr)) * 8;
#pragma unroll
            for (int ai = 0; ai < 2; ++ai)
#pragma unroll
                for (int m = 0; m < 4; ++m)
#pragma unroll
                    for (int bj = 0; bj < 2; ++bj) { const f32x4 v0 = acc[ai][bj][m][0], v1 = acc[ai][bj][m][1];
                        u32x4 w; w.x = cvt_pk_bf16(v0[0], v0[1]); w.y = cvt_pk_bf16(v0[2], v0[3]); w.z = cvt_pk_bf16(v1[0], v1[1]); w.w = cvt_pk_bf16(v1[2], v1[3]);
                        *(u32x4*)(zb + (size_t)((ai * 4 + m) * 2 + bj) * 512 * 8) = w; }
        } else if (u.pn < 12) {
            const int col0 = u.pn * BM + wc * 32 + 8 * fq;
#pragma unroll
            for (int ai = 0; ai < 2; ++ai)
#pragma unroll
                for (int m = 0; m < 4; ++m) { bf16_t* rowp = O + (size_t)(row0 + ai * HALF + m * 16) * 3072 + col0;
#pragma unroll
                    for (int bj = 0; bj < 2; ++bj) { const f32x4 v0 = acc[ai][bj][m][0], v1 = acc[ai][bj][m][1];
                        u32x4 w; w.x = cvt_pk_bf16(v0[0], v0[1]); w.y = cvt_pk_bf16(v0[2], v0[3]); w.z = cvt_pk_bf16(v1[0], v1[1]); w.w = cvt_pk_bf16(v1[2], v1[3]);
                        *(u32x4*)(rowp + bj * HALF) = w; } }
        } else if (wc == 0) {
#pragma unroll
            for (int ai = 0; ai < 2; ++ai)
#pragma unroll
                for (int m = 0; m < 4; ++m) { float* rp = SMp + (size_t)(row0 + ai * HALF + m * 16) * 32 + 8 * fq;
                    *(f32x4*)rp = acc[ai][0][m][0]; *(f32x4*)(rp + 4) = acc[ai][0][m][1]; }
        }
    }
};

struct EpiMix {
    static constexpr bool PERM = true, AFTER_DRAIN = false, CHAIN = true;
    const bf16_t* ZIMG; bf16_t* MIX;
    __device__ __forceinline__ void operator()(f32x4 (&acc)[2][2][4][2], const Unit& u, int wr, int wc, int fr, int fq) const {
        const int row0 = u.pm * BM + wr * 64 + fr, col0 = u.pn * BM + wc * 32 + 8 * fq; const int kind = u.aux;
        const bf16_t* zimg = ZIMG + ((size_t)((u.pm * 4 + u.pn) * 2) * 16 * 512 + (wr * 4 + wc) * 64 + (fq * 16 + fr)) * 8;
#pragma unroll
        for (int ai = 0; ai < 2; ++ai) {
            u32x4 zf[4][2], zg[4][2];
#pragma unroll
            for (int m = 0; m < 4; ++m)
#pragma unroll
                for (int bj = 0; bj < 2; ++bj) { const bf16_t* zp = zimg + (size_t)((ai * 4 + m) * 2 + bj) * 512 * 8;
                    zf[m][bj] = *(const u32x4*)(zp + 16 * 512 * 8); if (kind == 0) zg[m][bj] = *(const u32x4*)zp; }
#pragma unroll
            for (int m = 0; m < 4; ++m)
#pragma unroll
                for (int bj = 0; bj < 2; ++bj) {
                    const u32x4 a = zf[m][bj]; float ef[8] = {bf_lo(a.x), bf_hi(a.x), bf_lo(a.y), bf_hi(a.y), bf_lo(a.z), bf_hi(a.z), bf_lo(a.w), bf_hi(a.w)};
#pragma unroll
                    for (int j = 0; j < 8; ++j) ef[j] = 1.0f + __expf(-ef[j]);
                    if (kind == 0) {
                        const u32x4 g = zg[m][bj]; float eg[8] = {bf_lo(g.x), bf_hi(g.x), bf_lo(g.y), bf_hi(g.y), bf_lo(g.z), bf_hi(g.z), bf_lo(g.w), bf_hi(g.w)};
#pragma unroll
                        for (int j = 0; j < 8; ++j) { const float r = ef[j] * __builtin_amdgcn_rcpf(1.0f + __expf(-eg[j])); if (j < 4) acc[ai][bj][m][0][j] *= r; else acc[ai][bj][m][1][j - 4] *= r; }
                    } else {
                        float o[8];
#pragma unroll
                        for (int j = 0; j < 8; ++j) o[j] = (j < 4 ? acc[ai][bj][m][0][j] : acc[ai][bj][m][1][j - 4]) * __builtin_amdgcn_rcpf(ef[j]);
                        u32x4 w; w.x = cvt_pk_bf16(o[0], o[1]); w.y = cvt_pk_bf16(o[2], o[3]); w.z = cvt_pk_bf16(o[4], o[5]); w.w = cvt_pk_bf16(o[6], o[7]);
                        *(u32x4*)(MIX + (size_t)(row0 + ai * HALF + m * 16) * 1024 + col0 + bj * HALF) = w; } }
        }
    }
};

struct EpiAct {
    static constexpr bool PERM = true, AFTER_DRAIN = false;
    bf16_t* ACT; const float* bgu;
    __device__ __forceinline__ void operator()(const f32x4 (&acc)[2][2][4][2], const Unit& u, int wr, int wc, int fr, int fq) const {
        const int e = u.aux, c0 = wc * 32 + 8 * fq; const float* bg = bgu + (size_t)e * 2048 + u.pn * 128 + c0; const float* bu = bg + 1024;
        const f32x4 bg0 = *(const f32x4*)bg, bg1 = *(const f32x4*)(bg + 4), bu0 = *(const f32x4*)bu, bu1 = *(const f32x4*)(bu + 4);
#pragma unroll
        for (int ai = 0; ai < 2; ++ai)
#pragma unroll
            for (int m = 0; m < 4; ++m) { const size_t row = (size_t)u.ab * BM + ai * HALF + m * 16 + wr * 64 + fr;
                const f32x4 g0 = acc[ai][0][m][0] + bg0, g1 = acc[ai][0][m][1] + bg1, p0 = acc[ai][1][m][0] + bu0, p1 = acc[ai][1][m][1] + bu1;
                float o[8];
#pragma unroll
                for (int j = 0; j < 8; ++j) { const float gv = j < 4 ? g0[j & 3] : g1[j & 3], uv = j < 4 ? p0[j & 3] : p1[j & 3];
                    const float gate = fminf(gv, 7.0f), up = fminf(fmaxf(uv, -7.0f), 7.0f); o[j] = (up + 1.0f) * (gate * sigm(1.702f * gate)); }
                u32x4 w; w.x = cvt_pk_bf16(o[0], o[1]); w.y = cvt_pk_bf16(o[2], o[3]); w.z = cvt_pk_bf16(o[4], o[5]); w.w = cvt_pk_bf16(o[6], o[7]);
                *(u32x4*)(ACT + row * 1024 + u.pn * 128 + c0) = w; }
    }
};

struct EpiDown {
    static constexpr bool PERM = true, AFTER_DRAIN = false;
    bf16_t* YS; const float* bd;
    __device__ __forceinline__ void operator()(const f32x4 (&acc)[2][2][4][2], const Unit& u, int wr, int wc, int fr, int fq) const {
        const int e = u.aux, col0 = u.pn * BM + wc * 32 + 8 * fq;
        f32x4 bv[2][2];
#pragma unroll
        for (int bj = 0; bj < 2; ++bj)
#pragma unroll
            for (int n = 0; n < 2; ++n) bv[bj][n] = *(const f32x4*)(bd + (size_t)e * 1024 + col0 + bj * HALF + 4 * n);
#pragma unroll
        for (int ai = 0; ai < 2; ++ai)
#pragma unroll
            for (int m = 0; m < 4; ++m) { bf16_t* rowp = YS + ((size_t)u.ab * BM + ai * HALF + m * 16 + wr * 64 + fr) * 1024 + col0;
#pragma unroll
                for (int bj = 0; bj < 2; ++bj) { const f32x4 v0 = acc[ai][bj][m][0] + bv[bj][0], v1 = acc[ai][bj][m][1] + bv[bj][1];
                    u32x4 w; w.x = cvt_pk_bf16(v0[0], v0[1]); w.y = cvt_pk_bf16(v0[2], v0[3]); w.z = cvt_pk_bf16(v1[0], v1[1]); w.w = cvt_pk_bf16(v1[2], v1[3]);
                    *(u32x4*)(rowp + bj * HALF) = w; } }
    }
};

struct MixOrder {
    StaticOrder so;
    __device__ void init(int M, int N, int G_, int c_) { so.init(M, N, G_, c_); }
    __device__ __forceinline__ bool next(int i, Unit& u) const { if (!so.next(i >> 1, u)) return false; const int kind = i & 1; u.aux = kind; u.ab = kind * (so.nM) + u.pm; u.bb = kind * (so.nN) + u.pn; return true; }
    __device__ __forceinline__ void a_ready(const Unit&) const {}
    __device__ __forceinline__ void done(const Unit&) const {}
    __device__ __forceinline__ const PG8_LAS int* rowidx(int) const { return nullptr; }
};
constexpr int MAXU = 12;
struct GroupedOrder {
    const PG8_LAS int* desc; const PG8_LAS int* idx;
    __device__ __forceinline__ bool next(int i, Unit& u) const {
        if (i >= MAXU) return false; const PG8_LAS int* d = desc + i * 8;
        if (__builtin_amdgcn_readfirstlane(d[0]) == 0) return false;
        u.ab = __builtin_amdgcn_readfirstlane(d[1]); u.bb = __builtin_amdgcn_readfirstlane(d[2]); u.pn = __builtin_amdgcn_readfirstlane(d[3]); u.aux = __builtin_amdgcn_readfirstlane(d[4]); u.pm = u.ab; return true; }
    __device__ __forceinline__ void a_ready(const Unit&) const {}
    __device__ __forceinline__ void done(const Unit&) const {}
    __device__ __forceinline__ const PG8_LAS int* rowidx(int i) const { return idx + i * 256; }
};
}
namespace fox {
constexpr int D = 128, PKV = 128  , PO = 1024  ;
constexpr float THR = 8.f; constexpr bool WSKIP = false;
constexpr float SCALE = 0.08838834764831845f;
constexpr int NW = 8, QBLK = 32, KVBLK = 64, QB = NW * QBLK;
constexpr int SHM_V = KVBLK * D * 2, SHM_K = KVBLK * D * 2;
constexpr int LDS_BIAS = 2 * SHM_V + 2 * SHM_K + NW * 64 * 4;
constexpr int LDS_JUNK = LDS_BIAS + 2 * 4096 * 4;
constexpr int LDS_BYTES = LDS_JUNK + 256;

using bf16 = __hip_bfloat16;
typedef short bf16x8 __attribute__((ext_vector_type(8)));
typedef short s16x4 __attribute__((ext_vector_type(4)));
typedef float f32x16 __attribute__((ext_vector_type(16)));
typedef float f32x4 __attribute__((ext_vector_type(4)));
typedef unsigned u32x4 __attribute__((ext_vector_type(4)));
template <class A, class Bt> struct same_t { static constexpr bool v = false; };
template <class A> struct same_t<A, A> { static constexpr bool v = true; };

#define KSWZ(row, colB) ((row) * 256 + ((colB) ^ (((row) & 7) << 4)))
#define SBAR() __builtin_amdgcn_sched_barrier(0)
__device__ __forceinline__ int v_st(int k, int c) { const int kk = (k & ~0xC) | ((k & 4) << 1) | ((k & 8) >> 1); return ((kk >> 3) * 4 + (c >> 5)) * 512 + ((kk & 7) * 32 + (c & 31)) * 2; }
__device__ __forceinline__ int v_rd_base(int lane) { return ((lane & 3) << 3) | (((lane >> 2) & 3) << 6) | (((lane >> 4) & 1) << 5) | (((lane >> 5) & 1) << 8); }
constexpr int v_rd_off(int d0, int ks, int half) { return d0 * 512 + ks * 4096 + half * 2048; }
__device__ __forceinline__ int crow(int r, int hi) { return (r & 3) + 8 * (r >> 2) + 4 * hi; }
__device__ __forceinline__ unsigned cvtpk(float lo, float hi) {
    unsigned r; asm volatile("v_cvt_pk_bf16_f32 %0, %1, %2" : "=v"(r) : "v"(lo), "v"(hi)); return r;
}
__device__ __forceinline__ bf16x8 pack8(f32x4 a, f32x4 b) {
    u32x4 w = {cvtpk(a[0], a[1]), cvtpk(a[2], a[3]), cvtpk(b[0], b[1]), cvtpk(b[2], b[3])};
    return *reinterpret_cast<bf16x8*>(&w);
}
template <class T> __device__ __forceinline__ bf16x8 load8(const T* p) {
    if constexpr (same_t<T, float>::v) { return pack8(*(const f32x4*)p, *(const f32x4*)(p + 4)); }
    else { return *reinterpret_cast<const bf16x8*>(p); }
}
__device__ __forceinline__ void mask_tile(f32x16& p0, f32x16& p1, int dq, unsigned W) {
    const float NEG = -__builtin_inff();
#pragma unroll
    for (int r = 0; r < 16; ++r) {
        const int c = (r & 3) + 8 * (r >> 2);
        if ((unsigned)(dq - c) >= W) p0[r] = NEG;
        if ((unsigned)(dq - c - 32) >= W) p1[r] = NEG;
    }
}
__device__ __forceinline__ void partialSM(f32x16& p0, f32x16& p1, float& m_reg, float& mn, float& alpha) {
    float pmax = p0[0]; for (int r = 1; r < 16; ++r) pmax = fmaxf(pmax, p0[r]); for (int r = 0; r < 16; ++r) pmax = fmaxf(pmax, p1[r]);
    { auto rr = __builtin_amdgcn_permlane32_swap(__float_as_uint(pmax), __float_as_uint(pmax), false, false);
      pmax = fmaxf(__uint_as_float(rr[0]), __uint_as_float(rr[1])); }
    constexpr float C2 = 1.4426950408889634f * SCALE;
    if (__builtin_expect(__all((pmax - m_reg) * SCALE <= THR), 1)) { mn = m_reg; alpha = 1.f; }
    else { mn = fmaxf(m_reg, pmax); alpha = __builtin_amdgcn_exp2f((m_reg - mn) * C2); m_reg = mn; }
    const float mnL = -mn * C2;
    for (int r = 0; r < 16; ++r) p0[r] = fmaf(p0[r], C2, mnL); for (int r = 0; r < 16; ++r) p1[r] = fmaf(p1[r], C2, mnL);
    for (int r = 0; r < 16; ++r) p0[r] = __builtin_amdgcn_exp2f(p0[r]);
}
__device__ __forceinline__ void finishSM(f32x16& p0, f32x16& p1, float alpha, float& l_reg, bf16x8& pa0, bf16x8& pa1, bf16x8& pa2, bf16x8& pa3) {
    for (int r = 0; r < 16; ++r) p1[r] = __builtin_amdgcn_exp2f(p1[r]);
    float ps = 0; for (int r = 0; r < 16; ++r) ps += p0[r]; for (int r = 0; r < 16; ++r) ps += p1[r];
    { auto rr = __builtin_amdgcn_permlane32_swap(__float_as_uint(ps), __float_as_uint(ps), false, false);
      ps = __uint_as_float(rr[0]) + __uint_as_float(rr[1]); }
    l_reg = l_reg * alpha + ps;
#define PK4(P, B_, OUT) do { unsigned a0 = cvtpk(P[B_+0], P[B_+1]), a1 = cvtpk(P[B_+2], P[B_+3]);                          \
        unsigned b0 = cvtpk(P[B_+4], P[B_+5]), b1 = cvtpk(P[B_+6], P[B_+7]);                                             \
        auto r0 = __builtin_amdgcn_permlane32_swap(a0, b0, false, false); auto r1 = __builtin_amdgcn_permlane32_swap(a1, b1, false, false); \
        u32x4 w = {r0[0], r1[0], r0[1], r1[1]}; OUT = *reinterpret_cast<bf16x8*>(&w); } while (0)
    PK4(p0, 0, pa0); PK4(p0, 8, pa1); PK4(p1, 0, pa2); PK4(p1, 8, pa3);
#undef PK4
}
template <int KB, bool SK>
__device__ __forceinline__ void qkt(f32x16& p0, f32x16& p1, const char* K_lds, int r32, int hi, const bf16x8* qr, bool act, const float* bias_t  ) {
    if (SK && !act) { const float NEG = -__builtin_inff();
#pragma unroll
        for (int r = 0; r < 16; ++r) { p0[r] = NEG; p1[r] = NEG; } return; }
#pragma unroll
    for (int g4 = 0; g4 < 4; ++g4) { const f32x4 b0 = *(const f32x4*)(bias_t + 8 * g4), b1 = *(const f32x4*)(bias_t + 32 + 8 * g4);
#pragma unroll
        for (int j = 0; j < 4; ++j) { p0[4 * g4 + j] = b0[j]; p1[4 * g4 + j] = b1[j]; } }
    const char* kb[4];
#pragma unroll
    for (int dd = 0; dd < 4; ++dd) kb[dd] = K_lds + KB * SHM_K + KSWZ(r32, (dd * 16 + hi * 8) * 2);
#pragma unroll
    for (int d0 = 0; d0 < 8; ++d0) { const char* a = kb[d0 & 3] + (d0 >> 2) * 128;
        bf16x8 b0 = *reinterpret_cast<const bf16x8*>(a);
        bf16x8 b1 = *reinterpret_cast<const bf16x8*>(a + 32 * 256);
        p0 = __builtin_amdgcn_mfma_f32_32x32x16_bf16(b0, qr[d0], p0, 0, 0, 0);
        p1 = __builtin_amdgcn_mfma_f32_32x32x16_bf16(b1, qr[d0], p1, 0, 0, 0); }
}
template <int VB, bool SK>
__device__ __forceinline__ void pv_tile(f32x16* o, int vb0, bf16x8 pa0, bf16x8 pa1, bf16x8 pa2, bf16x8 pa3, bool act) {
    if (SK && !act) return;
#define TRRD(dst, off) asm volatile("ds_read_b64_tr_b16 %0, %1 offset:%2" : "=&v"(dst) : "v"(vb0), "i"(off) : "memory")
#define PV_D0(d0) do { s16x4 l0, l1, l2, l3, h0, h1, h2, h3; constexpr int b_ = VB * SHM_V + v_rd_off(d0, 0, 0);     \
        TRRD(l0, b_); TRRD(h0, b_ + 2048); TRRD(l1, b_ + 4096); TRRD(h1, b_ + 6144); TRRD(l2, b_ + 8192); TRRD(h2, b_ + 10240); TRRD(l3, b_ + 12288); TRRD(h3, b_ + 14336); \
        asm volatile("s_waitcnt lgkmcnt(0)" ::: "memory"); SBAR();                 \
        o[d0] = __builtin_amdgcn_mfma_f32_32x32x16_bf16(pa0, (bf16x8){l0[0], l0[1], l0[2], l0[3], h0[0], h0[1], h0[2], h0[3]}, o[d0], 0, 0, 0);   \
        o[d0] = __builtin_amdgcn_mfma_f32_32x32x16_bf16(pa1, (bf16x8){l1[0], l1[1], l1[2], l1[3], h1[0], h1[1], h1[2], h1[3]}, o[d0], 0, 0, 0);   \
        o[d0] = __builtin_amdgcn_mfma_f32_32x32x16_bf16(pa2, (bf16x8){l2[0], l2[1], l2[2], l2[3], h2[0], h2[1], h2[2], h2[3]}, o[d0], 0, 0, 0);   \
        o[d0] = __builtin_amdgcn_mfma_f32_32x32x16_bf16(pa3, (bf16x8){l3[0], l3[1], l3[2], l3[3], h3[0], h3[1], h3[2], h3[3]}, o[d0], 0, 0, 0); } while (0)
    PV_D0(0); PV_D0(1); PV_D0(2); PV_D0(3);
#undef PV_D0
#undef TRRD
}

template <class TIn, class TOut> struct BlockRef { const TIn* Q; const TIn* K; const TIn* V; TOut* O; int P0; };
template <class TIn> struct Seam {
    bf16x8 qr[8];
    bf16x8 st_v0, st_v1, st_k0, st_k1; f32x4 sf0, sf1, sf2, sf3;
    f32x4 tq[16];
};
__device__ __forceinline__ int swa_jlo(int P0, int W) { const int lowk = P0 - W + 1; return lowk > 0 ? lowk / KVBLK : 0; }
#define ROW(p, k0, rr) ((p) + (size_t)((k0) + (rr)) * PKV + sc)
#define VMW() asm volatile("s_waitcnt vmcnt(0)" ::: "memory")
#define VMWN(n) asm volatile("s_waitcnt vmcnt(%0)" :: "i"(n) : "memory")
#define SLOAD_H(Kp, Vp, k0) do { S.st_v0 = load8<TIn>(ROW(Vp, k0, sr)); S.st_v1 = load8<TIn>(ROW(Vp, k0, 32 + sr));              \
                         S.st_k0 = load8<TIn>(ROW(Kp, k0, sr)); S.st_k1 = load8<TIn>(ROW(Kp, k0, 32 + sr)); } while (0)
#define SWRITE_HK(bf) do { *(bf16x8*)(K_lds + (bf) * SHM_K + kws) = S.st_k0; *(bf16x8*)(K_lds + (bf) * SHM_K + kws + 32 * 256) = S.st_k1; } while (0)
#define SWRITE_HV(bf) do { *(bf16x8*)(V_lds + (bf) * SHM_V + vst0) = S.st_v0; *(bf16x8*)(V_lds + (bf) * SHM_V + vst1) = S.st_v1; } while (0)
#define SWRITE_H(bf) do { SWRITE_HV(bf); SWRITE_HK(bf); } while (0)
#define SLOAD_F(p, k0) do { S.sf0 = *(const f32x4*)ROW(p, k0, sr); S.sf1 = *(const f32x4*)(ROW(p, k0, sr) + 4);                \
                            S.sf2 = *(const f32x4*)ROW(p, k0, 32 + sr); S.sf3 = *(const f32x4*)(ROW(p, k0, 32 + sr) + 4); } while (0)
#define SWRITE_KF(bf) do { *(bf16x8*)(K_lds + (bf) * SHM_K + kws) = pack8(S.sf0, S.sf1); *(bf16x8*)(K_lds + (bf) * SHM_K + kws + 32 * 256) = pack8(S.sf2, S.sf3); } while (0)
#define SWRITE_VF(bf) do { *(bf16x8*)(V_lds + (bf) * SHM_V + vst0) = pack8(S.sf0, S.sf1); *(bf16x8*)(V_lds + (bf) * SHM_V + vst1) = pack8(S.sf2, S.sf3); } while (0)
template <class TIn, class TOut>
__device__ __forceinline__ void causal_swa_prime(const BlockRef<TIn, TOut>& cur, int W, char* lds, Seam<TIn>& S, int tid_in) {
    constexpr bool F32 = same_t<TIn, float>::v;
    const int tid = tid_in, wid = __builtin_amdgcn_readfirstlane(tid >> 6), lane = tid & 63, r32 = lane & 31, hi = lane >> 5;
    const int sr = tid >> 4, sc = (tid & 15) * 8, kws = KSWZ(sr, sc * 2); char* K_lds = lds + 2 * SHM_V;
    const int kb0 = swa_jlo(cur.P0, W) * KVBLK;
    for (int d0 = 0; d0 < 8; ++d0) S.qr[d0] = load8<TIn>(cur.Q + (size_t)(wid * QBLK + r32) * PKV + d0 * 16 + hi * 8);
    if constexpr (F32) { SLOAD_F((const float*)cur.K, kb0); VMW(); SWRITE_KF(0); SBAR(); SLOAD_F((const float*)cur.V, kb0); }
    else { SLOAD_H(cur.K, cur.V, kb0); VMW(); SWRITE_HK(0); }
    __syncthreads();
}
template <class TIn, class TOut>
__device__ __forceinline__ void causal_swa_block(const BlockRef<TIn, TOut>& cur, const BlockRef<TIn, TOut>& nxt, int skv, int W, char* lds, Seam<TIn>& S, int bias_buf, int tid_in) {
    constexpr bool F32 = same_t<TIn, float>::v;
    const int tid = tid_in, wid = __builtin_amdgcn_readfirstlane(tid >> 6), lane = tid & 63, r32 = lane & 31, hi = lane >> 5;
    const int j_lo = swa_jlo(cur.P0, W);
    int j_hi = (cur.P0 + QB - 1) / KVBLK + 1; if (j_hi > skv / KVBLK) j_hi = skv / KVBLK;
    const int NT = j_hi - j_lo;
    const int kbn = swa_jlo(nxt.P0, W) * KVBLK;
    const int qlo = cur.P0 + wid * QBLK, qm = qlo + r32 - 4 * hi;
    char* V_lds = lds; char* K_lds = lds + 2 * SHM_V;
    float* ws = (float*)(lds + 2 * SHM_V + 2 * SHM_K) + wid * 64; float* li_l = ws, * al_l = ws + 32;
    const float* bias_l = (const float*)(lds + LDS_BIAS + bias_buf * 16384) + 4 * hi;
    float m_reg = -1e30f, l_reg = 0; f32x16 o[4] = {};
    const int sr = tid >> 4, sc = (tid & 15) * 8, vst0 = v_st(sr, sc), vst1 = v_st(32 + sr, sc), kws = KSWZ(sr, sc * 2);
    const int vb0 = (int)(uintptr_t)V_lds + v_rd_base(lane);
    const TIn* Kh = cur.K; const TIn* Vh = cur.V;
#define RESC(a) do { if (__any((a) < 1.f)) { if (hi == 0) al_l[r32] = (a); asm volatile("s_waitcnt lgkmcnt(0)" ::: "memory");              \
                     for (int d_ = 0; d_ < 4; ++d_) for (int r = 0; r < 16; ++r) o[d_][r] *= al_l[crow(r, hi)]; } } while (0)
#define KBASE(t) ((j_lo + (t)) * KVBLK)
#define BIAS_T(t) (bias_l + KBASE(t))
    const TIn* pf_src = (((tid >> 7) & 1) ? Vh : Kh) + (size_t)((tid & 127) >> 1) * PKV + (tid & 1) * 64;
#define L2_PREFETCH(kb_) do { if (tid < 256) __builtin_amdgcn_global_load_lds((const unsigned*)(pf_src + (size_t)(kb_) * PKV), (__attribute__((address_space(3))) unsigned*)(uintptr_t)__builtin_amdgcn_readfirstlane((unsigned)(uintptr_t)(lds + LDS_JUNK)), 4, 0, 0); } while (0)
#define ACT(t) (KBASE(t) <= qlo + QBLK - 1 && KBASE(t) + KVBLK - 1 >= qlo - W + 1)
#define MASKT(P0_, P1_, t) do { const int kb_ = KBASE(t); if ((!SK || ACT(t)) && (kb_ + KVBLK - 1 > qlo || kb_ <= qlo + QBLK - 1 - W)) mask_tile(P0_, P1_, qm - kb_, (unsigned)W); } while (0)
    constexpr int NQL = F32 ? 16 : 8;
    constexpr bool SK = WSKIP && !F32;
#define SEAM_K0() do { VMWN(NQL); if constexpr (F32) { SWRITE_KF(0); SBAR(); SLOAD_F((const float*)nxt.V, kbn); } else { SWRITE_HK(0); } SBAR(); } while (0)
    f32x16 pA0, pA1, pB0, pB1; float mnA, mnB, alA, alB; bf16x8 pa0, pa1, pa2, pa3;
    if constexpr (F32) { VMW(); SWRITE_VF(0); SBAR(); } else { SWRITE_HV(0); SBAR(); }
    if (NT > 1) { if constexpr (F32) SLOAD_F((const float*)Kh, KBASE(1)); else SLOAD_H(Kh, Vh, KBASE(1)); }
    SBAR(); qkt<0, SK>(pA0, pA1, K_lds, r32, hi, S.qr, ACT(0), BIAS_T(0));
    if constexpr (F32) { if (NT > 1) { VMW(); SWRITE_KF(1); SBAR(); SLOAD_F((const float*)Vh, KBASE(1)); } }
    MASKT(pA0, pA1, 0); partialSM(pA0, pA1, m_reg, mnA, alA);
    if (NT > 1) { VMW(); if constexpr (F32) { SWRITE_VF(1); SBAR(); if (NT > 2) SLOAD_F((const float*)Kh, KBASE(2)); } else SWRITE_H(1); }
    __syncthreads();
#define HALF_STEP(PX0, PX1, mnX, alX, PY0, PY1, alY, t, KB, VB, SB) do {                                                      \
        SBAR(); qkt<KB, SK>(PX0, PX1, K_lds, r32, hi, S.qr, ACT(t), BIAS_T(t));                                             \
        finishSM(PY0, PY1, alY, l_reg, pa0, pa1, pa2, pa3); SBAR();                                                           \
        if ((t) + 1 < NT) { if constexpr (F32) { VMW(); SWRITE_KF(SB); SBAR(); SLOAD_F((const float*)Vh, KBASE((t) + 1)); }  \
                            else { SLOAD_H(Kh, Vh, KBASE((t) + 1)); } SBAR(); }                                               \
        pv_tile<VB, SK>(o, vb0, pa0, pa1, pa2, pa3, ACT((t) - 1)); MASKT(PX0, PX1, (t)); partialSM(PX0, PX1, m_reg, mnX, alX);                                        \
        __syncthreads();                                                                                                      \
        if ((t) + 1 < NT) { VMW(); if constexpr (F32) { SWRITE_VF(SB); SBAR(); if ((t) + 2 < NT) SLOAD_F((const float*)Kh, KBASE((t) + 2)); } \
                            else { SWRITE_H(SB); } }                                                                          \
        RESC(alX); __syncthreads(); } while (0)
    for (int t = 1; t + 1 < NT; t += 2) {
        HALF_STEP(pB0, pB1, mnB, alB, pA0, pA1, alA, t, 1, 0, 0);
        HALF_STEP(pA0, pA1, mnA, alA, pB0, pB1, alB, t + 1, 0, 1, 1);
    }
    const bool even = (NT & 1) == 0;
    if (even) { SBAR(); qkt<1, SK>(pB0, pB1, K_lds, r32, hi, S.qr, ACT(NT - 1), BIAS_T(NT - 1)); SBAR(); }
#define QROW(e) (nxt.Q + (size_t)(wid * QBLK + r32) * PKV + ((e) >> 1) * 16 + hi * 8 + ((e) & 1) * 4)
    if constexpr (F32) { SLOAD_F((const float*)nxt.K, kbn); SBAR();
#pragma unroll
        for (int e = 0; e < 8; ++e) S.tq[e] = *(const f32x4*)QROW(e); }
    else { SLOAD_H(nxt.K, nxt.V, kbn); SBAR();
#pragma unroll
        for (int d0 = 0; d0 < 8; ++d0) S.qr[d0] = load8<TIn>(nxt.Q + (size_t)(wid * QBLK + r32) * PKV + d0 * 16 + hi * 8); }
    SBAR();
    finishSM(pA0, pA1, alA, l_reg, pa0, pa1, pa2, pa3); SBAR();
    if constexpr (F32) {
#pragma unroll
        for (int e = 8; e < 16; ++e) S.tq[e] = *(const f32x4*)QROW(e); SBAR(); }
#undef QROW
    pv_tile<0, SK>(o, vb0, pa0, pa1, pa2, pa3, ACT(even ? NT - 2 : NT - 1));
    if (even) { MASKT(pB0, pB1, NT - 1); partialSM(pB0, pB1, m_reg, mnB, alB); __syncthreads(); RESC(alB);
        finishSM(pB0, pB1, alB, l_reg, pa0, pa1, pa2, pa3); SBAR(); pv_tile<1, SK>(o, vb0, pa0, pa1, pa2, pa3, ACT(NT - 1)); }
    SBAR(); SEAM_K0();
    if (hi == 0) li_l[r32] = l_reg; asm volatile("s_waitcnt lgkmcnt(0)" ::: "memory");
    float rli[16];
#pragma unroll
    for (int r = 0; r < 16; ++r) rli[r] = __builtin_amdgcn_rcpf(li_l[crow(r, hi)]);
    TOut* Ow = cur.O + (size_t)(wid * QBLK) * PO;
#pragma unroll
    for (int r = 0; r < 16; ++r) { const int orow = crow(r, hi);
#pragma unroll
        for (int d0 = 0; d0 < 4; ++d0) { const float v = o[d0][r] * rli[r];
            if constexpr (same_t<TOut, float>::v) { Ow[(size_t)orow * PO + d0 * 32 + r32] = v; }
            else { const float vn = __shfl_xor(v, 1);
                   if ((r32 & 1) == 0) *(unsigned*)(Ow + (size_t)orow * PO + d0 * 32 + r32) = cvtpk(v, vn); } } }
    if constexpr (F32) {
#pragma unroll
        for (int d0 = 0; d0 < 8; ++d0) S.qr[d0] = pack8(S.tq[2 * d0], S.tq[2 * d0 + 1]); }
    __syncthreads();
#undef RESC
#undef KBASE
#undef BIAS_T
#undef L2_PREFETCH
#undef ACT
#undef MASKT
#undef SEAM_K0
#undef HALF_STEP
}
#undef ROW
#undef VMW
#undef VMWN
#undef SLOAD_H
#undef SWRITE_HK
#undef SWRITE_HV
#undef SWRITE_H
#undef SLOAD_F
#undef SWRITE_KF
#undef SWRITE_VF

}
namespace fa128 {
typedef short bf16x8 __attribute__((ext_vector_type(8)));
typedef short s16x4 __attribute__((ext_vector_type(4)));
typedef short v4i16_t __attribute__((ext_vector_type(4)));
typedef float f32x16 __attribute__((ext_vector_type(16)));
typedef float f32x4 __attribute__((ext_vector_type(4)));
typedef unsigned u32x4 __attribute__((ext_vector_type(4)));
typedef __attribute__((address_space(3))) const char* lds_cptr;
constexpr int NW = 8, QBLK = 32, QB = 256, KVBLK = 64, PKV = 128  , PO = 1024  ;
constexpr int NSLOT = 3, SLOTB = 16384;
constexpr int LDS_K = 0, LDS_V = NSLOT * SLOTB, LDS_BIAS = 2 * NSLOT * SLOTB, LDS_BYTES = LDS_BIAS + 2 * 4096 * 4;
constexpr float C2 = 0.08838834764831845f * 1.4426950408889634f;
__device__ __forceinline__ int crow(int r, int hi) { return (r & 3) + 8 * (r >> 2) + 4 * hi; }
__device__ __forceinline__ void glds16(const void* gsrc, unsigned lds_dst) { unsigned keep;
    asm volatile("s_mov_b32 %0, m0\n\ts_mov_b32 m0, %2\n\ts_nop 0\n\tglobal_load_lds_dwordx4 %1, off\n\ts_mov_b32 m0, %0" : "=&s"(keep) : "v"(gsrc), "s"(lds_dst) : "memory"); }
typedef float f32x2_t __attribute__((ext_vector_type(2))); typedef __bf16 bf16x2_t __attribute__((ext_vector_type(2)));
__device__ __forceinline__ unsigned cvtpk_s(float lo, float hi) { f32x2_t v = {lo, hi}; bf16x2_t b = __builtin_convertvector(v, bf16x2_t); return __builtin_bit_cast(unsigned, b); }
__device__ __forceinline__ s16x4 vtr(lds_cptr p) { return __builtin_bit_cast(s16x4, __builtin_amdgcn_ds_read_tr16_b64_v4i16((__attribute__((address_space(3))) v4i16_t*)p)); }
#define FA_WAIT_BAR(N) asm volatile("s_waitcnt vmcnt(" #N ") lgkmcnt(0)\n\ts_barrier" ::: "memory")
#define FA_SBAR() __builtin_amdgcn_sched_barrier(0)
__device__ __forceinline__ void cmask(f32x16& p0, f32x16& p1, int jb, int qrel, int hi) {
    const float NEG = -__builtin_inff(); const int kb = 64 * jb + 4 * hi;
#pragma unroll
    for (int r = 0; r < 16; ++r) { const int kv = kb + (r & 3) + 8 * (r >> 2); if (kv > qrel) p0[r] = NEG; if (kv + 32 > qrel) p1[r] = NEG; }
}
__device__ __forceinline__ float rowmax(const f32x16& p0, const f32x16& p1) {
    float a = p0[0], b = p1[0];
#pragma unroll
    for (int r = 1; r < 16; ++r) { a = __builtin_fmaxf(a, p0[r]); b = __builtin_fmaxf(b, p1[r]); }
    float m = __builtin_fmaxf(a, b);
    auto rr = __builtin_amdgcn_permlane32_swap(__float_as_uint(m), __float_as_uint(m), false, false);
    return __builtin_fmaxf(__uint_as_float(rr[0]), __uint_as_float(rr[1]));
}
template <int THRL>
__device__ __forceinline__ void attn_unit(const unsigned short* Qb, const unsigned short* __restrict__ Kh, const unsigned short* __restrict__ Vh, unsigned short* Ob, int qb,
                                          __attribute__((address_space(3))) unsigned char* ring, const __attribute__((address_space(3))) float* biasl, __attribute__((address_space(3))) float* wsf, int tid) {
    typedef __attribute__((address_space(3))) const bf16x8* lds_b8;
    const int lane = tid & 63, r32 = lane & 31, hi = lane >> 5; const int wid = __builtin_amdgcn_readfirstlane(tid >> 6);
    const int NT = 4 * qb + 4;
    const unsigned lds0 = (unsigned)(uintptr_t)ring;
    const unsigned short* ksrc = Kh + (size_t)lane * PKV + wid * 8;
    const unsigned short* vsrc = Vh + (size_t)(16 * (wid & 3) + (lane >> 2)) * PKV + (wid >> 2) * 32 + (lane & 3) * 8;
    const unsigned kdst = lds0 + LDS_K + wid * 1024, vdst = lds0 + LDS_V + wid * 1024;
#define FA_DMA_K(t, slot) do { glds16(ksrc + (size_t)(t) * KVBLK * PKV, (unsigned)__builtin_amdgcn_readfirstlane(kdst + (slot))); glds16(ksrc + (size_t)(t) * KVBLK * PKV + 64, (unsigned)__builtin_amdgcn_readfirstlane(kdst + (slot) + 8192)); } while (0)
#define FA_DMA_V(t, slot) do { glds16(vsrc + (size_t)(t) * KVBLK * PKV, (unsigned)__builtin_amdgcn_readfirstlane(vdst + (slot))); glds16(vsrc + (size_t)(t) * KVBLK * PKV + 64, (unsigned)__builtin_amdgcn_readfirstlane(vdst + (slot) + 8192)); } while (0)
    const lds_cptr ring3 = (lds_cptr)ring; const lds_cptr kp0 = ring3 + LDS_K + hi * 1024 + r32 * 16; const lds_cptr vp0 = ring3 + LDS_V + ((lane >> 4) & 1) * 32 + (lane & 3) * 8 + (4 * hi + ((lane & 15) >> 2)) * 64;
    FA_DMA_K(0, 0); FA_DMA_V(0, 0); FA_DMA_K(1, SLOTB);
    bf16x8 qr[8];
#pragma unroll
    for (int d0 = 0; d0 < 8; ++d0) qr[d0] = *reinterpret_cast<const bf16x8*>(Qb + (size_t)(wid * QBLK + r32) * PKV + d0 * 16 + hi * 8);
    float mhat = 0.f, l_reg = 0.f; f32x16 o[4];
#pragma unroll
    for (int d = 0; d < 4; ++d)
#pragma unroll
        for (int r = 0; r < 16; ++r) o[d][r] = 0.f;
    const int qrel = wid * QBLK + r32; bool resc = false;
    f32x16 pA0, pA1, pB0, pB1;
    int sl_prev = 0, sl_cur = 0, sl_next = SLOTB, sl_nn = 2 * SLOTB;
#define FA_ROT() do { sl_prev = sl_cur; sl_cur = sl_next; sl_next = sl_nn; sl_nn = (sl_nn == (NSLOT - 1) * SLOTB) ? 0 : sl_nn + SLOTB; } while (0)
    unsigned pwa[16];
#define FA_PAF(k) __builtin_bit_cast(bf16x8, (u32x4){pwa[4 * (k)], pwa[4 * (k) + 1], pwa[4 * (k) + 2], pwa[4 * (k) + 3]})
#define FA_KFR(f) (*(lds_b8)(kp_ + ((f) >> 1) * 2048 + ((f) & 1) * 512))
#define FA_VLD(i, VL, VH) do { VL = vtr(vp_ + ((i) >> 2) * 4096 + ((i) & 3) * 1024); VH = vtr(vp_ + ((i) >> 2) * 4096 + ((i) & 3) * 1024 + 512); } while (0)
#define FA_VB(VL, VH) ((bf16x8){VL[0], VL[1], VL[2], VL[3], VH[0], VH[1], VH[2], VH[3]})
#define FA_EL(X0, X1, i) ((i) < 16 ? X0[(i) & 15] : X1[(i) & 15])
#define FA_GA(g, KR, C_, P0, P1, NEXT) do { C_ = __builtin_amdgcn_mfma_f32_32x32x16_bf16(KR, qr[(g) >> 1], C_, 0, 0, 0); NEXT; \
        { const float a_ = FA_EL(P0, P1, 2 * (g)), b_ = FA_EL(P0, P1, 2 * (g) + 1); sacc_ += a_; sacc_ += b_; pwa[g] = cvtpk_s(a_, b_); asm volatile("" : "+v"(sacc_), "+v"(pwa[g])); } FA_SBAR(); } while (0)
#define FA_GB(f, VL, VH, X0, X1, DOEXP, NEXT) do { o[(f) >> 2] = __builtin_amdgcn_mfma_f32_32x32x16_bf16(FA_PAF((f) & 3), FA_VB(VL, VH), o[(f) >> 2], 0, 0, 0); NEXT; \
        if (DOEXP) { if (2 * (f) < 16) { float e0_ = __builtin_amdgcn_exp2f(X0[(2 * (f)) & 15]), e1_ = __builtin_amdgcn_exp2f(X0[(2 * (f) + 1) & 15]); asm volatile("" : "+v"(e0_), "+v"(e1_)); X0[(2 * (f)) & 15] = e0_; X0[(2 * (f) + 1) & 15] = e1_; } \
                     else { float e0_ = __builtin_amdgcn_exp2f(X1[(2 * (f)) & 15]), e1_ = __builtin_amdgcn_exp2f(X1[(2 * (f) + 1) & 15]); asm volatile("" : "+v"(e0_), "+v"(e1_)); X1[(2 * (f)) & 15] = e0_; X1[(2 * (f) + 1) & 15] = e1_; } } FA_SBAR(); } while (0)
#define FA_NOP do { } while (0)
    s16x4 vl0, vh0, vl1, vh1, vl2, vh2, vl3, vh3;
#define FA_PHASE_A(C0, C1, P0, P1) do { const lds_cptr kp_ = kp0 + sl_cur; const lds_cptr vp_ = vp0 + sl_prev; float sacc_ = 0.f; \
        bf16x8 k0 = FA_KFR(0), k1 = FA_KFR(1), k2 = FA_KFR(2), k3 = FA_KFR(3); FA_SBAR(); \
        FA_GA(0, k0, C0, P0, P1, k0 = FA_KFR(4)); FA_GA(1, k1, C1, P0, P1, k1 = FA_KFR(5)); FA_GA(2, k2, C0, P0, P1, k2 = FA_KFR(6)); FA_GA(3, k3, C1, P0, P1, k3 = FA_KFR(7)); \
        FA_GA(4, k0, C0, P0, P1, k0 = FA_KFR(8)); FA_GA(5, k1, C1, P0, P1, k1 = FA_KFR(9)); FA_GA(6, k2, C0, P0, P1, k2 = FA_KFR(10)); FA_GA(7, k3, C1, P0, P1, k3 = FA_KFR(11)); \
        FA_GA(8, k0, C0, P0, P1, k0 = FA_KFR(12)); FA_GA(9, k1, C1, P0, P1, k1 = FA_KFR(13)); FA_GA(10, k2, C0, P0, P1, k2 = FA_KFR(14)); FA_GA(11, k3, C1, P0, P1, k3 = FA_KFR(15)); \
        FA_GA(12, k0, C0, P0, P1, FA_VLD(0, vl0, vh0)); FA_GA(13, k1, C1, P0, P1, FA_VLD(1, vl1, vh1)); FA_GA(14, k2, C0, P0, P1, FA_VLD(2, vl2, vh2)); FA_GA(15, k3, C1, P0, P1, FA_VLD(3, vl3, vh3)); \
        l_reg += sacc_; } while (0)
#define FA_PHASE_B(X0, X1, DOEXP) do { const lds_cptr vp_ = vp0 + sl_prev; \
        FA_GB(0, vl0, vh0, X0, X1, DOEXP, FA_VLD(4, vl0, vh0)); FA_GB(1, vl1, vh1, X0, X1, DOEXP, FA_VLD(5, vl1, vh1)); FA_GB(2, vl2, vh2, X0, X1, DOEXP, FA_VLD(6, vl2, vh2)); FA_GB(3, vl3, vh3, X0, X1, DOEXP, FA_VLD(7, vl3, vh3)); \
        FA_GB(4, vl0, vh0, X0, X1, DOEXP, FA_VLD(8, vl0, vh0)); FA_GB(5, vl1, vh1, X0, X1, DOEXP, FA_VLD(9, vl1, vh1)); FA_GB(6, vl2, vh2, X0, X1, DOEXP, FA_VLD(10, vl2, vh2)); FA_GB(7, vl3, vh3, X0, X1, DOEXP, FA_VLD(11, vl3, vh3)); \
        FA_GB(8, vl0, vh0, X0, X1, DOEXP, FA_VLD(12, vl0, vh0)); FA_GB(9, vl1, vh1, X0, X1, DOEXP, FA_VLD(13, vl1, vh1)); FA_GB(10, vl2, vh2, X0, X1, DOEXP, FA_VLD(14, vl2, vh2)); FA_GB(11, vl3, vh3, X0, X1, DOEXP, FA_VLD(15, vl3, vh3)); \
        FA_GB(12, vl0, vh0, X0, X1, DOEXP, FA_NOP); FA_GB(13, vl1, vh1, X0, X1, DOEXP, FA_NOP); FA_GB(14, vl2, vh2, X0, X1, DOEXP, FA_NOP); FA_GB(15, vl3, vh3, X0, X1, DOEXP, FA_NOP); } while (0)
#define FA_BIAS_INIT(N0, N1, tn) do { const __attribute__((address_space(3))) float* bt_ = biasl + (tn) * KVBLK + 4 * hi; \
        _Pragma("unroll") for (int g4 = 0; g4 < 4; ++g4) { const f32x4 b0_ = *(const __attribute__((address_space(3))) f32x4*)(bt_ + 8 * g4), b1_ = *(const __attribute__((address_space(3))) f32x4*)(bt_ + 32 + 8 * g4); \
            _Pragma("unroll") for (int j = 0; j < 4; ++j) { N0[4 * g4 + j] = b0_[j] - mhat; N1[4 * g4 + j] = b1_[j] - mhat; } } } while (0)
#define FA_CMASK(P0, P1, t) do { const int jb_ = (t) - (NT - 4); if (jb_ >= 0) cmask(P0, P1, jb_, qrel, hi); } while (0)
#define FA_DECIDE(C0, C1) do { const float rm_ = rowmax(C0, C1); resc = false; \
        if (__builtin_expect(__any(rm_ > (float)THRL), 0)) { const float dl_ = __builtin_fmaxf(rm_, 0.f); mhat += dl_; \
            _Pragma("unroll") for (int r = 0; r < 16; ++r) { C0[r] -= dl_; C1[r] -= dl_; } \
            const float f_ = __builtin_amdgcn_exp2f(-dl_); l_reg *= f_; if (hi == 0) wsf[r32] = f_; resc = true; } } while (0)
#define FA_RESC() do { if (resc) { asm volatile("s_waitcnt lgkmcnt(0)" ::: "memory"); \
        _Pragma("unroll") for (int d_ = 0; d_ < 4; ++d_) _Pragma("unroll") for (int r = 0; r < 16; ++r) o[d_][r] *= wsf[crow(r, hi)]; } } while (0)
#define FA_ENDW(t) do { if ((t) + 2 < NT) { FA_WAIT_BAR(4); } else if ((t) + 1 < NT) { FA_WAIT_BAR(2); } else { FA_WAIT_BAR(0); } } while (0)
#define FA_STEP(C0, C1, P0, P1, t) do { \
        if ((t) + 2 < NT) FA_DMA_K((t) + 2, sl_nn);            \
        FA_SBAR(); FA_PHASE_A(C0, C1, P0, P1); \
        if ((t) + 1 < NT) FA_DMA_V((t) + 1, sl_next);          \
        FA_CMASK(C0, C1, t); FA_DECIDE(C0, C1); FA_SBAR(); \
        FA_PHASE_B(C0, C1, true); \
        if ((t) + 1 < NT) FA_BIAS_INIT(P0, P1, (t) + 1); FA_SBAR(); \
        FA_ENDW(t); FA_RESC(); FA_ROT(); } while (0)
    FA_WAIT_BAR(0);
    if (2 < NT) FA_DMA_K(2, sl_nn);
    FA_BIAS_INIT(pA0, pA1, 0);
    { const lds_cptr kp_ = kp0 + sl_cur;
#pragma unroll
      for (int d0 = 0; d0 < 8; ++d0) { const bf16x8 ka = *(lds_b8)(kp_ + d0 * 2048), kb = *(lds_b8)(kp_ + d0 * 2048 + 512);
          pA0 = __builtin_amdgcn_mfma_f32_32x32x16_bf16(ka, qr[d0], pA0, 0, 0, 0); pA1 = __builtin_amdgcn_mfma_f32_32x32x16_bf16(kb, qr[d0], pA1, 0, 0, 0); } }
    FA_CMASK(pA0, pA1, 0);
    { const float rm = rowmax(pA0, pA1); mhat = rm;
#pragma unroll
        for (int r = 0; r < 16; ++r) { pA0[r] = __builtin_amdgcn_exp2f(pA0[r] - rm); pA1[r] = __builtin_amdgcn_exp2f(pA1[r] - rm); } }
    FA_DMA_V(1, sl_next);
    FA_BIAS_INIT(pB0, pB1, 1);
    FA_ENDW(0); FA_ROT();
    int t = 1;
    for (; t + 1 < NT; t += 2) { FA_STEP(pB0, pB1, pA0, pA1, t); FA_STEP(pA0, pA1, pB0, pB1, t + 1); }
    FA_STEP(pB0, pB1, pA0, pA1, NT - 1);
    { float sacc_ = 0.f;
#pragma unroll
      for (int g = 0; g < 16; ++g) { const float a_ = g < 8 ? pB0[2 * g] : pB1[2 * g - 16], b_ = g < 8 ? pB0[2 * g + 1] : pB1[2 * g - 15]; sacc_ += a_; sacc_ += b_; pwa[g] = cvtpk_s(a_, b_); }
      l_reg += sacc_;
      { const lds_cptr vp_ = vp0 + sl_prev; FA_VLD(0, vl0, vh0); FA_VLD(1, vl1, vh1); FA_VLD(2, vl2, vh2); FA_VLD(3, vl3, vh3); }
      FA_SBAR(); FA_PHASE_B(pB0, pB1, false); }
    { auto rr = __builtin_amdgcn_permlane32_swap(__float_as_uint(l_reg), __float_as_uint(l_reg), false, false); l_reg = __uint_as_float(rr[0]) + __uint_as_float(rr[1]); }
    if (hi == 0) wsf[32 + r32] = l_reg; asm volatile("s_waitcnt lgkmcnt(0)" ::: "memory");
    unsigned short* Ow = Ob + (size_t)(wid * QBLK) * PO;
#pragma unroll
    for (int r = 0; r < 16; ++r) { const int orow = crow(r, hi); const float rl = __builtin_amdgcn_rcpf(wsf[32 + orow]);
#pragma unroll
        for (int d0 = 0; d0 < 4; ++d0) { const float v = o[d0][r] * rl; const float vn = __shfl_xor(v, 1);
            if ((r32 & 1) == 0) *(unsigned*)(Ow + (size_t)orow * PO + d0 * 32 + r32) = cvtpk_s(v, vn); } }
    asm volatile("s_waitcnt lgkmcnt(0)\n\ts_barrier" ::: "memory");
#undef FA_DMA_K
#undef FA_DMA_V
#undef FA_ROT
#undef FA_KFR
#undef FA_VLD
#undef FA_VB
#undef FA_EL
#undef FA_GA
#undef FA_GB
#undef FA_NOP
#undef FA_PHASE_A
#undef FA_PHASE_B
#undef FA_BIAS_INIT
#undef FA_CMASK
#undef FA_PAF
#undef FA_DECIDE
#undef FA_RESC
#undef FA_ENDW
#undef FA_STEP
}
#undef FA_WAIT_BAR
#undef FA_SBAR
}
#define GAS __attribute__((address_space(1)))
#define LAS __attribute__((address_space(3)))
typedef unsigned short bf16;
typedef unsigned v4u __attribute__((ext_vector_type(4)));
typedef float f32x4 __attribute__((ext_vector_type(4)));
typedef short bf16x8 __attribute__((ext_vector_type(8)));
typedef GAS unsigned gu32;
typedef GAS unsigned long long gu64;
#define RLX_AGENT __ATOMIC_RELAXED, __HIP_MEMORY_SCOPE_AGENT
#define LDS_WAIT() asm volatile("s_waitcnt lgkmcnt(0)" ::: "memory")
#define VM_WAIT() asm volatile("s_waitcnt vmcnt(0)" ::: "memory")
__device__ __forceinline__ unsigned long long rt() { return __builtin_amdgcn_s_memrealtime(); }
__device__ __forceinline__ unsigned f2bf(float f) { unsigned u = __builtin_bit_cast(unsigned, f); return (u + 0x7fffu + ((u >> 16) & 1u)) >> 16; }
__device__ __forceinline__ unsigned pk2(float lo, float hi) { return f2bf(lo) | (f2bf(hi) << 16); }

#define XB_TMO      128
#define XB_XCNT(j)  (256  + 64 * (j))
#define XB_XSUB(j)  (1280 + 64 * (j))
#define XB_XGEN(j)  (2304 + 64 * (j))
#define XB_TOP      3328
#define XB_TOPGEN   3392
#define XCD_BAR_WORDS 3456
#define XB_SPIN_CAP (1u << 18)

__device__ __forceinline__ unsigned xb_ld(unsigned* p)              { return __hip_atomic_load(p, __ATOMIC_RELAXED, __HIP_MEMORY_SCOPE_AGENT); }
__device__ __forceinline__ unsigned xb_add(unsigned* p, unsigned v) { return __hip_atomic_fetch_add(p, v, __ATOMIC_RELAXED, __HIP_MEMORY_SCOPE_AGENT); }
__device__ __forceinline__ unsigned xb_xcc_id() { return (unsigned)__builtin_amdgcn_s_getreg((3 << 11) | 20) & 0xFu; }
#define XB_SPIN(cond, bar) do { unsigned _sp = 0; while (cond) { __builtin_amdgcn_s_sleep(1); \
    if ((++_sp & 255u) == 0u) { if (xb_ld(&(bar)[XB_TMO])) break; if (_sp > XB_SPIN_CAP) { atomicAdd(&(bar)[XB_TMO], 1u); break; } } } } while (0)

struct XcdBarrier {
    unsigned* bar; unsigned x;
    volatile LAS unsigned* st;
};

__device__ __forceinline__ XcdBarrier xcd_barrier_post(unsigned* bar, volatile LAS unsigned* st) {
    XcdBarrier b; b.bar = bar; b.x = xb_xcc_id(); b.st = st;
    if (threadIdx.x == 0) (void)xb_add(&bar[XB_XCNT(b.x)], 1u);
    return b;
}
__device__ __forceinline__ void xcd_barrier_complete(unsigned* bar, unsigned x, unsigned& nloc, unsigned& nx) {
    const unsigned G = gridDim.x * gridDim.y * gridDim.z;
    unsigned sum, cnt, mine, sp = 0u;
    for (;;) {
        sum = 0u; cnt = 0u; mine = 0u;
#pragma unroll
        for (unsigned j = 0; j < 16; ++j) { const unsigned c = xb_ld(&bar[XB_XCNT(j)]); sum += c; cnt += (c > 0u) ? 1u : 0u; mine = (j == x) ? c : mine; }
        if (sum == G) break;
        __builtin_amdgcn_s_sleep(1);
        if ((++sp & 255u) == 0u) { if (xb_ld(&bar[XB_TMO])) break; if (sp > XB_SPIN_CAP) { atomicAdd(&bar[XB_TMO], 1u); break; } }
    }
    nloc = mine > 0u ? mine : 1u; nx = cnt > 0u ? cnt : 1u;
}

__device__ __forceinline__ void xcd_barrier(const XcdBarrier& b) {
    asm volatile("s_waitcnt vmcnt(0)" ::: "memory");
    __syncthreads();
    if (threadIdx.x == 0) {
        unsigned* bar = b.bar;
        __builtin_amdgcn_s_waitcnt(0);
        unsigned nloc = b.st[0], nx = b.st[1];
        if (nloc == 0u) { xcd_barrier_complete(bar, b.x, nloc, nx); b.st[0] = nloc; b.st[1] = nx; }
        const unsigned old = xb_add(&bar[XB_XSUB(b.x)], 1u);
        const unsigned gen = old / nloc;
        if (old + 1u == (gen + 1u) * nloc) {
            __builtin_amdgcn_fence(__ATOMIC_RELEASE, "agent");
            asm volatile("s_waitcnt vmcnt(0)" ::: "memory");
            const unsigned og = xb_add(&bar[XB_TOP], 1u);
            const unsigned tg = og / nx;
            if (og + 1u == (tg + 1u) * nx) xb_add(&bar[XB_TOPGEN], 1u);
            else XB_SPIN(xb_ld(&bar[XB_TOPGEN]) == tg, bar);
            __builtin_amdgcn_fence(__ATOMIC_ACQUIRE, "agent");
            xb_add(&bar[XB_XGEN(b.x)], 1u);
            asm volatile("s_waitcnt vmcnt(0)" ::: "memory");
        } else {
            XB_SPIN(xb_ld(&bar[XB_XGEN(b.x)]) == gen, bar);
            __builtin_amdgcn_fence(__ATOMIC_ACQUIRE, "agent");
            asm volatile("s_waitcnt vmcnt(0)" ::: "memory");
        }
    }
    __syncthreads();
}
#ifndef STAMP_K
#define STAMP_K -1
#endif
#ifndef DUP_MASK
#define DUP_MASK 0
#endif
constexpr int NWAVES = 8, NTHR = NWAVES * 64;
constexpr int T_TOK = 16384, SEQ = 4096, NBATCH = 4, DM = 1024;
constexpr int IN_COLS = 8216, NPROJ = 8192, NPROJ_PAD = 8448;
constexpr int C_GQ = 0, C_GK = 512, C_GV = 1024, C_GR = 2048, PPITCH = 3072;
constexpr int NE = 32, DFF = 1024, NCHUNK = 64;
constexpr float LN_EPS = 1e-5f;
constexpr float DN_ALPHA = 1.189207115002721f;
constexpr float FOX_INV_SCALE = 1.4426950408889634f;
constexpr float GLA_QSCALE = 0.08838834764831845f;
constexpr int SLOT_ROWS = 73728;

constexpr size_t MiB = 1u << 20;
constexpr size_t WS_CTL = 0, CTL_ZERO_BYTES = 1 * MiB;
constexpr size_t WS_WIN = 2 * MiB;
constexpr size_t WS_WPROJ = 19 * MiB;
constexpr size_t WS_WOUT = 23 * MiB;
constexpr size_t WS_WGU = 25 * MiB;
constexpr size_t WS_WDN = 153 * MiB;
constexpr size_t WS_H0B = 217 * MiB;
constexpr size_t WS_SM = 249 * MiB;
constexpr size_t WS_FB = 251 * MiB;
constexpr size_t WS_DECAY = 252 * MiB;
constexpr size_t WS_KDEC = 253 * MiB;
constexpr size_t WS_AO = 269 * MiB;
constexpr size_t WS_MIXED = 333 * MiB;
constexpr size_t WS_H1F = 365 * MiB;
constexpr size_t WS_H1B = 429 * MiB;
constexpr size_t WS_TOKOF = 461 * MiB;
constexpr size_t WS_PAIR = 463 * MiB;
constexpr size_t WS_PROJ = 464 * MiB;
constexpr size_t WS_YS = 560 * MiB;
constexpr size_t WS_FQKV = 704 * MiB;
constexpr size_t WS_ZIMG = 800 * MiB;
constexpr size_t WS_ACT = WS_FQKV;
constexpr size_t WS_END = 864 * MiB;
static_assert(WS_WIN + (size_t)NPROJ_PAD * 1024 * 2 <= WS_WPROJ && WS_WGU + (size_t)32 * 2048 * 1024 * 2 <= WS_WDN && WS_WDN + (size_t)32 * 1024 * 1024 * 2 <= WS_H0B, "ws map");
static_assert(WS_PROJ + (size_t)T_TOK * PPITCH * 2 <= WS_YS && WS_YS + (size_t)SLOT_ROWS * 1024 * 2 <= WS_FQKV && WS_FQKV + (size_t)3 * 32 * 4096 * 128 * 2 <= WS_ZIMG && WS_ZIMG + (size_t)64 * MiB <= WS_END && WS_ACT + (size_t)SLOT_ROWS * 1024 * 2 <= WS_END, "ws map");
constexpr int CW_TMO = 0, CW_CODE = 1;
constexpr int CW_BAR = 4096;
constexpr int CW_CNT = 8192;
constexpr int CW_Q = 12288;

constexpr int RING_OFF = 0, RING_BYTES = 131072;
constexpr int LDSCTL_OFF = RING_BYTES, MISC_OFF = LDSCTL_OFF + 320;
constexpr int TBL_OFF = RING_BYTES + 512;
constexpr int TBL_CUM = TBL_OFF, TBL_CNT = TBL_OFF + 256, TBL_DESC = TBL_OFF + 384, TBL_IDX = TBL_OFF + 768;
constexpr int LDS_BYTES = 147456;
static_assert(TBL_IDX + pg8::MAXU * 256 * 4 <= LDS_BYTES && fa128::LDS_BYTES <= RING_BYTES, "LDS map");

__device__ __forceinline__ float bfu(unsigned short h) { return __uint_as_float((unsigned)h << 16); }
__device__ __forceinline__ float logsig(float x) { return fminf(x, 0.f) - __logf(1.0f + __expf(-fabsf(x))); }
__device__ __forceinline__ float wave_sum(float v) {
#pragma unroll
    for (int o = 1; o < 64; o <<= 1) v += __shfl_xor(v, o);
    return v;
}

__device__ __forceinline__ void p0_tile_load(f32x4 (&v)[16], const float* W, int npitch, int srccol, int kb, int lane) {
    const int q = lane & 15, rg = lane >> 4, k0 = 64 * kb + 16 * rg;
    const GAS f32x4* src = (const GAS f32x4*)(W + (size_t)k0 * npitch + srccol + 4 * q);
#pragma unroll
    for (int i = 0; i < 16; ++i) v[i] = src[(size_t)i * (npitch / 4)];
}
__device__ __forceinline__ void p0_tile_store(const f32x4 (&v)[16], bf16* WT, int dstrow, int kb, int lane) {
    const int q = lane & 15, rg = lane >> 4, k0 = 64 * kb + 16 * rg;
#pragma unroll
    for (int j = 0; j < 4; ++j) { GAS v4u* dst = (GAS v4u*)(WT + (size_t)(dstrow + 4 * q + j) * 1024 + k0);
        v4u a, b;
        a.x = pk2(v[0][j], v[1][j]); a.y = pk2(v[2][j], v[3][j]); a.z = pk2(v[4][j], v[5][j]); a.w = pk2(v[6][j], v[7][j]);
        b.x = pk2(v[8][j], v[9][j]); b.y = pk2(v[10][j], v[11][j]); b.z = pk2(v[12][j], v[13][j]); b.w = pk2(v[14][j], v[15][j]);
        dst[0] = a; dst[1] = b; }
}
__device__ __forceinline__ void p0_transpose_tile(const float* W, int npitch, int srccol, bf16* WT, int dstrow, int kb, int lane) {
    const int q = lane & 15, rg = lane >> 4, k0 = 64 * kb + 16 * rg;
    const GAS f32x4* src = (const GAS f32x4*)(W + (size_t)k0 * npitch + srccol + 4 * q);
    f32x4 v[16];
#pragma unroll
    for (int i = 0; i < 16; ++i) v[i] = __builtin_nontemporal_load(src + (size_t)i * (npitch / 4));
#pragma unroll
    for (int j = 0; j < 4; ++j) { GAS v4u* dst = (GAS v4u*)(WT + (size_t)(dstrow + 4 * q + j) * 1024 + k0);
        v4u a, b;
        a.x = pk2(v[0][j], v[1][j]); a.y = pk2(v[2][j], v[3][j]); a.z = pk2(v[4][j], v[5][j]); a.w = pk2(v[6][j], v[7][j]);
        b.x = pk2(v[8][j], v[9][j]); b.y = pk2(v[10][j], v[11][j]); b.z = pk2(v[12][j], v[13][j]); b.w = pk2(v[14][j], v[15][j]);
        __builtin_nontemporal_store(a, dst); __builtin_nontemporal_store(b, dst + 1); }
}
__device__ __forceinline__ void* ldptr(const LAS unsigned long long* PT, int i) { const unsigned long long v = PT[i];
    const unsigned lo = __builtin_amdgcn_readfirstlane((unsigned)v), hi = __builtin_amdgcn_readfirstlane((unsigned)(v >> 32)); return (void*)(GAS unsigned char*)(uintptr_t)(((unsigned long long)hi << 32) | lo); }
constexpr int CV_PRJ = 3 * 256, CV_GU = 32 * 512, CV_DN = 32 * 256, CV_ITEMS = CV_PRJ + CV_GU + CV_DN;
constexpr int CV_P1 = 192 * 8 * 3;
__device__ __forceinline__ void conv_tile(int it, const LAS unsigned long long* PT, int ln) {
    unsigned char* const wsb = (unsigned char*)ldptr(PT, 22);
    if (it < CV_PRJ) { const int mm = it >> 8, r = it & 255, db = r >> 4, kb = r & 15;
        const float* W = (const float*)ldptr(PT, 8 + mm); bf16* WT = mm < 2 ? (bf16*)(wsb + WS_WPROJ) + (size_t)mm * 1024 * 1024 : (bf16*)(wsb + WS_WOUT);
        p0_transpose_tile(W, 1024, 64 * db, WT, 64 * db, kb, ln); return; }
    it -= CV_PRJ;
    if (it < CV_GU) { const int e = it >> 9, r = it & 511, db = r >> 4, kb = r & 15, pn = db >> 2, jb = db & 3;
        const int src = jb < 2 ? 128 * pn + 64 * jb : 1024 + 128 * pn + 64 * (jb - 2);
        p0_transpose_tile((const float*)ldptr(PT, 15) + (size_t)e * 1024 * 2048, 2048, src, (bf16*)(wsb + WS_WGU) + (size_t)e * 2048 * 1024, 64 * db, kb, ln); return; }
    it -= CV_GU;
    { const int e = it >> 8, r = it & 255, db = r >> 4, kb = r & 15;
        p0_transpose_tile((const float*)ldptr(PT, 17) + (size_t)e * 1024 * 1024, 1024, 64 * db, (bf16*)(wsb + WS_WDN) + (size_t)e * 1024 * 1024, 64 * db, kb, ln); }
}
__device__ __forceinline__ void ln_row(const f32x4 (&xin)[4], f32x4 (&y)[4], const float* g, const float* b, int lane) {
    float s = 0.f;
#pragma unroll
    for (int j = 0; j < 4; ++j) s += (xin[j].x + xin[j].y) + (xin[j].z + xin[j].w);
    const float mean = wave_sum(s) * (1.f / DM); float s2 = 0.f;
#pragma unroll
    for (int j = 0; j < 4; ++j) { y[j] = xin[j] - mean; s2 += (y[j].x * y[j].x + y[j].y * y[j].y) + (y[j].z * y[j].z + y[j].w * y[j].w); }
    const float rstd = 1.f / sqrtf(wave_sum(s2) * (1.f / DM) + LN_EPS);
#pragma unroll
    for (int j = 0; j < 4; ++j) { const f32x4 gv = *(const f32x4*)(g + 4 * lane + 256 * j), bv = *(const f32x4*)(b + 4 * lane + 256 * j); y[j] = y[j] * rstd * gv + bv; }
}
__device__ __forceinline__ void store_row_bf16(bf16* orow, const f32x4 (&y)[4], int lane) {
    GAS unsigned long long* o8 = (GAS unsigned long long*)orow + lane;
#pragma unroll
    for (int j = 0; j < 4; ++j) o8[64 * j] = (unsigned long long)pk2(y[j].x, y[j].y) | ((unsigned long long)pk2(y[j].z, y[j].w) << 32);
}

struct Args { const float* in[21]; float* out; unsigned char* ws; int ph_lo, ph_hi, li, pad; };
constexpr int NPH = 11;

__global__ void __launch_bounds__(NTHR, 2) mega_fwd(Args args) {
    extern __shared__ __attribute__((aligned(16))) unsigned char lds[];
    LAS unsigned char* const ldsl = (LAS unsigned char*)lds;
    volatile LAS unsigned* const MISC = (volatile LAS unsigned*)(ldsl + MISC_OFF);
    const int tid = threadIdx.x, lane = tid & 63, wave = __builtin_amdgcn_readfirstlane(tid >> 6);
    const int G = gridDim.x; const int bx = blockIdx.x; const int vcu = (G % 8 == 0) ? (bx % 8) * (G / 8) + bx / 8 : bx;
    for (int u = tid; u < (LDS_BYTES - LDSCTL_OFF) / 4; u += NTHR) ((LAS unsigned*)(ldsl + LDSCTL_OFF))[u] = 0u;
    __syncthreads();
    LAS unsigned long long* const PT = (LAS unsigned long long*)(ldsl + LDSCTL_OFF);
    if (tid == 0) {
#pragma unroll
        for (int i = 0; i < 21; ++i) PT[i] = (unsigned long long)(uintptr_t)args.in[i];
        PT[21] = (unsigned long long)(uintptr_t)args.out; PT[22] = (unsigned long long)(uintptr_t)args.ws; }
    __syncthreads();
#define INP(i) ((const float*)ldptr(PT, (i)))
#define WSB ((unsigned char*)ldptr(PT, 22))
    const int lo = args.ph_lo, hi = args.ph_hi;
    unsigned long long att_time = 0ull, gla_time = 0ull; unsigned att_tiles = 0u;
    unsigned long long t_stamp_a = 0ull; const unsigned long long t_stamp_0 = (STAMP_K >= 0) ? __builtin_amdgcn_s_memrealtime() : 0ull;
    const bool use_bar = (hi - lo) > 1;
    if (use_bar) (void)xcd_barrier_post((unsigned*)(WSB + WS_CTL) + CW_BAR, MISC + 8);
#ifndef PH_MASK
#define PH_MASK 0x7FF
#endif
#define IN(k) ((((PH_MASK) >> (k)) & 1) && lo <= (k) && (k) < hi)
#ifndef DUP_MASK
#define DUP_MASK 0
#endif
#define DUP(k) for (int rep_ = 0; rep_ < 1 + (((DUP_MASK) >> (k)) & 1); ++rep_)
#define SEAM(k) do { if (STAMP_K == (k) && bx == 0 && tid == 0) { t_stamp_a = __builtin_amdgcn_s_memrealtime(); } if (IN(k) && IN((k) + 1)) { XcdBarrier b_; b_.bar = (unsigned*)(WSB + WS_CTL) + CW_BAR; b_.x = xb_xcc_id(); b_.st = MISC + 8; xcd_barrier(b_); if ((DUP_MASK >> 16) & 1) { xcd_barrier(b_); xcd_barrier(b_); } } if (STAMP_K == (k) + 100 && bx == 0 && tid == 0) { t_stamp_a = __builtin_amdgcn_s_memrealtime(); } } while (0)

    if (IN(0)) DUP(0) {
        bf16* const WIN_T = (bf16*)(WSB + WS_WIN); bf16* const WPROJ_T = (bf16*)(WSB + WS_WPROJ); bf16* const WOUT_T = (bf16*)(WSB + WS_WOUT); bf16* const WGU_T = (bf16*)(WSB + WS_WGU); bf16* const WDN_T = (bf16*)(WSB + WS_WDN); bf16* const H0B = (bf16*)(WSB + WS_H0B);
        const float* const x = INP(0); const float* const ln_in_g = INP(1); const float* const ln_in_b = INP(2); const float* const w_in = INP(3); const float* const w_gla_proj = INP(8); const float* const w_fox_proj = INP(9); const float* const w_out = INP(10); const float* const w_gate_up = INP(15); const float* const w_down = INP(17);
        const int gw = vcu * NWAVES + wave, NGW = G * NWAVES;
        constexpr int I_IN = 128 * 16;
        for (int it = gw; it < I_IN; it += NGW) { const int db = it >> 4, kb = it & 15, dst = 64 * db, src = dst + (dst < 2048 ? 0 : (dst < 6144 ? 16 : 24));
            p0_transpose_tile(w_in, IN_COLS, src, WIN_T, dst, kb, lane); }
        for (int i = vcu * NTHR + tid; i < 256 * 1024; i += G * NTHR) { const int r = i >> 10, k = i & 1023;
            float v = 0.f; if (r < 16) v = w_in[(size_t)k * IN_COLS + 2048 + r]; else if (r < 24) v = w_in[(size_t)k * IN_COLS + 6160 + (r - 16)];
            WIN_T[(size_t)(NPROJ + r) * 1024 + k] = (bf16)f2bf(v); }
        for (int m0 = gw; m0 < T_TOK; m0 += 4 * NGW) {
            f32x4 v[4][4], y[4];
#pragma unroll
            for (int r = 0; r < 4; ++r) { const GAS f32x4* xr = (const GAS f32x4*)(x + (size_t)(m0 + r * NGW) * DM) + lane;
#pragma unroll
                for (int j = 0; j < 4; ++j) v[r][j] = xr[64 * j]; }
#pragma unroll
            for (int r = 0; r < 4; ++r) { ln_row(v[r], y, ln_in_g, ln_in_b, lane); store_row_bf16(H0B + (size_t)(m0 + r * NGW) * DM, y, lane); } }
    }
    SEAM(0);

    if (IN(1)) DUP(1) {
        bf16* const H0B = (bf16*)(WSB + WS_H0B); bf16* const WIN_T = (bf16*)(WSB + WS_WIN); bf16* const PROJ = (bf16*)(WSB + WS_PROJ); float* const SM = (float*)(WSB + WS_SM);
        pg8::Gemm g{H0B, WIN_T, T_TOK, NPROJ_PAD, DM}; pg8::StaticOrder S; S.init(T_TOK, NPROJ_PAD, G, bx);
        pg8::EpiProj E{PROJ, SM, (bf16*)(WSB + WS_FQKV), (bf16*)(WSB + WS_ZIMG)};
        pg8::gemm_phase<pg8::EpiProj, pg8::StaticOrder, true, true, false>(ldsl + RING_OFF, g, S, E);
        if (bx >= 64 && rep_ == 0) {
            const int cw = ((bx - 64) * NWAVES + wave) * 3;
#pragma unroll 1
            for (int t = 0; t < 3; ++t) conv_tile(cw + t, PT, lane);
        }
    }
    SEAM(1);

    if (IN(2)) DUP(2) {
        float* const SM = (float*)(WSB + WS_SM); float* const FB = (float*)(WSB + WS_FB); float* const DECAY = (float*)(WSB + WS_DECAY); bf16* const KDEC = (bf16*)(WSB + WS_KDEC); bf16* const VT = (bf16*)(WSB + WS_MIXED); bf16* const PROJ = (bf16*)(WSB + WS_PROJ);
        const float* const w_gup = INP(4); const float* const b_gla_gate = INP(5); const float* const b_forget = INP(7);
        LAS float* sc = (LAS float*)(ldsl + RING_OFF);
        for (int bh = vcu; bh < 32; bh += G) {
            const int b = bh >> 3, h = bh & 7; const float bf_ = b_forget[h];
            float v[8]; float run = 0.f;
#pragma unroll
            for (int j = 0; j < 8; ++j) { const int s = tid * 8 + j; run += logsig(SM[(size_t)(b * SEQ + s) * 32 + 16 + h] + bf_); v[j] = run; }
            float incl = run;
#pragma unroll
            for (int o = 1; o < 64; o <<= 1) { const float t = __shfl_up(incl, o); if (lane >= o) incl += t; }
            if (lane == 63) sc[wave] = incl;
            __syncthreads();
            float woff = 0.f;
            for (int w = 0; w < wave; ++w) woff += sc[w];
            const float off = woff + (incl - run);
#pragma unroll
            for (int j = 0; j < 8; ++j) FB[(size_t)bh * SEQ + tid * 8 + j] = -(off + v[j]) * FOX_INV_SCALE;
            __syncthreads();
        }
        {
            LAS float* const GL = (LAS float*)(ldsl + RING_OFF + 4096);
            LAS unsigned short* const KL = (LAS unsigned short*)(ldsl + RING_OFF + 8192);
            LAS unsigned short* const VL = (LAS unsigned short*)(ldsl + RING_OFF + 8192 + 16384);
            const int j = tid & 127, cq = tid >> 7; const int h = vcu & 3; const int col = h * 128 + j;
            float wu[16];
#pragma unroll
            for (int r = 0; r < 16; ++r) wu[r] = w_gup[r * 512 + col];
            const float bg = b_gla_gate[col];
            v4u kq[2], vq[4]; f32x4 gq = {0.f, 0.f, 0.f, 0.f};
#define PREP_LOAD(it_) do { const int n_ = ((it_) >> 2) & 63, b_ = (it_) >> 8; const size_t t0_ = (size_t)b_ * SEQ + n_ * 64; \
                _Pragma("unroll") for (int i = 0; i < 2; ++i) { const int p = tid + NTHR * i; kq[i] = *(const GAS v4u*)(PROJ + (t0_ + (p >> 4)) * PPITCH + C_GK + h * 128 + (p & 15) * 8); } \
                _Pragma("unroll") for (int i = 0; i < 4; ++i) { const int p = tid + NTHR * i; vq[i] = *(const GAS v4u*)(PROJ + (t0_ + (p >> 5)) * PPITCH + C_GV + h * 256 + (p & 31) * 8); } \
                if (tid < 256) gq = *(const GAS f32x4*)(SM + (t0_ + (tid >> 2)) * 32 + 4 * (tid & 3)); } while (0)
            PREP_LOAD(vcu);
            for (int it = vcu; it < NBATCH * NCHUNK * 4; it += G) {
                const int n = (it >> 2) & 63, b = it >> 8;
#pragma unroll
                for (int i = 0; i < 2; ++i) { const int p = tid + NTHR * i; *(LAS v4u*)(KL + (p >> 4) * 128 + (p & 15) * 8) = kq[i]; }
#pragma unroll
                for (int i = 0; i < 4; ++i) { const int p = tid + NTHR * i; *(LAS v4u*)(VL + (p >> 5) * 256 + (p & 31) * 8) = vq[i]; }
                if (tid < 256) *(LAS f32x4*)(GL + (tid >> 2) * 16 + 4 * (tid & 3)) = gq;
                __syncthreads();
                if (it + G < NBATCH * NCHUNK * 4) PREP_LOAD(it + G);
                float cum[16]; float run = 0.f;
#pragma unroll
                for (int c = 0; c < 16; ++c) { const LAS float* gl = GL + (cq * 16 + c) * 16; float z = bg;
#pragma unroll
                    for (int r4 = 0; r4 < 4; ++r4) { const f32x4 g4 = *(const LAS f32x4*)(gl + 4 * r4); z += g4.x * wu[4 * r4] + g4.y * wu[4 * r4 + 1] + g4.z * wu[4 * r4 + 2] + g4.w * wu[4 * r4 + 3]; }
                    run += logsig(z) * (1.0f / 16.0f); cum[c] = run; }
                sc[cq * 128 + j] = run;
                __syncthreads();
                float off = 0.f, total = 0.f;
#pragma unroll
                for (int q = 0; q < 4; ++q) { const float t = sc[q * 128 + j]; total += t; if (q < cq) off += t; }
                {   unsigned pk[8];
#pragma unroll
                    for (int c = 0; c < 16; c += 2) { const int cc = cq * 16 + c;
                        pk[c >> 1] = pk2(bfu(KL[cc * 128 + j]) * __expf(total - (off + cum[c])), bfu(KL[(cc + 1) * 128 + j]) * __expf(total - (off + cum[c + 1]))); }
                    GAS v4u* dst = (GAS v4u*)(KDEC + (size_t)it * 8192 + j * 64 + cq * 16);
                    v4u w0, w1; w0.x = pk[0]; w0.y = pk[1]; w0.z = pk[2]; w0.w = pk[3]; w1.x = pk[4]; w1.y = pk[5]; w1.z = pk[6]; w1.w = pk[7]; dst[0] = w0; dst[1] = w1; }
                if (cq == 0) DECAY[(size_t)(b * NCHUNK + n) * 512 + col] = expf(total);
                {   const int dv = tid & 255, ch = tid >> 8; unsigned pk[16];
#pragma unroll
                    for (int c = 0; c < 32; c += 2) pk[c >> 1] = (unsigned)VL[(ch * 32 + c) * 256 + dv] | ((unsigned)VL[(ch * 32 + c + 1) * 256 + dv] << 16);
                    GAS v4u* dst = (GAS v4u*)(VT + (size_t)it * 16384 + dv * 64 + ch * 32);
#pragma unroll
                    for (int q = 0; q < 4; ++q) { v4u w; w.x = pk[4 * q]; w.y = pk[4 * q + 1]; w.z = pk[4 * q + 2]; w.w = pk[4 * q + 3]; dst[q] = w; } }
                __syncthreads();
            }
#undef PREP_LOAD
        }
    }
    SEAM(2);

    const unsigned long long tp2_0 = (STAMP_K == 202) ? __builtin_amdgcn_s_memrealtime() : 0ull;
    if (IN(3)) {
        float* const FB = (float*)(WSB + WS_FB); float* const DECAY = (float*)(WSB + WS_DECAY); bf16* const KDEC = (bf16*)(WSB + WS_KDEC); bf16* const VT = (bf16*)(WSB + WS_MIXED); bf16* const PROJ = (bf16*)(WSB + WS_PROJ); bf16* const AO = (bf16*)(WSB + WS_AO);
        const float* const g_gla_norm = INP(6);
        LAS int* const QW = (LAS int*)(ldsl + TBL_CUM);
        DUP(13) {
        gu32* const ctlq = (gu32*)(WSB + WS_CTL) + CW_Q + rep_ * 1024;
        int qoff = 0;
#define P2_FETCH(dst) do { if (tid == 0) { int code_ = -1, t_ = qoff; for (; t_ < 8; ++t_) { const int k_ = (bx + t_) & 7; const unsigned i_ = __hip_atomic_fetch_add(ctlq + 64 * k_, 1u, __ATOMIC_RELAXED, __HIP_MEMORY_SCOPE_AGENT); \
                if (i_ < 66u) { code_ = k_ * 66 + (int)i_; break; } } QW[0] = code_; QW[1] = t_; } \
            __syncthreads(); dst = __builtin_amdgcn_readfirstlane(QW[0]); qoff = __builtin_amdgcn_readfirstlane(QW[1]); __syncthreads(); } while (0)
        int code; P2_FETCH(code);
        bool primed = false, first_att = true; int bbuf = 0;
        const unsigned short* const Pq = (const unsigned short*)(WSB + WS_FQKV); unsigned short* const Oo = (unsigned short*)(AO + (size_t)T_TOK * 1024);
#define P2_BIAS(code_, buf_) do { const int k_ = (code_) / 66, a_ = (code_) % 66 - 2; const int bh_ = 4 * k_ + (a_ & 3); LAS f32x4* bl_ = (LAS f32x4*)(ldsl + fa128::LDS_BIAS + (buf_) * 16384); \
            const GAS f32x4* src_ = (const GAS f32x4*)(FB + (size_t)bh_ * SEQ); bl_[tidl] = src_[tidl]; bl_[tidl + NTHR] = src_[tidl + NTHR]; } while (0)
        while (code >= 0) {
          int tidl = tid; asm volatile("" : "+v"(tidl));
          if (code % 66 < 2) {
            primed = false;
            typedef float f32x16 __attribute__((ext_vector_type(16)));
            const int gitem = 2 * (code / 66) + code % 66;
            const unsigned long long tg0_ = (STAMP_K == 201) ? __builtin_amdgcn_s_memrealtime() : 0ull;
            const int tid = tidl, lane = tid & 63, wave = __builtin_amdgcn_readfirstlane(tid >> 6);
            const int b = gitem >> 2, h = gitem & 3; const int r32 = lane & 31, hi = lane >> 5;
#define GLA_KT(bf_) (ldsl + RING_OFF + (bf_) * 18432)
#define GLA_QT(bf_) (ldsl + RING_OFF + 36864 + (bf_) * 16896)
#define GLA_DC(bf_) ((LAS float*)(ldsl + RING_OFF + 70656 + (bf_) * 512))
#define GLA_OS (ldsl + RING_OFF + 71680)
#define GLA_SS ((LAS float*)(ldsl + RING_OFF + 71680 + 33792))
            bf16* const ORAW = (bf16*)(WSB + WS_H1B); float* const SSQ = (float*)(WSB + WS_TOKOF);
            f32x16 Sacc[4];
#pragma unroll
            for (int m = 0; m < 4; ++m)
#pragma unroll
                for (int r = 0; r < 16; ++r) Sacc[m][r] = 0.f;
            const int p0 = tid, p1 = tid + 512;
            const unsigned kdst0 = (p0 >> 3) * 144 + (p0 & 7) * 16, kdst1 = (p1 >> 3) * 144 + (p1 & 7) * 16, qdst0 = (p0 >> 4) * 264 + (p0 & 15) * 16, qdst1 = (p1 >> 4) * 264 + (p1 & 15) * 16;
            v4u kst0, kst1, qst0, qst1; float dcs = 0.f; bf16x8 vf[4];
#define GLA_LOAD_STAGE(n_) do { const size_t item_ = (size_t)((b * NCHUNK + (n_)) * 4 + h); const size_t tok0_ = (size_t)b * SEQ + (size_t)(n_) * 64; \
                kst0 = *(const GAS v4u*)(KDEC + item_ * 8192 + (p0 >> 3) * 64 + (p0 & 7) * 8); kst1 = *(const GAS v4u*)(KDEC + item_ * 8192 + (p1 >> 3) * 64 + (p1 & 7) * 8); \
                qst0 = *(const GAS v4u*)(PROJ + (tok0_ + (p0 >> 4)) * PPITCH + C_GQ + h * 128 + (p0 & 15) * 8); qst1 = *(const GAS v4u*)(PROJ + (tok0_ + (p1 >> 4)) * PPITCH + C_GQ + h * 128 + (p1 & 15) * 8); \
                if (tid < 128) dcs = DECAY[(size_t)(b * NCHUNK + (n_)) * 512 + h * 128 + tid]; } while (0)
#define GLA_LOAD_V(n_) do { const bf16* vb_ = VT + (size_t)((b * NCHUNK + (n_)) * 4 + h) * 16384 + (size_t)(32 * wave + r32) * 64 + 8 * hi; \
                _Pragma("unroll") for (int ks = 0; ks < 4; ++ks) vf[ks] = *(const GAS bf16x8*)(vb_ + 16 * ks); } while (0)
            GLA_LOAD_STAGE(0); GLA_LOAD_V(0);
            for (int n = 0; n < NCHUNK; ++n) {
                const size_t tok0 = (size_t)b * SEQ + (size_t)n * 64; const int bf = n & 1;
                LAS unsigned char* const KT = GLA_KT(bf); LAS unsigned char* const QT = GLA_QT(bf); LAS float* const DC = GLA_DC(bf);
                *(LAS v4u*)(KT + kdst0) = kst0; *(LAS v4u*)(KT + kdst1) = kst1; *(LAS v4u*)(QT + qdst0) = qst0; *(LAS v4u*)(QT + qdst1) = qst1;
                if (tid < 128) DC[tid] = dcs;
                __syncthreads();
                if (n + 1 < NCHUNK) GLA_LOAD_STAGE(n + 1);
#pragma unroll
                for (int m = 0; m < 4; ++m)
#pragma unroll
                    for (int g4 = 0; g4 < 4; ++g4) { const f32x4 d4 = *(const LAS f32x4*)(DC + 32 * m + 8 * g4 + 4 * hi);
                        Sacc[m][4 * g4 + 0] *= d4.x; Sacc[m][4 * g4 + 1] *= d4.y; Sacc[m][4 * g4 + 2] *= d4.z; Sacc[m][4 * g4 + 3] *= d4.w; }
#pragma unroll
                for (int m = 0; m < 4; ++m)
#pragma unroll
                    for (int ks = 0; ks < 4; ++ks) { const bf16x8 kf = *(const LAS bf16x8*)(KT + (32 * m + r32) * 144 + (16 * ks + 8 * hi) * 2);
                        Sacc[m] = __builtin_amdgcn_mfma_f32_32x32x16_bf16(kf, vf[ks], Sacc[m], 0, 0, 0); }
                if (n + 1 < NCHUNK) GLA_LOAD_V(n + 1);
                f32x16 ot[2];
#pragma unroll
                for (int nt = 0; nt < 2; ++nt)
#pragma unroll
                    for (int r = 0; r < 16; ++r) ot[nt][r] = 0.f;
#pragma unroll
                for (int m = 0; m < 4; ++m)
#pragma unroll
                    for (int sx = 0; sx < 2; ++sx) {
                        v4u ap; ap.x = pg8::cvt_pk_bf16(Sacc[m][8 * sx + 0], Sacc[m][8 * sx + 1]); ap.y = pg8::cvt_pk_bf16(Sacc[m][8 * sx + 2], Sacc[m][8 * sx + 3]);
                        ap.z = pg8::cvt_pk_bf16(Sacc[m][8 * sx + 4], Sacc[m][8 * sx + 5]); ap.w = pg8::cvt_pk_bf16(Sacc[m][8 * sx + 6], Sacc[m][8 * sx + 7]);
                        const bf16x8 af = __builtin_bit_cast(bf16x8, ap);
#pragma unroll
                        for (int nt = 0; nt < 2; ++nt) { const LAS unsigned char* qp = QT + (32 * nt + r32) * 264 + (32 * m + 16 * sx + 4 * hi) * 2;
                            const unsigned long long qlo = *(const LAS unsigned long long*)qp, qhi = *(const LAS unsigned long long*)(qp + 16);
                            v4u bp; bp.x = (unsigned)qlo; bp.y = (unsigned)(qlo >> 32); bp.z = (unsigned)qhi; bp.w = (unsigned)(qhi >> 32);
                            ot[nt] = __builtin_amdgcn_mfma_f32_32x32x16_bf16(af, __builtin_bit_cast(bf16x8, bp), ot[nt], 0, 0, 0); } }
#pragma unroll
                for (int nt = 0; nt < 2; ++nt) { float a = 0.f; const int c = 32 * nt + r32;
#pragma unroll
                    for (int r = 0; r < 16; ++r) a += ot[nt][r] * ot[nt][r];
                    a += __shfl_xor(a, 32);
                    if (hi == 0) GLA_SS[c * 8 + wave] = a;
#pragma unroll
                    for (int g4 = 0; g4 < 4; ++g4)
                        *(LAS unsigned long long*)(GLA_OS + c * 528 + (32 * wave + 8 * g4 + 4 * hi) * 2) = (unsigned long long)pg8::cvt_pk_bf16(ot[nt][4 * g4 + 0], ot[nt][4 * g4 + 1]) | ((unsigned long long)pg8::cvt_pk_bf16(ot[nt][4 * g4 + 2], ot[nt][4 * g4 + 3]) << 32); }
                __syncthreads();
#pragma unroll
                for (int i = 0; i < 4; ++i) { const int c = (tid >> 5) + 16 * i, ch = tid & 31;
                    *(GAS v4u*)(ORAW + (tok0 + c) * 1024 + h * 256 + ch * 8) = *(const LAS v4u*)(GLA_OS + c * 528 + ch * 16); }
                if (tid < 64) { float t = 0.f;
#pragma unroll
                    for (int w = 0; w < 8; ++w) t += GLA_SS[tid * 8 + w];
                    SSQ[(tok0 + tid) * 4 + h] = t; }
            }
#undef GLA_KT
#undef GLA_QT
#undef GLA_DC
#undef GLA_OS
#undef GLA_SS
#undef GLA_LOAD_STAGE
#undef GLA_LOAD_V
            __syncthreads();
            if (STAMP_K == 201) gla_time += __builtin_amdgcn_s_memrealtime() - tg0_;
            P2_FETCH(code);
          } else {
            const int k_ = code / 66, a_ = code % 66 - 2; const int qb_ = 15 - (a_ >> 2), bh_ = 4 * k_ + (a_ & 3);
            const int pq3 = first_att ? ((bx >> 3) & 3) : 0; first_att = false;
            if (rep_ == 0 && pq3 > 0) { const int cvnum = pq3;
                const int ntc = 4 * (16 - ((code % 66 - 2) >> 2)); const int ncv = ((ntc * (CV_ITEMS - CV_P1) + 17407) / 17408 * cvnum + 2) / 3;
                if (tid == 0) QW[2] = (int)__hip_atomic_fetch_add(ctlq + 64 * 8, (unsigned)ncv, __ATOMIC_RELAXED, __HIP_MEMORY_SCOPE_AGENT);
                __syncthreads();
                const int cv0 = __builtin_amdgcn_readfirstlane(QW[2]); int cv1 = cv0 + ncv; if (cv1 > CV_ITEMS - CV_P1) cv1 = CV_ITEMS - CV_P1;
                const int wv = __builtin_amdgcn_readfirstlane(tidl >> 6), ln = tidl & 63;
                for (int it0 = cv0 + wv; it0 < cv1; it0 += NWAVES) conv_tile(CV_P1 + it0, PT, ln);
                __syncthreads();
            }
            if (!primed) { P2_BIAS(code, bbuf); }
            int ncode; P2_FETCH(ncode);
            const bool nx_att = ncode >= 0 && (ncode % 66) >= 2;
            if (nx_att) { P2_BIAS(ncode, bbuf ^ 1); }
            const unsigned long long tu0_ = (STAMP_K == 200 || STAMP_K == 203) ? __builtin_amdgcn_s_memrealtime() : 0ull;
            fa128::attn_unit<8>(Pq + ((size_t)bh_ * SEQ + qb_ * 256) * 128, Pq + ((size_t)32 + bh_) * (SEQ * 128), Pq + ((size_t)64 + bh_) * (SEQ * 128), Oo + (size_t)((bh_ >> 3) * SEQ + qb_ * 256) * 1024 + (bh_ & 7) * 128, qb_,
                                ldsl + RING_OFF, (const LAS float*)(ldsl + fa128::LDS_BIAS + bbuf * 16384), (LAS float*)(ldsl + TBL_IDX) + __builtin_amdgcn_readfirstlane(tidl >> 6) * 64, tidl);
            if (STAMP_K == 200 || STAMP_K == 203) { att_time += __builtin_amdgcn_s_memrealtime() - tu0_; att_tiles += 4 * (qb_ + 1); }
            if (rep_ == 0 && pq3 < 3) { const int cvnum = 3 - pq3;
                const int ntc = 4 * (16 - ((code % 66 - 2) >> 2)); const int ncv = ((ntc * (CV_ITEMS - CV_P1) + 17407) / 17408 * cvnum + 2) / 3;
                if (tid == 0) QW[2] = (int)__hip_atomic_fetch_add(ctlq + 64 * 8, (unsigned)ncv, __ATOMIC_RELAXED, __HIP_MEMORY_SCOPE_AGENT);
                __syncthreads();
                const int cv0 = __builtin_amdgcn_readfirstlane(QW[2]); int cv1 = cv0 + ncv; if (cv1 > CV_ITEMS - CV_P1) cv1 = CV_ITEMS - CV_P1;
                const int wv = __builtin_amdgcn_readfirstlane(tidl >> 6), ln = tidl & 63;
                for (int it0 = cv0 + wv; it0 < cv1; it0 += NWAVES) conv_tile(CV_P1 + it0, PT, ln);
                __syncthreads();
            }
            primed = nx_att; bbuf ^= 1; code = ncode;
          }
        }
#undef P2_FETCH
#undef P2_BIAS
        }
    }
    if (STAMP_K == 202 && tid == 0 && IN(3)) __hip_atomic_fetch_add((gu32*)(WSB + WS_CTL) + 20000, (unsigned)(__builtin_amdgcn_s_memrealtime() - tp2_0), __ATOMIC_RELAXED, __HIP_MEMORY_SCOPE_AGENT);
    SEAM(3);

    if (IN(4)) DUP(4) {
        bf16* const AO = (bf16*)(WSB + WS_AO); bf16* const PROJ = (bf16*)(WSB + WS_PROJ); const bf16* const ORAW = (const bf16*)(WSB + WS_H1B); const float* const SSQ = (const float*)(WSB + WS_TOKOF);
        const float* const g_gla_norm = INP(6);
        const int gw = vcu * NWAVES + wave, NGW = G * NWAVES;
        const f32x4 gn = *(const f32x4*)(g_gla_norm + 4 * lane);
        for (int m0 = gw; m0 < T_TOK; m0 += 4 * NGW) {
            f32x4 hs4[4]; unsigned long long ow[4][4], rw[4][4];
#pragma unroll
            for (int r = 0; r < 4; ++r) { const size_t mm = (size_t)(m0 + r * NGW); hs4[r] = *(const f32x4*)(SSQ + mm * 4);
                const GAS unsigned long long* orow = (const GAS unsigned long long*)(ORAW + mm * 1024) + lane; const GAS unsigned long long* rrow = (const GAS unsigned long long*)(PROJ + mm * PPITCH + C_GR) + lane;
#pragma unroll
                for (int j = 0; j < 4; ++j) { ow[r][j] = orow[64 * j]; rw[r][j] = rrow[64 * j]; } }
#pragma unroll
            for (int r = 0; r < 4; ++r) { GAS unsigned long long* drow = (GAS unsigned long long*)(AO + (size_t)(m0 + r * NGW) * 1024) + lane;
#pragma unroll
                for (int j = 0; j < 4; ++j) { const float tot = hs4[r][j] * (GLA_QSCALE * GLA_QSCALE); const float rs = GLA_QSCALE / sqrtf(tot * (1.0f / 256.0f) + LN_EPS);
                    const unsigned ol = (unsigned)ow[r][j], oh = (unsigned)(ow[r][j] >> 32), rl = (unsigned)rw[r][j], rh = (unsigned)(rw[r][j] >> 32);
                    const float r0 = pg8::bf_lo(rl), r1 = pg8::bf_hi(rl), r2 = pg8::bf_lo(rh), r3 = pg8::bf_hi(rh);
                    const float o0 = pg8::bf_lo(ol) * rs * gn.x * (r0 * pg8::sigm(r0)), o1 = pg8::bf_hi(ol) * rs * gn.y * (r1 * pg8::sigm(r1)), o2 = pg8::bf_lo(oh) * rs * gn.z * (r2 * pg8::sigm(r2)), o3 = pg8::bf_hi(oh) * rs * gn.w * (r3 * pg8::sigm(r3));
                    drow[64 * j] = (unsigned long long)pg8::cvt_pk_bf16(o0, o1) | ((unsigned long long)pg8::cvt_pk_bf16(o2, o3) << 32); } } }
    }
    SEAM(4);

    if (IN(5)) DUP(5) {
        bf16* const AO = (bf16*)(WSB + WS_AO); bf16* const WPROJ_T = (bf16*)(WSB + WS_WPROJ); bf16* const PROJ = (bf16*)(WSB + WS_PROJ); bf16* const MIXED = (bf16*)(WSB + WS_MIXED);
        pg8::Gemm g{AO, WPROJ_T, 2 * T_TOK, 2048, DM}; pg8::MixOrder S; S.init(T_TOK, DM, G, bx);
        pg8::EpiMix E{(const bf16*)(WSB + WS_ZIMG), MIXED};
        pg8::gemm_phase<pg8::EpiMix, pg8::MixOrder, true, true, false>(ldsl + RING_OFF, g, S, E);
    }
    SEAM(5);

    if (IN(6)) DUP(6) {
        bf16* const MIXED = (bf16*)(WSB + WS_MIXED); bf16* const WOUT_T = (bf16*)(WSB + WS_WOUT); float* const H1F = (float*)(WSB + WS_H1F);
        pg8::Gemm g{MIXED, WOUT_T, T_TOK, DM, DM}; pg8::StaticOrder S; S.init(T_TOK, DM, G, bx);
        pg8::EpiBf16<0> E{(bf16*)(WSB + WS_YS), DM, nullptr, 0, 0, 1.f};
        pg8::gemm_phase<pg8::EpiBf16<0>, pg8::StaticOrder, true, true, false>(ldsl + RING_OFF, g, S, E);
    }
    SEAM(6);

    if (IN(7)) {
        gu32* const ctl = (gu32*)(WSB + WS_CTL);
        bf16* const H1B = (bf16*)(WSB + WS_H1B); int* const TOKOF = (int*)(WSB + WS_TOKOF); int* const PAIR_E = (int*)(WSB + WS_PAIR); int* const PAIR_POS = PAIR_E + T_TOK * 4; float* const PAIR_G = (float*)(PAIR_POS + T_TOK * 4);
        const float* const x = INP(0); const float* const ln_in_g = INP(1); const float* const ln_in_b = INP(2); const float* const ln_mix_g = INP(11); const float* const ln_mix_b = INP(12);
        const float* const w_router = INP(13); const float* const b_router = INP(14); const bf16* const PRE = (const bf16*)(WSB + WS_YS);
        LAS float* const WRT = (LAS float*)(ldsl + RING_OFF);
        LAS float* const LOGT = (LAS float*)(ldsl + TBL_IDX) + wave * 64;
        LAS int* const HIST = (LAS int*)(ldsl + TBL_CNT); LAS int* const BASE = (LAS int*)(ldsl + TBL_CUM);
#pragma unroll 4
        for (int i = 0; i < 16; ++i) { const int p = tid + NTHR * i, e4 = p & 7, k = p >> 3; const f32x4 w = *(const GAS f32x4*)(w_router + 4 * p);
            WRT[(4 * e4 + 0) * 1024 + k] = w.x; WRT[(4 * e4 + 1) * 1024 + k] = w.y; WRT[(4 * e4 + 2) * 1024 + k] = w.z; WRT[(4 * e4 + 3) * 1024 + k] = w.w; }
        if (tid < 32) HIST[tid] = 0;
        __syncthreads();
        const int gw = vcu * NWAVES + wave, NGW = G * NWAVES;
        int te[4][4], tr[4][4]; float tgt[4][4];
        f32x4 vx[2][4]; unsigned long long vp[2][4];
#define ROW_LOAD(g_) do { _Pragma("unroll") for (int r = 0; r < 2; ++r) { const size_t mm = (size_t)(gw + (2 * (g_) + r) * NGW); const GAS f32x4* xr = (const GAS f32x4*)(x + mm * DM) + lane; const GAS unsigned long long* pr = (const GAS unsigned long long*)(PRE + mm * DM) + lane; \
            _Pragma("unroll") for (int j = 0; j < 4; ++j) { vx[r][j] = xr[64 * j]; vp[r][j] = pr[64 * j]; } } } while (0)
        ROW_LOAD(0);
#pragma unroll 1
        for (int g = 0; g < 4; ++g) {
            f32x4 z[2][4];
            {   f32x4 y[4];
#pragma unroll
                for (int r = 0; r < 2; ++r) { const size_t mm = (size_t)(gw + (2 * g + r) * NGW);
                    ln_row(vx[r], y, ln_in_g, ln_in_b, lane);
#pragma unroll
                    for (int j = 0; j < 4; ++j) { const unsigned wl = (unsigned)vp[r][j], wh = (unsigned)(vp[r][j] >> 32); y[j] = y[j] * DN_ALPHA + (f32x4){pg8::bf_lo(wl), pg8::bf_hi(wl), pg8::bf_lo(wh), pg8::bf_hi(wh)}; }
                    ln_row(y, z[r], ln_mix_g, ln_mix_b, lane);
                    store_row_bf16(H1B + mm * DM, z[r], lane); } }
            if (g < 3) ROW_LOAD(g + 1);
            float vals[64];
            typedef float f32x2r __attribute__((ext_vector_type(2)));
            f32x2r zz[4][4];
#pragma unroll
            for (int j = 0; j < 4; ++j) { zz[j][0] = (f32x2r){z[0][j].x, z[1][j].x}; zz[j][1] = (f32x2r){z[0][j].y, z[1][j].y}; zz[j][2] = (f32x2r){z[0][j].z, z[1][j].z}; zz[j][3] = (f32x2r){z[0][j].w, z[1][j].w}; }
#pragma unroll
            for (int e = 0; e < 32; ++e) { f32x2r a = {0.f, 0.f};
#pragma unroll
                for (int j = 0; j < 4; ++j) { const f32x4 w = *(const LAS f32x4*)(WRT + e * 1024 + 4 * lane + 256 * j);
                    a = __builtin_elementwise_fma(zz[j][0], (f32x2r){w.x, w.x}, a); a = __builtin_elementwise_fma(zz[j][1], (f32x2r){w.y, w.y}, a);
                    a = __builtin_elementwise_fma(zz[j][2], (f32x2r){w.z, w.z}, a); a = __builtin_elementwise_fma(zz[j][3], (f32x2r){w.w, w.w}, a); }
                vals[e] = a.x; vals[32 + e] = a.y; }
#define ROW_RED(S_, H_) _Pragma("unroll") for (int i = 0; i < (H_); ++i) { const bool up = (lane & (S_)) != 0; const float snd = up ? vals[i] : vals[i + (H_)], kp = up ? vals[i + (H_)] : vals[i]; vals[i] = kp + __shfl_xor(snd, (S_)); }
            ROW_RED(32, 32) ROW_RED(16, 16) ROW_RED(8, 8) ROW_RED(4, 4) ROW_RED(2, 2) ROW_RED(1, 1)
#undef ROW_RED
            float lv = vals[0] + b_router[lane & 31];
            int te_[4] = {0, 0, 0, 0}, tr_[4] = {0, 0, 0, 0}; float tg_[4] = {0.f, 0.f, 0.f, 0.f}, tv[4];
#pragma unroll
            for (int k = 0; k < 4; ++k) { float bv = lv; int bi = lane & 31;
#pragma unroll
                for (int s = 1; s < 32; s <<= 1) { const float ov = __shfl_xor(bv, s); const int oi = __shfl_xor(bi, s); const bool tk = (ov > bv) || (ov == bv && oi < bi); bv = tk ? ov : bv; bi = tk ? oi : bi; }
                tv[k] = bv; te_[k] = bi; if ((lane & 31) == bi) lv = -3.0e38f; }
            { float ssum = 0.f;
#pragma unroll
                for (int k = 0; k < 4; ++k) { tg_[k] = __expf(tv[k] - tv[0]); ssum += tg_[k]; }
                const float rs = 1.0f / ssum;
#pragma unroll
                for (int k = 0; k < 4; ++k) tg_[k] *= rs; }
            if ((lane & 31) == 0) {
#pragma unroll
                for (int k = 0; k < 4; ++k) tr_[k] = atomicAdd((int*)(HIST + te_[k]), 1); }
#pragma unroll
            for (int gg = 0; gg < 4; ++gg) if (gg == g) {
#pragma unroll
                for (int k = 0; k < 4; ++k) { te[gg][k] = te_[k]; tr[gg][k] = tr_[k]; tgt[gg][k] = tg_[k]; } }
        }
#undef ROW_LOAD
        __syncthreads();
        if (tid < 32) BASE[tid] = (int)__hip_atomic_fetch_add(ctl + CW_CNT + 64 * tid, (unsigned)HIST[tid], __ATOMIC_RELAXED, __HIP_MEMORY_SCOPE_AGENT);
        __syncthreads();
        if ((lane & 31) == 0) {
#pragma unroll
            for (int g = 0; g < 4; ++g) { const int t2 = gw + (2 * g + (lane >> 5)) * NGW;
#pragma unroll
                for (int k = 0; k < 4; ++k) { const int e = te[g][k], pos = BASE[e] + tr[g][k];
                    TOKOF[(size_t)e * T_TOK + pos] = t2; PAIR_E[t2 * 4 + k] = e; PAIR_POS[t2 * 4 + k] = pos; PAIR_G[t2 * 4 + k] = tgt[g][k]; } } }
    }
    SEAM(7);

#define GROUPED_PREP(NT_, GATHER_) do { \
        LAS int* CUM = (LAS int*)(ldsl + TBL_CUM); LAS int* CNT = (LAS int*)(ldsl + TBL_CNT); LAS int* DESC = (LAS int*)(ldsl + TBL_DESC); LAS int* IDX = (LAS int*)(ldsl + TBL_IDX); \
        if (tid == 0) { int c = 0; for (int e = 0; e < NE; ++e) { const int n = (int)__hip_atomic_load(ctl + CW_CNT + 64 * e, __ATOMIC_RELAXED, __HIP_MEMORY_SCOPE_AGENT); CNT[e] = n; CUM[e] = c; c += (n + 255) >> 8; } CUM[NE] = c; } \
        __syncthreads(); \
        if (tid < pg8::MAXU) { const int nwg = (NT_) * CUM[NE]; const long L = (long)tid * G + bx; int valid = 0, ab = 0, bb = 0, pn = 0, e = 0, pm = 0; \
            if (L < nwg) { int wgid = (int)L; { const int q = nwg / 8, r = nwg % 8, xcd = wgid % 8, off = wgid / 8; wgid = (xcd < r ? xcd * (q + 1) : r * (q + 1) + (xcd - r) * q) + off; } \
                while (e < NE - 1 && wgid >= (NT_) * CUM[e + 1]) ++e; \
                const int r2 = wgid - (NT_) * CUM[e], te_ = CUM[e + 1] - CUM[e]; pn = r2 / te_; pm = r2 % te_; ab = CUM[e] + pm; bb = e * (NT_) + pn; valid = 1; } \
            DESC[tid * 8 + 0] = valid; DESC[tid * 8 + 1] = ab; DESC[tid * 8 + 2] = bb; DESC[tid * 8 + 3] = pn; DESC[tid * 8 + 4] = e; DESC[tid * 8 + 5] = pm; } \
        __syncthreads(); \
        if (GATHER_) { for (int i = 0; i < pg8::MAXU; ++i) { if (DESC[i * 8] == 0) break; const int e = DESC[i * 8 + 4], pm = DESC[i * 8 + 5]; \
            if (tid < 256) { const int slot = pm * 256 + tid; IDX[i * 256 + tid] = slot < CNT[e] ? TOKOF[(size_t)e * T_TOK + slot] : 0; } } \
            __syncthreads(); } } while (0)
    if (IN(8)) DUP(8) {
        gu32* const ctl = (gu32*)(WSB + WS_CTL);
        int* const TOKOF = (int*)(WSB + WS_TOKOF); bf16* const H1B = (bf16*)(WSB + WS_H1B); bf16* const WGU_T = (bf16*)(WSB + WS_WGU); bf16* const ACT = (bf16*)(WSB + WS_ACT);
        const float* const b_gate_up = INP(16);
        GROUPED_PREP(8, true);
        pg8::Gemm g{H1B, WGU_T, T_TOK, 2048, DM}; pg8::GroupedOrder S{(const LAS int*)(ldsl + TBL_DESC), (const LAS int*)(ldsl + TBL_IDX)};
        pg8::EpiAct E{ACT, b_gate_up};
        pg8::gemm_phase<pg8::EpiAct, pg8::GroupedOrder, true, true, true>(ldsl + RING_OFF, g, S, E);
    }
#if (DUP_MASK >> 12) & 1
    if (IN(8)) {
        gu32* const ctl = (gu32*)(WSB + WS_CTL);
        int* const TOKOF = (int*)(WSB + WS_TOKOF); bf16* const H1B = (bf16*)(WSB + WS_H1B); bf16* const WGU_T = (bf16*)(WSB + WS_WGU); bf16* const ACT = (bf16*)(WSB + WS_ACT);
        const float* const b_gate_up = INP(16);
        GROUPED_PREP(8, true);
        pg8::Gemm g{H1B, WGU_T, T_TOK, 2048, DM}; pg8::GroupedOrder S{(const LAS int*)(ldsl + TBL_DESC), (const LAS int*)(ldsl + TBL_IDX)};
        pg8::EpiAct E{ACT, b_gate_up};
        pg8::gemm_phase<pg8::EpiAct, pg8::GroupedOrder, true, true, true>(ldsl + RING_OFF, g, S, E);
    }
#endif
    SEAM(8);
    if (IN(9)) DUP(9) {
        gu32* const ctl = (gu32*)(WSB + WS_CTL);
        bf16* const ACT = (bf16*)(WSB + WS_ACT); bf16* const WDN_T = (bf16*)(WSB + WS_WDN); bf16* const YS = (bf16*)(WSB + WS_YS);
        int* const TOKOF = nullptr;
        const float* const b_down = INP(18);
        GROUPED_PREP(4, false);
        pg8::Gemm g{ACT, WDN_T, SLOT_ROWS, 1024, DFF}; pg8::GroupedOrder S{(const LAS int*)(ldsl + TBL_DESC), (const LAS int*)(ldsl + TBL_IDX)};
        pg8::EpiDown E{YS, b_down};
        pg8::gemm_phase<pg8::EpiDown, pg8::GroupedOrder, true, true, false>(ldsl + RING_OFF, g, S, E);
    }
    SEAM(9);

    if (IN(10)) DUP(10) {
        gu32* const ctl = (gu32*)(WSB + WS_CTL);
        const bf16* const H1B = (const bf16*)(WSB + WS_H1B); int* const PAIR_E = (int*)(WSB + WS_PAIR); int* const PAIR_POS = PAIR_E + T_TOK * 4; float* const PAIR_G = (float*)(PAIR_POS + T_TOK * 4); bf16* const YS = (bf16*)(WSB + WS_YS);
        const float* const ln_ffn_g = INP(19); const float* const ln_ffn_b = INP(20);
        float* const out = (float*)ldptr(PT, 21);
        LAS int* CUM = (LAS int*)(ldsl + TBL_CUM);
        if (tid == 0) { int c = 0; for (int e = 0; e < NE; ++e) { const int n = (int)__hip_atomic_load(ctl + CW_CNT + 64 * e, __ATOMIC_RELAXED, __HIP_MEMORY_SCOPE_AGENT); CUM[e] = c; c += (n + 255) >> 8; } CUM[NE] = c; }
        __syncthreads();
        const int gw = vcu * NWAVES + wave, NGW = G * NWAVES;
        int pslot = 0; float pgate = 0.f;
        if (lane < 32) { const int q = (gw + (lane >> 2) * NGW) * 4 + (lane & 3); pslot = CUM[PAIR_E[q]] * 256 + PAIR_POS[q]; pgate = PAIR_G[q]; }
        for (int it = 0; it < 4; ++it) {
            f32x4 v[2][4], y[4]; unsigned long long yv[2][4][4]; float gk[2][4];
#pragma unroll
            for (int r = 0; r < 2; ++r) { const size_t mm = (size_t)(gw + (2 * it + r) * NGW); const GAS unsigned long long* hr = (const GAS unsigned long long*)(H1B + mm * DM) + lane;
#pragma unroll
                for (int j = 0; j < 4; ++j) { const unsigned long long w = hr[64 * j]; const unsigned wl = (unsigned)w, wh = (unsigned)(w >> 32); v[r][j] = (f32x4){pg8::bf_lo(wl), pg8::bf_hi(wl), pg8::bf_lo(wh), pg8::bf_hi(wh)}; }
#pragma unroll
                for (int k = 0; k < 4; ++k) { const int slot = __builtin_amdgcn_readfirstlane(__shfl(pslot, (2 * it + r) * 4 + k)); gk[r][k] = __shfl(pgate, (2 * it + r) * 4 + k);
                    const GAS unsigned long long* yr = (const GAS unsigned long long*)(YS + (size_t)slot * 1024) + lane;
#pragma unroll
                    for (int j = 0; j < 4; ++j) yv[r][k][j] = yr[64 * j]; } }
#pragma unroll
            for (int r = 0; r < 2; ++r) { const size_t mm = (size_t)(gw + (2 * it + r) * NGW);
#pragma unroll
                for (int j = 0; j < 4; ++j) v[r][j] = v[r][j] * DN_ALPHA;
#pragma unroll
                for (int k = 0; k < 4; ++k)
#pragma unroll
                    for (int j = 0; j < 4; ++j) { const unsigned long long w = yv[r][k][j]; const unsigned wl = (unsigned)w, wh = (unsigned)(w >> 32); const float g = gk[r][k];
                        v[r][j].x += g * pg8::bf_lo(wl); v[r][j].y += g * pg8::bf_hi(wl); v[r][j].z += g * pg8::bf_lo(wh); v[r][j].w += g * pg8::bf_hi(wh); }
                ln_row(v[r], y, ln_ffn_g, ln_ffn_b, lane);
                GAS f32x4* orow = (GAS f32x4*)(out + mm * DM) + lane;
#pragma unroll
                for (int j = 0; j < 4; ++j) orow[64 * j] = y[j]; } }
    }
    if (STAMP_K == 200) { t_stamp_a = t_stamp_0 + (att_tiles ? att_time * 64ull / att_tiles : 0ull); }
    if (STAMP_K == 201 && tid == 0 && gla_time) { const unsigned long long t_end = __builtin_amdgcn_s_memrealtime(); while (__builtin_amdgcn_s_memrealtime() - t_end < gla_time) __builtin_amdgcn_s_sleep(8); }
    if (STAMP_K == 201) { t_stamp_a = t_stamp_0; }
    if (STAMP_K == 203 && tid == 0 && att_tiles) { const unsigned long long t_end = __builtin_amdgcn_s_memrealtime(), dd = att_time * 64ull / att_tiles; while (__builtin_amdgcn_s_memrealtime() - t_end < dd) __builtin_amdgcn_s_sleep(8); }
    if (STAMP_K == 203) { t_stamp_a = t_stamp_0; }
    if (STAMP_K == 202) { t_stamp_a = t_stamp_0 + (unsigned long long)(__hip_atomic_load((gu32*)(WSB + WS_CTL) + 20000, __ATOMIC_RELAXED, __HIP_MEMORY_SCOPE_AGENT) / 256u); }
    if (STAMP_K >= 0 && bx == 0 && tid == 0) { const unsigned long long t_end = __builtin_amdgcn_s_memrealtime(), dt = t_stamp_a - t_stamp_0; while (__builtin_amdgcn_s_memrealtime() - t_end < dt) __builtin_amdgcn_s_sleep(8); }
#undef IN
#undef INP
#undef WSB
#undef SEAM
#undef GROUPED_PREP
}

#ifndef MK_SPLIT
#define MK_SPLIT 0
#endif
extern "C" void kernel_launch(void* const* d_in, const int* in_sizes, int n_in, void* d_out, int out_size, void* d_ws, size_t ws_size, hipStream_t stream) {
    static int grid = 0;
    if (grid == 0) {
        if (n_in != 21 || in_sizes[0] != T_TOK * DM || out_size != T_TOK * DM || ws_size < WS_END) {
            fprintf(stderr, "kernel_launch: built for 21 inputs, x/out of %d floats, >= %zu bytes of workspace; got n_in %d, in0 %d, out %d, ws %zu; nothing launched\n", T_TOK * DM, (size_t)WS_END, n_in, n_in > 0 ? in_sizes[0] : -1, out_size, ws_size); grid = -1; return; }
        int dev = 0, cus = 0, per_cu = 0;
        if (hipGetDevice(&dev) != hipSuccess || hipDeviceGetAttribute(&cus, hipDeviceAttributeMultiprocessorCount, dev) != hipSuccess) { fprintf(stderr, "kernel_launch: device query failed\n"); grid = -1; return; }
        if (hipFuncSetAttribute((const void*)mega_fwd, hipFuncAttributeMaxDynamicSharedMemorySize, LDS_BYTES) != hipSuccess) { fprintf(stderr, "kernel_launch: hipFuncSetAttribute failed\n"); grid = -1; return; }
        if (hipOccupancyMaxActiveBlocksPerMultiprocessor(&per_cu, (const void*)mega_fwd, NTHR, LDS_BYTES) != hipSuccess || per_cu < 1) fprintf(stderr, "kernel_launch: occupancy query reports %d blocks per CU\n", per_cu);
        (void)hipGetLastError();
        grid = cus;
        if (grid != 256) { fprintf(stderr, "kernel_launch: this kernel's work split needs exactly 256 CUs, device has %d; nothing launched\n", grid); grid = -1; return; }
    }
    if (grid < 0) return;
    if (hipMemsetAsync((char*)d_ws + WS_CTL, 0, CTL_ZERO_BYTES, stream) != hipSuccess) { fprintf(stderr, "kernel_launch: hipMemsetAsync failed\n"); return; }
    Args a{};
    for (int i = 0; i < 21; ++i) a.in[i] = (const float*)d_in[i];
    a.out = (float*)d_out; a.ws = (unsigned char*)d_ws;
#if MK_SPLIT
    for (int p = 0; p < NPH; ++p) { a.ph_lo = p; a.ph_hi = p + 1; a.li = p; hipLaunchKernelGGL(mega_fwd, dim3(grid), dim3(NTHR), LDS_BYTES, stream, a); }
#else
    a.ph_lo = 0; a.ph_hi = NPH; a.li = 0;
    hipLaunchKernelGGL(mega_fwd, dim3(grid), dim3(NTHR), LDS_BYTES, stream, a);
#endif
    const hipError_t le = hipPeekAtLastError();
    if (le != hipSuccess) fprintf(stderr, "kernel_launch: launch failed: %s\n", hipGetErrorName(le));
}
```
